# Optimizing an MI355X kernel written in HIP

```python
import jax, jax.numpy as jnp
from jax import lax
import numpy as np

D_MODEL = 2048
BATCH = 4
SEQ = 4096
DEPTH = 1

D_SSM = D_MODEL
SSM_HEADDIM = 64
SSM_HEADS = D_SSM // SSM_HEADDIM
SSM_GROUPS = 8
SSM_STATE = 128
SSM_CONV = 4
CHUNK = 128
DT_MIN = 1e-3
DT_MAX = 1e-1
D_CONV = D_MODEL
SHORT_CONV = 3
D_MIX = D_SSM + D_CONV
D_FF = -(-(8 * D_MODEL) // (3 * 256)) * 256
EPS = 1e-5

D_XBC = D_SSM + 2 * SSM_GROUPS * SSM_STATE
OFF_Z = 0
OFF_XBC = OFF_Z + D_SSM
OFF_DT = OFF_XBC + D_XBC
OFF_CB = OFF_DT + SSM_HEADS
OFF_CC = OFF_CB + D_CONV
OFF_CX = OFF_CC + D_CONV
D_IN = OFF_CX + D_CONV

kernel_name = "hymba_ssd_shortconv_block"


def _rmsnorm(x, g):
    xf = x.astype(jnp.float32)
    y = xf * lax.rsqrt(jnp.mean(xf * xf, axis=-1, keepdims=True) + EPS)
    return (y * g.astype(jnp.float32)).astype(x.dtype)


def _causal_dwconv(u, w):
    K = w.shape[0]
    S = u.shape[1]
    up = jnp.pad(u, ((0, 0), (K - 1, 0), (0, 0)))
    y = up[:, K - 1:K - 1 + S] * w[K - 1]
    for k in range(K - 1):
        y = y + up[:, k:k + S] * w[k]
    return y


def _ssd_chunked(xh, dt, A, Bm, Cm):
    b, S, H, P = xh.shape
    G, N = Bm.shape[2], Bm.shape[3]
    R = H // G
    nc = S // CHUNK
    f32 = jnp.float32
    X = (xh.astype(f32) * dt[..., None]).reshape(b, nc, CHUNK, G, R, P)
    dA = jnp.moveaxis((dt * A).reshape(b, nc, CHUNK, G, R), 2, -1)
    Bc = Bm.astype(f32).reshape(b, nc, CHUNK, G, N)
    Cc = Cm.astype(f32).reshape(b, nc, CHUNK, G, N)
    dA_cs = jnp.cumsum(dA, axis=-1)
    causal = jnp.tril(jnp.ones((CHUNK, CHUNK), dtype=bool))
    seg = dA_cs[..., :, None] - dA_cs[..., None, :]
    L = jnp.exp(jnp.where(causal, seg, -jnp.inf))
    CB = jnp.einsum('bclgn,bcsgn->bcgls', Cc, Bc)
    M = CB[:, :, :, None] * L
    y_diag = jnp.einsum('bcgrls,bcsgrp->bclgrp', M, X)
    decay_states = jnp.exp(dA_cs[..., -1:] - dA_cs)
    states = jnp.einsum('bclgn,bcgrl,bclgrp->bcgrpn', Bc, decay_states, X)
    chunk_decay = jnp.exp(dA_cs[..., -1])

    def step(h, inp):
        dec, st = inp
        return h * dec[..., None, None] + st, h

    h0 = jnp.zeros((b, G, R, P, N), f32)
    _, prev = lax.scan(step, h0, (jnp.moveaxis(chunk_decay, 1, 0), jnp.moveaxis(states, 1, 0)))
    prev = jnp.moveaxis(prev, 0, 1)
    y_off = jnp.einsum('bclgn,bcgrpn,bcgrl->bclgrp', Cc, prev, jnp.exp(dA_cs))
    return (y_diag + y_off).reshape(b, S, H, P)


def _ssd_group(z, xbc, dt_raw, conv_w, conv_b, dt_bias, A_log, Dskip, norm_g):
    b, S, _ = z.shape
    xbc = jax.nn.silu(_causal_dwconv(xbc, conv_w) + conv_b)
    xs = xbc[..., :D_SSM].reshape(b, S, SSM_HEADS, SSM_HEADDIM)
    Bm = xbc[..., D_SSM:D_SSM + SSM_GROUPS * SSM_STATE].reshape(b, S, SSM_GROUPS, SSM_STATE)
    Cm = xbc[..., D_SSM + SSM_GROUPS * SSM_STATE:].reshape(b, S, SSM_GROUPS, SSM_STATE)
    dt = jax.nn.softplus(dt_raw.astype(jnp.float32) + dt_bias.astype(jnp.float32))
    A = -jnp.exp(A_log.astype(jnp.float32))
    y = _ssd_chunked(xs, dt, A, Bm, Cm)
    y = y + Dskip.astype(jnp.float32)[:, None] * xs.astype(jnp.float32)
    y = y.reshape(b, S, D_SSM).astype(z.dtype)
    return _rmsnorm(y * jax.nn.silu(z), norm_g)


def _shortconv_group(gb, gc, u, conv_w):
    return gb * _causal_dwconv(gc * u, conv_w)


def setup_inputs(seed: int = 0) -> dict:
    key = jax.random.key(seed)
    ks = jax.random.split(key, 16)
    f32 = jnp.float32
    nrm = lambda k, shape, s: jax.random.normal(k, shape, f32) * s
    x = jax.random.normal(ks[0], (BATCH, SEQ, D_MODEL), f32)
    norm_mix_g = 1.0 + nrm(ks[1], (DEPTH, D_MODEL), 0.02)
    w_in = nrm(ks[2], (DEPTH, D_MODEL, D_IN), D_MODEL ** -0.5)
    ssm_conv_w = nrm(ks[3], (DEPTH, SSM_CONV, D_XBC), SSM_CONV ** -0.5)
    ssm_conv_b = nrm(ks[4], (DEPTH, D_XBC), 0.02)
    dt0 = jnp.exp(jax.random.uniform(ks[5], (DEPTH, SSM_HEADS), f32)
                  * (np.log(DT_MAX) - np.log(DT_MIN)) + np.log(DT_MIN))
    ssm_dt_bias = dt0 + jnp.log(-jnp.expm1(-dt0))
    ssm_A_log = jnp.log(jax.random.uniform(ks[6], (DEPTH, SSM_HEADS), f32, 1.0, 16.0))
    ssm_D = 1.0 + nrm(ks[7], (DEPTH, SSM_HEADS), 0.1)
    ssm_norm_g = 1.0 + nrm(ks[8], (DEPTH, D_SSM), 0.02)
    sc_conv_w = nrm(ks[9], (DEPTH, SHORT_CONV, D_CONV), SHORT_CONV ** -0.5)
    w_out = nrm(ks[10], (DEPTH, D_MIX, D_MODEL), D_MIX ** -0.5)
    norm_ffn_g = 1.0 + nrm(ks[11], (DEPTH, D_MODEL), 0.02)
    w_gate = nrm(ks[12], (DEPTH, D_MODEL, D_FF), D_MODEL ** -0.5)
    w_up = nrm(ks[13], (DEPTH, D_MODEL, D_FF), D_MODEL ** -0.5)
    w_down = nrm(ks[14], (DEPTH, D_FF, D_MODEL), D_FF ** -0.5)
    norm_final_g = 1.0 + nrm(ks[15], (D_MODEL,), 0.02)
    return {"x": x, "norm_mix_g": norm_mix_g, "w_in": w_in, "ssm_conv_w": ssm_conv_w,
            "ssm_conv_b": ssm_conv_b, "ssm_dt_bias": ssm_dt_bias, "ssm_A_log": ssm_A_log,
            "ssm_D": ssm_D, "ssm_norm_g": ssm_norm_g, "sc_conv_w": sc_conv_w, "w_out": w_out,
            "norm_ffn_g": norm_ffn_g, "w_gate": w_gate, "w_up": w_up, "w_down": w_down,
            "norm_final_g": norm_final_g}


def reference(x, norm_mix_g, w_in, ssm_conv_w, ssm_conv_b, ssm_dt_bias, ssm_A_log, ssm_D,
              ssm_norm_g, sc_conv_w, w_out, norm_ffn_g, w_gate, w_up, w_down, norm_final_g):
    h = x
    for l in range(DEPTH):
        n = _rmsnorm(h, norm_mix_g[l])
        proj = jnp.einsum('bsd,de->bse', n, w_in[l])
        y_ssm = _ssd_group(proj[..., OFF_Z:OFF_XBC], proj[..., OFF_XBC:OFF_DT],
                           proj[..., OFF_DT:OFF_CB], ssm_conv_w[l], ssm_conv_b[l],
                           ssm_dt_bias[l], ssm_A_log[l], ssm_D[l], ssm_norm_g[l])
        y_sc = _shortconv_group(proj[..., OFF_CB:OFF_CC], proj[..., OFF_CC:OFF_CX],
                                proj[..., OFF_CX:D_IN], sc_conv_w[l])
        y_mix = jnp.concatenate([y_ssm, y_sc], axis=-1)
        h = h + jnp.einsum('bse,ed->bsd', y_mix, w_out[l])
        n2 = _rmsnorm(h, norm_ffn_g[l])
        g = jnp.einsum('bsd,df->bsf', n2, w_gate[l])
        u = jnp.einsum('bsd,df->bsf', n2, w_up[l])
        h = h + jnp.einsum('bsf,fd->bsd', jax.nn.silu(g) * u, w_down[l])
    return _rmsnorm(h, norm_final_g)
```

```cpp
#include <hip/hip_runtime.h>
#include <hip/hip_cooperative_groups.h>
#include <cstdio>
namespace cg = cooperative_groups;

#define LAS __attribute__((address_space(3)))
typedef unsigned short bf16_t;
typedef short bf16x8 __attribute__((ext_vector_type(8)));
typedef float f32x4 __attribute__((ext_vector_type(4)));
typedef unsigned u32x4 __attribute__((ext_vector_type(4)));
typedef unsigned u32x2 __attribute__((ext_vector_type(2)));

constexpr int M_ = 16384, D_ = 2048, DIN = 12320, NPROJ = 12288, DFF = 5632, DMIX = 4096, NGU = 11264;
constexpr int SEQ = 4096;
constexpr float EPS = 1e-5f;
constexpr int LDS_BYTES = 159744;
#ifndef PROBE_PHASE
#define PROBE_PHASE -1
#endif
#define NREP(k) ((PROBE_PHASE == (k)) ? 1 + (p.ph_hi < 100) : 1)
constexpr int TAB_OFF = 131072;

constexpr size_t WS_PROJ = 0;
constexpr size_t WS_R = (size_t)M_ * NPROJ * 2;
constexpr size_t WS_XN = WS_R;
constexpr size_t WS_BTIN = WS_R + (size_t)M_ * D_ * 2;
constexpr size_t WS_YMIX = WS_R;
constexpr size_t WS_H1F = 0;
constexpr size_t WS_H1B = (size_t)M_ * D_ * 4;
constexpr size_t WS_HFF = WS_H1B + (size_t)M_ * D_ * 2;
constexpr size_t WS_SSQ3 = WS_HFF + (size_t)M_ * DFF * 2;
constexpr size_t WS_NEED = WS_R + (size_t)M_ * DMIX * 2;
constexpr size_t DO_BTOUT = 0;
constexpr size_t DO_BTGU = (size_t)D_ * DMIX * 2;
constexpr size_t DO_BTDN = DO_BTGU + (size_t)NGU * D_ * 2;
constexpr size_t DO_DT = DO_BTDN + (size_t)D_ * DFF * 2;
constexpr size_t DO_SSQ1 = DO_DT + (size_t)M_ * 32 * 4;
constexpr size_t DO_SSQ2 = DO_SSQ1 + (size_t)M_ * 32 * 4;
static_assert(DO_SSQ2 + (size_t)M_ * 32 * 4 <= (size_t)M_ * D_ * 4, "d_out scratch");
static_assert(WS_SSQ3 + (size_t)M_ * 32 * 4 <= WS_R, "ws overlay");

struct Params {
    const float* x; const float* norm_mix_g; const float* w_in; const float* ssm_conv_w; const float* ssm_conv_b;
    const float* ssm_dt_bias; const float* ssm_A_log; const float* ssm_D; const float* ssm_norm_g; const float* sc_conv_w;
    const float* w_out; const float* norm_ffn_g; const float* w_gate; const float* w_up; const float* w_down; const float* norm_final_g;
    float* out; unsigned char* ws; int ph_lo, ph_hi;
};

typedef float f32x2_t __attribute__((ext_vector_type(2)));
typedef __bf16 bf16x2_t __attribute__((ext_vector_type(2)));
__device__ __forceinline__ unsigned cvt_pk_bf16(float lo, float hi) { const f32x2_t v = {lo, hi}; return __builtin_bit_cast(unsigned, __builtin_convertvector(v, bf16x2_t)); }
__device__ __forceinline__ float bflo(unsigned u) { return __uint_as_float(u << 16); }
__device__ __forceinline__ float bfhi(unsigned u) { return __uint_as_float(u & 0xffff0000u); }
__device__ __forceinline__ int lane_id() { int l; asm volatile("v_mbcnt_lo_u32_b32 %0, -1, 0\n\tv_mbcnt_hi_u32_b32 %0, -1, %0" : "=v"(l)); return l; }
__device__ __forceinline__ float silu_f(float v) { return v * __builtin_amdgcn_rcpf(1.0f + __expf(-v)); }

__device__ __forceinline__ size_t ssq_idx(int row, int part) { return ((size_t)(row >> 5) * 32 + part) * 32 + (row & 31); }

namespace pg8 {
constexpr int BM = 256, BK = 64, HALF = 128, HTB = HALF * BK * 2, STAGE_BYTES = 8 * HTB, NXCD = 8, WGM = 8;
__device__ __forceinline__ int lds_byte(int r, int c) { const int st = (r >> 4) * 2 + (c >> 5), rr = r & 15, cc = c & 31, ob = rr * 64 + cc * 2; return st * 1024 + (ob ^ (((ob >> 9) & 1) << 5)); }
__device__ __forceinline__ void stage_rc(int b, int& R, int& C) { const int st = b / 1024, sb = b % 1024, swz = sb ^ (((sb >> 9) & 1) << 5); R = (st >> 1) * 16 + swz / 64; C = (st & 1) * 32 + (swz % 64) / 2; }
__device__ __forceinline__ int perm32(int rho) { const int n = rho >> 4, i = rho & 15; return 8 * (i >> 2) + 4 * n + (i & 3); }
struct Unit { int pm, pn; };
struct Gemm { const bf16_t* A; const bf16_t* Bt; int M, N, K; };
struct StaticOrder {
    int nM, nN, nwg, G, c;
    __device__ void init(int M, int N, int G_, int c_) { nM = M / BM; nN = N / BM; nwg = nM * nN; G = G_; c = c_; }
    __device__ bool next(int i, Unit& u) const {
        const long L = (long)i * G + c; if (L >= nwg) return false;
        int wgid = (int)L; { const int q = nwg / NXCD, r = nwg % NXCD, xcd = wgid % NXCD, off = wgid / NXCD; wgid = (xcd < r ? xcd * (q + 1) : r * (q + 1) + (xcd - r) * q) + off; }
        const int nig = WGM * nN, gid = wgid / nig, fm = gid * WGM, gsz = (nM - fm) < WGM ? (nM - fm) : WGM;
        u.pm = fm + ((wgid % nig) % gsz); u.pn = (wgid % nig) / gsz; return true;
    }
};
template <class Epi>
__device__ __forceinline__ void gemm_phase(LAS unsigned char* lds, const Gemm g, const StaticOrder& S, const Epi& E, int wv) {
    const int wid = wv, lane = lane_id(), tid = wid * 64 + lane, wr = wid >> 2, wc = wid & 3, fr = lane & 15, fq = lane >> 4;
    const int K = g.K, nt = K / BK;
    unsigned voffA[2], voffB[2];
#pragma unroll
    for (int i = 0; i < 2; ++i) { int R, C; stage_rc(tid * 16 + i * 8192, R, C); const int Rb = (R & ~31) + perm32(R & 31);
        voffA[i] = (unsigned)(R * K + C) * 2u; voffB[i] = (unsigned)(Rb * K + C) * 2u; }
    const size_t kstep = (size_t)(BK * 2);
    const size_t hstep = (size_t)HALF * K * 2;
    const size_t tstep = 2 * hstep;
    const unsigned ldsw = (unsigned)wid * 1024u;
    const int aoff = lds_byte(wr * 64 + fr, fq * 8), boff = lds_byte(wc * 32 + fr, fq * 8);
#define PG8_SA(b, h) (((b) * 2 + (h)) * HTB)
#define PG8_SB(b, h) ((4 + (b) * 2 + (h)) * HTB)
#define PG8_STAGE(bufoff, gbase, voff) do { _Pragma("unroll") for (int _i = 0; _i < 2; ++_i) \
        __builtin_amdgcn_global_load_lds((const unsigned*)((const char*)(gbase) + (voff)[_i]), (LAS unsigned*)(lds + (bufoff) + ldsw + _i * 8192), 16, 0, 0); } while (0)
#define PG8_LDA(dst, b, h) do { _Pragma("unroll") for (int m = 0; m < 4; ++m) _Pragma("unroll") for (int k = 0; k < 2; ++k) dst[m][k] = *(const LAS bf16x8*)(lds + PG8_SA(b, h) + aoff + m * 2048 + k * 1024); } while (0)
#define PG8_LDB(dst, b, h) do { _Pragma("unroll") for (int n = 0; n < 2; ++n) _Pragma("unroll") for (int k = 0; k < 2; ++k) dst[n][k] = *(const LAS bf16x8*)(lds + PG8_SB(b, h) + boff + n * 2048 + k * 1024); } while (0)
#define PG8_MMA(ai, bj, At, Bt) do { __builtin_amdgcn_s_setprio(1); _Pragma("unroll") for (int m = 0; m < 4; ++m) _Pragma("unroll") for (int n = 0; n < 2; ++n) _Pragma("unroll") for (int k = 0; k < 2; ++k) \
        acc[ai][bj][m][n] = __builtin_amdgcn_mfma_f32_16x16x32_bf16(Bt[n][k], At[m][k], acc[ai][bj][m][n], 0, 0, 0); __builtin_amdgcn_s_setprio(0); } while (0)
#define PG8_WAIT_V(n) asm volatile("s_waitcnt vmcnt(" #n ")" ::: "memory")
#define PG8_WAIT_L(n) asm volatile("s_waitcnt lgkmcnt(" #n ")" ::: "memory")
#define PG8_BAR __builtin_amdgcn_s_barrier()
#define PG8_SCHED __builtin_amdgcn_sched_barrier(0)
    Unit cur, nxt; int ui = 0;
    if (!S.next(0, cur)) return;
    f32x4 acc[2][2][4][2];
#pragma unroll
    for (int a = 0; a < 2; ++a)
#pragma unroll
        for (int b = 0; b < 2; ++b)
#pragma unroll
            for (int m = 0; m < 4; ++m)
#pragma unroll
                for (int n = 0; n < 2; ++n) acc[a][b][m][n] = (f32x4){0.f, 0.f, 0.f, 0.f};
    bf16x8 At[4][2], B0[2][2], B1[2][2];
    const char* cA = (const char*)g.A + (size_t)cur.pm * tstep; const char* cB = (const char*)g.Bt + (size_t)cur.pn * tstep;
    if constexpr (Epi::HAS_TAB) {
        Unit uu; for (int i = 0; i < 28 && S.next(i, uu); ++i) E.prep(uu, (LAS float*)(lds + TAB_OFF + i * 1024), tid);
    }
    PG8_STAGE(PG8_SB(0, 0), cB, voffB); PG8_STAGE(PG8_SB(0, 1), cB + hstep, voffB); PG8_STAGE(PG8_SA(0, 0), cA, voffA); PG8_STAGE(PG8_SA(0, 1), cA + hstep, voffA);
    if (wr == 1) PG8_BAR;
    PG8_WAIT_V(2); PG8_BAR;
    PG8_STAGE(PG8_SB(1, 0), cB + kstep, voffB); PG8_STAGE(PG8_SA(1, 0), cA + kstep, voffA); PG8_STAGE(PG8_SB(1, 1), cB + hstep + kstep, voffB);
    PG8_WAIT_V(6); PG8_BAR;
    for (;;) {
        const bool has_next = S.next(ui + 1, nxt);
        const char* nA = has_next ? (const char*)g.A + (size_t)nxt.pm * tstep : cA; const char* nB = has_next ? (const char*)g.Bt + (size_t)nxt.pn * tstep : cB;
        LAS const float* tabc = (LAS const float*)(lds + TAB_OFF + ui * 1024);
        for (int t = 0; t < nt; t += 2) {
            const bool last = (t == nt - 2);
            const char* a1 = cA + (size_t)(t + 1) * kstep;
            const char* a2 = last ? nA : cA + (size_t)(t + 2) * kstep; const char* b2 = last ? nB : cB + (size_t)(t + 2) * kstep;
            const char* a3 = a2 + kstep; const char* b3 = b2 + kstep;
            if constexpr (Epi::MID_T >= 0) { if (t == Epi::MID_T) {
#pragma unroll
                for (int ai = 0; ai < 2; ++ai)
#pragma unroll
                    for (int m = 0; m < 4; ++m) { const float s = tabc[ai * HALF + wr * 64 + m * 16 + fr];
#pragma unroll
                        for (int bj = 0; bj < 2; ++bj)
#pragma unroll
                            for (int n = 0; n < 2; ++n) acc[ai][bj][m][n] *= s; } } }
            PG8_LDB(B0, 0, 0); PG8_LDB(B1, 0, 1); PG8_SCHED; PG8_LDA(At, 0, 0); PG8_STAGE(PG8_SA(1, 1), a1 + hstep, voffA);
            PG8_WAIT_V(8); PG8_WAIT_L(0); PG8_BAR; PG8_MMA(0, 0, At, B0); PG8_MMA(0, 1, At, B1); PG8_BAR; PG8_SCHED;
            PG8_LDA(At, 0, 1); PG8_STAGE(PG8_SB(0, 0), b2, voffB); PG8_STAGE(PG8_SB(0, 1), b2 + hstep, voffB); PG8_STAGE(PG8_SA(0, 0), a2, voffA);
            PG8_WAIT_V(8); PG8_WAIT_L(0); PG8_BAR; PG8_MMA(1, 0, At, B0); PG8_MMA(1, 1, At, B1); PG8_BAR; PG8_SCHED;
            PG8_LDB(B0, 1, 0); PG8_LDB(B1, 1, 1); PG8_SCHED; PG8_LDA(At, 1, 0); PG8_STAGE(PG8_SA(0, 1), a2 + hstep, voffA);
            PG8_WAIT_V(8); PG8_WAIT_L(0); PG8_BAR; PG8_MMA(0, 0, At, B0); PG8_MMA(0, 1, At, B1); PG8_BAR; PG8_SCHED;
            PG8_LDA(At, 1, 1); PG8_STAGE(PG8_SB(1, 0), b3, voffB); PG8_STAGE(PG8_SB(1, 1), b3 + hstep, voffB); PG8_STAGE(PG8_SA(1, 0), a3, voffA);
            PG8_WAIT_V(8); PG8_WAIT_L(0); PG8_BAR; PG8_MMA(1, 0, At, B0); PG8_MMA(1, 1, At, B1); PG8_BAR; PG8_SCHED;
        }
        if (wr == 0) PG8_BAR;
        E(acc, cur, tabc, wr, wc, fr, fq);
        if (!has_next) break;
#pragma unroll
        for (int a = 0; a < 2; ++a)
#pragma unroll
            for (int b = 0; b < 2; ++b)
#pragma unroll
                for (int m = 0; m < 4; ++m)
#pragma unroll
                    for (int n = 0; n < 2; ++n) acc[a][b][m][n] = (f32x4){0.f, 0.f, 0.f, 0.f};
        cur = nxt; cA = nA; cB = nB; ++ui;
        if (wr == 1) PG8_BAR;
    }
    PG8_WAIT_V(0);
    PG8_BAR;
#undef PG8_SA
#undef PG8_SB
#undef PG8_STAGE
#undef PG8_LDA
#undef PG8_LDB
#undef PG8_MMA
#undef PG8_WAIT_V
#undef PG8_WAIT_L
#undef PG8_BAR
#undef PG8_SCHED
}
}

__device__ __forceinline__ void rstd_table(const float* ssq, int row0, LAS float* tab, int t) {
    const int r = t >> 1, hf = t & 1;
    const float* p = ssq + ssq_idx(row0 + r, hf * 16);
    float s = 0.f;
#pragma unroll
    for (int i = 0; i < 16; ++i) s += p[i * 32];
    s += __shfl_xor(s, 1);
    if (!hf) tab[r] = rsqrtf(s * (1.0f / 2048.0f) + EPS);
}

struct EpiProj {
    static constexpr bool HAS_TAB = false; static constexpr int MID_T = -1;
    bf16_t* O;
    __device__ __forceinline__ void prep(const pg8::Unit&, LAS float*, int) const {}
    __device__ __forceinline__ void operator()(const f32x4 (&acc)[2][2][4][2], const pg8::Unit& u, LAS const float*, int wr, int wc, int fr, int fq) const {
        const int row0 = u.pm * 256 + wr * 64 + fr, col0 = u.pn * 256 + wc * 32 + 8 * fq;
#pragma unroll
        for (int ai = 0; ai < 2; ++ai)
#pragma unroll
            for (int m = 0; m < 4; ++m) { bf16_t* rowp = O + (size_t)(row0 + ai * 128 + m * 16) * NPROJ + col0;
#pragma unroll
                for (int bj = 0; bj < 2; ++bj) { const f32x4 v0 = acc[ai][bj][m][0], v1 = acc[ai][bj][m][1];
                    u32x4 w; w.x = cvt_pk_bf16(v0[0], v0[1]); w.y = cvt_pk_bf16(v0[2], v0[3]); w.z = cvt_pk_bf16(v1[0], v1[1]); w.w = cvt_pk_bf16(v1[2], v1[3]);
                    *(u32x4*)(rowp + bj * 128) = w; } }
    }
};
struct EpiOut {
    static constexpr bool HAS_TAB = true; static constexpr int MID_T = 32;
    const float* x; float* h1f; bf16_t* h1b; const float* ssq1; float* ssq2;
    __device__ __forceinline__ void prep(const pg8::Unit& u, LAS float* tab, int t) const { rstd_table(ssq1, u.pm * 256, tab, t); }
    __device__ __forceinline__ void operator()(const f32x4 (&acc)[2][2][4][2], const pg8::Unit& u, LAS const float*, int wr, int wc, int fr, int fq) const {
        const int row0 = u.pm * 256 + wr * 64 + fr, col0 = u.pn * 256 + wc * 32 + 8 * fq;
#pragma unroll
        for (int ai = 0; ai < 2; ++ai)
#pragma unroll
            for (int m = 0; m < 4; ++m) { const int row = row0 + ai * 128 + m * 16; const size_t off = (size_t)row * D_ + col0; float ss = 0.f;
#pragma unroll
                for (int bj = 0; bj < 2; ++bj) {
                    const f32x4 x0 = *(const f32x4*)(x + off + bj * 128), x1 = *(const f32x4*)(x + off + bj * 128 + 4);
                    const f32x4 v0 = acc[ai][bj][m][0] + x0, v1 = acc[ai][bj][m][1] + x1;
                    *(f32x4*)(h1f + off + bj * 128) = v0; *(f32x4*)(h1f + off + bj * 128 + 4) = v1;
                    u32x4 w; w.x = cvt_pk_bf16(v0[0], v0[1]); w.y = cvt_pk_bf16(v0[2], v0[3]); w.z = cvt_pk_bf16(v1[0], v1[1]); w.w = cvt_pk_bf16(v1[2], v1[3]);
                    *(u32x4*)(h1b + off + bj * 128) = w;
                    ss += (v0[0] * v0[0] + v0[1] * v0[1]) + (v0[2] * v0[2] + v0[3] * v0[3]) + (v1[0] * v1[0] + v1[1] * v1[1]) + (v1[2] * v1[2] + v1[3] * v1[3]); }
                ss += __shfl_xor(ss, 16); ss += __shfl_xor(ss, 32);
                if (fq == 0) ssq2[ssq_idx(row, u.pn * 4 + wc)] = ss; }
    }
};
struct EpiGU {
    static constexpr bool HAS_TAB = true; static constexpr int MID_T = -1;
    const float* ssq2; bf16_t* hff;
    __device__ __forceinline__ void prep(const pg8::Unit& u, LAS float* tab, int t) const { rstd_table(ssq2, u.pm * 256, tab, t); }
    __device__ __forceinline__ void operator()(const f32x4 (&acc)[2][2][4][2], const pg8::Unit& u, LAS const float* tab, int wr, int wc, int fr, int fq) const {
        const int row0 = u.pm * 256 + wr * 64 + fr, col0 = u.pn * 128 + wc * 32 + 8 * fq;
#pragma unroll
        for (int ai = 0; ai < 2; ++ai)
#pragma unroll
            for (int m = 0; m < 4; ++m) { const float rs = tab[ai * 128 + wr * 64 + m * 16 + fr];
                float o[8];
#pragma unroll
                for (int n = 0; n < 2; ++n)
#pragma unroll
                    for (int j = 0; j < 4; ++j) { const float gg = acc[ai][0][m][n][j] * rs, uu = acc[ai][1][m][n][j] * rs; o[n * 4 + j] = silu_f(gg) * uu; }
                u32x4 w; w.x = cvt_pk_bf16(o[0], o[1]); w.y = cvt_pk_bf16(o[2], o[3]); w.z = cvt_pk_bf16(o[4], o[5]); w.w = cvt_pk_bf16(o[6], o[7]);
                *(u32x4*)(hff + (size_t)(row0 + ai * 128 + m * 16) * DFF + col0) = w; }
    }
};
struct EpiDown {
    static constexpr bool HAS_TAB = false; static constexpr int MID_T = -1;
    float* h; float* ssq3;
    __device__ __forceinline__ void prep(const pg8::Unit&, LAS float*, int) const {}
    __device__ __forceinline__ void operator()(const f32x4 (&acc)[2][2][4][2], const pg8::Unit& u, LAS const float*, int wr, int wc, int fr, int fq) const {
        const int row0 = u.pm * 256 + wr * 64 + fr, col0 = u.pn * 256 + wc * 32 + 8 * fq;
#pragma unroll
        for (int ai = 0; ai < 2; ++ai)
#pragma unroll
            for (int m = 0; m < 4; ++m) { const int row = row0 + ai * 128 + m * 16; const size_t off = (size_t)row * D_ + col0; float ss = 0.f;
#pragma unroll
                for (int bj = 0; bj < 2; ++bj) {
                    const f32x4 x0 = *(const f32x4*)(h + off + bj * 128), x1 = *(const f32x4*)(h + off + bj * 128 + 4);
                    const f32x4 v0 = acc[ai][bj][m][0] + x0, v1 = acc[ai][bj][m][1] + x1;
                    *(f32x4*)(h + off + bj * 128) = v0; *(f32x4*)(h + off + bj * 128 + 4) = v1;
                    ss += (v0[0] * v0[0] + v0[1] * v0[1]) + (v0[2] * v0[2] + v0[3] * v0[3]) + (v1[0] * v1[0] + v1[1] * v1[1]) + (v1[2] * v1[2] + v1[3] * v1[3]); }
                ss += __shfl_xor(ss, 16); ss += __shfl_xor(ss, 32);
                if (fq == 0) ssq3[ssq_idx(row, u.pn * 4 + wc)] = ss; }
    }
};

__device__ __forceinline__ void p0_tile(LAS float* t, const float* src, int ldsrc, int k0, int c0, int jvalid, bf16_t* dst, int K, int j0, const float* scale, int scale_kmax, int tid) {
    const int jc4 = (tid & 15) * 4, kr0 = tid >> 4;
#pragma unroll
    for (int i = 0; i < 4; ++i) {
        const int kr = kr0 + 32 * i;
        f32x4 v = (f32x4){0.f, 0.f, 0.f, 0.f};
        if (jc4 < jvalid) v = *(const f32x4*)(src + (size_t)(k0 + kr) * ldsrc + c0 + jc4);
        const float s = (scale != nullptr && (k0 + kr) < scale_kmax) ? scale[k0 + kr] : 1.0f;
        t[kr * 65 + jc4 + 0] = v[0] * s; t[kr * 65 + jc4 + 1] = v[1] * s; t[kr * 65 + jc4 + 2] = v[2] * s; t[kr * 65 + jc4 + 3] = v[3] * s;
    }
    __syncthreads();
    const int kp = (tid & 63) * 2, jr0 = tid >> 6;
#pragma unroll
    for (int i = 0; i < 8; ++i) {
        const int j = jr0 + 8 * i;
        if (j < jvalid) { const float a = t[kp * 65 + j], b = t[(kp + 1) * 65 + j];
            *(unsigned*)(dst + (size_t)(j0 + j) * K + k0 + kp) = cvt_pk_bf16(a, b); }
    }
    __syncthreads();
}
__device__ void phase0(const Params& p, LAS unsigned char* lds, int wv) {
    const int lane = lane_id(), wave = wv, tid = wv * 64 + lane, G = gridDim.x;
    LAS float* t = (LAS float*)lds;
    bf16_t* bt_in = (bf16_t*)(p.ws + WS_BTIN);
    bf16_t* xn = (bf16_t*)(p.ws + WS_XN);
    for (int row = blockIdx.x * 8 + wave; row < M_; row += G * 8) {
        const f32x4* xr = (const f32x4*)(p.x + (size_t)row * D_);
        f32x4 v[8]; float ss = 0.f;
#pragma unroll
        for (int i = 0; i < 8; ++i) { v[i] = xr[lane + 64 * i]; ss += (v[i][0] * v[i][0] + v[i][1] * v[i][1]) + (v[i][2] * v[i][2] + v[i][3] * v[i][3]); }
#pragma unroll
        for (int o = 32; o >= 1; o >>= 1) ss += __shfl_xor(ss, o);
        const float rstd = rsqrtf(ss * (1.0f / 2048.0f) + EPS);
#pragma unroll
        for (int i = 0; i < 8; ++i) { const f32x4 g4 = ((const f32x4*)p.norm_mix_g)[lane + 64 * i];
            u32x2 w; w.x = cvt_pk_bf16(v[i][0] * rstd * g4[0], v[i][1] * rstd * g4[1]); w.y = cvt_pk_bf16(v[i][2] * rstd * g4[2], v[i][3] * rstd * g4[3]);
            *(u32x2*)(xn + (size_t)row * D_ + 4 * (lane + 64 * i)) = w; }
    }
    constexpr int U_IN = 16 * 193;
    for (int u = blockIdx.x; u < U_IN; u += G) {
        const int kt = u & 15, jt = u >> 4, j0 = jt * 64; const int jvalid = (jt == 192) ? 32 : 64;
        const int c0 = j0 < 6144 ? j0 : (j0 < 12288 ? j0 + 32 : 6144);
        p0_tile(t, p.w_in, DIN, kt * 128, c0, jvalid, bt_in, D_, j0, nullptr, 0, tid);
    }
}
__device__ void wconv_units(const Params& p, LAS unsigned char* lds, int first, int stride, int wv) {
    const int tid = wv * 64 + lane_id();
    LAS float* t = (LAS float*)lds;
    bf16_t* bt_out = (bf16_t*)((unsigned char*)p.out + DO_BTOUT);
    bf16_t* bt_gu = (bf16_t*)((unsigned char*)p.out + DO_BTGU);
    bf16_t* bt_dn = (bf16_t*)((unsigned char*)p.out + DO_BTDN);
    constexpr int U_OUT = 32 * 32, U_GU = 16 * 176, U_DN = 44 * 32;
    for (int u = first; u < U_OUT + U_GU + U_DN; u += stride) {
        if (u < U_OUT) { const int v = u, kt = v & 31, jt = v >> 5;
            p0_tile(t, p.w_out, D_, kt * 128, jt * 64, 64, bt_out, DMIX, jt * 64, p.ssm_norm_g, 2048, tid); }
        else if (u < U_OUT + U_GU) { const int v = u - U_OUT, kt = v & 15, jt = v >> 4, j0 = jt * 64, pn = j0 >> 8, r0 = j0 & 255;
            p0_tile(t, r0 < 128 ? p.w_gate : p.w_up, DFF, kt * 128, 128 * pn + (r0 & 127), 64, bt_gu, D_, j0, p.norm_ffn_g, 2048, tid); }
        else { const int v = u - U_OUT - U_GU, kt = v % 44, jt = v / 44;
            p0_tile(t, p.w_down, D_, kt * 128, jt * 64, 64, bt_dn, DFF, jt * 64, nullptr, 0, tid); }
    }
}

__device__ void dt_units(const Params& p, LAS unsigned char* lds, int wv) {
    const int lane = lane_id(), w = wv, tid = wv * 64 + lane, fr = lane & 15, fq = lane >> 4;
    const bf16_t* xn = (const bf16_t*)(p.ws + WS_XN);
    const bf16_t* bt = (const bf16_t*)(p.ws + WS_BTIN) + (size_t)NPROJ * D_;
    float* dt = (float*)((unsigned char*)p.out + DO_DT);
    LAS float* red = (LAS float*)lds;
    for (int rb = blockIdx.x; rb < M_ / 64; rb += gridDim.x) {
        const int row0 = rb * 64;
        f32x4 acc[4][2];
#pragma unroll
        for (int m = 0; m < 4; ++m)
#pragma unroll
            for (int n = 0; n < 2; ++n) acc[m][n] = (f32x4){0.f, 0.f, 0.f, 0.f};
#pragma unroll 2
        for (int ks = 0; ks < 8; ++ks) {
            const int kb = w * 256 + ks * 32 + fq * 8;
            bf16x8 a[4], b[2];
#pragma unroll
            for (int m = 0; m < 4; ++m) a[m] = *(const bf16x8*)(xn + (size_t)(row0 + 16 * m + fr) * D_ + kb);
#pragma unroll
            for (int n = 0; n < 2; ++n) b[n] = *(const bf16x8*)(bt + (size_t)(16 * n + fr) * D_ + kb);
#pragma unroll
            for (int m = 0; m < 4; ++m)
#pragma unroll
                for (int n = 0; n < 2; ++n) acc[m][n] = __builtin_amdgcn_mfma_f32_16x16x32_bf16(a[m], b[n], acc[m][n], 0, 0, 0);
        }
#pragma unroll
        for (int m = 0; m < 4; ++m)
#pragma unroll
            for (int n = 0; n < 2; ++n)
#pragma unroll
                for (int j = 0; j < 4; ++j) red[w * 2048 + (16 * m + 4 * fq + j) * 32 + 16 * n + fr] = acc[m][n][j];
        __syncthreads();
        {
            const int idx = tid * 4, r = idx >> 5, c = idx & 31;
            f32x4 s = (f32x4){0.f, 0.f, 0.f, 0.f};
#pragma unroll
            for (int ww = 0; ww < 8; ++ww) s += *(LAS const f32x4*)(red + ww * 2048 + idx);
            const f32x4 bias = *(const f32x4*)(p.ssm_dt_bias + c);
            f32x4 o;
#pragma unroll
            for (int j = 0; j < 4; ++j) { const float v = s[j] + bias[j]; o[j] = v > 20.f ? v : log1pf(expf(v)); }
            *(f32x4*)(dt + (size_t)(row0 + r) * 32 + c) = o;
        }
        __syncthreads();
    }
}

__device__ void bc_conv_phase(const Params& p, LAS unsigned char* lds, int wv) {
    const int tid = wv * 64 + lane_id(), cv = tid & 3, run = tid >> 2;
    bf16_t* proj = (bf16_t*)(p.ws + WS_PROJ);
    LAS u32x4* stash = (LAS u32x4*)lds;
    for (int sq = blockIdx.x; sq < 4 * 64; sq += gridDim.x) {
        const int b = sq >> 6, slab = sq & 63;
        const int xcol = 2048 + slab * 32 + cv * 8;
        float wk[4][8], bs[8];
#pragma unroll
        for (int k = 0; k < 4; ++k) { const f32x4 a = *(const f32x4*)(p.ssm_conv_w + k * 4096 + xcol), c = *(const f32x4*)(p.ssm_conv_w + k * 4096 + xcol + 4);
#pragma unroll
            for (int j = 0; j < 4; ++j) { wk[k][j] = a[j]; wk[k][4 + j] = c[j]; } }
        { const f32x4 a = *(const f32x4*)(p.ssm_conv_b + xcol), c = *(const f32x4*)(p.ssm_conv_b + xcol + 4);
#pragma unroll
          for (int j = 0; j < 4; ++j) { bs[j] = a[j]; bs[4 + j] = c[j]; } }
        __syncthreads();
#pragma unroll 1
        for (int tile = 0; tile < 8; ++tile) {
            bf16_t* base = proj + (size_t)(b * SEQ + tile * 512 + run * 4) * NPROJ + 2048 + xcol;
            u32x4 raw[7];
#pragma unroll
            for (int r = 0; r < 7; ++r) {
                const int row = run * 4 + r - 3;
                if (row >= 0) raw[r] = *(const u32x4*)(base + (long)(r - 3) * NPROJ);
                else raw[r] = (tile == 0) ? (u32x4){0u, 0u, 0u, 0u} : stash[(row + 3) * 4 + cv];
            }
            u32x4 ov[4];
#pragma unroll
            for (int j = 0; j < 4; ++j) {
                float o[8];
#pragma unroll
                for (int q = 0; q < 4; ++q) {
                    const unsigned x0 = raw[j][q], x1 = raw[j + 1][q], x2 = raw[j + 2][q], x3 = raw[j + 3][q];
                    o[2 * q] = silu_f(bs[2 * q] + wk[0][2 * q] * bflo(x0) + wk[1][2 * q] * bflo(x1) + wk[2][2 * q] * bflo(x2) + wk[3][2 * q] * bflo(x3));
                    o[2 * q + 1] = silu_f(bs[2 * q + 1] + wk[0][2 * q + 1] * bfhi(x0) + wk[1][2 * q + 1] * bfhi(x1) + wk[2][2 * q + 1] * bfhi(x2) + wk[3][2 * q + 1] * bfhi(x3));
                }
                ov[j].x = cvt_pk_bf16(o[0], o[1]); ov[j].y = cvt_pk_bf16(o[2], o[3]); ov[j].z = cvt_pk_bf16(o[4], o[5]); ov[j].w = cvt_pk_bf16(o[6], o[7]);
            }
            asm volatile("s_waitcnt vmcnt(0) lgkmcnt(0)" ::: "memory");
            __syncthreads();
            if (run == 127) { stash[0 * 4 + cv] = raw[4]; stash[1 * 4 + cv] = raw[5]; stash[2 * 4 + cv] = raw[6]; }
#pragma unroll
            for (int j = 0; j < 4; ++j) *(u32x4*)(base + (long)j * NPROJ) = ov[j];
            __syncthreads();
        }
    }
}

constexpr int SROW = 272;
constexpr int L_CM = 0, L_BM = 34816, L_BDT = 69632, L_XT = 104448, L_HB = 121856  , L_CS = 156672, L_DT = 157184, L_CW = 157696  ;
__device__ __forceinline__ int swz_off(int row, int kblk) { return row * SROW + ((kblk ^ ((row >> 3) & 7)) << 4); }
__device__ __forceinline__ void ssd_load(u32x4 (&raw)[5], const bf16_t* base, bool first, int l0) {
#pragma unroll
    for (int r = 0; r < 5; ++r) raw[r] = (first && (l0 + r - 3) < 0) ? (u32x4){0u, 0u, 0u, 0u} : *(const u32x4*)(base + (long)(r - 3) * NPROJ);
}
template <int GI>
__device__ __forceinline__ void ssd_conv(LAS unsigned char* lds, const u32x4 (&raw)[5], int cv, int l0, float sa, float sb) {
    LAS const f32x4* cw = (LAS const f32x4*)(lds + L_CW) + cv * 10;
    float o0[8], o1[8];
#pragma unroll
    for (int hq = 0; hq < 2; ++hq) {
        const f32x4 w0 = cw[0 + hq], w1 = cw[2 + hq], w2 = cw[4 + hq], w3 = cw[6 + hq], bs = cw[8 + hq];
#pragma unroll
        for (int e2 = 0; e2 < 2; ++e2) {
            const int q = hq * 2 + e2;
            const unsigned x0 = raw[0][q], x1 = raw[1][q], x2 = raw[2][q], x3 = raw[3][q], x4 = raw[4][q];
            const int ea = e2 * 2, eb = e2 * 2 + 1;
            const float va = bs[ea] + w0[ea] * bflo(x0) + w1[ea] * bflo(x1) + w2[ea] * bflo(x2) + w3[ea] * bflo(x3);
            const float vb = bs[eb] + w0[eb] * bfhi(x0) + w1[eb] * bfhi(x1) + w2[eb] * bfhi(x2) + w3[eb] * bfhi(x3);
            const float ua = bs[ea] + w0[ea] * bflo(x1) + w1[ea] * bflo(x2) + w2[ea] * bflo(x3) + w3[ea] * bflo(x4);
            const float ub = bs[eb] + w0[eb] * bfhi(x1) + w1[eb] * bfhi(x2) + w2[eb] * bfhi(x3) + w3[eb] * bfhi(x4);
            o0[2 * q] = silu_f(va); o0[2 * q + 1] = silu_f(vb); o1[2 * q] = silu_f(ua); o1[2 * q + 1] = silu_f(ub);
        }
    }
    if (GI == 0) {
#pragma unroll
        for (int e = 0; e < 8; ++e) { const int prow = cv * 8 + e;
            *(LAS unsigned*)(lds + L_XT + swz_off(prow, l0 >> 3) + (l0 & 7) * 2) = cvt_pk_bf16(o0[e] * sa, o1[e] * sb); }
    } else {
        u32x4 w0; w0.x = cvt_pk_bf16(o0[0], o0[1]); w0.y = cvt_pk_bf16(o0[2], o0[3]); w0.z = cvt_pk_bf16(o0[4], o0[5]); w0.w = cvt_pk_bf16(o0[6], o0[7]);
        u32x4 w1; w1.x = cvt_pk_bf16(o1[0], o1[1]); w1.y = cvt_pk_bf16(o1[2], o1[3]); w1.z = cvt_pk_bf16(o1[4], o1[5]); w1.w = cvt_pk_bf16(o1[6], o1[7]);
        const int nb = ((GI - 1) & 1) * 64 + cv * 8;
        if (GI < 3) {
            *(LAS u32x4*)(lds + L_BM + l0 * SROW + nb * 2) = w0; *(LAS u32x4*)(lds + L_BM + (l0 + 1) * SROW + nb * 2) = w1;
#pragma unroll
            for (int e = 0; e < 8; ++e) { const int nrow = nb + e;
                *(LAS unsigned*)(lds + L_BDT + swz_off(nrow, l0 >> 3) + (l0 & 7) * 2) = cvt_pk_bf16(o0[e] * sa, o1[e] * sb); }
        } else {
            *(LAS u32x4*)(lds + L_CM + l0 * SROW + nb * 2) = w0; *(LAS u32x4*)(lds + L_CM + (l0 + 1) * SROW + nb * 2) = w1;
        }
    }
}
template <int GI>
__device__ __forceinline__ void ssd_put(LAS unsigned char* lds, const u32x4 (&rw)[2], int cv, int l0, float sa, float sb) {
    const int nb = ((GI - 1) & 1) * 64 + cv * 8;
    if (GI < 3) {
        *(LAS u32x4*)(lds + L_BM + l0 * SROW + nb * 2) = rw[0]; *(LAS u32x4*)(lds + L_BM + (l0 + 1) * SROW + nb * 2) = rw[1];
#pragma unroll
        for (int q = 0; q < 4; ++q) {
            *(LAS unsigned*)(lds + L_BDT + swz_off(nb + 2 * q, l0 >> 3) + (l0 & 7) * 2) = cvt_pk_bf16(bflo(rw[0][q]) * sa, bflo(rw[1][q]) * sb);
            *(LAS unsigned*)(lds + L_BDT + swz_off(nb + 2 * q + 1, l0 >> 3) + (l0 & 7) * 2) = cvt_pk_bf16(bfhi(rw[0][q]) * sa, bfhi(rw[1][q]) * sb);
        }
    } else {
        *(LAS u32x4*)(lds + L_CM + l0 * SROW + nb * 2) = rw[0]; *(LAS u32x4*)(lds + L_CM + (l0 + 1) * SROW + nb * 2) = rw[1];
    }
}
__device__ void ssd_unit(const Params& p, LAS unsigned char* lds, int b, int h, int wv) {
    const int lane = lane_id(), w = wv, tid = wv * 64 + lane, fr = lane & 15, fq = lane >> 4;
    const int g = h >> 2;
    const bf16_t* proj = (const bf16_t*)(p.ws + WS_PROJ);
    const float* dtg = (const float*)((const unsigned char*)p.out + DO_DT);
    bf16_t* ymix = (bf16_t*)(p.ws + WS_YMIX);
    float* ssq1 = (float*)((unsigned char*)p.out + DO_SSQ1);
    LAS float* CSv = (LAS float*)(lds + L_CS);
    LAS float* DTv = (LAS float*)(lds + L_DT);
    LAS float* CW = (LAS float*)(lds + L_CW);
    const float Aneg = -__expf(p.ssm_A_log[h]);
    const float Dh = p.ssm_D[h];
    for (int idx = tid; idx < 320; idx += 512) {
        const int e = idx & 7, k = (idx >> 3) % 5, cvi = idx / 40;
        const int xcol = h * 64 + cvi * 8 + e;
        CW[idx] = (k < 4) ? p.ssm_conv_w[k * 4096 + xcol] : p.ssm_conv_b[xcol];
    }
    for (int idx = tid; idx < 64 * 17; idx += 512) *(LAS u32x4*)(lds + L_HB + idx * 16) = (u32x4){0u, 0u, 0u, 0u};
    f32x4 Hacc[4];
#pragma unroll
    for (int pt = 0; pt < 4; ++pt) Hacc[pt] = (f32x4){0.f, 0.f, 0.f, 0.f};
    __syncthreads();
    const int cv = lane & 7;
    const int l0 = 16 * w + 2 * (lane >> 3);
    const int srcl = (w & 3) * 16 + 2 * (lane >> 3);
    u32x4 r0[5], r1[2], r2[2], r3[2], r4[2];
    const bf16_t* pbase = proj + (size_t)(b * SEQ + l0) * NPROJ + 2048 + cv * 8;
    const int xc0 = h * 64, xc1 = 2048 + g * 128, xc2 = xc1 + 64, xc3 = 3072 + g * 128, xc4 = xc3 + 64;
    ssd_load(r0, pbase + xc0, true, l0);
    r1[0] = *(const u32x4*)(pbase + xc1); r1[1] = *(const u32x4*)(pbase + xc1 + NPROJ); r2[0] = *(const u32x4*)(pbase + xc2); r2[1] = *(const u32x4*)(pbase + xc2 + NPROJ);
    r3[0] = *(const u32x4*)(pbase + xc3); r3[1] = *(const u32x4*)(pbase + xc3 + NPROJ); r4[0] = *(const u32x4*)(pbase + xc4); r4[1] = *(const u32x4*)(pbase + xc4 + NPROJ);
    float dt0n = dtg[(size_t)(b * SEQ + lane) * 32 + h], dt1n = dtg[(size_t)(b * SEQ + 64 + lane) * 32 + h];
    for (int c = 0; c < 32; ++c) {
        const int row0 = b * SEQ + c * 128;
        const float dt0 = dt0n, dt1 = dt1n;
        float a0 = dt0 * Aneg, a1 = dt1 * Aneg;
#pragma unroll
        for (int o = 1; o < 64; o <<= 1) { const float t0 = __shfl_up(a0, o), t1 = __shfl_up(a1, o); if (lane >= o) { a0 += t0; a1 += t1; } }
        a1 += __shfl(a0, 63);
        const float cs_end = __shfl(a1, 63);
        if (w == 0) { CSv[lane] = a0; CSv[64 + lane] = a1; DTv[lane] = dt0; DTv[64 + lane] = dt1; }
        const float csv = (w >= 4) ? a1 : a0, dtv = (w >= 4) ? dt1 : dt0;
        const float cs_l0 = __shfl(csv, srcl), cs_l1 = __shfl(csv, srcl + 1), dt_l0 = __shfl(dtv, srcl), dt_l1 = __shfl(dtv, srcl + 1);
        const float dec0 = __expf(cs_end - cs_l0), dec1 = __expf(cs_end - cs_l1);
        ssd_conv<0>(lds, r0, cv, l0, dt_l0, dt_l1);
        ssd_put<1>(lds, r1, cv, l0, dec0, dec1); ssd_put<2>(lds, r2, cv, l0, dec0, dec1);
        ssd_put<3>(lds, r3, cv, l0, 0.f, 0.f);   ssd_put<4>(lds, r4, cv, l0, 0.f, 0.f);
        __builtin_amdgcn_sched_barrier(0);
        if (c + 1 < 32) {
            const bf16_t* cb = pbase + (size_t)(c + 1) * 128 * NPROJ;
            ssd_load(r0, cb + xc0, false, l0);
            r1[0] = *(const u32x4*)(cb + xc1); r1[1] = *(const u32x4*)(cb + xc1 + NPROJ); r2[0] = *(const u32x4*)(cb + xc2); r2[1] = *(const u32x4*)(cb + xc2 + NPROJ);
            r3[0] = *(const u32x4*)(cb + xc3); r3[1] = *(const u32x4*)(cb + xc3 + NPROJ); r4[0] = *(const u32x4*)(cb + xc4); r4[1] = *(const u32x4*)(cb + xc4 + NPROJ);
            dt0n = dtg[(size_t)(row0 + 128 + lane) * 32 + h]; dt1n = dtg[(size_t)(row0 + 192 + lane) * 32 + h];
        }
        __builtin_amdgcn_sched_barrier(0);
        u32x2 zr[4];
#pragma unroll
        for (int pt = 0; pt < 4; ++pt) zr[pt] = *(const u32x2*)(proj + (size_t)(row0 + 16 * w + fr) * NPROJ + h * 64 + 16 * pt + 4 * fq);
        __syncthreads();
        const int lrow = 16 * w + fr;
        const int hb_cur = L_HB + (c & 1) * 17408, hb_nxt = L_HB + ((c + 1) & 1) * 17408;
        bf16x8 cf[4];
#pragma unroll
        for (int ks = 0; ks < 4; ++ks) cf[ks] = *(LAS const bf16x8*)(lds + L_CM + lrow * SROW + (32 * ks + 8 * fq) * 2);
        const float cs_l = CSv[lrow], dt_l = DTv[lrow];
        asm volatile("" ::: "memory");
        f32x4 y[4];
        { const float el = __expf(cs_l);
#pragma unroll
          for (int pt = 0; pt < 4; ++pt) { f32x4 a = (f32x4){0.f, 0.f, 0.f, 0.f};
#pragma unroll
            for (int ks = 0; ks < 4; ++ks) { const bf16x8 hf = *(LAS const bf16x8*)(lds + hb_cur + (16 * pt + fr) * SROW + (32 * ks + 8 * fq) * 2);
                a = __builtin_amdgcn_mfma_f32_16x16x32_bf16(hf, cf[ks], a, 0, 0, 0); }
            y[pt] = a * el; } }
#pragma unroll
        for (int j = 0; j < 8; ++j) {
            if (j <= w) {
                f32x4 gacc = (f32x4){0.f, 0.f, 0.f, 0.f};
#pragma unroll
                for (int ks = 0; ks < 4; ++ks) { const bf16x8 bf = *(LAS const bf16x8*)(lds + L_BM + (16 * j + fr) * SROW + (32 * ks + 8 * fq) * 2);
                    gacc = __builtin_amdgcn_mfma_f32_16x16x32_bf16(bf, cf[ks], gacc, 0, 0, 0); }
                const f32x4 css = *(LAS const f32x4*)(CSv + 16 * j + 4 * fq);
                float mv[4];
#pragma unroll
                for (int i = 0; i < 4; ++i) { const int sx = 16 * j + 4 * fq + i; float v = gacc[i] * __expf(cs_l - css[i]);
                    if (j == w) { v = (sx <= lrow) ? v : 0.f; if (sx == lrow) v += Dh / dt_l; }
                    mv[i] = v; }
                u32x2 wv2; wv2.x = cvt_pk_bf16(mv[0], mv[1]); wv2.y = cvt_pk_bf16(mv[2], mv[3]);
                *(LAS u32x2*)(lds + L_CM + lrow * SROW + (16 * j + 4 * fq) * 2) = wv2;
            } else if (j == w + 1 && (w & 1) == 0) {
                *(LAS u32x2*)(lds + L_CM + lrow * SROW + (16 * j + 4 * fq) * 2) = (u32x2){0u, 0u};
            }
        }
        asm volatile("" ::: "memory");
        { const float de = __expf(cs_end);
#pragma unroll
          for (int pt = 0; pt < 4; ++pt) Hacc[pt] *= de; }
        const int nks2 = (w >> 1) + 1;
#pragma unroll
        for (int ks = 0; ks < 4; ++ks) {
            bf16x8 xf[4];
#pragma unroll
            for (int pt = 0; pt < 4; ++pt) xf[pt] = *(LAS const bf16x8*)(lds + L_XT + swz_off(16 * pt + fr, 4 * ks + fq));
            if (ks < nks2) { const bf16x8 mf = *(LAS const bf16x8*)(lds + L_CM + lrow * SROW + (32 * ks + 8 * fq) * 2);
#pragma unroll
                for (int pt = 0; pt < 4; ++pt) y[pt] = __builtin_amdgcn_mfma_f32_16x16x32_bf16(xf[pt], mf, y[pt], 0, 0, 0); }
            const bf16x8 bdf = *(LAS const bf16x8*)(lds + L_BDT + swz_off(16 * w + fr, 4 * ks + fq));
#pragma unroll
            for (int pt = 0; pt < 4; ++pt) Hacc[pt] = __builtin_amdgcn_mfma_f32_16x16x32_bf16(bdf, xf[pt], Hacc[pt], 0, 0, 0);
        }
#pragma unroll
        for (int pt = 0; pt < 4; ++pt) { u32x2 wv2; wv2.x = cvt_pk_bf16(Hacc[pt][0], Hacc[pt][1]); wv2.y = cvt_pk_bf16(Hacc[pt][2], Hacc[pt][3]);
            *(LAS u32x2*)(lds + hb_nxt + (16 * pt + fr) * SROW + (16 * w + 4 * fq) * 2) = wv2; }
        { float ss = 0.f; const size_t orow = (size_t)(row0 + lrow);
#pragma unroll
          for (int pt = 0; pt < 4; ++pt) {
            const float z0 = bflo(zr[pt].x), z1 = bfhi(zr[pt].x), z2 = bflo(zr[pt].y), z3 = bfhi(zr[pt].y);
            const float v0 = y[pt][0] * silu_f(z0), v1 = y[pt][1] * silu_f(z1), v2 = y[pt][2] * silu_f(z2), v3 = y[pt][3] * silu_f(z3);
            ss += (v0 * v0 + v1 * v1) + (v2 * v2 + v3 * v3);
            u32x2 wv; wv.x = cvt_pk_bf16(v0, v1); wv.y = cvt_pk_bf16(v2, v3);
            *(u32x2*)(ymix + orow * DMIX + h * 64 + 16 * pt + 4 * fq) = wv; }
          ss += __shfl_xor(ss, 16); ss += __shfl_xor(ss, 32);
          if (fq == 0) ssq1[ssq_idx((int)orow, h)] = ss; }
        __syncthreads();
    }
}
__device__ void sc_unit(const Params& p, int unit, int wv) {
    const int tid = wv * 64 + lane_id(), cvx = tid & 255, th = tid >> 8;
    const bf16_t* proj = (const bf16_t*)(p.ws + WS_PROJ);
    bf16_t* ymix = (bf16_t*)(p.ws + WS_YMIX);
    const int t0 = unit * 64 + th * 32, c0 = cvx * 8;
    float w0[8], w1[8], w2[8];
    { const f32x4* a = (const f32x4*)(p.sc_conv_w + c0); const f32x4* bq = (const f32x4*)(p.sc_conv_w + 2048 + c0); const f32x4* cq = (const f32x4*)(p.sc_conv_w + 4096 + c0);
#pragma unroll
      for (int q = 0; q < 2; ++q) { const f32x4 x0 = a[q], x1 = bq[q], x2 = cq[q];
#pragma unroll
        for (int j = 0; j < 4; ++j) { w0[q * 4 + j] = x0[j]; w1[q * 4 + j] = x1[j]; w2[q * 4 + j] = x2[j]; } } }
    float pm1[8], pm2[8];
#pragma unroll
    for (int e = 0; e < 8; ++e) { pm1[e] = 0.f; pm2[e] = 0.f; }
    if ((t0 & (SEQ - 1)) != 0) {
        const bf16_t* r2 = proj + (size_t)(t0 - 2) * NPROJ, * r1 = proj + (size_t)(t0 - 1) * NPROJ;
        const u32x4 c2 = *(const u32x4*)(r2 + 8192 + c0), x2 = *(const u32x4*)(r2 + 10240 + c0), c1 = *(const u32x4*)(r1 + 8192 + c0), x1 = *(const u32x4*)(r1 + 10240 + c0);
#pragma unroll
        for (int q = 0; q < 4; ++q) { pm2[2 * q] = bflo(c2[q]) * bflo(x2[q]); pm2[2 * q + 1] = bfhi(c2[q]) * bfhi(x2[q]); pm1[2 * q] = bflo(c1[q]) * bflo(x1[q]); pm1[2 * q + 1] = bfhi(c1[q]) * bfhi(x1[q]); }
    }
#pragma unroll 4
    for (int i = 0; i < 32; ++i) {
        const bf16_t* r = proj + (size_t)(t0 + i) * NPROJ;
        const u32x4 gb = *(const u32x4*)(r + 6144 + c0), gc = *(const u32x4*)(r + 8192 + c0), gx = *(const u32x4*)(r + 10240 + c0);
        float o[8];
#pragma unroll
        for (int q = 0; q < 4; ++q) {
            const float pa = bflo(gc[q]) * bflo(gx[q]), pb = bfhi(gc[q]) * bfhi(gx[q]);
            o[2 * q] = bflo(gb[q]) * (w0[2 * q] * pm2[2 * q] + w1[2 * q] * pm1[2 * q] + w2[2 * q] * pa);
            o[2 * q + 1] = bfhi(gb[q]) * (w0[2 * q + 1] * pm2[2 * q + 1] + w1[2 * q + 1] * pm1[2 * q + 1] + w2[2 * q + 1] * pb);
            pm2[2 * q] = pm1[2 * q]; pm2[2 * q + 1] = pm1[2 * q + 1]; pm1[2 * q] = pa; pm1[2 * q + 1] = pb;
        }
        u32x4 wv; wv.x = cvt_pk_bf16(o[0], o[1]); wv.y = cvt_pk_bf16(o[2], o[3]); wv.z = cvt_pk_bf16(o[4], o[5]); wv.w = cvt_pk_bf16(o[6], o[7]);
        *(u32x4*)(ymix + (size_t)(t0 + i) * DMIX + 2048 + c0) = wv;
    }
}
__device__ void phase2(const Params& p, LAS unsigned char* lds, int wv) {
    const int G = gridDim.x, bid = blockIdx.x;
    const bool split = G >= 256;
    if (!split || bid < 128) { for (int u = bid; u < 128; u += (split ? 128 : G)) ssd_unit(p, lds, u >> 5, u & 31, wv); }
    if (!split || bid >= 128) { for (int u = (split ? bid - 128 : bid); u < M_ / 64; u += (split ? G - 128 : G)) sc_unit(p, u, wv); }
    if (!split || bid >= 128) wconv_units(p, lds, split ? bid - 128 : bid, split ? G - 128 : G, wv);
}

__device__ void phase6(const Params& p, int wv) {
    const int lane = lane_id(), wave = wv;
    const float* h2 = (const float*)(p.ws + WS_H1F);
    const float* ssq3 = (const float*)(p.ws + WS_SSQ3);
    for (int row = blockIdx.x * 8 + wave; row < M_; row += gridDim.x * 8) {
        float s = (lane < 32) ? ssq3[ssq_idx(row, lane)] : 0.f;
#pragma unroll
        for (int o = 32; o >= 1; o >>= 1) s += __shfl_xor(s, o);
        const float rstd = rsqrtf(s * (1.0f / 2048.0f) + EPS);
        const f32x4* hr = (const f32x4*)(h2 + (size_t)row * D_);
        f32x4* orow = (f32x4*)(p.out + (size_t)row * D_);
#pragma unroll
        for (int i = 0; i < 8; ++i) { const f32x4 v = hr[lane + 64 * i], g4 = ((const f32x4*)p.norm_final_g)[lane + 64 * i]; orow[lane + 64 * i] = v * rstd * g4; }
    }
}

__global__ void __launch_bounds__(512) hymba_fwd(Params p) {
    extern __shared__ __attribute__((aligned(16))) unsigned char shm[];
    LAS unsigned char* lds = (LAS unsigned char*)shm;
    cg::grid_group grid = cg::this_grid();
    const int lo = p.ph_lo, hi = p.ph_hi;
    const int wv = __builtin_amdgcn_readfirstlane(threadIdx.x >> 6);
#ifdef DBG_CLEAR
    for (int i = threadIdx.x; i < LDS_BYTES / 16; i += 512) *(LAS u32x4*)(lds + i * 16) = (u32x4){0u, 0u, 0u, 0u};
    __syncthreads();
#endif
#define IN(k) (lo <= (k) && (k) < hi)
#define SEAM(k) do { if (IN(k) && IN((k) + 1)) { \
        asm volatile("s_waitcnt vmcnt(0) lgkmcnt(0)" ::: "memory"); __syncthreads();                 \
        if (wv == 0) { __builtin_amdgcn_fence(__ATOMIC_RELEASE, "agent"); asm volatile("s_waitcnt vmcnt(0)" ::: "memory"); }     \
        grid.sync(); \
        if (wv == 0) { __builtin_amdgcn_fence(__ATOMIC_ACQUIRE, "agent"); asm volatile("s_waitcnt vmcnt(0)" ::: "memory"); }     \
        __syncthreads(); } } while (0)
    if (IN(0)) for (int rep = 0; rep < NREP(0); ++rep) phase0(p, lds, wv);
    SEAM(0);
    if (IN(1)) for (int rep = 0; rep < NREP(1); ++rep) {
        pg8::Gemm g{(const bf16_t*)(p.ws + WS_XN), (const bf16_t*)(p.ws + WS_BTIN), M_, NPROJ, D_}; pg8::StaticOrder S; S.init(M_, NPROJ, gridDim.x, blockIdx.x);
        EpiProj E{(bf16_t*)(p.ws + WS_PROJ)};
        pg8::gemm_phase<EpiProj>(lds, g, S, E, wv);
        dt_units(p, lds, wv);
    }
    SEAM(1);
    if (IN(2)) bc_conv_phase(p, lds, wv);
    SEAM(2);
    if (IN(3)) for (int rep = 0; rep < NREP(3); ++rep) phase2(p, lds, wv);
    SEAM(3);
    if (IN(4)) for (int rep = 0; rep < NREP(4); ++rep) {
        pg8::Gemm g{(const bf16_t*)(p.ws + WS_YMIX), (const bf16_t*)((unsigned char*)p.out + DO_BTOUT), M_, D_, DMIX}; pg8::StaticOrder S; S.init(M_, D_, gridDim.x, blockIdx.x);
        EpiOut E{p.x, (float*)(p.ws + WS_H1F), (bf16_t*)(p.ws + WS_H1B), (const float*)((unsigned char*)p.out + DO_SSQ1), (float*)((unsigned char*)p.out + DO_SSQ2)};
        pg8::gemm_phase<EpiOut>(lds, g, S, E, wv);
    }
    SEAM(4);
    if (IN(5)) for (int rep = 0; rep < NREP(5); ++rep) {
        pg8::Gemm g{(const bf16_t*)(p.ws + WS_H1B), (const bf16_t*)((unsigned char*)p.out + DO_BTGU), M_, NGU, D_}; pg8::StaticOrder S; S.init(M_, NGU, gridDim.x, blockIdx.x);
        EpiGU E{(const float*)((unsigned char*)p.out + DO_SSQ2), (bf16_t*)(p.ws + WS_HFF)};
        pg8::gemm_phase<EpiGU>(lds, g, S, E, wv);
    }
    SEAM(5);
    if (IN(6)) {
        pg8::Gemm g{(const bf16_t*)(p.ws + WS_HFF), (const bf16_t*)((unsigned char*)p.out + DO_BTDN), M_, D_, DFF}; pg8::StaticOrder S; S.init(M_, D_, gridDim.x, blockIdx.x);
        EpiDown E{(float*)(p.ws + WS_H1F), (float*)(p.ws + WS_SSQ3)};
        pg8::gemm_phase<EpiDown>(lds, g, S, E, wv);
    }
    SEAM(6);
    if (IN(7)) for (int rep = 0; rep < NREP(7); ++rep) phase6(p, wv);
#undef IN
#undef SEAM
}

extern "C" void kernel_launch(void* const* d_in, const int* in_sizes, int n_in, void* d_out, int out_size, void* d_ws, size_t ws_size, hipStream_t stream) {
    static int grid = 0;
    if (grid == 0) {
        if (n_in != 16 || out_size != M_ * D_ || ws_size < WS_NEED) { fprintf(stderr, "kernel_launch: unexpected shapes (n_in %d out %d ws %zu, need %zu)\n", n_in, out_size, ws_size, (size_t)WS_NEED); grid = -1; return; }
        int dev = 0, cus = 0, per_cu = 0;
        (void)hipGetDevice(&dev);
        (void)hipDeviceGetAttribute(&cus, hipDeviceAttributeMultiprocessorCount, dev);
        if (hipFuncSetAttribute((const void*)hymba_fwd, hipFuncAttributeMaxDynamicSharedMemorySize, LDS_BYTES) != hipSuccess) { fprintf(stderr, "kernel_launch: hipFuncSetAttribute failed\n"); grid = -1; return; }
        if (hipOccupancyMaxActiveBlocksPerMultiprocessor(&per_cu, (const void*)hymba_fwd, 512, LDS_BYTES) != hipSuccess || per_cu < 1) { fprintf(stderr, "kernel_launch: occupancy query failed (%d)\n", per_cu); (void)hipGetLastError(); per_cu = 1; }
        grid = cus * per_cu;
    }
    if (grid < 0) return;
    Params p{};
    p.x = (const float*)d_in[0]; p.norm_mix_g = (const float*)d_in[1]; p.w_in = (const float*)d_in[2]; p.ssm_conv_w = (const float*)d_in[3]; p.ssm_conv_b = (const float*)d_in[4];
    p.ssm_dt_bias = (const float*)d_in[5]; p.ssm_A_log = (const float*)d_in[6]; p.ssm_D = (const float*)d_in[7]; p.ssm_norm_g = (const float*)d_in[8]; p.sc_conv_w = (const float*)d_in[9];
    p.w_out = (const float*)d_in[10]; p.norm_ffn_g = (const float*)d_in[11]; p.w_gate = (const float*)d_in[12]; p.w_up = (const float*)d_in[13]; p.w_down = (const float*)d_in[14]; p.norm_final_g = (const float*)d_in[15];
    p.out = (float*)d_out; p.ws = (unsigned char*)d_ws;
#ifdef DBG_MEMSET
    (void)hipMemsetAsync(d_ws, 0, WS_NEED, stream); (void)hipMemsetAsync(d_out, 0, (size_t)out_size * 4, stream);
#endif
#ifndef N_CUTS
#define N_CUTS 1
#endif
    for (int li = 0; li < N_CUTS; ++li) {
        p.ph_lo = (N_CUTS == 8) ? li : 0; p.ph_hi = (N_CUTS == 8) ? li + 1 : 8;
        void* args[] = {&p};
        hipError_t e = hipLaunchCooperativeKernel((const void*)hymba_fwd, dim3(grid), dim3(512), args, LDS_BYTES, stream);
        if (e != hipSuccess) fprintf(stderr, "kernel_launch: cooperative launch failed: %s (grid %d)\n", hipGetErrorString(e), grid);
    }
}
```

```cpp
#include <hip/hip_runtime.h>
#include <hip/hip_cooperative_groups.h>
#include <cstdio>
namespace cg = cooperative_groups;

#define LAS __attribute__((address_space(3)))
typedef unsigned short bf16_t;
typedef short bf16x8 __attribute__((ext_vector_type(8)));
typedef float f32x4 __attribute__((ext_vector_type(4)));
typedef unsigned u32x4 __attribute__((ext_vector_type(4)));
typedef unsigned u32x2 __attribute__((ext_vector_type(2)));

constexpr int M_ = 16384, D_ = 2048, DIN = 12320, NPROJ = 12288, DFF = 5632, DMIX = 4096, NGU = 11264;
constexpr int SEQ = 4096;
constexpr float EPS = 1e-5f;
constexpr int LDS_BYTES = 159744;
#ifndef PROBE_PHASE
#define PROBE_PHASE -1
#endif
#define NREP(k) ((PROBE_PHASE == (k)) ? 1 + (p.ph_hi < 100) : 1)
constexpr int TAB_OFF = 131072;

constexpr size_t WS_PROJ = 0;
constexpr size_t WS_R = (size_t)M_ * NPROJ * 2;
constexpr size_t WS_XN = WS_R;
constexpr size_t WS_BTIN = WS_R + (size_t)M_ * D_ * 2;
constexpr size_t WS_YMIX = WS_R;
constexpr size_t WS_H1F = 0;
constexpr size_t WS_H1B = (size_t)M_ * D_ * 4;
constexpr size_t WS_HFF = WS_H1B + (size_t)M_ * D_ * 2;
constexpr size_t WS_SSQ3 = WS_HFF + (size_t)M_ * DFF * 2;
constexpr size_t WS_NEED = WS_R + (size_t)M_ * DMIX * 2;
constexpr size_t DO_BTOUT = 0;
constexpr size_t DO_BTGU = (size_t)D_ * DMIX * 2;
constexpr size_t DO_BTDN = DO_BTGU + (size_t)NGU * D_ * 2;
constexpr size_t DO_DT = DO_BTDN + (size_t)D_ * DFF * 2;
constexpr size_t DO_SSQ1 = DO_DT + (size_t)M_ * 32 * 4;
constexpr size_t DO_SSQ2 = DO_SSQ1 + (size_t)M_ * 32 * 4;
constexpr size_t DO_XBAR = DO_SSQ2 + (size_t)M_ * 32 * 4;
static_assert(DO_XBAR + 16384 <= (size_t)M_ * D_ * 4, "d_out scratch");
static_assert(WS_SSQ3 + (size_t)M_ * 32 * 4 <= WS_R, "ws overlay");

struct Params {
    const float* x; const float* norm_mix_g; const float* w_in; const float* ssm_conv_w; const float* ssm_conv_b;
    const float* ssm_dt_bias; const float* ssm_A_log; const float* ssm_D; const float* ssm_norm_g; const float* sc_conv_w;
    const float* w_out; const float* norm_ffn_g; const float* w_gate; const float* w_up; const float* w_down; const float* norm_final_g;
    float* out; unsigned char* ws; int ph_lo, ph_hi;
};

typedef float f32x2_t __attribute__((ext_vector_type(2)));
typedef __bf16 bf16x2_t __attribute__((ext_vector_type(2)));
__device__ __forceinline__ unsigned cvt_pk_bf16(float lo, float hi) { const f32x2_t v = {lo, hi}; return __builtin_bit_cast(unsigned, __builtin_convertvector(v, bf16x2_t)); }
__device__ __forceinline__ float bflo(unsigned u) { return __uint_as_float(u << 16); }
__device__ __forceinline__ float bfhi(unsigned u) { return __uint_as_float(u & 0xffff0000u); }
__device__ __forceinline__ int lane_id() { int l; asm volatile("v_mbcnt_lo_u32_b32 %0, -1, 0\n\tv_mbcnt_hi_u32_b32 %0, -1, %0" : "=v"(l)); return l; }
__device__ __forceinline__ float silu_f(float v) { return v * __builtin_amdgcn_rcpf(1.0f + __expf(-v)); }

__device__ __forceinline__ size_t ssq_idx(int row, int part) { return ((size_t)(row >> 5) * 32 + part) * 32 + (row & 31); }

namespace pg8 {
constexpr int BM = 256, BK = 64, HALF = 128, HTB = HALF * BK * 2, STAGE_BYTES = 8 * HTB, NXCD = 8, WGM = 8;
__device__ __forceinline__ int lds_byte(int r, int c) { const int st = (r >> 4) * 2 + (c >> 5), rr = r & 15, cc = c & 31, ob = rr * 64 + cc * 2; return st * 1024 + (ob ^ (((ob >> 9) & 1) << 5)); }
__device__ __forceinline__ void stage_rc(int b, int& R, int& C) { const int st = b / 1024, sb = b % 1024, swz = sb ^ (((sb >> 9) & 1) << 5); R = (st >> 1) * 16 + swz / 64; C = (st & 1) * 32 + (swz % 64) / 2; }
__device__ __forceinline__ int perm32(int rho) { const int n = rho >> 4, i = rho & 15; return 8 * (i >> 2) + 4 * n + (i & 3); }
struct Unit { int pm, pn; };
struct Gemm { const bf16_t* A; const bf16_t* Bt; int M, N, K; };
struct StaticOrder {
    int nM, nN, nwg, G, c;
    __device__ void init(int M, int N, int G_, int c_) { nM = M / BM; nN = N / BM; nwg = nM * nN; G = G_; c = c_; }
    __device__ bool next(int i, Unit& u) const {
        const long L = (long)i * G + c; if (L >= nwg) return false;
        int wgid = (int)L; { const int q = nwg / NXCD, r = nwg % NXCD, xcd = wgid % NXCD, off = wgid / NXCD; wgid = (xcd < r ? xcd * (q + 1) : r * (q + 1) + (xcd - r) * q) + off; }
        const int nig = WGM * nN, gid = wgid / nig, fm = gid * WGM, gsz = (nM - fm) < WGM ? (nM - fm) : WGM;
        u.pm = fm + ((wgid % nig) % gsz); u.pn = (wgid % nig) / gsz; return true;
    }
};
template <class Epi>
__device__ __forceinline__ void gemm_phase(LAS unsigned char* lds, const Gemm g, const StaticOrder& S, const Epi& E, int wv) {
    const int wid = wv, lane = lane_id(), tid = wid * 64 + lane, wr = wid >> 2, wc = wid & 3, fr = lane & 15, fq = lane >> 4;
    const int K = g.K, nt = K / BK;
    unsigned voffA[2], voffB[2];
#pragma unroll
    for (int i = 0; i < 2; ++i) { int R, C; stage_rc(tid * 16 + i * 8192, R, C); const int Rb = (R & ~31) + perm32(R & 31);
        voffA[i] = (unsigned)(R * K + C) * 2u; voffB[i] = (unsigned)(Rb * K + C) * 2u; }
    const size_t kstep = (size_t)(BK * 2);
    const size_t hstep = (size_t)HALF * K * 2;
    const size_t tstep = 2 * hstep;
    const unsigned ldsw = (unsigned)wid * 1024u;
    const int aoff = lds_byte(wr * 64 + fr, fq * 8), boff = lds_byte(wc * 32 + fr, fq * 8);
#define PG8_SA(b, h) (((b) * 2 + (h)) * HTB)
#define PG8_SB(b, h) ((4 + (b) * 2 + (h)) * HTB)
#define PG8_STAGE(bufoff, gbase, voff) do { _Pragma("unroll") for (int _i = 0; _i < 2; ++_i) \
        __builtin_amdgcn_global_load_lds((const unsigned*)((const char*)(gbase) + (voff)[_i]), (LAS unsigned*)(lds + (bufoff) + ldsw + _i * 8192), 16, 0, 0); } while (0)
#define PG8_LDA(dst, b, h) do { _Pragma("unroll") for (int m = 0; m < 4; ++m) _Pragma("unroll") for (int k = 0; k < 2; ++k) dst[m][k] = *(const LAS bf16x8*)(lds + PG8_SA(b, h) + aoff + m * 2048 + k * 1024); } while (0)
#define PG8_LDB(dst, b, h) do { _Pragma("unroll") for (int n = 0; n < 2; ++n) _Pragma("unroll") for (int k = 0; k < 2; ++k) dst[n][k] = *(const LAS bf16x8*)(lds + PG8_SB(b, h) + boff + n * 2048 + k * 1024); } while (0)
#define PG8_MMA(ai, bj, At, Bt) do { __builtin_amdgcn_s_setprio(1); _Pragma("unroll") for (int m = 0; m < 4; ++m) _Pragma("unroll") for (int n = 0; n < 2; ++n) _Pragma("unroll") for (int k = 0; k < 2; ++k) \
        acc[ai][bj][m][n] = __builtin_amdgcn_mfma_f32_16x16x32_bf16(Bt[n][k], At[m][k], acc[ai][bj][m][n], 0, 0, 0); __builtin_amdgcn_s_setprio(0); } while (0)
#define PG8_WAIT_V(n) asm volatile("s_waitcnt vmcnt(" #n ")" ::: "memory")
#define PG8_WAIT_L(n) asm volatile("s_waitcnt lgkmcnt(" #n ")" ::: "memory")
#define PG8_BAR __builtin_amdgcn_s_barrier()
#define PG8_SCHED __builtin_amdgcn_sched_barrier(0)
    Unit cur, nxt; int ui = 0;
    if (!S.next(0, cur)) return;
    f32x4 acc[2][2][4][2];
#pragma unroll
    for (int a = 0; a < 2; ++a)
#pragma unroll
        for (int b = 0; b < 2; ++b)
#pragma unroll
            for (int m = 0; m < 4; ++m)
#pragma unroll
                for (int n = 0; n < 2; ++n) acc[a][b][m][n] = (f32x4){0.f, 0.f, 0.f, 0.f};
    bf16x8 At[4][2], B0[2][2], B1[2][2];
    const char* cA = (const char*)g.A + (size_t)cur.pm * tstep; const char* cB = (const char*)g.Bt + (size_t)cur.pn * tstep;
    if constexpr (Epi::HAS_TAB) {
        Unit uu; for (int i = 0; i < 27 && S.next(i, uu); ++i) E.prep(uu, (LAS float*)(lds + TAB_OFF + i * 1024), tid);
    }
    PG8_STAGE(PG8_SB(0, 0), cB, voffB); PG8_STAGE(PG8_SB(0, 1), cB + hstep, voffB); PG8_STAGE(PG8_SA(0, 0), cA, voffA); PG8_STAGE(PG8_SA(0, 1), cA + hstep, voffA);
    if (wr == 1) PG8_BAR;
    PG8_WAIT_V(2); PG8_BAR;
    PG8_STAGE(PG8_SB(1, 0), cB + kstep, voffB); PG8_STAGE(PG8_SA(1, 0), cA + kstep, voffA); PG8_STAGE(PG8_SB(1, 1), cB + hstep + kstep, voffB);
    PG8_WAIT_V(6); PG8_BAR;
    for (;;) {
        const bool has_next = S.next(ui + 1, nxt);
        const char* nA = has_next ? (const char*)g.A + (size_t)nxt.pm * tstep : cA; const char* nB = has_next ? (const char*)g.Bt + (size_t)nxt.pn * tstep : cB;
        LAS const float* tabc = (LAS const float*)(lds + TAB_OFF + ui * 1024);
        for (int t = 0; t < nt; t += 2) {
            const bool last = (t == nt - 2);
            const char* a1 = cA + (size_t)(t + 1) * kstep;
            const char* a2 = last ? nA : cA + (size_t)(t + 2) * kstep; const char* b2 = last ? nB : cB + (size_t)(t + 2) * kstep;
            const char* a3 = a2 + kstep; const char* b3 = b2 + kstep;
            if constexpr (Epi::MID_T >= 0) { if (t == Epi::MID_T) {
#pragma unroll
                for (int ai = 0; ai < 2; ++ai)
#pragma unroll
                    for (int m = 0; m < 4; ++m) { const float s = tabc[ai * HALF + wr * 64 + m * 16 + fr];
#pragma unroll
                        for (int bj = 0; bj < 2; ++bj)
#pragma unroll
                            for (int n = 0; n < 2; ++n) acc[ai][bj][m][n] *= s; } } }
            PG8_LDB(B0, 0, 0); PG8_LDB(B1, 0, 1); PG8_SCHED; PG8_LDA(At, 0, 0); PG8_STAGE(PG8_SA(1, 1), a1 + hstep, voffA);
            PG8_WAIT_V(8); PG8_WAIT_L(0); PG8_BAR; PG8_MMA(0, 0, At, B0); PG8_MMA(0, 1, At, B1); PG8_BAR; PG8_SCHED;
            PG8_LDA(At, 0, 1); PG8_STAGE(PG8_SB(0, 0), b2, voffB); PG8_STAGE(PG8_SB(0, 1), b2 + hstep, voffB); PG8_STAGE(PG8_SA(0, 0), a2, voffA);
            PG8_WAIT_V(8); PG8_WAIT_L(0); PG8_BAR; PG8_MMA(1, 0, At, B0); PG8_MMA(1, 1, At, B1); PG8_BAR; PG8_SCHED;
            PG8_LDB(B0, 1, 0); PG8_LDB(B1, 1, 1); PG8_SCHED; PG8_LDA(At, 1, 0); PG8_STAGE(PG8_SA(0, 1), a2 + hstep, voffA);
            PG8_WAIT_V(8); PG8_WAIT_L(0); PG8_BAR; PG8_MMA(0, 0, At, B0); PG8_MMA(0, 1, At, B1); PG8_BAR; PG8_SCHED;
            PG8_LDA(At, 1, 1); PG8_STAGE(PG8_SB(1, 0), b3, voffB); PG8_STAGE(PG8_SB(1, 1), b3 + hstep, voffB); PG8_STAGE(PG8_SA(1, 0), a3, voffA);
            PG8_WAIT_V(8); PG8_WAIT_L(0); PG8_BAR; PG8_MMA(1, 0, At, B0); PG8_MMA(1, 1, At, B1); PG8_BAR; PG8_SCHED;
        }
        if (wr == 0) PG8_BAR;
        E(acc, cur, tabc, wr, wc, fr, fq);
        if (!has_next) break;
#pragma unroll
        for (int a = 0; a < 2; ++a)
#pragma unroll
            for (int b = 0; b < 2; ++b)
#pragma unroll
                for (int m = 0; m < 4; ++m)
#pragma unroll
                    for (int n = 0; n < 2; ++n) acc[a][b][m][n] = (f32x4){0.f, 0.f, 0.f, 0.f};
        cur = nxt; cA = nA; cB = nB; ++ui;
        if (wr == 1) PG8_BAR;
    }
    PG8_WAIT_V(0);
    PG8_BAR;
#undef PG8_SA
#undef PG8_SB
#undef PG8_STAGE
#undef PG8_LDA
#undef PG8_LDB
#undef PG8_MMA
#undef PG8_WAIT_V
#undef PG8_WAIT_L
#undef PG8_BAR
#undef PG8_SCHED
}
}

__device__ __forceinline__ void rstd_table(const float* ssq, int row0, LAS float* tab, int t) {
    const int r = t >> 1, hf = t & 1;
    const float* p = ssq + ssq_idx(row0 + r, hf * 16);
    float s = 0.f;
#pragma unroll
    for (int i = 0; i < 16; ++i) s += p[i * 32];
    s += __shfl_xor(s, 1);
    if (!hf) tab[r] = rsqrtf(s * (1.0f / 2048.0f) + EPS);
}

struct EpiProj {
    static constexpr bool HAS_TAB = false; static constexpr int MID_T = -1;
    bf16_t* O;
    __device__ __forceinline__ void prep(const pg8::Unit&, LAS float*, int) const {}
    __device__ __forceinline__ void operator()(const f32x4 (&acc)[2][2][4][2], const pg8::Unit& u, LAS const float*, int wr, int wc, int fr, int fq) const {
        const int row0 = u.pm * 256 + wr * 64 + fr, col0 = u.pn * 256 + wc * 32 + 8 * fq;
#pragma unroll
        for (int ai = 0; ai < 2; ++ai)
#pragma unroll
            for (int m = 0; m < 4; ++m) { bf16_t* rowp = O + (size_t)(row0 + ai * 128 + m * 16) * NPROJ + col0;
#pragma unroll
                for (int bj = 0; bj < 2; ++bj) { const f32x4 v0 = acc[ai][bj][m][0], v1 = acc[ai][bj][m][1];
                    u32x4 w; w.x = cvt_pk_bf16(v0[0], v0[1]); w.y = cvt_pk_bf16(v0[2], v0[3]); w.z = cvt_pk_bf16(v1[0], v1[1]); w.w = cvt_pk_bf16(v1[2], v1[3]);
                    *(u32x4*)(rowp + bj * 128) = w; } }
    }
};
struct EpiOut {
    static constexpr bool HAS_TAB = true; static constexpr int MID_T = 32;
    const float* x; float* h1f; bf16_t* h1b; const float* ssq1; float* ssq2;
    __device__ __forceinline__ void prep(const pg8::Unit& u, LAS float* tab, int t) const { rstd_table(ssq1, u.pm * 256, tab, t); }
    __device__ __forceinline__ void operator()(const f32x4 (&acc)[2][2][4][2], const pg8::Unit& u, LAS const float*, int wr, int wc, int fr, int fq) const {
        const int row0 = u.pm * 256 + wr * 64 + fr, col0 = u.pn * 256 + wc * 32 + 8 * fq;
#pragma unroll
        for (int ai = 0; ai < 2; ++ai)
#pragma unroll
            for (int m = 0; m < 4; ++m) { const int row = row0 + ai * 128 + m * 16; const size_t off = (size_t)row * D_ + col0; float ss = 0.f;
#pragma unroll
                for (int bj = 0; bj < 2; ++bj) {
                    const f32x4 x0 = *(const f32x4*)(x + off + bj * 128), x1 = *(const f32x4*)(x + off + bj * 128 + 4);
                    const f32x4 v0 = acc[ai][bj][m][0] + x0, v1 = acc[ai][bj][m][1] + x1;
                    *(f32x4*)(h1f + off + bj * 128) = v0; *(f32x4*)(h1f + off + bj * 128 + 4) = v1;
                    u32x4 w; w.x = cvt_pk_bf16(v0[0], v0[1]); w.y = cvt_pk_bf16(v0[2], v0[3]); w.z = cvt_pk_bf16(v1[0], v1[1]); w.w = cvt_pk_bf16(v1[2], v1[3]);
                    *(u32x4*)(h1b + off + bj * 128) = w;
                    ss += (v0[0] * v0[0] + v0[1] * v0[1]) + (v0[2] * v0[2] + v0[3] * v0[3]) + (v1[0] * v1[0] + v1[1] * v1[1]) + (v1[2] * v1[2] + v1[3] * v1[3]); }
                ss += __shfl_xor(ss, 16); ss += __shfl_xor(ss, 32);
                if (fq == 0) ssq2[ssq_idx(row, u.pn * 4 + wc)] = ss; }
    }
};
struct EpiGU {
    static constexpr bool HAS_TAB = true; static constexpr int MID_T = -1;
    const float* ssq2; bf16_t* hff;
    __device__ __forceinline__ void prep(const pg8::Unit& u, LAS float* tab, int t) const { rstd_table(ssq2, u.pm * 256, tab, t); }
    __device__ __forceinline__ void operator()(const f32x4 (&acc)[2][2][4][2], const pg8::Unit& u, LAS const float* tab, int wr, int wc, int fr, int fq) const {
        const int row0 = u.pm * 256 + wr * 64 + fr, col0 = u.pn * 128 + wc * 32 + 8 * fq;
#pragma unroll
        for (int ai = 0; ai < 2; ++ai)
#pragma unroll
            for (int m = 0; m < 4; ++m) { const float rs = tab[ai * 128 + wr * 64 + m * 16 + fr];
                float o[8];
#pragma unroll
                for (int n = 0; n < 2; ++n)
#pragma unroll
                    for (int j = 0; j < 4; ++j) { const float gg = acc[ai][0][m][n][j] * rs, uu = acc[ai][1][m][n][j] * rs; o[n * 4 + j] = silu_f(gg) * uu; }
                u32x4 w; w.x = cvt_pk_bf16(o[0], o[1]); w.y = cvt_pk_bf16(o[2], o[3]); w.z = cvt_pk_bf16(o[4], o[5]); w.w = cvt_pk_bf16(o[6], o[7]);
                *(u32x4*)(hff + (size_t)(row0 + ai * 128 + m * 16) * DFF + col0) = w; }
    }
};
struct EpiDown {
    static constexpr bool HAS_TAB = false; static constexpr int MID_T = -1;
    float* h; float* ssq3;
    __device__ __forceinline__ void prep(const pg8::Unit&, LAS float*, int) const {}
    __device__ __forceinline__ void operator()(const f32x4 (&acc)[2][2][4][2], const pg8::Unit& u, LAS const float*, int wr, int wc, int fr, int fq) const {
        const int row0 = u.pm * 256 + wr * 64 + fr, col0 = u.pn * 256 + wc * 32 + 8 * fq;
#pragma unroll
        for (int ai = 0; ai < 2; ++ai)
#pragma unroll
            for (int m = 0; m < 4; ++m) { const int row = row0 + ai * 128 + m * 16; const size_t off = (size_t)row * D_ + col0; float ss = 0.f;
#pragma unroll
                for (int bj = 0; bj < 2; ++bj) {
                    const f32x4 x0 = *(const f32x4*)(h + off + bj * 128), x1 = *(const f32x4*)(h + off + bj * 128 + 4);
                    const f32x4 v0 = acc[ai][bj][m][0] + x0, v1 = acc[ai][bj][m][1] + x1;
                    *(f32x4*)(h + off + bj * 128) = v0; *(f32x4*)(h + off + bj * 128 + 4) = v1;
                    ss += (v0[0] * v0[0] + v0[1] * v0[1]) + (v0[2] * v0[2] + v0[3] * v0[3]) + (v1[0] * v1[0] + v1[1] * v1[1]) + (v1[2] * v1[2] + v1[3] * v1[3]); }
                ss += __shfl_xor(ss, 16); ss += __shfl_xor(ss, 32);
                if (fq == 0) ssq3[ssq_idx(row, u.pn * 4 + wc)] = ss; }
    }
};

__device__ __forceinline__ void p0_tile(LAS float* t, const float* src, int ldsrc, int k0, int c0, int jvalid, bf16_t* dst, int K, int j0, const float* scale, int scale_kmax, int tid) {
    const int jc4 = (tid & 15) * 4, kr0 = tid >> 4;
#pragma unroll
    for (int i = 0; i < 4; ++i) {
        const int kr = kr0 + 32 * i;
        f32x4 v = (f32x4){0.f, 0.f, 0.f, 0.f};
        if (jc4 < jvalid) v = *(const f32x4*)(src + (size_t)(k0 + kr) * ldsrc + c0 + jc4);
        const float s = (scale != nullptr && (k0 + kr) < scale_kmax) ? scale[k0 + kr] : 1.0f;
        t[kr * 65 + jc4 + 0] = v[0] * s; t[kr * 65 + jc4 + 1] = v[1] * s; t[kr * 65 + jc4 + 2] = v[2] * s; t[kr * 65 + jc4 + 3] = v[3] * s;
    }
    __syncthreads();
    const int kp = (tid & 63) * 2, jr0 = tid >> 6;
#pragma unroll
    for (int i = 0; i < 8; ++i) {
        const int j = jr0 + 8 * i;
        if (j < jvalid) { const float a = t[kp * 65 + j], b = t[(kp + 1) * 65 + j];
            *(unsigned*)(dst + (size_t)(j0 + j) * K + k0 + kp) = cvt_pk_bf16(a, b); }
    }
    __syncthreads();
}
__device__ void phase0(const Params& p, LAS unsigned char* lds, int wv) {
    const int lane = lane_id(), wave = wv, tid = wv * 64 + lane, G = gridDim.x;
    LAS float* t = (LAS float*)lds;
    bf16_t* bt_in = (bf16_t*)(p.ws + WS_BTIN);
    bf16_t* xn = (bf16_t*)(p.ws + WS_XN);
    for (int row = blockIdx.x * 8 + wave; row < M_; row += G * 8) {
        const f32x4* xr = (const f32x4*)(p.x + (size_t)row * D_);
        f32x4 v[8]; float ss = 0.f;
#pragma unroll
        for (int i = 0; i < 8; ++i) { v[i] = xr[lane + 64 * i]; ss += (v[i][0] * v[i][0] + v[i][1] * v[i][1]) + (v[i][2] * v[i][2] + v[i][3] * v[i][3]); }
#pragma unroll
        for (int o = 32; o >= 1; o >>= 1) ss += __shfl_xor(ss, o);
        const float rstd = rsqrtf(ss * (1.0f / 2048.0f) + EPS);
#pragma unroll
        for (int i = 0; i < 8; ++i) { const f32x4 g4 = ((const f32x4*)p.norm_mix_g)[lane + 64 * i];
            u32x2 w; w.x = cvt_pk_bf16(v[i][0] * rstd * g4[0], v[i][1] * rstd * g4[1]); w.y = cvt_pk_bf16(v[i][2] * rstd * g4[2], v[i][3] * rstd * g4[3]);
            *(u32x2*)(xn + (size_t)row * D_ + 4 * (lane + 64 * i)) = w; }
    }
    constexpr int U_IN = 16 * 193;
    for (int u = blockIdx.x; u < U_IN; u += G) {
        const int kt = u & 15, jt = u >> 4, j0 = jt * 64; const int jvalid = (jt == 192) ? 32 : 64;
        const int c0 = j0 < 6144 ? j0 : (j0 < 12288 ? j0 + 32 : 6144);
        p0_tile(t, p.w_in, DIN, kt * 128, c0, jvalid, bt_in, D_, j0, nullptr, 0, tid);
    }
}
__device__ void wconv_units(const Params& p, LAS unsigned char* lds, int first, int stride, int wv) {
    const int tid = wv * 64 + lane_id();
    LAS float* t = (LAS float*)lds;
    bf16_t* bt_out = (bf16_t*)((unsigned char*)p.out + DO_BTOUT);
    bf16_t* bt_gu = (bf16_t*)((unsigned char*)p.out + DO_BTGU);
    bf16_t* bt_dn = (bf16_t*)((unsigned char*)p.out + DO_BTDN);
    constexpr int U_OUT = 32 * 32, U_GU = 16 * 176, U_DN = 44 * 32;
    for (int u = first; u < U_OUT + U_GU + U_DN; u += stride) {
        if (u < U_OUT) { const int v = u, kt = v & 31, jt = v >> 5;
            p0_tile(t, p.w_out, D_, kt * 128, jt * 64, 64, bt_out, DMIX, jt * 64, p.ssm_norm_g, 2048, tid); }
        else if (u < U_OUT + U_GU) { const int v = u - U_OUT, kt = v & 15, jt = v >> 4, j0 = jt * 64, pn = j0 >> 8, r0 = j0 & 255;
            p0_tile(t, r0 < 128 ? p.w_gate : p.w_up, DFF, kt * 128, 128 * pn + (r0 & 127), 64, bt_gu, D_, j0, p.norm_ffn_g, 2048, tid); }
        else { const int v = u - U_OUT - U_GU, kt = v % 44, jt = v / 44;
            p0_tile(t, p.w_down, D_, kt * 128, jt * 64, 64, bt_dn, DFF, jt * 64, nullptr, 0, tid); }
    }
}

__device__ void dt_units(const Params& p, LAS unsigned char* lds, int wv) {
    const int lane = lane_id(), w = wv, tid = wv * 64 + lane, fr = lane & 15, fq = lane >> 4;
    const bf16_t* xn = (const bf16_t*)(p.ws + WS_XN);
    const bf16_t* bt = (const bf16_t*)(p.ws + WS_BTIN) + (size_t)NPROJ * D_;
    float* dt = (float*)((unsigned char*)p.out + DO_DT);
    LAS float* red = (LAS float*)lds;
    for (int rb = blockIdx.x; rb < M_ / 64; rb += gridDim.x) {
        const int row0 = rb * 64;
        f32x4 acc[4][2];
#pragma unroll
        for (int m = 0; m < 4; ++m)
#pragma unroll
            for (int n = 0; n < 2; ++n) acc[m][n] = (f32x4){0.f, 0.f, 0.f, 0.f};
#pragma unroll 2
        for (int ks = 0; ks < 8; ++ks) {
            const int kb = w * 256 + ks * 32 + fq * 8;
            bf16x8 a[4], b[2];
#pragma unroll
            for (int m = 0; m < 4; ++m) a[m] = *(const bf16x8*)(xn + (size_t)(row0 + 16 * m + fr) * D_ + kb);
#pragma unroll
            for (int n = 0; n < 2; ++n) b[n] = *(const bf16x8*)(bt + (size_t)(16 * n + fr) * D_ + kb);
#pragma unroll
            for (int m = 0; m < 4; ++m)
#pragma unroll
                for (int n = 0; n < 2; ++n) acc[m][n] = __builtin_amdgcn_mfma_f32_16x16x32_bf16(a[m], b[n], acc[m][n], 0, 0, 0);
        }
#pragma unroll
        for (int m = 0; m < 4; ++m)
#pragma unroll
            for (int n = 0; n < 2; ++n)
#pragma unroll
                for (int j = 0; j < 4; ++j) red[w * 2048 + (16 * m + 4 * fq + j) * 32 + 16 * n + fr] = acc[m][n][j];
        __syncthreads();
        {
            const int idx = tid * 4, r = idx >> 5, c = idx & 31;
            f32x4 s = (f32x4){0.f, 0.f, 0.f, 0.f};
#pragma unroll
            for (int ww = 0; ww < 8; ++ww) s += *(LAS const f32x4*)(red + ww * 2048 + idx);
            const f32x4 bias = *(const f32x4*)(p.ssm_dt_bias + c);
            f32x4 o;
#pragma unroll
            for (int j = 0; j < 4; ++j) { const float v = s[j] + bias[j]; o[j] = v > 20.f ? v : log1pf(expf(v)); }
            *(f32x4*)(dt + (size_t)(row0 + r) * 32 + c) = o;
        }
        __syncthreads();
    }
}

__device__ void bc_conv_phase(const Params& p, LAS unsigned char* lds, int wv) {
    const int tid = wv * 64 + lane_id(), cv = tid & 7, run = tid >> 3;
    bf16_t* proj = (bf16_t*)(p.ws + WS_PROJ);
    LAS u32x4* stash = (LAS u32x4*)lds;
    for (int sq = blockIdx.x; sq < 4 * 32; sq += gridDim.x) {
        const int b = sq >> 5, slab = sq & 31;
        const int xcol = 2048 + slab * 64 + cv * 8;
        float wk[4][8], bs[8];
#pragma unroll
        for (int k = 0; k < 4; ++k) { const f32x4 a = *(const f32x4*)(p.ssm_conv_w + k * 4096 + xcol), c = *(const f32x4*)(p.ssm_conv_w + k * 4096 + xcol + 4);
#pragma unroll
            for (int j = 0; j < 4; ++j) { wk[k][j] = a[j]; wk[k][4 + j] = c[j]; } }
        { const f32x4 a = *(const f32x4*)(p.ssm_conv_b + xcol), c = *(const f32x4*)(p.ssm_conv_b + xcol + 4);
#pragma unroll
          for (int j = 0; j < 4; ++j) { bs[j] = a[j]; bs[4 + j] = c[j]; } }
        __syncthreads();
#pragma unroll 1
        for (int tile = 0; tile < 8; ++tile) {
            bf16_t* base = proj + (size_t)(b * SEQ + tile * 512 + run * 8) * NPROJ + 2048 + xcol;
            u32x4 raw[11];
#pragma unroll
            for (int r = 0; r < 11; ++r) {
                const int row = run * 8 + r - 3;
                if (row >= 0) raw[r] = *(const u32x4*)(base + (long)(r - 3) * NPROJ);
                else raw[r] = (tile == 0) ? (u32x4){0u, 0u, 0u, 0u} : stash[(row + 3) * 8 + cv];
            }
            u32x4 ov[8];
#pragma unroll
            for (int j = 0; j < 8; ++j) {
                float o[8];
#pragma unroll
                for (int q = 0; q < 4; ++q) {
                    const unsigned x0 = raw[j][q], x1 = raw[j + 1][q], x2 = raw[j + 2][q], x3 = raw[j + 3][q];
                    o[2 * q] = silu_f(bs[2 * q] + wk[0][2 * q] * bflo(x0) + wk[1][2 * q] * bflo(x1) + wk[2][2 * q] * bflo(x2) + wk[3][2 * q] * bflo(x3));
                    o[2 * q + 1] = silu_f(bs[2 * q + 1] + wk[0][2 * q + 1] * bfhi(x0) + wk[1][2 * q + 1] * bfhi(x1) + wk[2][2 * q + 1] * bfhi(x2) + wk[3][2 * q + 1] * bfhi(x3));
                }
                ov[j].x = cvt_pk_bf16(o[0], o[1]); ov[j].y = cvt_pk_bf16(o[2], o[3]); ov[j].z = cvt_pk_bf16(o[4], o[5]); ov[j].w = cvt_pk_bf16(o[6], o[7]);
            }
            asm volatile("s_waitcnt vmcnt(0) lgkmcnt(0)" ::: "memory");
            __syncthreads();
            if (run == 63) { stash[0 * 8 + cv] = raw[8]; stash[1 * 8 + cv] = raw[9]; stash[2 * 8 + cv] = raw[10]; }
#pragma unroll
            for (int j = 0; j < 8; ++j) *(u32x4*)(base + (long)j * NPROJ) = ov[j];
            __syncthreads();
        }
    }
}

constexpr int SROW = 272;
constexpr int L_CM = 0, L_BM = 34816, L_BDT = 69632, L_XT = 104448, L_HB = 121856  , L_CS = 156672, L_DT = 157184, L_CW = 157696  ;
__device__ __forceinline__ int swz_off(int row, int kblk) { return row * SROW + ((kblk ^ ((row >> 3) & 7)) << 4); }
__device__ __forceinline__ void ssd_load(u32x4 (&raw)[5], const bf16_t* base, bool first, int l0) {
#pragma unroll
    for (int r = 0; r < 5; ++r) raw[r] = (first && (l0 + r - 3) < 0) ? (u32x4){0u, 0u, 0u, 0u} : *(const u32x4*)(base + (long)(r - 3) * NPROJ);
}
template <int GI>
__device__ __forceinline__ void ssd_conv(LAS unsigned char* lds, const u32x4 (&raw)[5], int cv, int l0, float sa, float sb) {
    LAS const f32x4* cw = (LAS const f32x4*)(lds + L_CW) + cv * 10;
    float o0[8], o1[8];
#pragma unroll
    for (int hq = 0; hq < 2; ++hq) {
        const f32x4 w0 = cw[0 + hq], w1 = cw[2 + hq], w2 = cw[4 + hq], w3 = cw[6 + hq], bs = cw[8 + hq];
#pragma unroll
        for (int e2 = 0; e2 < 2; ++e2) {
            const int q = hq * 2 + e2;
            const unsigned x0 = raw[0][q], x1 = raw[1][q], x2 = raw[2][q], x3 = raw[3][q], x4 = raw[4][q];
            const int ea = e2 * 2, eb = e2 * 2 + 1;
            const float va = bs[ea] + w0[ea] * bflo(x0) + w1[ea] * bflo(x1) + w2[ea] * bflo(x2) + w3[ea] * bflo(x3);
            const float vb = bs[eb] + w0[eb] * bfhi(x0) + w1[eb] * bfhi(x1) + w2[eb] * bfhi(x2) + w3[eb] * bfhi(x3);
            const float ua = bs[ea] + w0[ea] * bflo(x1) + w1[ea] * bflo(x2) + w2[ea] * bflo(x3) + w3[ea] * bflo(x4);
            const float ub = bs[eb] + w0[eb] * bfhi(x1) + w1[eb] * bfhi(x2) + w2[eb] * bfhi(x3) + w3[eb] * bfhi(x4);
            o0[2 * q] = silu_f(va); o0[2 * q + 1] = silu_f(vb); o1[2 * q] = silu_f(ua); o1[2 * q + 1] = silu_f(ub);
        }
    }
    if (GI == 0) {
#pragma unroll
        for (int e = 0; e < 8; ++e) { const int prow = cv * 8 + e;
            *(LAS unsigned*)(lds + L_XT + swz_off(prow, l0 >> 3) + (l0 & 7) * 2) = cvt_pk_bf16(o0[e] * sa, o1[e] * sb); }
    } else {
        u32x4 w0; w0.x = cvt_pk_bf16(o0[0], o0[1]); w0.y = cvt_pk_bf16(o0[2], o0[3]); w0.z = cvt_pk_bf16(o0[4], o0[5]); w0.w = cvt_pk_bf16(o0[6], o0[7]);
        u32x4 w1; w1.x = cvt_pk_bf16(o1[0], o1[1]); w1.y = cvt_pk_bf16(o1[2], o1[3]); w1.z = cvt_pk_bf16(o1[4], o1[5]); w1.w = cvt_pk_bf16(o1[6], o1[7]);
        const int nb = ((GI - 1) & 1) * 64 + cv * 8;
        if (GI < 3) {
            *(LAS u32x4*)(lds + L_BM + l0 * SROW + nb * 2) = w0; *(LAS u32x4*)(lds + L_BM + (l0 + 1) * SROW + nb * 2) = w1;
#pragma unroll
            for (int e = 0; e < 8; ++e) { const int nrow = nb + e;
                *(LAS unsigned*)(lds + L_BDT + swz_off(nrow, l0 >> 3) + (l0 & 7) * 2) = cvt_pk_bf16(o0[e] * sa, o1[e] * sb); }
        } else {
            *(LAS u32x4*)(lds + L_CM + l0 * SROW + nb * 2) = w0; *(LAS u32x4*)(lds + L_CM + (l0 + 1) * SROW + nb * 2) = w1;
        }
    }
}
template <int GI>
__device__ __forceinline__ void ssd_put(LAS unsigned char* lds, const u32x4 (&rw)[2], int cv, int l0, float sa, float sb) {
    const int nb = ((GI - 1) & 1) * 64 + cv * 8;
    if (GI < 3) {
        *(LAS u32x4*)(lds + L_BM + l0 * SROW + nb * 2) = rw[0]; *(LAS u32x4*)(lds + L_BM + (l0 + 1) * SROW + nb * 2) = rw[1];
#pragma unroll
        for (int q = 0; q < 4; ++q) {
            *(LAS unsigned*)(lds + L_BDT + swz_off(nb + 2 * q, l0 >> 3) + (l0 & 7) * 2) = cvt_pk_bf16(bflo(rw[0][q]) * sa, bflo(rw[1][q]) * sb);
            *(LAS unsigned*)(lds + L_BDT + swz_off(nb + 2 * q + 1, l0 >> 3) + (l0 & 7) * 2) = cvt_pk_bf16(bfhi(rw[0][q]) * sa, bfhi(rw[1][q]) * sb);
        }
    } else {
        *(LAS u32x4*)(lds + L_CM + l0 * SROW + nb * 2) = rw[0]; *(LAS u32x4*)(lds + L_CM + (l0 + 1) * SROW + nb * 2) = rw[1];
    }
}
__device__ void ssd_unit(const Params& p, LAS unsigned char* lds, int b, int h, int wv) {
    const int lane = lane_id(), w = wv, tid = wv * 64 + lane, fr = lane & 15, fq = lane >> 4;
    const int g = h >> 2;
    const bf16_t* proj = (const bf16_t*)(p.ws + WS_PROJ);
    const float* dtg = (const float*)((const unsigned char*)p.out + DO_DT);
    bf16_t* ymix = (bf16_t*)(p.ws + WS_YMIX);
    float* ssq1 = (float*)((unsigned char*)p.out + DO_SSQ1);
    LAS float* CSv = (LAS float*)(lds + L_CS);
    LAS float* DTv = (LAS float*)(lds + L_DT);
    LAS float* CW = (LAS float*)(lds + L_CW);
    const float Aneg = -__expf(p.ssm_A_log[h]);
    const float Dh = p.ssm_D[h];
    for (int idx = tid; idx < 320; idx += 512) {
        const int e = idx & 7, k = (idx >> 3) % 5, cvi = idx / 40;
        const int xcol = h * 64 + cvi * 8 + e;
        CW[idx] = (k < 4) ? p.ssm_conv_w[k * 4096 + xcol] : p.ssm_conv_b[xcol];
    }
    for (int idx = tid; idx < 64 * 17; idx += 512) *(LAS u32x4*)(lds + L_HB + idx * 16) = (u32x4){0u, 0u, 0u, 0u};
    f32x4 Hacc[4];
#pragma unroll
    for (int pt = 0; pt < 4; ++pt) Hacc[pt] = (f32x4){0.f, 0.f, 0.f, 0.f};
    __syncthreads();
    const int cv = lane & 7;
    const int l0 = 16 * w + 2 * (lane >> 3);
    const int srcl = (w & 3) * 16 + 2 * (lane >> 3);
    u32x4 r0[5], r1[2], r2[2], r3[2], r4[2];
    const bf16_t* pbase = proj + (size_t)(b * SEQ + l0) * NPROJ + 2048 + cv * 8;
    const int xc0 = h * 64, xc1 = 2048 + g * 128, xc2 = xc1 + 64, xc3 = 3072 + g * 128, xc4 = xc3 + 64;
    ssd_load(r0, pbase + xc0, true, l0);
    r1[0] = *(const u32x4*)(pbase + xc1); r1[1] = *(const u32x4*)(pbase + xc1 + NPROJ); r2[0] = *(const u32x4*)(pbase + xc2); r2[1] = *(const u32x4*)(pbase + xc2 + NPROJ);
    r3[0] = *(const u32x4*)(pbase + xc3); r3[1] = *(const u32x4*)(pbase + xc3 + NPROJ); r4[0] = *(const u32x4*)(pbase + xc4); r4[1] = *(const u32x4*)(pbase + xc4 + NPROJ);
    float dt0n = dtg[(size_t)(b * SEQ + lane) * 32 + h], dt1n = dtg[(size_t)(b * SEQ + 64 + lane) * 32 + h];
    for (int c = 0; c < 32; ++c) {
        const int row0 = b * SEQ + c * 128;
        const float dt0 = dt0n, dt1 = dt1n;
        float a0 = dt0 * Aneg, a1 = dt1 * Aneg;
#pragma unroll
        for (int o = 1; o < 64; o <<= 1) { const float t0 = __shfl_up(a0, o), t1 = __shfl_up(a1, o); if (lane >= o) { a0 += t0; a1 += t1; } }
        a1 += __shfl(a0, 63);
        const float cs_end = __shfl(a1, 63);
        if (w == 0) { CSv[lane] = a0; CSv[64 + lane] = a1; DTv[lane] = dt0; DTv[64 + lane] = dt1; }
        const float csv = (w >= 4) ? a1 : a0, dtv = (w >= 4) ? dt1 : dt0;
        const float cs_l0 = __shfl(csv, srcl), cs_l1 = __shfl(csv, srcl + 1), dt_l0 = __shfl(dtv, srcl), dt_l1 = __shfl(dtv, srcl + 1);
        const float dec0 = __expf(cs_end - cs_l0), dec1 = __expf(cs_end - cs_l1);
        ssd_conv<0>(lds, r0, cv, l0, dt_l0, dt_l1);
        ssd_put<1>(lds, r1, cv, l0, dec0, dec1); ssd_put<2>(lds, r2, cv, l0, dec0, dec1);
        ssd_put<3>(lds, r3, cv, l0, 0.f, 0.f);   ssd_put<4>(lds, r4, cv, l0, 0.f, 0.f);
        __builtin_amdgcn_sched_barrier(0);
        if (c + 1 < 32) {
            const bf16_t* cb = pbase + (size_t)(c + 1) * 128 * NPROJ;
            ssd_load(r0, cb + xc0, false, l0);
            r1[0] = *(const u32x4*)(cb + xc1); r1[1] = *(const u32x4*)(cb + xc1 + NPROJ); r2[0] = *(const u32x4*)(cb + xc2); r2[1] = *(const u32x4*)(cb + xc2 + NPROJ);
            r3[0] = *(const u32x4*)(cb + xc3); r3[1] = *(const u32x4*)(cb + xc3 + NPROJ); r4[0] = *(const u32x4*)(cb + xc4); r4[1] = *(const u32x4*)(cb + xc4 + NPROJ);
            dt0n = dtg[(size_t)(row0 + 128 + lane) * 32 + h]; dt1n = dtg[(size_t)(row0 + 192 + lane) * 32 + h];
        }
        __builtin_amdgcn_sched_barrier(0);
        u32x2 zr[4];
#pragma unroll
        for (int pt = 0; pt < 4; ++pt) zr[pt] = *(const u32x2*)(proj + (size_t)(row0 + 16 * w + fr) * NPROJ + h * 64 + 16 * pt + 4 * fq);
        __syncthreads();
        const int lrow = 16 * w + fr;
        const int hb_cur = L_HB + (c & 1) * 17408, hb_nxt = L_HB + ((c + 1) & 1) * 17408;
        bf16x8 cf[4];
#pragma unroll
        for (int ks = 0; ks < 4; ++ks) cf[ks] = *(LAS const bf16x8*)(lds + L_CM + lrow * SROW + (32 * ks + 8 * fq) * 2);
        const float cs_l = CSv[lrow], dt_l = DTv[lrow];
        asm volatile("" ::: "memory");
        f32x4 y[4];
        { const float el = __expf(cs_l);
#pragma unroll
          for (int pt = 0; pt < 4; ++pt) { f32x4 a = (f32x4){0.f, 0.f, 0.f, 0.f};
#pragma unroll
            for (int ks = 0; ks < 4; ++ks) { const bf16x8 hf = *(LAS const bf16x8*)(lds + hb_cur + (16 * pt + fr) * SROW + (32 * ks + 8 * fq) * 2);
                a = __builtin_amdgcn_mfma_f32_16x16x32_bf16(hf, cf[ks], a, 0, 0, 0); }
            y[pt] = a * el; } }
#pragma unroll
        for (int j = 0; j < 8; ++j) {
            if (j <= w) {
                f32x4 gacc = (f32x4){0.f, 0.f, 0.f, 0.f};
#pragma unroll
                for (int ks = 0; ks < 4; ++ks) { const bf16x8 bf = *(LAS const bf16x8*)(lds + L_BM + (16 * j + fr) * SROW + (32 * ks + 8 * fq) * 2);
                    gacc = __builtin_amdgcn_mfma_f32_16x16x32_bf16(bf, cf[ks], gacc, 0, 0, 0); }
                const f32x4 css = *(LAS const f32x4*)(CSv + 16 * j + 4 * fq);
                float mv[4];
#pragma unroll
                for (int i = 0; i < 4; ++i) { const int sx = 16 * j + 4 * fq + i; float v = gacc[i] * __expf(cs_l - css[i]);
                    if (j == w) { v = (sx <= lrow) ? v : 0.f; if (sx == lrow) v += Dh / dt_l; }
                    mv[i] = v; }
                u32x2 wv2; wv2.x = cvt_pk_bf16(mv[0], mv[1]); wv2.y = cvt_pk_bf16(mv[2], mv[3]);
                *(LAS u32x2*)(lds + L_CM + lrow * SROW + (16 * j + 4 * fq) * 2) = wv2;
            } else if (j == w + 1 && (w & 1) == 0) {
                *(LAS u32x2*)(lds + L_CM + lrow * SROW + (16 * j + 4 * fq) * 2) = (u32x2){0u, 0u};
            }
        }
        asm volatile("" ::: "memory");
        { const float de = __expf(cs_end);
#pragma unroll
          for (int pt = 0; pt < 4; ++pt) Hacc[pt] *= de; }
        const int nks2 = (w >> 1) + 1;
#pragma unroll
        for (int ks = 0; ks < 4; ++ks) {
            bf16x8 xf[4];
#pragma unroll
            for (int pt = 0; pt < 4; ++pt) xf[pt] = *(LAS const bf16x8*)(lds + L_XT + swz_off(16 * pt + fr, 4 * ks + fq));
            if (ks < nks2) { const bf16x8 mf = *(LAS const bf16x8*)(lds + L_CM + lrow * SROW + (32 * ks + 8 * fq) * 2);
#pragma unroll
                for (int pt = 0; pt < 4; ++pt) y[pt] = __builtin_amdgcn_mfma_f32_16x16x32_bf16(xf[pt], mf, y[pt], 0, 0, 0); }
            const bf16x8 bdf = *(LAS const bf16x8*)(lds + L_BDT + swz_off(16 * w + fr, 4 * ks + fq));
#pragma unroll
            for (int pt = 0; pt < 4; ++pt) Hacc[pt] = __builtin_amdgcn_mfma_f32_16x16x32_bf16(bdf, xf[pt], Hacc[pt], 0, 0, 0);
        }
#pragma unroll
        for (int pt = 0; pt < 4; ++pt) { u32x2 wv2; wv2.x = cvt_pk_bf16(Hacc[pt][0], Hacc[pt][1]); wv2.y = cvt_pk_bf16(Hacc[pt][2], Hacc[pt][3]);
            *(LAS u32x2*)(lds + hb_nxt + (16 * pt + fr) * SROW + (16 * w + 4 * fq) * 2) = wv2; }
        { float ss = 0.f; const size_t orow = (size_t)(row0 + lrow);
#pragma unroll
          for (int pt = 0; pt < 4; ++pt) {
            const float z0 = bflo(zr[pt].x), z1 = bfhi(zr[pt].x), z2 = bflo(zr[pt].y), z3 = bfhi(zr[pt].y);
            const float v0 = y[pt][0] * silu_f(z0), v1 = y[pt][1] * silu_f(z1), v2 = y[pt][2] * silu_f(z2), v3 = y[pt][3] * silu_f(z3);
            ss += (v0 * v0 + v1 * v1) + (v2 * v2 + v3 * v3);
            u32x2 wv; wv.x = cvt_pk_bf16(v0, v1); wv.y = cvt_pk_bf16(v2, v3);
            *(u32x2*)(ymix + orow * DMIX + h * 64 + 16 * pt + 4 * fq) = wv; }
          ss += __shfl_xor(ss, 16); ss += __shfl_xor(ss, 32);
          if (fq == 0) ssq1[ssq_idx((int)orow, h)] = ss; }
        __syncthreads();
    }
}
__device__ void sc_unit(const Params& p, int unit, int wv) {
    const int tid = wv * 64 + lane_id(), cvx = tid & 255, th = tid >> 8;
    const bf16_t* proj = (const bf16_t*)(p.ws + WS_PROJ);
    bf16_t* ymix = (bf16_t*)(p.ws + WS_YMIX);
    const int t0 = unit * 64 + th * 32, c0 = cvx * 8;
    float w0[8], w1[8], w2[8];
    { const f32x4* a = (const f32x4*)(p.sc_conv_w + c0); const f32x4* bq = (const f32x4*)(p.sc_conv_w + 2048 + c0); const f32x4* cq = (const f32x4*)(p.sc_conv_w + 4096 + c0);
#pragma unroll
      for (int q = 0; q < 2; ++q) { const f32x4 x0 = a[q], x1 = bq[q], x2 = cq[q];
#pragma unroll
        for (int j = 0; j < 4; ++j) { w0[q * 4 + j] = x0[j]; w1[q * 4 + j] = x1[j]; w2[q * 4 + j] = x2[j]; } } }
    float pm1[8], pm2[8];
#pragma unroll
    for (int e = 0; e < 8; ++e) { pm1[e] = 0.f; pm2[e] = 0.f; }
    if ((t0 & (SEQ - 1)) != 0) {
        const bf16_t* r2 = proj + (size_t)(t0 - 2) * NPROJ, * r1 = proj + (size_t)(t0 - 1) * NPROJ;
        const u32x4 c2 = *(const u32x4*)(r2 + 8192 + c0), x2 = *(const u32x4*)(r2 + 10240 + c0), c1 = *(const u32x4*)(r1 + 8192 + c0), x1 = *(const u32x4*)(r1 + 10240 + c0);
#pragma unroll
        for (int q = 0; q < 4; ++q) { pm2[2 * q] = bflo(c2[q]) * bflo(x2[q]); pm2[2 * q + 1] = bfhi(c2[q]) * bfhi(x2[q]); pm1[2 * q] = bflo(c1[q]) * bflo(x1[q]); pm1[2 * q + 1] = bfhi(c1[q]) * bfhi(x1[q]); }
    }
#pragma unroll 4
    for (int i = 0; i < 32; ++i) {
        const bf16_t* r = proj + (size_t)(t0 + i) * NPROJ;
        const u32x4 gb = *(const u32x4*)(r + 6144 + c0), gc = *(const u32x4*)(r + 8192 + c0), gx = *(const u32x4*)(r + 10240 + c0);
        float o[8];
#pragma unroll
        for (int q = 0; q < 4; ++q) {
            const float pa = bflo(gc[q]) * bflo(gx[q]), pb = bfhi(gc[q]) * bfhi(gx[q]);
            o[2 * q] = bflo(gb[q]) * (w0[2 * q] * pm2[2 * q] + w1[2 * q] * pm1[2 * q] + w2[2 * q] * pa);
            o[2 * q + 1] = bfhi(gb[q]) * (w0[2 * q + 1] * pm2[2 * q + 1] + w1[2 * q + 1] * pm1[2 * q + 1] + w2[2 * q + 1] * pb);
            pm2[2 * q] = pm1[2 * q]; pm2[2 * q + 1] = pm1[2 * q + 1]; pm1[2 * q] = pa; pm1[2 * q + 1] = pb;
        }
        u32x4 wv; wv.x = cvt_pk_bf16(o[0], o[1]); wv.y = cvt_pk_bf16(o[2], o[3]); wv.z = cvt_pk_bf16(o[4], o[5]); wv.w = cvt_pk_bf16(o[6], o[7]);
        *(u32x4*)(ymix + (size_t)(t0 + i) * DMIX + 2048 + c0) = wv;
    }
}
__device__ void phase2(const Params& p, LAS unsigned char* lds, int wv) {
    const int G = gridDim.x, bid = blockIdx.x;
    const bool split = G >= 256;
    if (!split || bid < 128) { for (int u = bid; u < 128; u += (split ? 128 : G)) ssd_unit(p, lds, u >> 5, u & 31, wv); }
    if (!split || bid >= 128) { for (int u = (split ? bid - 128 : bid); u < M_ / 64; u += (split ? G - 128 : G)) sc_unit(p, u, wv); }
    if (!split || bid >= 128) wconv_units(p, lds, split ? bid - 128 : bid, split ? G - 128 : G, wv);
}

__device__ void phase6(const Params& p, int wv) {
    const int lane = lane_id(), wave = wv;
    const float* h2 = (const float*)(p.ws + WS_H1F);
    const float* ssq3 = (const float*)(p.ws + WS_SSQ3);
    for (int row = blockIdx.x * 8 + wave; row < M_; row += gridDim.x * 8) {
        float s = (lane < 32) ? ssq3[ssq_idx(row, lane)] : 0.f;
#pragma unroll
        for (int o = 32; o >= 1; o >>= 1) s += __shfl_xor(s, o);
        const float rstd = rsqrtf(s * (1.0f / 2048.0f) + EPS);
        const f32x4* hr = (const f32x4*)(h2 + (size_t)row * D_);
        f32x4* orow = (f32x4*)(p.out + (size_t)row * D_);
#pragma unroll
        for (int i = 0; i < 8; ++i) { const f32x4 v = hr[lane + 64 * i], g4 = ((const f32x4*)p.norm_final_g)[lane + 64 * i]; orow[lane + 64 * i] = v * rstd * g4; }
    }
}


#define XB_TMO      128
#define XB_XCNT(j)  (256  + 64 * (j))
#define XB_XSUB(j)  (1280 + 64 * (j))
#define XB_XGEN(j)  (2304 + 64 * (j))
#define XB_TOP      3328
#define XB_TOPGEN   3392
#define XCD_BAR_WORDS 3456
#define XB_SPIN_CAP (1u << 18)
__device__ __forceinline__ unsigned xb_ld(unsigned* p)              { return __hip_atomic_load(p, __ATOMIC_RELAXED, __HIP_MEMORY_SCOPE_AGENT); }
__device__ __forceinline__ unsigned xb_add(unsigned* p, unsigned v) { return __hip_atomic_fetch_add(p, v, __ATOMIC_RELAXED, __HIP_MEMORY_SCOPE_AGENT); }
__device__ __forceinline__ unsigned xb_xcc_id() { return (unsigned)__builtin_amdgcn_s_getreg((3 << 11) | 20) & 0xFu; }
#define XB_SPIN(cond, bar) do { unsigned _sp = 0; while (cond) { __builtin_amdgcn_s_sleep(1); \
    if ((++_sp & 255u) == 0u) { if (xb_ld(&(bar)[XB_TMO])) break; if (_sp > XB_SPIN_CAP) { atomicAdd(&(bar)[XB_TMO], 1u); break; } } } } while (0)
struct XcdBarrier { unsigned* bar; unsigned x; volatile LAS unsigned* st; };
__device__ __forceinline__ void xcd_barrier_complete(unsigned* bar, unsigned x, unsigned& nloc, unsigned& nx) {
    const unsigned G = gridDim.x * gridDim.y * gridDim.z;
    unsigned sum, cnt, mine, sp = 0u;
    for (;;) {
        sum = 0u; cnt = 0u; mine = 0u;
#pragma unroll
        for (unsigned j = 0; j < 16; ++j) { const unsigned c = xb_ld(&bar[XB_XCNT(j)]); sum += c; cnt += (c > 0u) ? 1u : 0u; mine = (j == x) ? c : mine; }
        if (sum == G) break;
        __builtin_amdgcn_s_sleep(1);
        if ((++sp & 255u) == 0u) { if (xb_ld(&bar[XB_TMO])) break; if (sp > XB_SPIN_CAP) { atomicAdd(&bar[XB_TMO], 1u); break; } }
    }
    nloc = mine > 0u ? mine : 1u; nx = cnt > 0u ? cnt : 1u;
}
__device__ __forceinline__ void xcd_barrier(const XcdBarrier& b, bool leader) {
    asm volatile("s_waitcnt vmcnt(0)" ::: "memory");
    __syncthreads();
    if (leader) {
        unsigned* bar = b.bar;
        __builtin_amdgcn_s_waitcnt(0);
        unsigned nloc = b.st[0], nx = b.st[1];
        if (nloc == 0u) { xcd_barrier_complete(bar, b.x, nloc, nx); b.st[0] = nloc; b.st[1] = nx; }
        const unsigned old = xb_add(&bar[XB_XSUB(b.x)], 1u);
        const unsigned gen = old / nloc;
        if (old + 1u == (gen + 1u) * nloc) {
            __builtin_amdgcn_fence(__ATOMIC_RELEASE, "agent");
            asm volatile("s_waitcnt vmcnt(0)" ::: "memory");
            const unsigned og = xb_add(&bar[XB_TOP], 1u);
            const unsigned tg = og / nx;
            if (og + 1u == (tg + 1u) * nx) xb_add(&bar[XB_TOPGEN], 1u);
            else XB_SPIN(xb_ld(&bar[XB_TOPGEN]) == tg, bar);
            __builtin_amdgcn_fence(__ATOMIC_ACQUIRE, "agent");
            xb_add(&bar[XB_XGEN(b.x)], 1u);
            asm volatile("s_waitcnt vmcnt(0)" ::: "memory");
        } else {
            XB_SPIN(xb_ld(&bar[XB_XGEN(b.x)]) == gen, bar);
            __builtin_amdgcn_fence(__ATOMIC_ACQUIRE, "agent");
            asm volatile("s_waitcnt vmcnt(0)" ::: "memory");
        }
    }
    __syncthreads();
}

__global__ void __launch_bounds__(512) hymba_fwd(Params p) {
    extern __shared__ __attribute__((aligned(16))) unsigned char shm[];
    LAS unsigned char* lds = (LAS unsigned char*)shm;
    cg::grid_group grid = cg::this_grid();
    const int lo = p.ph_lo, hi = p.ph_hi;
    const int wv = __builtin_amdgcn_readfirstlane(threadIdx.x >> 6);
#ifdef DBG_CLEAR
    for (int i = threadIdx.x; i < LDS_BYTES / 16; i += 512) *(LAS u32x4*)(lds + i * 16) = (u32x4){0u, 0u, 0u, 0u};
    __syncthreads();
#endif
#define IN(k) (lo <= (k) && (k) < hi)
#define SEAM(k) do { if (IN(k) && IN((k) + 1)) { \
        asm volatile("s_waitcnt vmcnt(0) lgkmcnt(0)" ::: "memory"); __syncthreads();                 \
        if (wv == 0) { __builtin_amdgcn_fence(__ATOMIC_RELEASE, "agent"); asm volatile("s_waitcnt vmcnt(0)" ::: "memory"); }     \
        grid.sync(); \
        if (wv == 0) { __builtin_amdgcn_fence(__ATOMIC_ACQUIRE, "agent"); asm volatile("s_waitcnt vmcnt(0)" ::: "memory"); }     \
        __syncthreads(); } } while (0)
    volatile LAS unsigned* xst = (volatile LAS unsigned*)(lds + LDS_BYTES - 16);
    const bool xlead = (wv == 0) && (lane_id() == 0);
    if (xlead) { xst[0] = 0u; xst[1] = 0u; }
    __syncthreads();
    XcdBarrier xb; xb.bar = (unsigned*)((unsigned char*)p.out + DO_XBAR); xb.x = xb_xcc_id(); xb.st = xst;
    if (xlead) (void)xb_add(&xb.bar[XB_XCNT(xb.x)], 1u);
#define XSEAM(k) do { if (IN(k) && IN((k) + 1)) xcd_barrier(xb, (wv == 0) && (lane_id() == 0)); } while (0)
    if (IN(0)) for (int rep = 0; rep < NREP(0); ++rep) phase0(p, lds, wv);
    XSEAM(0);
    if (IN(1)) for (int rep = 0; rep < NREP(1); ++rep) {
        pg8::Gemm g{(const bf16_t*)(p.ws + WS_XN), (const bf16_t*)(p.ws + WS_BTIN), M_, NPROJ, D_}; pg8::StaticOrder S; S.init(M_, NPROJ, gridDim.x, blockIdx.x);
        EpiProj E{(bf16_t*)(p.ws + WS_PROJ)};
        pg8::gemm_phase<EpiProj>(lds, g, S, E, wv);
        dt_units(p, lds, wv);
    }
    XSEAM(1);
    if (IN(2)) bc_conv_phase(p, lds, wv);
    XSEAM(2);
    if (IN(3)) for (int rep = 0; rep < NREP(3); ++rep) phase2(p, lds, wv);
    XSEAM(3);
    if (IN(4)) for (int rep = 0; rep < NREP(4); ++rep) {
        pg8::Gemm g{(const bf16_t*)(p.ws + WS_YMIX), (const bf16_t*)((unsigned char*)p.out + DO_BTOUT), M_, D_, DMIX}; pg8::StaticOrder S; S.init(M_, D_, gridDim.x, blockIdx.x);
        EpiOut E{p.x, (float*)(p.ws + WS_H1F), (bf16_t*)(p.ws + WS_H1B), (const float*)((unsigned char*)p.out + DO_SSQ1), (float*)((unsigned char*)p.out + DO_SSQ2)};
        pg8::gemm_phase<EpiOut>(lds, g, S, E, wv);
    }
    XSEAM(4);
    if (IN(5)) for (int rep = 0; rep < NREP(5); ++rep) {
        pg8::Gemm g{(const bf16_t*)(p.ws + WS_H1B), (const bf16_t*)((unsigned char*)p.out + DO_BTGU), M_, NGU, D_}; pg8::StaticOrder S; S.init(M_, NGU, gridDim.x, blockIdx.x);
        EpiGU E{(const float*)((unsigned char*)p.out + DO_SSQ2), (bf16_t*)(p.ws + WS_HFF)};
        pg8::gemm_phase<EpiGU>(lds, g, S, E, wv);
    }
    XSEAM(5);
    if (IN(6)) {
        pg8::Gemm g{(const bf16_t*)(p.ws + WS_HFF), (const bf16_t*)((unsigned char*)p.out + DO_BTDN), M_, D_, DFF}; pg8::StaticOrder S; S.init(M_, D_, gridDim.x, blockIdx.x);
        EpiDown E{(float*)(p.ws + WS_H1F), (float*)(p.ws + WS_SSQ3)};
        pg8::gemm_phase<EpiDown>(lds, g, S, E, wv);
    }
    SEAM(6);
    if (IN(7)) for (int rep = 0; rep < NREP(7); ++rep) phase6(p, wv);
#undef IN
#undef SEAM
}

extern "C" void kernel_launch(void* const* d_in, const int* in_sizes, int n_in, void* d_out, int out_size, void* d_ws, size_t ws_size, hipStream_t stream) {
    static int grid = 0;
    if (grid == 0) {
        if (n_in != 16 || out_size != M_ * D_ || ws_size < WS_NEED) { fprintf(stderr, "kernel_launch: unexpected shapes (n_in %d out %d ws %zu, need %zu)\n", n_in, out_size, ws_size, (size_t)WS_NEED); grid = -1; return; }
        int dev = 0, cus = 0, per_cu = 0;
        (void)hipGetDevice(&dev);
        (void)hipDeviceGetAttribute(&cus, hipDeviceAttributeMultiprocessorCount, dev);
        if (hipFuncSetAttribute((const void*)hymba_fwd, hipFuncAttributeMaxDynamicSharedMemorySize, LDS_BYTES) != hipSuccess) { fprintf(stderr, "kernel_launch: hipFuncSetAttribute failed\n"); grid = -1; return; }
        if (hipOccupancyMaxActiveBlocksPerMultiprocessor(&per_cu, (const void*)hymba_fwd, 512, LDS_BYTES) != hipSuccess || per_cu < 1) { fprintf(stderr, "kernel_launch: occupancy query failed (%d)\n", per_cu); (void)hipGetLastError(); per_cu = 1; }
        grid = cus * per_cu;
    }
    if (grid < 0) return;
    Params p{};
    p.x = (const float*)d_in[0]; p.norm_mix_g = (const float*)d_in[1]; p.w_in = (const float*)d_in[2]; p.ssm_conv_w = (const float*)d_in[3]; p.ssm_conv_b = (const float*)d_in[4];
    p.ssm_dt_bias = (const float*)d_in[5]; p.ssm_A_log = (const float*)d_in[6]; p.ssm_D = (const float*)d_in[7]; p.ssm_norm_g = (const float*)d_in[8]; p.sc_conv_w = (const float*)d_in[9];
    p.w_out = (const float*)d_in[10]; p.norm_ffn_g = (const float*)d_in[11]; p.w_gate = (const float*)d_in[12]; p.w_up = (const float*)d_in[13]; p.w_down = (const float*)d_in[14]; p.norm_final_g = (const float*)d_in[15];
    p.out = (float*)d_out; p.ws = (unsigned char*)d_ws;
#ifdef DBG_MEMSET
    (void)hipMemsetAsync(d_ws, 0, WS_NEED, stream); (void)hipMemsetAsync(d_out, 0, (size_t)out_size * 4, stream);
#endif
#ifndef N_CUTS
#define N_CUTS 1
#endif
    for (int li = 0; li < N_CUTS; ++li) {
        p.ph_lo = (N_CUTS == 8) ? li : 0; p.ph_hi = (N_CUTS == 8) ? li + 1 : 8;
        (void)hipMemsetAsync((unsigned char*)d_out + DO_XBAR, 0, XCD_BAR_WORDS * sizeof(unsigned), stream);
    void* args[] = {&p};
        hipError_t e = hipLaunchCooperativeKernel((const void*)hymba_fwd, dim3(grid), dim3(512), args, LDS_BYTES, stream);
        if (e != hipSuccess) fprintf(stderr, "kernel_launch: cooperative launch failed: %s (grid %d)\n", hipGetErrorString(e), grid);
    }
}
```

```cpp
#include <hip/hip_runtime.h>
#include <hip/hip_cooperative_groups.h>
#include <cstdio>
namespace cg = cooperative_groups;

#define LAS __attribute__((address_space(3)))
typedef unsigned short bf16_t;
typedef short bf16x8 __attribute__((ext_vector_type(8)));
typedef float f32x4 __attribute__((ext_vector_type(4)));
typedef unsigned u32x4 __attribute__((ext_vector_type(4)));
typedef unsigned u32x2 __attribute__((ext_vector_type(2)));

constexpr int M_ = 16384, D_ = 2048, DIN = 12320, NPROJ = 12288, DFF = 5632, DMIX = 4096, NGU = 11264;
constexpr int SEQ = 4096;
constexpr float EPS = 1e-5f;
constexpr int LDS_BYTES = 159744;
constexpr int XCD_BAR_WORDS_C = 3456;
#ifndef PROBE_PHASE
#define PROBE_PHASE -1
#endif
#define NREP(k) ((PROBE_PHASE == (k)) ? 1 + (p.ph_hi < 100) : 1)
constexpr int TAB_OFF = 131072;

constexpr size_t WS_PROJ = 0;
constexpr size_t WS_R = (size_t)M_ * NPROJ * 2;
constexpr size_t WS_XN = WS_R;
constexpr size_t WS_BTIN = WS_R + (size_t)M_ * D_ * 2;
constexpr size_t WS_YMIX = WS_R;
constexpr size_t WS_H1F = 0;
constexpr size_t WS_H1B = (size_t)M_ * D_ * 4;
constexpr size_t WS_HFF = WS_H1B + (size_t)M_ * D_ * 2;
constexpr size_t WS_SSQ3 = WS_HFF + (size_t)M_ * DFF * 2;
constexpr size_t WS_NEED = WS_R + (size_t)M_ * DMIX * 2;
constexpr size_t DO_BTOUT = 0;
constexpr size_t DO_BTGU = (size_t)D_ * DMIX * 2;
constexpr size_t DO_BTDN = DO_BTGU + (size_t)NGU * D_ * 2;
constexpr size_t DO_DT = DO_BTDN + (size_t)D_ * DFF * 2;
constexpr size_t DO_SSQ1 = DO_DT + (size_t)M_ * 32 * 4;
constexpr size_t DO_SSQ2 = DO_SSQ1 + (size_t)M_ * 32 * 4;
constexpr size_t DO_XBAR = (size_t)M_ * D_ * 4 - 16384;
static_assert(DO_SSQ2 + (size_t)M_ * 32 * 4 <= DO_XBAR && XCD_BAR_WORDS_C * 4 <= 16384, "d_out scratch");

static_assert(WS_SSQ3 + (size_t)M_ * 32 * 4 <= WS_R, "ws overlay");

struct Params {
    const float* x; const float* norm_mix_g; const float* w_in; const float* ssm_conv_w; const float* ssm_conv_b;
    const float* ssm_dt_bias; const float* ssm_A_log; const float* ssm_D; const float* ssm_norm_g; const float* sc_conv_w;
    const float* w_out; const float* norm_ffn_g; const float* w_gate; const float* w_up; const float* w_down; const float* norm_final_g;
    float* out; unsigned char* ws; int ph_lo, ph_hi;
};

typedef float f32x2_t __attribute__((ext_vector_type(2)));
typedef __bf16 bf16x2_t __attribute__((ext_vector_type(2)));
__device__ __forceinline__ unsigned cvt_pk_bf16(float lo, float hi) { const f32x2_t v = {lo, hi}; return __builtin_bit_cast(unsigned, __builtin_convertvector(v, bf16x2_t)); }
__device__ __forceinline__ float bflo(unsigned u) { return __uint_as_float(u << 16); }
__device__ __forceinline__ float bfhi(unsigned u) { return __uint_as_float(u & 0xffff0000u); }
__device__ __forceinline__ int lane_id() { int l; asm volatile("v_mbcnt_lo_u32_b32 %0, -1, 0\n\tv_mbcnt_hi_u32_b32 %0, -1, %0" : "=v"(l)); return l; }
__device__ __forceinline__ float silu_f(float v) { return v * __builtin_amdgcn_rcpf(1.0f + __expf(-v)); }

__device__ __forceinline__ size_t ssq_idx(int row, int part) { return ((size_t)(row >> 5) * 32 + part) * 32 + (row & 31); }

namespace pg8 {
constexpr int BM = 256, BK = 64, HALF = 128, HTB = HALF * BK * 2, STAGE_BYTES = 8 * HTB, NXCD = 8, WGM = 8;
__device__ __forceinline__ int lds_byte(int r, int c) { const int st = (r >> 4) * 2 + (c >> 5), rr = r & 15, cc = c & 31, ob = rr * 64 + cc * 2; return st * 1024 + (ob ^ (((ob >> 9) & 1) << 5)); }
__device__ __forceinline__ void stage_rc(int b, int& R, int& C) { const int st = b / 1024, sb = b % 1024, swz = sb ^ (((sb >> 9) & 1) << 5); R = (st >> 1) * 16 + swz / 64; C = (st & 1) * 32 + (swz % 64) / 2; }
__device__ __forceinline__ int perm32(int rho) { const int n = rho >> 4, i = rho & 15; return 8 * (i >> 2) + 4 * n + (i & 3); }
struct Unit { int pm, pn; };
struct Gemm { const bf16_t* A; const bf16_t* Bt; int M, N, K; };
struct StaticOrder {
    int nM, nN, nwg, G, c;
    __device__ void init(int M, int N, int G_, int c_) { nM = M / BM; nN = N / BM; nwg = nM * nN; G = G_; c = c_; }
    __device__ bool next(int i, Unit& u) const {
        const long L = (long)i * G + c; if (L >= nwg) return false;
        int wgid = (int)L; { const int q = nwg / NXCD, r = nwg % NXCD, xcd = wgid % NXCD, off = wgid / NXCD; wgid = (xcd < r ? xcd * (q + 1) : r * (q + 1) + (xcd - r) * q) + off; }
        const int nig = WGM * nN, gid = wgid / nig, fm = gid * WGM, gsz = (nM - fm) < WGM ? (nM - fm) : WGM;
        u.pm = fm + ((wgid % nig) % gsz); u.pn = (wgid % nig) / gsz; return true;
    }
};
template <class Epi>
__device__ __forceinline__ void gemm_phase(LAS unsigned char* lds, const Gemm g, const StaticOrder& S, const Epi& E, int wv) {
    const int wid = wv, lane = lane_id(), tid = wid * 64 + lane, wr = wid >> 2, wc = wid & 3, fr = lane & 15, fq = lane >> 4;
    const int K = g.K, nt = K / BK;
    unsigned voffA[2], voffB[2];
#pragma unroll
    for (int i = 0; i < 2; ++i) { int R, C; stage_rc(tid * 16 + i * 8192, R, C); const int Rb = (R & ~31) + perm32(R & 31);
        voffA[i] = (unsigned)(R * K + C) * 2u; voffB[i] = (unsigned)(Rb * K + C) * 2u; }
    const size_t kstep = (size_t)(BK * 2);
    const size_t hstep = (size_t)HALF * K * 2;
    const size_t tstep = 2 * hstep;
    const unsigned ldsw = (unsigned)wid * 1024u;
    const int aoff = lds_byte(wr * 64 + fr, fq * 8), boff = lds_byte(wc * 32 + fr, fq * 8);
#define PG8_SA(b, h) (((b) * 2 + (h)) * HTB)
#define PG8_SB(b, h) ((4 + (b) * 2 + (h)) * HTB)
#define PG8_STAGE(bufoff, gbase, voff) do { _Pragma("unroll") for (int _i = 0; _i < 2; ++_i) \
        __builtin_amdgcn_global_load_lds((const unsigned*)((const char*)(gbase) + (voff)[_i]), (LAS unsigned*)(lds + (bufoff) + ldsw + _i * 8192), 16, 0, 0); } while (0)
#define PG8_LDA(dst, b, h) do { _Pragma("unroll") for (int m = 0; m < 4; ++m) _Pragma("unroll") for (int k = 0; k < 2; ++k) dst[m][k] = *(const LAS bf16x8*)(lds + PG8_SA(b, h) + aoff + m * 2048 + k * 1024); } while (0)
#define PG8_LDB(dst, b, h) do { _Pragma("unroll") for (int n = 0; n < 2; ++n) _Pragma("unroll") for (int k = 0; k < 2; ++k) dst[n][k] = *(const LAS bf16x8*)(lds + PG8_SB(b, h) + boff + n * 2048 + k * 1024); } while (0)
#define PG8_MMA(ai, bj, At, Bt) do { __builtin_amdgcn_s_setprio(1); _Pragma("unroll") for (int m = 0; m < 4; ++m) _Pragma("unroll") for (int n = 0; n < 2; ++n) _Pragma("unroll") for (int k = 0; k < 2; ++k) \
        acc[ai][bj][m][n] = __builtin_amdgcn_mfma_f32_16x16x32_bf16(Bt[n][k], At[m][k], acc[ai][bj][m][n], 0, 0, 0); __builtin_amdgcn_s_setprio(0); } while (0)
#define PG8_WAIT_V(n) asm volatile("s_waitcnt vmcnt(" #n ")" ::: "memory")
#define PG8_WAIT_L(n) asm volatile("s_waitcnt lgkmcnt(" #n ")" ::: "memory")
#define PG8_BAR __builtin_amdgcn_s_barrier()
#define PG8_SCHED __builtin_amdgcn_sched_barrier(0)
    Unit cur, nxt; int ui = 0;
    if (!S.next(0, cur)) return;
    f32x4 acc[2][2][4][2];
#pragma unroll
    for (int a = 0; a < 2; ++a)
#pragma unroll
        for (int b = 0; b < 2; ++b)
#pragma unroll
            for (int m = 0; m < 4; ++m)
#pragma unroll
                for (int n = 0; n < 2; ++n) acc[a][b][m][n] = (f32x4){0.f, 0.f, 0.f, 0.f};
    bf16x8 At[4][2], B0[2][2], B1[2][2];
    const char* cA = (const char*)g.A + (size_t)cur.pm * tstep; const char* cB = (const char*)g.Bt + (size_t)cur.pn * tstep;
    if constexpr (Epi::HAS_TAB) {
        Unit uu; for (int i = 0; i < 27 && S.next(i, uu); ++i) E.prep(uu, (LAS float*)(lds + TAB_OFF + i * 1024), tid);
    }
    PG8_STAGE(PG8_SB(0, 0), cB, voffB); PG8_STAGE(PG8_SB(0, 1), cB + hstep, voffB); PG8_STAGE(PG8_SA(0, 0), cA, voffA); PG8_STAGE(PG8_SA(0, 1), cA + hstep, voffA);
    if (wr == 1) PG8_BAR;
    PG8_WAIT_V(2); PG8_BAR;
    PG8_STAGE(PG8_SB(1, 0), cB + kstep, voffB); PG8_STAGE(PG8_SA(1, 0), cA + kstep, voffA); PG8_STAGE(PG8_SB(1, 1), cB + hstep + kstep, voffB);
    PG8_WAIT_V(6); PG8_BAR;
    for (;;) {
        const bool has_next = S.next(ui + 1, nxt);
        const char* nA = has_next ? (const char*)g.A + (size_t)nxt.pm * tstep : cA; const char* nB = has_next ? (const char*)g.Bt + (size_t)nxt.pn * tstep : cB;
        LAS const float* tabc = (LAS const float*)(lds + TAB_OFF + ui * 1024);
        for (int t = 0; t < nt; t += 2) {
            const bool last = (t == nt - 2);
            const char* a1 = cA + (size_t)(t + 1) * kstep;
            const char* a2 = last ? nA : cA + (size_t)(t + 2) * kstep; const char* b2 = last ? nB : cB + (size_t)(t + 2) * kstep;
            const char* a3 = a2 + kstep; const char* b3 = b2 + kstep;
            if constexpr (Epi::MID_T >= 0) { if (t == Epi::MID_T) {
#pragma unroll
                for (int ai = 0; ai < 2; ++ai)
#pragma unroll
                    for (int m = 0; m < 4; ++m) { const float s = tabc[ai * HALF + wr * 64 + m * 16 + fr];
#pragma unroll
                        for (int bj = 0; bj < 2; ++bj)
#pragma unroll
                            for (int n = 0; n < 2; ++n) acc[ai][bj][m][n] *= s; } } }
            PG8_LDB(B0, 0, 0); PG8_LDB(B1, 0, 1); PG8_SCHED; PG8_LDA(At, 0, 0); PG8_STAGE(PG8_SA(1, 1), a1 + hstep, voffA);
            PG8_WAIT_V(8); PG8_WAIT_L(0); PG8_BAR; PG8_MMA(0, 0, At, B0); PG8_MMA(0, 1, At, B1); PG8_BAR; PG8_SCHED;
            PG8_LDA(At, 0, 1); PG8_STAGE(PG8_SB(0, 0), b2, voffB); PG8_STAGE(PG8_SB(0, 1), b2 + hstep, voffB); PG8_STAGE(PG8_SA(0, 0), a2, voffA);
            PG8_WAIT_V(8); PG8_WAIT_L(0); PG8_BAR; PG8_MMA(1, 0, At, B0); PG8_MMA(1, 1, At, B1); PG8_BAR; PG8_SCHED;
            PG8_LDB(B0, 1, 0); PG8_LDB(B1, 1, 1); PG8_SCHED; PG8_LDA(At, 1, 0); PG8_STAGE(PG8_SA(0, 1), a2 + hstep, voffA);
            PG8_WAIT_V(8); PG8_WAIT_L(0); PG8_BAR; PG8_MMA(0, 0, At, B0); PG8_MMA(0, 1, At, B1); PG8_BAR; PG8_SCHED;
            PG8_LDA(At, 1, 1); PG8_STAGE(PG8_SB(1, 0), b3, voffB); PG8_STAGE(PG8_SB(1, 1), b3 + hstep, voffB); PG8_STAGE(PG8_SA(1, 0), a3, voffA);
            PG8_WAIT_V(8); PG8_WAIT_L(0); PG8_BAR; PG8_MMA(1, 0, At, B0); PG8_MMA(1, 1, At, B1); PG8_BAR; PG8_SCHED;
        }
        if (wr == 0) PG8_BAR;
        E(acc, cur, tabc, wr, wc, fr, fq);
        if (!has_next) break;
#pragma unroll
        for (int a = 0; a < 2; ++a)
#pragma unroll
            for (int b = 0; b < 2; ++b)
#pragma unroll
                for (int m = 0; m < 4; ++m)
#pragma unroll
                    for (int n = 0; n < 2; ++n) acc[a][b][m][n] = (f32x4){0.f, 0.f, 0.f, 0.f};
        cur = nxt; cA = nA; cB = nB; ++ui;
        if (wr == 1) PG8_BAR;
    }
    PG8_WAIT_V(0);
    PG8_BAR;
#undef PG8_SA
#undef PG8_SB
#undef PG8_STAGE
#undef PG8_LDA
#undef PG8_LDB
#undef PG8_MMA
#undef PG8_WAIT_V
#undef PG8_WAIT_L
#undef PG8_BAR
#undef PG8_SCHED
}
}

__device__ __forceinline__ void rstd_table(const float* ssq, int row0, LAS float* tab, int t) {
    const int r = t >> 1, hf = t & 1;
    const float* p = ssq + ssq_idx(row0 + r, hf * 16);
    float s = 0.f;
#pragma unroll
    for (int i = 0; i < 16; ++i) s += p[i * 32];
    s += __shfl_xor(s, 1);
    if (!hf) tab[r] = rsqrtf(s * (1.0f / 2048.0f) + EPS);
}

struct EpiProj {
    static constexpr bool HAS_TAB = false; static constexpr int MID_T = -1;
    bf16_t* O;
    __device__ __forceinline__ void prep(const pg8::Unit&, LAS float*, int) const {}
    __device__ __forceinline__ void operator()(const f32x4 (&acc)[2][2][4][2], const pg8::Unit& u, LAS const float*, int wr, int wc, int fr, int fq) const {
        const int row0 = u.pm * 256 + wr * 64 + fr, col0 = u.pn * 256 + wc * 32 + 8 * fq;
#pragma unroll
        for (int ai = 0; ai < 2; ++ai)
#pragma unroll
            for (int m = 0; m < 4; ++m) { bf16_t* rowp = O + (size_t)(row0 + ai * 128 + m * 16) * NPROJ + col0;
#pragma unroll
                for (int bj = 0; bj < 2; ++bj) { const f32x4 v0 = acc[ai][bj][m][0], v1 = acc[ai][bj][m][1];
                    u32x4 w; w.x = cvt_pk_bf16(v0[0], v0[1]); w.y = cvt_pk_bf16(v0[2], v0[3]); w.z = cvt_pk_bf16(v1[0], v1[1]); w.w = cvt_pk_bf16(v1[2], v1[3]);
                    *(u32x4*)(rowp + bj * 128) = w; } }
    }
};
struct EpiOut {
    static constexpr bool HAS_TAB = true; static constexpr int MID_T = 32;
    const float* x; float* h1f; bf16_t* h1b; const float* ssq1; float* ssq2;
    __device__ __forceinline__ void prep(const pg8::Unit& u, LAS float* tab, int t) const { rstd_table(ssq1, u.pm * 256, tab, t); }
    __device__ __forceinline__ void operator()(const f32x4 (&acc)[2][2][4][2], const pg8::Unit& u, LAS const float*, int wr, int wc, int fr, int fq) const {
        const int row0 = u.pm * 256 + wr * 64 + fr, col0 = u.pn * 256 + wc * 32 + 8 * fq;
#pragma unroll
        for (int ai = 0; ai < 2; ++ai)
#pragma unroll
            for (int m = 0; m < 4; ++m) { const int row = row0 + ai * 128 + m * 16; const size_t off = (size_t)row * D_ + col0; float ss = 0.f;
#pragma unroll
                for (int bj = 0; bj < 2; ++bj) {
                    const f32x4 x0 = *(const f32x4*)(x + off + bj * 128), x1 = *(const f32x4*)(x + off + bj * 128 + 4);
                    const f32x4 v0 = acc[ai][bj][m][0] + x0, v1 = acc[ai][bj][m][1] + x1;
                    *(f32x4*)(h1f + off + bj * 128) = v0; *(f32x4*)(h1f + off + bj * 128 + 4) = v1;
                    u32x4 w; w.x = cvt_pk_bf16(v0[0], v0[1]); w.y = cvt_pk_bf16(v0[2], v0[3]); w.z = cvt_pk_bf16(v1[0], v1[1]); w.w = cvt_pk_bf16(v1[2], v1[3]);
                    *(u32x4*)(h1b + off + bj * 128) = w;
                    ss += (v0[0] * v0[0] + v0[1] * v0[1]) + (v0[2] * v0[2] + v0[3] * v0[3]) + (v1[0] * v1[0] + v1[1] * v1[1]) + (v1[2] * v1[2] + v1[3] * v1[3]); }
                ss += __shfl_xor(ss, 16); ss += __shfl_xor(ss, 32);
                if (fq == 0) ssq2[ssq_idx(row, u.pn * 4 + wc)] = ss; }
    }
};
struct EpiGU {
    static constexpr bool HAS_TAB = true; static constexpr int MID_T = -1;
    const float* ssq2; bf16_t* hff;
    __device__ __forceinline__ void prep(const pg8::Unit& u, LAS float* tab, int t) const { rstd_table(ssq2, u.pm * 256, tab, t); }
    __device__ __forceinline__ void operator()(const f32x4 (&acc)[2][2][4][2], const pg8::Unit& u, LAS const float* tab, int wr, int wc, int fr, int fq) const {
        const int row0 = u.pm * 256 + wr * 64 + fr, col0 = u.pn * 128 + wc * 32 + 8 * fq;
#pragma unroll
        for (int ai = 0; ai < 2; ++ai)
#pragma unroll
            for (int m = 0; m < 4; ++m) { const float rs = tab[ai * 128 + wr * 64 + m * 16 + fr];
                float o[8];
#pragma unroll
                for (int n = 0; n < 2; ++n)
#pragma unroll
                    for (int j = 0; j < 4; ++j) { const float gg = acc[ai][0][m][n][j] * rs, uu = acc[ai][1][m][n][j] * rs; o[n * 4 + j] = silu_f(gg) * uu; }
                u32x4 w; w.x = cvt_pk_bf16(o[0], o[1]); w.y = cvt_pk_bf16(o[2], o[3]); w.z = cvt_pk_bf16(o[4], o[5]); w.w = cvt_pk_bf16(o[6], o[7]);
                *(u32x4*)(hff + (size_t)(row0 + ai * 128 + m * 16) * DFF + col0) = w; }
    }
};
struct EpiDown {
    static constexpr bool HAS_TAB = false; static constexpr int MID_T = -1;
    float* h; float* ssq3;
    __device__ __forceinline__ void prep(const pg8::Unit&, LAS float*, int) const {}
    __device__ __forceinline__ void operator()(const f32x4 (&acc)[2][2][4][2], const pg8::Unit& u, LAS const float*, int wr, int wc, int fr, int fq) const {
        const int row0 = u.pm * 256 + wr * 64 + fr, col0 = u.pn * 256 + wc * 32 + 8 * fq;
#pragma unroll
        for (int ai = 0; ai < 2; ++ai)
#pragma unroll
            for (int m = 0; m < 4; ++m) { const int row = row0 + ai * 128 + m * 16; const size_t off = (size_t)row * D_ + col0; float ss = 0.f;
#pragma unroll
                for (int bj = 0; bj < 2; ++bj) {
                    const f32x4 x0 = *(const f32x4*)(h + off + bj * 128), x1 = *(const f32x4*)(h + off + bj * 128 + 4);
                    const f32x4 v0 = acc[ai][bj][m][0] + x0, v1 = acc[ai][bj][m][1] + x1;
                    *(f32x4*)(h + off + bj * 128) = v0; *(f32x4*)(h + off + bj * 128 + 4) = v1;
                    ss += (v0[0] * v0[0] + v0[1] * v0[1]) + (v0[2] * v0[2] + v0[3] * v0[3]) + (v1[0] * v1[0] + v1[1] * v1[1]) + (v1[2] * v1[2] + v1[3] * v1[3]); }
                ss += __shfl_xor(ss, 16); ss += __shfl_xor(ss, 32);
                if (fq == 0) ssq3[ssq_idx(row, u.pn * 4 + wc)] = ss; }
    }
};

__device__ __forceinline__ void p0_tile(LAS float* t, const float* src, int ldsrc, int k0, int c0, int jvalid, bf16_t* dst, int K, int j0, const float* scale, int scale_kmax, int tid) {
    const int jc4 = (tid & 15) * 4, kr0 = tid >> 4;
#pragma unroll
    for (int i = 0; i < 4; ++i) {
        const int kr = kr0 + 32 * i;
        f32x4 v = (f32x4){0.f, 0.f, 0.f, 0.f};
        if (jc4 < jvalid) v = *(const f32x4*)(src + (size_t)(k0 + kr) * ldsrc + c0 + jc4);
        const float s = (scale != nullptr && (k0 + kr) < scale_kmax) ? scale[k0 + kr] : 1.0f;
        t[kr * 65 + jc4 + 0] = v[0] * s; t[kr * 65 + jc4 + 1] = v[1] * s; t[kr * 65 + jc4 + 2] = v[2] * s; t[kr * 65 + jc4 + 3] = v[3] * s;
    }
    __syncthreads();
    const int kp = (tid & 63) * 2, jr0 = tid >> 6;
#pragma unroll
    for (int i = 0; i < 8; ++i) {
        const int j = jr0 + 8 * i;
        if (j < jvalid) { const float a = t[kp * 65 + j], b = t[(kp + 1) * 65 + j];
            *(unsigned*)(dst + (size_t)(j0 + j) * K + k0 + kp) = cvt_pk_bf16(a, b); }
    }
    __syncthreads();
}
__device__ void phase0(const Params& p, LAS unsigned char* lds, int wv) {
    const int lane = lane_id(), wave = wv, tid = wv * 64 + lane, G = gridDim.x;
    LAS float* t = (LAS float*)lds;
    bf16_t* bt_in = (bf16_t*)(p.ws + WS_BTIN);
    bf16_t* xn = (bf16_t*)(p.ws + WS_XN);
    for (int row = blockIdx.x * 8 + wave; row < M_; row += G * 8) {
        const f32x4* xr = (const f32x4*)(p.x + (size_t)row * D_);
        f32x4 v[8]; float ss = 0.f;
#pragma unroll
        for (int i = 0; i < 8; ++i) { v[i] = xr[lane + 64 * i]; ss += (v[i][0] * v[i][0] + v[i][1] * v[i][1]) + (v[i][2] * v[i][2] + v[i][3] * v[i][3]); }
#pragma unroll
        for (int o = 32; o >= 1; o >>= 1) ss += __shfl_xor(ss, o);
        const float rstd = rsqrtf(ss * (1.0f / 2048.0f) + EPS);
#pragma unroll
        for (int i = 0; i < 8; ++i) { const f32x4 g4 = ((const f32x4*)p.norm_mix_g)[lane + 64 * i];
            u32x2 w; w.x = cvt_pk_bf16(v[i][0] * rstd * g4[0], v[i][1] * rstd * g4[1]); w.y = cvt_pk_bf16(v[i][2] * rstd * g4[2], v[i][3] * rstd * g4[3]);
            *(u32x2*)(xn + (size_t)row * D_ + 4 * (lane + 64 * i)) = w; }
    }
    constexpr int U_IN = 16 * 193;
    for (int u = blockIdx.x; u < U_IN; u += G) {
        const int kt = u & 15, jt = u >> 4, j0 = jt * 64; const int jvalid = (jt == 192) ? 32 : 64;
        const int c0 = j0 < 6144 ? j0 : (j0 < 12288 ? j0 + 32 : 6144);
        p0_tile(t, p.w_in, DIN, kt * 128, c0, jvalid, bt_in, D_, j0, nullptr, 0, tid);
    }
}
__device__ void wconv_units(const Params& p, LAS unsigned char* lds, int first, int stride, int wv) {
    const int tid = wv * 64 + lane_id();
    LAS float* t = (LAS float*)lds;
    bf16_t* bt_out = (bf16_t*)((unsigned char*)p.out + DO_BTOUT);
    bf16_t* bt_gu = (bf16_t*)((unsigned char*)p.out + DO_BTGU);
    bf16_t* bt_dn = (bf16_t*)((unsigned char*)p.out + DO_BTDN);
    constexpr int U_OUT = 32 * 32, U_GU = 16 * 176, U_DN = 44 * 32;
    for (int u = first; u < U_OUT + U_GU + U_DN; u += stride) {
        if (u < U_OUT) { const int v = u, kt = v & 31, jt = v >> 5;
            p0_tile(t, p.w_out, D_, kt * 128, jt * 64, 64, bt_out, DMIX, jt * 64, p.ssm_norm_g, 2048, tid); }
        else if (u < U_OUT + U_GU) { const int v = u - U_OUT, kt = v & 15, jt = v >> 4, j0 = jt * 64, pn = j0 >> 8, r0 = j0 & 255;
            p0_tile(t, r0 < 128 ? p.w_gate : p.w_up, DFF, kt * 128, 128 * pn + (r0 & 127), 64, bt_gu, D_, j0, p.norm_ffn_g, 2048, tid); }
        else { const int v = u - U_OUT - U_GU, kt = v % 44, jt = v / 44;
            p0_tile(t, p.w_down, D_, kt * 128, jt * 64, 64, bt_dn, DFF, jt * 64, nullptr, 0, tid); }
    }
}

__device__ void dt_units(const Params& p, LAS unsigned char* lds, int wv) {
    const int lane = lane_id(), w = wv, tid = wv * 64 + lane, fr = lane & 15, fq = lane >> 4;
    const bf16_t* xn = (const bf16_t*)(p.ws + WS_XN);
    const bf16_t* bt = (const bf16_t*)(p.ws + WS_BTIN) + (size_t)NPROJ * D_;
    float* dt = (float*)((unsigned char*)p.out + DO_DT);
    LAS float* red = (LAS float*)lds;
    for (int rb = blockIdx.x; rb < M_ / 64; rb += gridDim.x) {
        const int row0 = rb * 64;
        f32x4 acc[4][2];
#pragma unroll
        for (int m = 0; m < 4; ++m)
#pragma unroll
            for (int n = 0; n < 2; ++n) acc[m][n] = (f32x4){0.f, 0.f, 0.f, 0.f};
#pragma unroll 2
        for (int ks = 0; ks < 8; ++ks) {
            const int kb = w * 256 + ks * 32 + fq * 8;
            bf16x8 a[4], b[2];
#pragma unroll
            for (int m = 0; m < 4; ++m) a[m] = *(const bf16x8*)(xn + (size_t)(row0 + 16 * m + fr) * D_ + kb);
#pragma unroll
            for (int n = 0; n < 2; ++n) b[n] = *(const bf16x8*)(bt + (size_t)(16 * n + fr) * D_ + kb);
#pragma unroll
            for (int m = 0; m < 4; ++m)
#pragma unroll
                for (int n = 0; n < 2; ++n) acc[m][n] = __builtin_amdgcn_mfma_f32_16x16x32_bf16(a[m], b[n], acc[m][n], 0, 0, 0);
        }
#pragma unroll
        for (int m = 0; m < 4; ++m)
#pragma unroll
            for (int n = 0; n < 2; ++n)
#pragma unroll
                for (int j = 0; j < 4; ++j) red[w * 2048 + (16 * m + 4 * fq + j) * 32 + 16 * n + fr] = acc[m][n][j];
        __syncthreads();
        {
            const int idx = tid * 4, r = idx >> 5, c = idx & 31;
            f32x4 s = (f32x4){0.f, 0.f, 0.f, 0.f};
#pragma unroll
            for (int ww = 0; ww < 8; ++ww) s += *(LAS const f32x4*)(red + ww * 2048 + idx);
            const f32x4 bias = *(const f32x4*)(p.ssm_dt_bias + c);
            f32x4 o;
#pragma unroll
            for (int j = 0; j < 4; ++j) { const float v = s[j] + bias[j]; o[j] = v > 20.f ? v : log1pf(expf(v)); }
            *(f32x4*)(dt + (size_t)(row0 + r) * 32 + c) = o;
        }
        __syncthreads();
    }
}

__device__ void bc_conv_phase(const Params& p, LAS unsigned char* lds, int wv) {
    const int tid = wv * 64 + lane_id(), cv = tid & 7, run = tid >> 3;
    bf16_t* proj = (bf16_t*)(p.ws + WS_PROJ);
    LAS u32x4* stash = (LAS u32x4*)lds;
    for (int sq = blockIdx.x; sq < 4 * 32; sq += gridDim.x) {
        const int b = sq >> 5, slab = sq & 31;
        const int xcol = 2048 + slab * 64 + cv * 8;
        float wk[4][8], bs[8];
#pragma unroll
        for (int k = 0; k < 4; ++k) { const f32x4 a = *(const f32x4*)(p.ssm_conv_w + k * 4096 + xcol), c = *(const f32x4*)(p.ssm_conv_w + k * 4096 + xcol + 4);
#pragma unroll
            for (int j = 0; j < 4; ++j) { wk[k][j] = a[j]; wk[k][4 + j] = c[j]; } }
        { const f32x4 a = *(const f32x4*)(p.ssm_conv_b + xcol), c = *(const f32x4*)(p.ssm_conv_b + xcol + 4);
#pragma unroll
          for (int j = 0; j < 4; ++j) { bs[j] = a[j]; bs[4 + j] = c[j]; } }
        __syncthreads();
#pragma unroll 1
        for (int tile = 0; tile < 8; ++tile) {
            bf16_t* base = proj + (size_t)(b * SEQ + tile * 512 + run * 8) * NPROJ + 2048 + xcol;
            u32x4 raw[11];
#pragma unroll
            for (int r = 0; r < 11; ++r) {
                const int row = run * 8 + r - 3;
                if (row >= 0) raw[r] = *(const u32x4*)(base + (long)(r - 3) * NPROJ);
                else raw[r] = (tile == 0) ? (u32x4){0u, 0u, 0u, 0u} : stash[(row + 3) * 8 + cv];
            }
            u32x4 ov[8];
#pragma unroll
            for (int j = 0; j < 8; ++j) {
                float o[8];
#pragma unroll
                for (int q = 0; q < 4; ++q) {
                    const unsigned x0 = raw[j][q], x1 = raw[j + 1][q], x2 = raw[j + 2][q], x3 = raw[j + 3][q];
                    o[2 * q] = silu_f(bs[2 * q] + wk[0][2 * q] * bflo(x0) + wk[1][2 * q] * bflo(x1) + wk[2][2 * q] * bflo(x2) + wk[3][2 * q] * bflo(x3));
                    o[2 * q + 1] = silu_f(bs[2 * q + 1] + wk[0][2 * q + 1] * bfhi(x0) + wk[1][2 * q + 1] * bfhi(x1) + wk[2][2 * q + 1] * bfhi(x2) + wk[3][2 * q + 1] * bfhi(x3));
                }
                ov[j].x = cvt_pk_bf16(o[0], o[1]); ov[j].y = cvt_pk_bf16(o[2], o[3]); ov[j].z = cvt_pk_bf16(o[4], o[5]); ov[j].w = cvt_pk_bf16(o[6], o[7]);
            }
            asm volatile("s_waitcnt vmcnt(0) lgkmcnt(0)" ::: "memory");
            __syncthreads();
            if (run == 63) { stash[0 * 8 + cv] = raw[8]; stash[1 * 8 + cv] = raw[9]; stash[2 * 8 + cv] = raw[10]; }
#pragma unroll
            for (int j = 0; j < 8; ++j) *(u32x4*)(base + (long)j * NPROJ) = ov[j];
            __syncthreads();
        }
    }
}

constexpr int SROW = 272;
constexpr int L_CM = 0, L_BM = 34816, L_BDT = 69632, L_XT = 104448, L_HB = 121856  , L_CS = 156672, L_DT = 157184, L_CW = 157696  ;
__device__ __forceinline__ int swz_off(int row, int kblk) { return row * SROW + ((kblk ^ ((row >> 3) & 7)) << 4); }
__device__ __forceinline__ void ssd_load(u32x4 (&raw)[5], const bf16_t* base, bool first, int l0) {
#pragma unroll
    for (int r = 0; r < 5; ++r) raw[r] = (first && (l0 + r - 3) < 0) ? (u32x4){0u, 0u, 0u, 0u} : *(const u32x4*)(base + (long)(r - 3) * NPROJ);
}
template <int GI>
__device__ __forceinline__ void ssd_conv(LAS unsigned char* lds, const u32x4 (&raw)[5], int cv, int l0, float sa, float sb) {
    LAS const f32x4* cw = (LAS const f32x4*)(lds + L_CW) + cv * 10;
    float o0[8], o1[8];
#pragma unroll
    for (int hq = 0; hq < 2; ++hq) {
        const f32x4 w0 = cw[0 + hq], w1 = cw[2 + hq], w2 = cw[4 + hq], w3 = cw[6 + hq], bs = cw[8 + hq];
#pragma unroll
        for (int e2 = 0; e2 < 2; ++e2) {
            const int q = hq * 2 + e2;
            const unsigned x0 = raw[0][q], x1 = raw[1][q], x2 = raw[2][q], x3 = raw[3][q], x4 = raw[4][q];
            const int ea = e2 * 2, eb = e2 * 2 + 1;
            const float va = bs[ea] + w0[ea] * bflo(x0) + w1[ea] * bflo(x1) + w2[ea] * bflo(x2) + w3[ea] * bflo(x3);
            const float vb = bs[eb] + w0[eb] * bfhi(x0) + w1[eb] * bfhi(x1) + w2[eb] * bfhi(x2) + w3[eb] * bfhi(x3);
            const float ua = bs[ea] + w0[ea] * bflo(x1) + w1[ea] * bflo(x2) + w2[ea] * bflo(x3) + w3[ea] * bflo(x4);
            const float ub = bs[eb] + w0[eb] * bfhi(x1) + w1[eb] * bfhi(x2) + w2[eb] * bfhi(x3) + w3[eb] * bfhi(x4);
            o0[2 * q] = silu_f(va); o0[2 * q + 1] = silu_f(vb); o1[2 * q] = silu_f(ua); o1[2 * q + 1] = silu_f(ub);
        }
    }
    if (GI == 0) {
#pragma unroll
        for (int e = 0; e < 8; ++e) { const int prow = cv * 8 + e;
            *(LAS unsigned*)(lds + L_XT + swz_off(prow, l0 >> 3) + (l0 & 7) * 2) = cvt_pk_bf16(o0[e] * sa, o1[e] * sb); }
    } else {
        u32x4 w0; w0.x = cvt_pk_bf16(o0[0], o0[1]); w0.y = cvt_pk_bf16(o0[2], o0[3]); w0.z = cvt_pk_bf16(o0[4], o0[5]); w0.w = cvt_pk_bf16(o0[6], o0[7]);
        u32x4 w1; w1.x = cvt_pk_bf16(o1[0], o1[1]); w1.y = cvt_pk_bf16(o1[2], o1[3]); w1.z = cvt_pk_bf16(o1[4], o1[5]); w1.w = cvt_pk_bf16(o1[6], o1[7]);
        const int nb = ((GI - 1) & 1) * 64 + cv * 8;
        if (GI < 3) {
            *(LAS u32x4*)(lds + L_BM + l0 * SROW + nb * 2) = w0; *(LAS u32x4*)(lds + L_BM + (l0 + 1) * SROW + nb * 2) = w1;
#pragma unroll
            for (int e = 0; e < 8; ++e) { const int nrow = nb + e;
                *(LAS unsigned*)(lds + L_BDT + swz_off(nrow, l0 >> 3) + (l0 & 7) * 2) = cvt_pk_bf16(o0[e] * sa, o1[e] * sb); }
        } else {
            *(LAS u32x4*)(lds + L_CM + l0 * SROW + nb * 2) = w0; *(LAS u32x4*)(lds + L_CM + (l0 + 1) * SROW + nb * 2) = w1;
        }
    }
}
template <int GI>
__device__ __forceinline__ void ssd_put(LAS unsigned char* lds, const u32x4 (&rw)[2], int cv, int l0, float sa, float sb) {
    const int nb = ((GI - 1) & 1) * 64 + cv * 8;
    if (GI < 3) {
        *(LAS u32x4*)(lds + L_BM + l0 * SROW + nb * 2) = rw[0]; *(LAS u32x4*)(lds + L_BM + (l0 + 1) * SROW + nb * 2) = rw[1];
#pragma unroll
        for (int q = 0; q < 4; ++q) {
            *(LAS unsigned*)(lds + L_BDT + swz_off(nb + 2 * q, l0 >> 3) + (l0 & 7) * 2) = cvt_pk_bf16(bflo(rw[0][q]) * sa, bflo(rw[1][q]) * sb);
            *(LAS unsigned*)(lds + L_BDT + swz_off(nb + 2 * q + 1, l0 >> 3) + (l0 & 7) * 2) = cvt_pk_bf16(bfhi(rw[0][q]) * sa, bfhi(rw[1][q]) * sb);
        }
    } else {
        *(LAS u32x4*)(lds + L_CM + l0 * SROW + nb * 2) = rw[0]; *(LAS u32x4*)(lds + L_CM + (l0 + 1) * SROW + nb * 2) = rw[1];
    }
}
__device__ void ssd_unit(const Params& p, LAS unsigned char* lds, int b, int h, int wv) {
    const int lane = lane_id(), w = wv, tid = wv * 64 + lane, fr = lane & 15, fq = lane >> 4;
    const int g = h >> 2;
    const bf16_t* proj = (const bf16_t*)(p.ws + WS_PROJ);
    const float* dtg = (const float*)((const unsigned char*)p.out + DO_DT);
    bf16_t* ymix = (bf16_t*)(p.ws + WS_YMIX);
    float* ssq1 = (float*)((unsigned char*)p.out + DO_SSQ1);
    LAS float* CSv = (LAS float*)(lds + L_CS);
    LAS float* DTv = (LAS float*)(lds + L_DT);
    LAS float* CW = (LAS float*)(lds + L_CW);
    const float Aneg = -__expf(p.ssm_A_log[h]);
    const float Dh = p.ssm_D[h];
    for (int idx = tid; idx < 320; idx += 512) {
        const int e = idx & 7, k = (idx >> 3) % 5, cvi = idx / 40;
        const int xcol = h * 64 + cvi * 8 + e;
        CW[idx] = (k < 4) ? p.ssm_conv_w[k * 4096 + xcol] : p.ssm_conv_b[xcol];
    }
    for (int idx = tid; idx < 64 * 17; idx += 512) *(LAS u32x4*)(lds + L_HB + idx * 16) = (u32x4){0u, 0u, 0u, 0u};
    f32x4 Hacc[4];
#pragma unroll
    for (int pt = 0; pt < 4; ++pt) Hacc[pt] = (f32x4){0.f, 0.f, 0.f, 0.f};
    __syncthreads();
    const int cv = lane & 7;
    const int l0 = 16 * w + 2 * (lane >> 3);
    const int srcl = (w & 3) * 16 + 2 * (lane >> 3);
    u32x4 r0[5], r1[2], r2[2], r3[2], r4[2];
    const bf16_t* pbase = proj + (size_t)(b * SEQ + l0) * NPROJ + 2048 + cv * 8;
    const int xc0 = h * 64, xc1 = 2048 + g * 128, xc2 = xc1 + 64, xc3 = 3072 + g * 128, xc4 = xc3 + 64;
    ssd_load(r0, pbase + xc0, true, l0);
    r1[0] = *(const u32x4*)(pbase + xc1); r1[1] = *(const u32x4*)(pbase + xc1 + NPROJ); r2[0] = *(const u32x4*)(pbase + xc2); r2[1] = *(const u32x4*)(pbase + xc2 + NPROJ);
    r3[0] = *(const u32x4*)(pbase + xc3); r3[1] = *(const u32x4*)(pbase + xc3 + NPROJ); r4[0] = *(const u32x4*)(pbase + xc4); r4[1] = *(const u32x4*)(pbase + xc4 + NPROJ);
    float dt0n = dtg[(size_t)(b * SEQ + lane) * 32 + h], dt1n = dtg[(size_t)(b * SEQ + 64 + lane) * 32 + h];
    for (int c = 0; c < 32; ++c) {
        const int row0 = b * SEQ + c * 128;
        const float dt0 = dt0n, dt1 = dt1n;
        float a0 = dt0 * Aneg, a1 = dt1 * Aneg;
#pragma unroll
        for (int o = 1; o < 64; o <<= 1) { const float t0 = __shfl_up(a0, o), t1 = __shfl_up(a1, o); if (lane >= o) { a0 += t0; a1 += t1; } }
        a1 += __shfl(a0, 63);
        const float cs_end = __shfl(a1, 63);
        if (w == 0) { CSv[lane] = a0; CSv[64 + lane] = a1; DTv[lane] = dt0; DTv[64 + lane] = dt1; }
        const float csv = (w >= 4) ? a1 : a0, dtv = (w >= 4) ? dt1 : dt0;
        const float cs_l0 = __shfl(csv, srcl), cs_l1 = __shfl(csv, srcl + 1), dt_l0 = __shfl(dtv, srcl), dt_l1 = __shfl(dtv, srcl + 1);
        const float dec0 = __expf(cs_end - cs_l0), dec1 = __expf(cs_end - cs_l1);
        ssd_conv<0>(lds, r0, cv, l0, dt_l0, dt_l1);
        ssd_put<1>(lds, r1, cv, l0, dec0, dec1); ssd_put<2>(lds, r2, cv, l0, dec0, dec1);
        ssd_put<3>(lds, r3, cv, l0, 0.f, 0.f);   ssd_put<4>(lds, r4, cv, l0, 0.f, 0.f);
        __builtin_amdgcn_sched_barrier(0);
        if (c + 1 < 32) {
            const bf16_t* cb = pbase + (size_t)(c + 1) * 128 * NPROJ;
            ssd_load(r0, cb + xc0, false, l0);
            r1[0] = *(const u32x4*)(cb + xc1); r1[1] = *(const u32x4*)(cb + xc1 + NPROJ); r2[0] = *(const u32x4*)(cb + xc2); r2[1] = *(const u32x4*)(cb + xc2 + NPROJ);
            r3[0] = *(const u32x4*)(cb + xc3); r3[1] = *(const u32x4*)(cb + xc3 + NPROJ); r4[0] = *(const u32x4*)(cb + xc4); r4[1] = *(const u32x4*)(cb + xc4 + NPROJ);
            dt0n = dtg[(size_t)(row0 + 128 + lane) * 32 + h]; dt1n = dtg[(size_t)(row0 + 192 + lane) * 32 + h];
        }
        __builtin_amdgcn_sched_barrier(0);
        u32x2 zr[4];
#pragma unroll
        for (int pt = 0; pt < 4; ++pt) zr[pt] = *(const u32x2*)(proj + (size_t)(row0 + 16 * w + fr) * NPROJ + h * 64 + 16 * pt + 4 * fq);
        __syncthreads();
        const int lrow = 16 * w + fr;
        const int hb_cur = L_HB + (c & 1) * 17408, hb_nxt = L_HB + ((c + 1) & 1) * 17408;
        bf16x8 cf[4];
#pragma unroll
        for (int ks = 0; ks < 4; ++ks) cf[ks] = *(LAS const bf16x8*)(lds + L_CM + lrow * SROW + (32 * ks + 8 * fq) * 2);
        const float cs_l = CSv[lrow], dt_l = DTv[lrow];
        asm volatile("" ::: "memory");
        f32x4 y[4];
        { const float el = __expf(cs_l);
#pragma unroll
          for (int pt = 0; pt < 4; ++pt) { f32x4 a = (f32x4){0.f, 0.f, 0.f, 0.f};
#pragma unroll
            for (int ks = 0; ks < 4; ++ks) { const bf16x8 hf = *(LAS const bf16x8*)(lds + hb_cur + (16 * pt + fr) * SROW + (32 * ks + 8 * fq) * 2);
                a = __builtin_amdgcn_mfma_f32_16x16x32_bf16(hf, cf[ks], a, 0, 0, 0); }
            y[pt] = a * el; } }
#pragma unroll
        for (int j = 0; j < 8; ++j) {
            if (j <= w) {
                f32x4 gacc = (f32x4){0.f, 0.f, 0.f, 0.f};
#pragma unroll
                for (int ks = 0; ks < 4; ++ks) { const bf16x8 bf = *(LAS const bf16x8*)(lds + L_BM + (16 * j + fr) * SROW + (32 * ks + 8 * fq) * 2);
                    gacc = __builtin_amdgcn_mfma_f32_16x16x32_bf16(bf, cf[ks], gacc, 0, 0, 0); }
                const f32x4 css = *(LAS const f32x4*)(CSv + 16 * j + 4 * fq);
                float mv[4];
#pragma unroll
                for (int i = 0; i < 4; ++i) { const int sx = 16 * j + 4 * fq + i; float v = gacc[i] * __expf(cs_l - css[i]);
                    if (j == w) { v = (sx <= lrow) ? v : 0.f; if (sx == lrow) v += Dh / dt_l; }
                    mv[i] = v; }
                u32x2 wv2; wv2.x = cvt_pk_bf16(mv[0], mv[1]); wv2.y = cvt_pk_bf16(mv[2], mv[3]);
                *(LAS u32x2*)(lds + L_CM + lrow * SROW + (16 * j + 4 * fq) * 2) = wv2;
            } else if (j == w + 1 && (w & 1) == 0) {
                *(LAS u32x2*)(lds + L_CM + lrow * SROW + (16 * j + 4 * fq) * 2) = (u32x2){0u, 0u};
            }
        }
        asm volatile("" ::: "memory");
        { const float de = __expf(cs_end);
#pragma unroll
          for (int pt = 0; pt < 4; ++pt) Hacc[pt] *= de; }
        const int nks2 = (w >> 1) + 1;
#pragma unroll
        for (int ks = 0; ks < 4; ++ks) {
            bf16x8 xf[4];
#pragma unroll
            for (int pt = 0; pt < 4; ++pt) xf[pt] = *(LAS const bf16x8*)(lds + L_XT + swz_off(16 * pt + fr, 4 * ks + fq));
            if (ks < nks2) { const bf16x8 mf = *(LAS const bf16x8*)(lds + L_CM + lrow * SROW + (32 * ks + 8 * fq) * 2);
#pragma unroll
                for (int pt = 0; pt < 4; ++pt) y[pt] = __builtin_amdgcn_mfma_f32_16x16x32_bf16(xf[pt], mf, y[pt], 0, 0, 0); }
            const bf16x8 bdf = *(LAS const bf16x8*)(lds + L_BDT + swz_off(16 * w + fr, 4 * ks + fq));
#pragma unroll
            for (int pt = 0; pt < 4; ++pt) Hacc[pt] = __builtin_amdgcn_mfma_f32_16x16x32_bf16(bdf, xf[pt], Hacc[pt], 0, 0, 0);
        }
#pragma unroll
        for (int pt = 0; pt < 4; ++pt) { u32x2 wv2; wv2.x = cvt_pk_bf16(Hacc[pt][0], Hacc[pt][1]); wv2.y = cvt_pk_bf16(Hacc[pt][2], Hacc[pt][3]);
            *(LAS u32x2*)(lds + hb_nxt + (16 * pt + fr) * SROW + (16 * w + 4 * fq) * 2) = wv2; }
        { float ss = 0.f; const size_t orow = (size_t)(row0 + lrow);
#pragma unroll
          for (int pt = 0; pt < 4; ++pt) {
            const float z0 = bflo(zr[pt].x), z1 = bfhi(zr[pt].x), z2 = bflo(zr[pt].y), z3 = bfhi(zr[pt].y);
            const float v0 = y[pt][0] * silu_f(z0), v1 = y[pt][1] * silu_f(z1), v2 = y[pt][2] * silu_f(z2), v3 = y[pt][3] * silu_f(z3);
            ss += (v0 * v0 + v1 * v1) + (v2 * v2 + v3 * v3);
            u32x2 wv; wv.x = cvt_pk_bf16(v0, v1); wv.y = cvt_pk_bf16(v2, v3);
            *(u32x2*)(ymix + orow * DMIX + h * 64 + 16 * pt + 4 * fq) = wv; }
          ss += __shfl_xor(ss, 16); ss += __shfl_xor(ss, 32);
          if (fq == 0) ssq1[ssq_idx((int)orow, h)] = ss; }
        __syncthreads();
    }
}
__device__ void sc_unit(const Params& p, int unit, int wv) {
    const int tid = wv * 64 + lane_id(), cvx = tid & 255, th = tid >> 8;
    const bf16_t* proj = (const bf16_t*)(p.ws + WS_PROJ);
    bf16_t* ymix = (bf16_t*)(p.ws + WS_YMIX);
    const int t0 = unit * 64 + th * 32, c0 = cvx * 8;
    float w0[8], w1[8], w2[8];
    { const f32x4* a = (const f32x4*)(p.sc_conv_w + c0); const f32x4* bq = (const f32x4*)(p.sc_conv_w + 2048 + c0); const f32x4* cq = (const f32x4*)(p.sc_conv_w + 4096 + c0);
#pragma unroll
      for (int q = 0; q < 2; ++q) { const f32x4 x0 = a[q], x1 = bq[q], x2 = cq[q];
#pragma unroll
        for (int j = 0; j < 4; ++j) { w0[q * 4 + j] = x0[j]; w1[q * 4 + j] = x1[j]; w2[q * 4 + j] = x2[j]; } } }
    float pm1[8], pm2[8];
#pragma unroll
    for (int e = 0; e < 8; ++e) { pm1[e] = 0.f; pm2[e] = 0.f; }
    if ((t0 & (SEQ - 1)) != 0) {
        const bf16_t* r2 = proj + (size_t)(t0 - 2) * NPROJ, * r1 = proj + (size_t)(t0 - 1) * NPROJ;
        const u32x4 c2 = *(const u32x4*)(r2 + 8192 + c0), x2 = *(const u32x4*)(r2 + 10240 + c0), c1 = *(const u32x4*)(r1 + 8192 + c0), x1 = *(const u32x4*)(r1 + 10240 + c0);
#pragma unroll
        for (int q = 0; q < 4; ++q) { pm2[2 * q] = bflo(c2[q]) * bflo(x2[q]); pm2[2 * q + 1] = bfhi(c2[q]) * bfhi(x2[q]); pm1[2 * q] = bflo(c1[q]) * bflo(x1[q]); pm1[2 * q + 1] = bfhi(c1[q]) * bfhi(x1[q]); }
    }
#pragma unroll 4
    for (int i = 0; i < 32; ++i) {
        const bf16_t* r = proj + (size_t)(t0 + i) * NPROJ;
        const u32x4 gb = *(const u32x4*)(r + 6144 + c0), gc = *(const u32x4*)(r + 8192 + c0), gx = *(const u32x4*)(r + 10240 + c0);
        float o[8];
#pragma unroll
        for (int q = 0; q < 4; ++q) {
            const float pa = bflo(gc[q]) * bflo(gx[q]), pb = bfhi(gc[q]) * bfhi(gx[q]);
            o[2 * q] = bflo(gb[q]) * (w0[2 * q] * pm2[2 * q] + w1[2 * q] * pm1[2 * q] + w2[2 * q] * pa);
            o[2 * q + 1] = bfhi(gb[q]) * (w0[2 * q + 1] * pm2[2 * q + 1] + w1[2 * q + 1] * pm1[2 * q + 1] + w2[2 * q + 1] * pb);
            pm2[2 * q] = pm1[2 * q]; pm2[2 * q + 1] = pm1[2 * q + 1]; pm1[2 * q] = pa; pm1[2 * q + 1] = pb;
        }
        u32x4 wv; wv.x = cvt_pk_bf16(o[0], o[1]); wv.y = cvt_pk_bf16(o[2], o[3]); wv.z = cvt_pk_bf16(o[4], o[5]); wv.w = cvt_pk_bf16(o[6], o[7]);
        *(u32x4*)(ymix + (size_t)(t0 + i) * DMIX + 2048 + c0) = wv;
    }
}
__device__ void phase2(const Params& p, LAS unsigned char* lds, int wv) {
    const int G = gridDim.x, bid = blockIdx.x;
    const bool split = G >= 256;
    if (!split || bid < 128) { for (int u = bid; u < 128; u += (split ? 128 : G)) ssd_unit(p, lds, u >> 5, u & 31, wv); }
    if (!split || bid >= 128) { for (int u = (split ? bid - 128 : bid); u < M_ / 64; u += (split ? G - 128 : G)) sc_unit(p, u, wv); }
    if (!split || bid >= 128) wconv_units(p, lds, split ? bid - 128 : bid, split ? G - 128 : G, wv);
}

__device__ void phase6(const Params& p, int wv) {
    const int lane = lane_id(), wave = wv;
    const float* h2 = (const float*)(p.ws + WS_H1F);
    const float* ssq3 = (const float*)(p.ws + WS_SSQ3);
    for (int row = blockIdx.x * 8 + wave; row < M_; row += gridDim.x * 8) {
        float s = (lane < 32) ? ssq3[ssq_idx(row, lane)] : 0.f;
#pragma unroll
        for (int o = 32; o >= 1; o >>= 1) s += __shfl_xor(s, o);
        const float rstd = rsqrtf(s * (1.0f / 2048.0f) + EPS);
        const f32x4* hr = (const f32x4*)(h2 + (size_t)row * D_);
        f32x4* orow = (f32x4*)(p.out + (size_t)row * D_);
#pragma unroll
        for (int i = 0; i < 8; ++i) { const f32x4 v = hr[lane + 64 * i], g4 = ((const f32x4*)p.norm_final_g)[lane + 64 * i]; orow[lane + 64 * i] = v * rstd * g4; }
    }
}


#define XB_TMO      128
#define XB_XCNT(j)  (256  + 64 * (j))
#define XB_XSUB(j)  (1280 + 64 * (j))
#define XB_XGEN(j)  (2304 + 64 * (j))
#define XB_TOP      3328
#define XB_TOPGEN   3392
#define XCD_BAR_WORDS 3456
#define XB_SPIN_CAP (1u << 18)
__device__ __forceinline__ unsigned xb_ld(unsigned* p)              { return __hip_atomic_load(p, __ATOMIC_RELAXED, __HIP_MEMORY_SCOPE_AGENT); }
__device__ __forceinline__ unsigned xb_add(unsigned* p, unsigned v) { return __hip_atomic_fetch_add(p, v, __ATOMIC_RELAXED, __HIP_MEMORY_SCOPE_AGENT); }
__device__ __forceinline__ unsigned xb_xcc_id() { return (unsigned)__builtin_amdgcn_s_getreg((3 << 11) | 20) & 0xFu; }
#define XB_SPIN(cond, bar) do { unsigned _sp = 0; while (cond) { __builtin_amdgcn_s_sleep(1); \
    if ((++_sp & 255u) == 0u) { if (xb_ld(&(bar)[XB_TMO])) break; if (_sp > XB_SPIN_CAP) { atomicAdd(&(bar)[XB_TMO], 1u); break; } } } } while (0)
struct XcdBarrier { unsigned* bar; unsigned x; volatile LAS unsigned* st; };
__device__ __forceinline__ void xcd_barrier_complete(unsigned* bar, unsigned x, unsigned& nloc, unsigned& nx) {
    const unsigned G = gridDim.x * gridDim.y * gridDim.z;
    unsigned sum, cnt, mine, sp = 0u;
    for (;;) {
        sum = 0u; cnt = 0u; mine = 0u;
#pragma unroll
        for (unsigned j = 0; j < 16; ++j) { const unsigned c = xb_ld(&bar[XB_XCNT(j)]); sum += c; cnt += (c > 0u) ? 1u : 0u; mine = (j == x) ? c : mine; }
        if (sum == G) break;
        __builtin_amdgcn_s_sleep(1);
        if ((++sp & 255u) == 0u) { if (xb_ld(&bar[XB_TMO])) break; if (sp > XB_SPIN_CAP) { atomicAdd(&bar[XB_TMO], 1u); break; } }
    }
    nloc = mine > 0u ? mine : 1u; nx = cnt > 0u ? cnt : 1u;
}
__device__ __forceinline__ void xcd_barrier(const XcdBarrier& b, bool leader) {
    asm volatile("s_waitcnt vmcnt(0)" ::: "memory");
    __syncthreads();
    if (leader) {
        unsigned* bar = b.bar;
        __builtin_amdgcn_s_waitcnt(0);
        unsigned nloc = b.st[0], nx = b.st[1];
        if (nloc == 0u) { xcd_barrier_complete(bar, b.x, nloc, nx); b.st[0] = nloc; b.st[1] = nx; }
        const unsigned old = xb_add(&bar[XB_XSUB(b.x)], 1u);
        const unsigned gen = old / nloc;
        if (old + 1u == (gen + 1u) * nloc) {
            __builtin_amdgcn_fence(__ATOMIC_RELEASE, "agent");
            asm volatile("s_waitcnt vmcnt(0)" ::: "memory");
            const unsigned og = xb_add(&bar[XB_TOP], 1u);
            const unsigned tg = og / nx;
            if (og + 1u == (tg + 1u) * nx) xb_add(&bar[XB_TOPGEN], 1u);
            else XB_SPIN(xb_ld(&bar[XB_TOPGEN]) == tg, bar);
            __builtin_amdgcn_fence(__ATOMIC_ACQUIRE, "agent");
            xb_add(&bar[XB_XGEN(b.x)], 1u);
            asm volatile("s_waitcnt vmcnt(0)" ::: "memory");
        } else {
            XB_SPIN(xb_ld(&bar[XB_XGEN(b.x)]) == gen, bar);
            __builtin_amdgcn_fence(__ATOMIC_ACQUIRE, "agent");
            asm volatile("s_waitcnt vmcnt(0)" ::: "memory");
        }
    }
    __syncthreads();
}

__global__ void __launch_bounds__(512) hymba_fwd(Params p) {
    extern __shared__ __attribute__((aligned(16))) unsigned char shm[];
    LAS unsigned char* lds = (LAS unsigned char*)shm;
    cg::grid_group grid = cg::this_grid();
    const int lo = p.ph_lo, hi = p.ph_hi;
    const int wv = __builtin_amdgcn_readfirstlane(threadIdx.x >> 6);
#ifdef DBG_CLEAR
    for (int i = threadIdx.x; i < LDS_BYTES / 16; i += 512) *(LAS u32x4*)(lds + i * 16) = (u32x4){0u, 0u, 0u, 0u};
    __syncthreads();
#endif
#define IN(k) (lo <= (k) && (k) < hi)
#define SEAM(k) do { if (IN(k) && IN((k) + 1)) { \
        asm volatile("s_waitcnt vmcnt(0) lgkmcnt(0)" ::: "memory"); __syncthreads();                 \
        if (wv == 0) { __builtin_amdgcn_fence(__ATOMIC_RELEASE, "agent"); asm volatile("s_waitcnt vmcnt(0)" ::: "memory"); }     \
        grid.sync(); \
        if (wv == 0) { __builtin_amdgcn_fence(__ATOMIC_ACQUIRE, "agent"); asm volatile("s_waitcnt vmcnt(0)" ::: "memory"); }     \
        __syncthreads(); } } while (0)
    volatile LAS unsigned* xst = (volatile LAS unsigned*)(lds + LDS_BYTES - 16);
    const bool xlead = (wv == 0) && (lane_id() == 0);
    if (xlead) { xst[0] = 0u; xst[1] = 0u; }
    __syncthreads();
    XcdBarrier xb; xb.bar = (unsigned*)((unsigned char*)p.out + DO_XBAR); xb.x = xb_xcc_id(); xb.st = xst;
    if (xlead) (void)xb_add(&xb.bar[XB_XCNT(xb.x)], 1u);
#define XSEAM(k) do { if (IN(k) && IN((k) + 1)) xcd_barrier(xb, (wv == 0) && (lane_id() == 0)); } while (0)
    if (IN(0)) for (int rep = 0; rep < NREP(0); ++rep) phase0(p, lds, wv);
    XSEAM(0);
    if (IN(1)) for (int rep = 0; rep < NREP(1); ++rep) {
        pg8::Gemm g{(const bf16_t*)(p.ws + WS_XN), (const bf16_t*)(p.ws + WS_BTIN), M_, NPROJ, D_}; pg8::StaticOrder S; S.init(M_, NPROJ, gridDim.x, blockIdx.x);
        EpiProj E{(bf16_t*)(p.ws + WS_PROJ)};
        pg8::gemm_phase<EpiProj>(lds, g, S, E, wv);
        dt_units(p, lds, wv);
    }
    XSEAM(1);
    if (IN(2)) bc_conv_phase(p, lds, wv);
    XSEAM(2);
    if (IN(3)) for (int rep = 0; rep < NREP(3); ++rep) phase2(p, lds, wv);
    XSEAM(3);
    if (IN(4)) for (int rep = 0; rep < NREP(4); ++rep) {
        pg8::Gemm g{(const bf16_t*)(p.ws + WS_YMIX), (const bf16_t*)((unsigned char*)p.out + DO_BTOUT), M_, D_, DMIX}; pg8::StaticOrder S; S.init(M_, D_, gridDim.x, blockIdx.x);
        EpiOut E{p.x, (float*)(p.ws + WS_H1F), (bf16_t*)(p.ws + WS_H1B), (const float*)((unsigned char*)p.out + DO_SSQ1), (float*)((unsigned char*)p.out + DO_SSQ2)};
        pg8::gemm_phase<EpiOut>(lds, g, S, E, wv);
    }
    XSEAM(4);
    if (IN(5)) for (int rep = 0; rep < NREP(5); ++rep) {
        pg8::Gemm g{(const bf16_t*)(p.ws + WS_H1B), (const bf16_t*)((unsigned char*)p.out + DO_BTGU), M_, NGU, D_}; pg8::StaticOrder S; S.init(M_, NGU, gridDim.x, blockIdx.x);
        EpiGU E{(const float*)((unsigned char*)p.out + DO_SSQ2), (bf16_t*)(p.ws + WS_HFF)};
        pg8::gemm_phase<EpiGU>(lds, g, S, E, wv);
    }
    XSEAM(5);
    if (IN(6)) {
        pg8::Gemm g{(const bf16_t*)(p.ws + WS_HFF), (const bf16_t*)((unsigned char*)p.out + DO_BTDN), M_, D_, DFF}; pg8::StaticOrder S; S.init(M_, D_, gridDim.x, blockIdx.x);
        EpiDown E{(float*)(p.ws + WS_H1F), (float*)(p.ws + WS_SSQ3)};
        pg8::gemm_phase<EpiDown>(lds, g, S, E, wv);
    }
    XSEAM(6);
    if (p.ph_hi > 1000) grid.sync();
    if (IN(7)) for (int rep = 0; rep < NREP(7); ++rep) phase6(p, wv);
#undef IN
#undef SEAM
}

extern "C" void kernel_launch(void* const* d_in, const int* in_sizes, int n_in, void* d_out, int out_size, void* d_ws, size_t ws_size, hipStream_t stream) {
    static int grid = 0;
    if (grid == 0) {
        if (n_in != 16 || out_size != M_ * D_ || ws_size < WS_NEED) { fprintf(stderr, "kernel_launch: unexpected shapes (n_in %d out %d ws %zu, need %zu)\n", n_in, out_size, ws_size, (size_t)WS_NEED); grid = -1; return; }
        int dev = 0, cus = 0, per_cu = 0;
        (void)hipGetDevice(&dev);
        (void)hipDeviceGetAttribute(&cus, hipDeviceAttributeMultiprocessorCount, dev);
        if (hipFuncSetAttribute((const void*)hymba_fwd, hipFuncAttributeMaxDynamicSharedMemorySize, LDS_BYTES) != hipSuccess) { fprintf(stderr, "kernel_launch: hipFuncSetAttribute failed\n"); grid = -1; return; }
        if (hipOccupancyMaxActiveBlocksPerMultiprocessor(&per_cu, (const void*)hymba_fwd, 512, LDS_BYTES) != hipSuccess || per_cu < 1) { fprintf(stderr, "kernel_launch: occupancy query failed (%d)\n", per_cu); (void)hipGetLastError(); per_cu = 1; }
        grid = cus * per_cu;
    }
    if (grid < 0) return;
    Params p{};
    p.x = (const float*)d_in[0]; p.norm_mix_g = (const float*)d_in[1]; p.w_in = (const float*)d_in[2]; p.ssm_conv_w = (const float*)d_in[3]; p.ssm_conv_b = (const float*)d_in[4];
    p.ssm_dt_bias = (const float*)d_in[5]; p.ssm_A_log = (const float*)d_in[6]; p.ssm_D = (const float*)d_in[7]; p.ssm_norm_g = (const float*)d_in[8]; p.sc_conv_w = (const float*)d_in[9];
    p.w_out = (const float*)d_in[10]; p.norm_ffn_g = (const float*)d_in[11]; p.w_gate = (const float*)d_in[12]; p.w_up = (const float*)d_in[13]; p.w_down = (const float*)d_in[14]; p.norm_final_g = (const float*)d_in[15];
    p.out = (float*)d_out; p.ws = (unsigned char*)d_ws;
#ifdef DBG_MEMSET
    (void)hipMemsetAsync(d_ws, 0, WS_NEED, stream); (void)hipMemsetAsync(d_out, 0, (size_t)out_size * 4, stream);
#endif
#ifndef N_CUTS
#define N_CUTS 1
#endif
    for (int li = 0; li < N_CUTS; ++li) {
        p.ph_lo = (N_CUTS == 8) ? li : 0; p.ph_hi = (N_CUTS == 8) ? li + 1 : 8;
        (void)hipMemsetAsync((unsigned char*)d_out + DO_XBAR, 0, XCD_BAR_WORDS * sizeof(unsigned), stream);
    void* args[] = {&p};
        hipError_t e = hipLaunchCooperativeKernel((const void*)hymba_fwd, dim3(grid), dim3(512), args, LDS_BYTES, stream);
        if (e != hipSuccess) fprintf(stderr, "kernel_launch: cooperative launch failed: %s (grid %d)\n", hipGetErrorString(e), grid);
    }
}
```

```cpp
#include <hip/hip_runtime.h>
#include <hip/hip_cooperative_groups.h>
#include <cstdio>
namespace cg = cooperative_groups;

#define LAS __attribute__((address_space(3)))
typedef unsigned short bf16_t;
typedef short bf16x8 __attribute__((ext_vector_type(8)));
typedef float f32x4 __attribute__((ext_vector_type(4)));
typedef unsigned u32x4 __attribute__((ext_vector_type(4)));
typedef unsigned u32x2 __attribute__((ext_vector_type(2)));

constexpr int M_ = 16384, D_ = 2048, DIN = 12320, NPROJ = 12288, DFF = 5632, DMIX = 4096, NGU = 11264;
constexpr int SEQ = 4096;
constexpr float EPS = 1e-5f;
constexpr int LDS_BYTES = 159744;
constexpr int XCD_BAR_WORDS_C = 3456;
#ifndef PROBE_PHASE
#define PROBE_PHASE -1
#endif
#define NREP(k) ((PROBE_PHASE == (k)) ? 1 + (p.ph_hi < 100) : 1)
constexpr int TAB_OFF = 131072;

constexpr size_t WS_PROJ = 0;
constexpr size_t WS_R = (size_t)M_ * NPROJ * 2;
constexpr size_t WS_XN = WS_R;
constexpr size_t WS_BTIN = WS_R + (size_t)M_ * D_ * 2;
constexpr size_t WS_YMIX = WS_R;
constexpr size_t WS_H1F = 0;
constexpr size_t WS_H1B = (size_t)M_ * D_ * 4;
constexpr size_t WS_HFF = WS_H1B + (size_t)M_ * D_ * 2;
constexpr size_t WS_SSQ3 = WS_HFF + (size_t)M_ * DFF * 2;
constexpr size_t WS_NEED = WS_R + (size_t)M_ * DMIX * 2;
constexpr size_t DO_BTOUT = 0;
constexpr size_t DO_BTGU = (size_t)D_ * DMIX * 2;
constexpr size_t DO_BTDN = DO_BTGU + (size_t)NGU * D_ * 2;
constexpr size_t DO_DT = DO_BTDN + (size_t)D_ * DFF * 2;
constexpr size_t DO_SSQ1 = DO_DT + (size_t)M_ * 32 * 4;
constexpr size_t DO_SSQ2 = DO_SSQ1 + (size_t)M_ * 32 * 4;
constexpr size_t DO_XBAR = (size_t)M_ * D_ * 4 - 16384;
static_assert(DO_SSQ2 + (size_t)M_ * 32 * 4 <= DO_XBAR && XCD_BAR_WORDS_C * 4 <= 16384, "d_out scratch");

static_assert(WS_SSQ3 + (size_t)M_ * 32 * 4 <= WS_R, "ws overlay");

struct Params {
    const float* x; const float* norm_mix_g; const float* w_in; const float* ssm_conv_w; const float* ssm_conv_b;
    const float* ssm_dt_bias; const float* ssm_A_log; const float* ssm_D; const float* ssm_norm_g; const float* sc_conv_w;
    const float* w_out; const float* norm_ffn_g; const float* w_gate; const float* w_up; const float* w_down; const float* norm_final_g;
    float* out; unsigned char* ws; int ph_lo, ph_hi;
};

typedef float f32x2_t __attribute__((ext_vector_type(2)));
typedef __bf16 bf16x2_t __attribute__((ext_vector_type(2)));
__device__ __forceinline__ unsigned cvt_pk_bf16(float lo, float hi) { const f32x2_t v = {lo, hi}; return __builtin_bit_cast(unsigned, __builtin_convertvector(v, bf16x2_t)); }
__device__ __forceinline__ float bflo(unsigned u) { return __uint_as_float(u << 16); }
__device__ __forceinline__ float bfhi(unsigned u) { return __uint_as_float(u & 0xffff0000u); }
__device__ __forceinline__ int lane_id() { int l; asm volatile("v_mbcnt_lo_u32_b32 %0, -1, 0\n\tv_mbcnt_hi_u32_b32 %0, -1, %0" : "=v"(l)); return l; }
__device__ __forceinline__ float silu_f(float v) { return v * __builtin_amdgcn_rcpf(1.0f + __expf(-v)); }

__device__ __forceinline__ size_t ssq_idx(int row, int part) { return ((size_t)(row >> 5) * 32 + part) * 32 + (row & 31); }

namespace pg8 {
constexpr int BM = 256, BK = 64, HALF = 128, HTB = HALF * BK * 2, STAGE_BYTES = 8 * HTB, NXCD = 8, WGM = 8;
__device__ __forceinline__ int lds_byte(int r, int c) { const int st = (r >> 4) * 2 + (c >> 5), rr = r & 15, cc = c & 31, ob = rr * 64 + cc * 2; return st * 1024 + (ob ^ (((ob >> 9) & 1) << 5)); }
__device__ __forceinline__ void stage_rc(int b, int& R, int& C) { const int st = b / 1024, sb = b % 1024, swz = sb ^ (((sb >> 9) & 1) << 5); R = (st >> 1) * 16 + swz / 64; C = (st & 1) * 32 + (swz % 64) / 2; }
__device__ __forceinline__ int perm32(int rho) { const int n = rho >> 4, i = rho & 15; return 8 * (i >> 2) + 4 * n + (i & 3); }
struct Unit { int pm, pn; };
struct Gemm { const bf16_t* A; const bf16_t* Bt; int M, N, K; };
struct StaticOrder {
    int nM, nN, nwg, G, c;
    __device__ void init(int M, int N, int G_, int c_) { nM = M / BM; nN = N / BM; nwg = nM * nN; G = G_; c = c_; }
    __device__ bool next(int i, Unit& u) const {
        const long L = (long)i * G + c; if (L >= nwg) return false;
        int wgid = (int)L; { const int q = nwg / NXCD, r = nwg % NXCD, xcd = wgid % NXCD, off = wgid / NXCD; wgid = (xcd < r ? xcd * (q + 1) : r * (q + 1) + (xcd - r) * q) + off; }
        const int nig = WGM * nN, gid = wgid / nig, fm = gid * WGM, gsz = (nM - fm) < WGM ? (nM - fm) : WGM;
        u.pm = fm + ((wgid % nig) % gsz); u.pn = (wgid % nig) / gsz; return true;
    }
};
template <class Epi>
__device__ __forceinline__ void gemm_phase(LAS unsigned char* lds, const Gemm g, const StaticOrder& S, const Epi& E, int wv) {
    const int wid = wv, lane = lane_id(), tid = wid * 64 + lane, wr = wid >> 2, wc = wid & 3, fr = lane & 15, fq = lane >> 4;
    const int K = g.K, nt = K / BK;
    unsigned voffA[2], voffB[2];
#pragma unroll
    for (int i = 0; i < 2; ++i) { int R, C; stage_rc(tid * 16 + i * 8192, R, C); const int Rb = (R & ~31) + perm32(R & 31);
        voffA[i] = (unsigned)(R * K + C) * 2u; voffB[i] = (unsigned)(Rb * K + C) * 2u; }
    const size_t kstep = (size_t)(BK * 2);
    const size_t hstep = (size_t)HALF * K * 2;
    const size_t tstep = 2 * hstep;
    const unsigned ldsw = (unsigned)wid * 1024u;
    const int aoff = lds_byte(wr * 64 + fr, fq * 8), boff = lds_byte(wc * 32 + fr, fq * 8);
#define PG8_SA(b, h) (((b) * 2 + (h)) * HTB)
#define PG8_SB(b, h) ((4 + (b) * 2 + (h)) * HTB)
#define PG8_STAGE(bufoff, gbase, voff) do { _Pragma("unroll") for (int _i = 0; _i < 2; ++_i) \
        __builtin_amdgcn_global_load_lds((const unsigned*)((const char*)(gbase) + (voff)[_i]), (LAS unsigned*)(lds + (bufoff) + ldsw + _i * 8192), 16, 0, 0); } while (0)
#define PG8_LDA(dst, b, h) do { _Pragma("unroll") for (int m = 0; m < 4; ++m) _Pragma("unroll") for (int k = 0; k < 2; ++k) dst[m][k] = *(const LAS bf16x8*)(lds + PG8_SA(b, h) + aoff + m * 2048 + k * 1024); } while (0)
#define PG8_LDB(dst, b, h) do { _Pragma("unroll") for (int n = 0; n < 2; ++n) _Pragma("unroll") for (int k = 0; k < 2; ++k) dst[n][k] = *(const LAS bf16x8*)(lds + PG8_SB(b, h) + boff + n * 2048 + k * 1024); } while (0)
#define PG8_MMA(ai, bj, At, Bt) do { __builtin_amdgcn_s_setprio(1); _Pragma("unroll") for (int m = 0; m < 4; ++m) _Pragma("unroll") for (int n = 0; n < 2; ++n) _Pragma("unroll") for (int k = 0; k < 2; ++k) \
        acc[ai][bj][m][n] = __builtin_amdgcn_mfma_f32_16x16x32_bf16(Bt[n][k], At[m][k], acc[ai][bj][m][n], 0, 0, 0); __builtin_amdgcn_s_setprio(0); } while (0)
#define PG8_WAIT_V(n) asm volatile("s_waitcnt vmcnt(" #n ")" ::: "memory")
#define PG8_WAIT_L(n) asm volatile("s_waitcnt lgkmcnt(" #n ")" ::: "memory")
#define PG8_BAR __builtin_amdgcn_s_barrier()
#define PG8_SCHED __builtin_amdgcn_sched_barrier(0)
    Unit cur, nxt; int ui = 0;
    if (!S.next(0, cur)) return;
    f32x4 acc[2][2][4][2];
#pragma unroll
    for (int a = 0; a < 2; ++a)
#pragma unroll
        for (int b = 0; b < 2; ++b)
#pragma unroll
            for (int m = 0; m < 4; ++m)
#pragma unroll
                for (int n = 0; n < 2; ++n) acc[a][b][m][n] = (f32x4){0.f, 0.f, 0.f, 0.f};
    bf16x8 At[4][2], B0[2][2], B1[2][2];
    const char* cA = (const char*)g.A + (size_t)cur.pm * tstep; const char* cB = (const char*)g.Bt + (size_t)cur.pn * tstep;
    if constexpr (Epi::HAS_TAB) {
        Unit uu; for (int i = 0; i < 27 && S.next(i, uu); ++i) E.prep(uu, (LAS float*)(lds + TAB_OFF + i * 1024), tid);
    }
    PG8_STAGE(PG8_SB(0, 0), cB, voffB); PG8_STAGE(PG8_SB(0, 1), cB + hstep, voffB); PG8_STAGE(PG8_SA(0, 0), cA, voffA); PG8_STAGE(PG8_SA(0, 1), cA + hstep, voffA);
    if (wr == 1) PG8_BAR;
    PG8_WAIT_V(2); PG8_BAR;
    PG8_STAGE(PG8_SB(1, 0), cB + kstep, voffB); PG8_STAGE(PG8_SA(1, 0), cA + kstep, voffA); PG8_STAGE(PG8_SB(1, 1), cB + hstep + kstep, voffB);
    PG8_WAIT_V(6); PG8_BAR;
    for (;;) {
        const bool has_next = S.next(ui + 1, nxt);
        const char* nA = has_next ? (const char*)g.A + (size_t)nxt.pm * tstep : cA; const char* nB = has_next ? (const char*)g.Bt + (size_t)nxt.pn * tstep : cB;
        LAS const float* tabc = (LAS const float*)(lds + TAB_OFF + ui * 1024);
        for (int t = 0; t < nt; t += 2) {
            const bool last = (t == nt - 2);
            const char* a1 = cA + (size_t)(t + 1) * kstep;
            const char* a2 = last ? nA : cA + (size_t)(t + 2) * kstep; const char* b2 = last ? nB : cB + (size_t)(t + 2) * kstep;
            const char* a3 = a2 + kstep; const char* b3 = b2 + kstep;
            if constexpr (Epi::MID_T >= 0) { if (t == Epi::MID_T) {
#pragma unroll
                for (int ai = 0; ai < 2; ++ai)
#pragma unroll
                    for (int m = 0; m < 4; ++m) { const float s = tabc[ai * HALF + wr * 64 + m * 16 + fr];
#pragma unroll
                        for (int bj = 0; bj < 2; ++bj)
#pragma unroll
                            for (int n = 0; n < 2; ++n) acc[ai][bj][m][n] *= s; } } }
            PG8_LDB(B0, 0, 0); PG8_LDB(B1, 0, 1); PG8_SCHED; PG8_LDA(At, 0, 0); PG8_STAGE(PG8_SA(1, 1), a1 + hstep, voffA);
            PG8_WAIT_V(8); PG8_WAIT_L(0); PG8_BAR; PG8_MMA(0, 0, At, B0); PG8_MMA(0, 1, At, B1); PG8_BAR; PG8_SCHED;
            PG8_LDA(At, 0, 1); PG8_STAGE(PG8_SB(0, 0), b2, voffB); PG8_STAGE(PG8_SB(0, 1), b2 + hstep, voffB); PG8_STAGE(PG8_SA(0, 0), a2, voffA);
            PG8_WAIT_V(8); PG8_WAIT_L(0); PG8_BAR; PG8_MMA(1, 0, At, B0); PG8_MMA(1, 1, At, B1); PG8_BAR; PG8_SCHED;
            PG8_LDB(B0, 1, 0); PG8_LDB(B1, 1, 1); PG8_SCHED; PG8_LDA(At, 1, 0); PG8_STAGE(PG8_SA(0, 1), a2 + hstep, voffA);
            PG8_WAIT_V(8); PG8_WAIT_L(0); PG8_BAR; PG8_MMA(0, 0, At, B0); PG8_MMA(0, 1, At, B1); PG8_BAR; PG8_SCHED;
            PG8_LDA(At, 1, 1); PG8_STAGE(PG8_SB(1, 0), b3, voffB); PG8_STAGE(PG8_SB(1, 1), b3 + hstep, voffB); PG8_STAGE(PG8_SA(1, 0), a3, voffA);
            PG8_WAIT_V(8); PG8_WAIT_L(0); PG8_BAR; PG8_MMA(1, 0, At, B0); PG8_MMA(1, 1, At, B1); PG8_BAR; PG8_SCHED;
        }
        if (wr == 0) PG8_BAR;
        E(acc, cur, tabc, wr, wc, fr, fq);
        if (!has_next) break;
#pragma unroll
        for (int a = 0; a < 2; ++a)
#pragma unroll
            for (int b = 0; b < 2; ++b)
#pragma unroll
                for (int m = 0; m < 4; ++m)
#pragma unroll
                    for (int n = 0; n < 2; ++n) acc[a][b][m][n] = (f32x4){0.f, 0.f, 0.f, 0.f};
        cur = nxt; cA = nA; cB = nB; ++ui;
        if (wr == 1) PG8_BAR;
    }
    PG8_WAIT_V(0);
    PG8_BAR;
#undef PG8_SA
#undef PG8_SB
#undef PG8_STAGE
#undef PG8_LDA
#undef PG8_LDB
#undef PG8_MMA
#undef PG8_WAIT_V
#undef PG8_WAIT_L
#undef PG8_BAR
#undef PG8_SCHED
}
}

__device__ __forceinline__ void rstd_table(const float* ssq, int row0, LAS float* tab, int t) {
    const int r = t >> 1, hf = t & 1;
    const float* p = ssq + ssq_idx(row0 + r, hf * 16);
    float s = 0.f;
#pragma unroll
    for (int i = 0; i < 16; ++i) s += p[i * 32];
    s += __shfl_xor(s, 1);
    if (!hf) tab[r] = rsqrtf(s * (1.0f / 2048.0f) + EPS);
}

struct EpiProj {
    static constexpr bool HAS_TAB = false; static constexpr int MID_T = -1;
    bf16_t* O;
    __device__ __forceinline__ void prep(const pg8::Unit&, LAS float*, int) const {}
    __device__ __forceinline__ void operator()(const f32x4 (&acc)[2][2][4][2], const pg8::Unit& u, LAS const float*, int wr, int wc, int fr, int fq) const {
        const int row0 = u.pm * 256 + wr * 64 + fr, col0 = u.pn * 256 + wc * 32 + 8 * fq;
#pragma unroll
        for (int ai = 0; ai < 2; ++ai)
#pragma unroll
            for (int m = 0; m < 4; ++m) { bf16_t* rowp = O + (size_t)(row0 + ai * 128 + m * 16) * NPROJ + col0;
#pragma unroll
                for (int bj = 0; bj < 2; ++bj) { const f32x4 v0 = acc[ai][bj][m][0], v1 = acc[ai][bj][m][1];
                    u32x4 w; w.x = cvt_pk_bf16(v0[0], v0[1]); w.y = cvt_pk_bf16(v0[2], v0[3]); w.z = cvt_pk_bf16(v1[0], v1[1]); w.w = cvt_pk_bf16(v1[2], v1[3]);
                    *(u32x4*)(rowp + bj * 128) = w; } }
    }
};
struct EpiOut {
    static constexpr bool HAS_TAB = true; static constexpr int MID_T = 32;
    const float* x; float* h1f; bf16_t* h1b; const float* ssq1; float* ssq2;
    __device__ __forceinline__ void prep(const pg8::Unit& u, LAS float* tab, int t) const { rstd_table(ssq1, u.pm * 256, tab, t); }
    __device__ __forceinline__ void operator()(const f32x4 (&acc)[2][2][4][2], const pg8::Unit& u, LAS const float*, int wr, int wc, int fr, int fq) const {
        const int row0 = u.pm * 256 + wr * 64 + fr, col0 = u.pn * 256 + wc * 32 + 8 * fq;
#pragma unroll
        for (int ai = 0; ai < 2; ++ai)
#pragma unroll
            for (int m = 0; m < 4; ++m) { const int row = row0 + ai * 128 + m * 16; const size_t off = (size_t)row * D_ + col0; float ss = 0.f;
#pragma unroll
                for (int bj = 0; bj < 2; ++bj) {
                    const f32x4 x0 = *(const f32x4*)(x + off + bj * 128), x1 = *(const f32x4*)(x + off + bj * 128 + 4);
                    const f32x4 v0 = acc[ai][bj][m][0] + x0, v1 = acc[ai][bj][m][1] + x1;
                    *(f32x4*)(h1f + off + bj * 128) = v0; *(f32x4*)(h1f + off + bj * 128 + 4) = v1;
                    u32x4 w; w.x = cvt_pk_bf16(v0[0], v0[1]); w.y = cvt_pk_bf16(v0[2], v0[3]); w.z = cvt_pk_bf16(v1[0], v1[1]); w.w = cvt_pk_bf16(v1[2], v1[3]);
                    *(u32x4*)(h1b + off + bj * 128) = w;
                    ss += (v0[0] * v0[0] + v0[1] * v0[1]) + (v0[2] * v0[2] + v0[3] * v0[3]) + (v1[0] * v1[0] + v1[1] * v1[1]) + (v1[2] * v1[2] + v1[3] * v1[3]); }
                ss += __shfl_xor(ss, 16); ss += __shfl_xor(ss, 32);
                if (fq == 0) ssq2[ssq_idx(row, u.pn * 4 + wc)] = ss; }
    }
};
struct EpiGU {
    static constexpr bool HAS_TAB = true; static constexpr int MID_T = -1;
    const float* ssq2; bf16_t* hff;
    __device__ __forceinline__ void prep(const pg8::Unit& u, LAS float* tab, int t) const { rstd_table(ssq2, u.pm * 256, tab, t); }
    __device__ __forceinline__ void operator()(const f32x4 (&acc)[2][2][4][2], const pg8::Unit& u, LAS const float* tab, int wr, int wc, int fr, int fq) const {
        const int row0 = u.pm * 256 + wr * 64 + fr, col0 = u.pn * 128 + wc * 32 + 8 * fq;
#pragma unroll
        for (int ai = 0; ai < 2; ++ai)
#pragma unroll
            for (int m = 0; m < 4; ++m) { const float rs = tab[ai * 128 + wr * 64 + m * 16 + fr];
                float o[8];
#pragma unroll
                for (int n = 0; n < 2; ++n)
#pragma unroll
                    for (int j = 0; j < 4; ++j) { const float gg = acc[ai][0][m][n][j] * rs, uu = acc[ai][1][m][n][j] * rs; o[n * 4 + j] = silu_f(gg) * uu; }
                u32x4 w; w.x = cvt_pk_bf16(o[0], o[1]); w.y = cvt_pk_bf16(o[2], o[3]); w.z = cvt_pk_bf16(o[4], o[5]); w.w = cvt_pk_bf16(o[6], o[7]);
                *(u32x4*)(hff + (size_t)(row0 + ai * 128 + m * 16) * DFF + col0) = w; }
    }
};
struct EpiDown {
    static constexpr bool HAS_TAB = false; static constexpr int MID_T = -1;
    float* h; float* ssq3;
    __device__ __forceinline__ void prep(const pg8::Unit&, LAS float*, int) const {}
    __device__ __forceinline__ void operator()(const f32x4 (&acc)[2][2][4][2], const pg8::Unit& u, LAS const float*, int wr, int wc, int fr, int fq) const {
        const int row0 = u.pm * 256 + wr * 64 + fr, col0 = u.pn * 256 + wc * 32 + 8 * fq;
#pragma unroll
        for (int ai = 0; ai < 2; ++ai)
#pragma unroll
            for (int m = 0; m < 4; ++m) { const int row = row0 + ai * 128 + m * 16; const size_t off = (size_t)row * D_ + col0; float ss = 0.f;
#pragma unroll
                for (int bj = 0; bj < 2; ++bj) {
                    const f32x4 x0 = *(const f32x4*)(h + off + bj * 128), x1 = *(const f32x4*)(h + off + bj * 128 + 4);
                    const f32x4 v0 = acc[ai][bj][m][0] + x0, v1 = acc[ai][bj][m][1] + x1;
                    *(f32x4*)(h + off + bj * 128) = v0; *(f32x4*)(h + off + bj * 128 + 4) = v1;
                    ss += (v0[0] * v0[0] + v0[1] * v0[1]) + (v0[2] * v0[2] + v0[3] * v0[3]) + (v1[0] * v1[0] + v1[1] * v1[1]) + (v1[2] * v1[2] + v1[3] * v1[3]); }
                ss += __shfl_xor(ss, 16); ss += __shfl_xor(ss, 32);
                if (fq == 0) ssq3[ssq_idx(row, u.pn * 4 + wc)] = ss; }
    }
};

__device__ __forceinline__ void p0_tile(LAS float* t, const float* src, int ldsrc, int k0, int c0, int jvalid, bf16_t* dst, int K, int j0, const float* scale, int scale_kmax, int tid) {
    const int jc4 = (tid & 15) * 4, kr0 = tid >> 4;
#pragma unroll
    for (int i = 0; i < 4; ++i) {
        const int kr = kr0 + 32 * i;
        f32x4 v = (f32x4){0.f, 0.f, 0.f, 0.f};
        if (jc4 < jvalid) v = *(const f32x4*)(src + (size_t)(k0 + kr) * ldsrc + c0 + jc4);
        const float s = (scale != nullptr && (k0 + kr) < scale_kmax) ? scale[k0 + kr] : 1.0f;
        t[kr * 65 + jc4 + 0] = v[0] * s; t[kr * 65 + jc4 + 1] = v[1] * s; t[kr * 65 + jc4 + 2] = v[2] * s; t[kr * 65 + jc4 + 3] = v[3] * s;
    }
    __syncthreads();
    const int kp = (tid & 63) * 2, jr0 = tid >> 6;
#pragma unroll
    for (int i = 0; i < 8; ++i) {
        const int j = jr0 + 8 * i;
        if (j < jvalid) { const float a = t[kp * 65 + j], b = t[(kp + 1) * 65 + j];
            *(unsigned*)(dst + (size_t)(j0 + j) * K + k0 + kp) = cvt_pk_bf16(a, b); }
    }
    __syncthreads();
}
struct TileD { const float* src; const float* scale; bf16_t* dst; int ldsrc, k0, c0, jvalid, K, j0, kmax; };
__device__ __forceinline__ TileD tile_decode(const Params& p, int u) {
    constexpr int U_IN = 16 * 193, U_OUT = 32 * 32, U_GU = 16 * 176;
    TileD d;
    if (u < U_IN) { const int kt = u & 15, jt = u >> 4, j0 = jt * 64;
        d.src = p.w_in; d.scale = nullptr; d.dst = (bf16_t*)(p.ws + WS_BTIN); d.ldsrc = DIN; d.k0 = kt * 128; d.c0 = j0 < 6144 ? j0 : (j0 < 12288 ? j0 + 32 : 6144); d.jvalid = (jt == 192) ? 32 : 64; d.K = D_; d.j0 = j0; d.kmax = 0; }
    else if (u < U_IN + U_OUT) { const int v = u - U_IN, kt = v & 31, jt = v >> 5;
        d.src = p.w_out; d.scale = p.ssm_norm_g; d.dst = (bf16_t*)((unsigned char*)p.out + DO_BTOUT); d.ldsrc = D_; d.k0 = kt * 128; d.c0 = jt * 64; d.jvalid = 64; d.K = DMIX; d.j0 = jt * 64; d.kmax = 2048; }
    else if (u < U_IN + U_OUT + U_GU) { const int v = u - U_IN - U_OUT, kt = v & 15, jt = v >> 4, j0 = jt * 64, pn = j0 >> 8, r0 = j0 & 255;
        d.src = r0 < 128 ? p.w_gate : p.w_up; d.scale = p.norm_ffn_g; d.dst = (bf16_t*)((unsigned char*)p.out + DO_BTGU); d.ldsrc = DFF; d.k0 = kt * 128; d.c0 = 128 * pn + (r0 & 127); d.jvalid = 64; d.K = D_; d.j0 = j0; d.kmax = 2048; }
    else { const int v = u - U_IN - U_OUT - U_GU, kt = v % 44, jt = v / 44;
        d.src = p.w_down; d.scale = nullptr; d.dst = (bf16_t*)((unsigned char*)p.out + DO_BTDN); d.ldsrc = D_; d.k0 = kt * 128; d.c0 = jt * 64; d.jvalid = 64; d.K = DFF; d.j0 = jt * 64; d.kmax = 0; }
    return d;
}
__device__ __forceinline__ void tile_load(const TileD& d, int tid, f32x4 (&v)[4], float (&scl)[4]) {
    const int jc4 = (tid & 15) * 4, kr0 = tid >> 4;
#pragma unroll
    for (int i = 0; i < 4; ++i) { const int kr = kr0 + 32 * i;
        f32x4 x = (f32x4){0.f, 0.f, 0.f, 0.f};
        if (jc4 < d.jvalid) x = *(const f32x4*)(d.src + (size_t)(d.k0 + kr) * d.ldsrc + d.c0 + jc4);
        scl[i] = (d.scale != nullptr && (d.k0 + kr) < d.kmax) ? d.scale[d.k0 + kr] : 1.0f;
        v[i] = x; }
}
__device__ __forceinline__ void tile_finish(LAS float* t, const TileD& d, int tid, const f32x4 (&v)[4], const float (&scl)[4]) {
    const int jc4 = (tid & 15) * 4, kr0 = tid >> 4;
#pragma unroll
    for (int i = 0; i < 4; ++i) { const int kr = kr0 + 32 * i;
        t[kr * 65 + jc4 + 0] = v[i][0] * scl[i]; t[kr * 65 + jc4 + 1] = v[i][1] * scl[i]; t[kr * 65 + jc4 + 2] = v[i][2] * scl[i]; t[kr * 65 + jc4 + 3] = v[i][3] * scl[i]; }
    asm volatile("s_waitcnt lgkmcnt(0)" ::: "memory"); __builtin_amdgcn_s_barrier(); asm volatile("" ::: "memory");
    const int kp = (tid & 63) * 2, jr0 = tid >> 6;
#pragma unroll
    for (int i = 0; i < 8; ++i) { const int j = jr0 + 8 * i;
        if (j < d.jvalid) { const float a = t[kp * 65 + j], b = t[(kp + 1) * 65 + j];
            *(unsigned*)(d.dst + (size_t)(d.j0 + j) * d.K + d.k0 + kp) = cvt_pk_bf16(a, b); } }
    asm volatile("s_waitcnt lgkmcnt(0)" ::: "memory"); __builtin_amdgcn_s_barrier(); asm volatile("" ::: "memory");
}
__device__ __forceinline__ void conv_tiles(const Params& p, LAS unsigned char* lds, int u_begin, int u_end, int first, int stride, int tid) {
    LAS float* t = (LAS float*)lds;
    int u = u_begin + first;
    if (u >= u_end) return;
    TileD d = tile_decode(p, u); f32x4 v[4]; float sc[4]; tile_load(d, tid, v, sc);
    for (;;) {
        const int un = u + stride; const bool more = un < u_end;
        TileD dn = d; f32x4 vn[4]; float scn[4];
#pragma unroll
        for (int i = 0; i < 4; ++i) { vn[i] = v[i]; scn[i] = sc[i]; }
        if (more) { dn = tile_decode(p, un); tile_load(dn, tid, vn, scn); }
        tile_finish(t, d, tid, v, sc);
        if (!more) break;
        d = dn; u = un;
#pragma unroll
        for (int i = 0; i < 4; ++i) { v[i] = vn[i]; sc[i] = scn[i]; }
    }
}
__device__ void phase0(const Params& p, LAS unsigned char* lds, int wv) {
    const int lane = lane_id(), wave = wv, tid = wv * 64 + lane, G = gridDim.x;
    LAS float* t = (LAS float*)lds;
    bf16_t* bt_in = (bf16_t*)(p.ws + WS_BTIN);
    bf16_t* xn = (bf16_t*)(p.ws + WS_XN);
    for (int row = blockIdx.x * 8 + wave; row < M_; row += G * 8) {
        const f32x4* xr = (const f32x4*)(p.x + (size_t)row * D_);
        f32x4 v[8]; float ss = 0.f;
#pragma unroll
        for (int i = 0; i < 8; ++i) { v[i] = xr[lane + 64 * i]; ss += (v[i][0] * v[i][0] + v[i][1] * v[i][1]) + (v[i][2] * v[i][2] + v[i][3] * v[i][3]); }
#pragma unroll
        for (int o = 32; o >= 1; o >>= 1) ss += __shfl_xor(ss, o);
        const float rstd = rsqrtf(ss * (1.0f / 2048.0f) + EPS);
#pragma unroll
        for (int i = 0; i < 8; ++i) { const f32x4 g4 = ((const f32x4*)p.norm_mix_g)[lane + 64 * i];
            u32x2 w; w.x = cvt_pk_bf16(v[i][0] * rstd * g4[0], v[i][1] * rstd * g4[1]); w.y = cvt_pk_bf16(v[i][2] * rstd * g4[2], v[i][3] * rstd * g4[3]);
            *(u32x2*)(xn + (size_t)row * D_ + 4 * (lane + 64 * i)) = w; }
    }
    __syncthreads();
    conv_tiles(p, lds, 0, 16 * 193, blockIdx.x, G, tid);
}
__device__ void wconv_units(const Params& p, LAS unsigned char* lds, int first, int stride, int wv) {
    const int tid = wv * 64 + lane_id();
    __syncthreads();
    conv_tiles(p, lds, 16 * 193, 16 * 193 + 32 * 32 + 16 * 176 + 44 * 32, first, stride, tid);
}

__device__ void dt_units(const Params& p, LAS unsigned char* lds, int wv) {
    const int lane = lane_id(), w = wv, tid = wv * 64 + lane, fr = lane & 15, fq = lane >> 4;
    const bf16_t* xn = (const bf16_t*)(p.ws + WS_XN);
    const bf16_t* bt = (const bf16_t*)(p.ws + WS_BTIN) + (size_t)NPROJ * D_;
    float* dt = (float*)((unsigned char*)p.out + DO_DT);
    LAS float* red = (LAS float*)lds;
    for (int rb = blockIdx.x; rb < M_ / 64; rb += gridDim.x) {
        const int row0 = rb * 64;
        f32x4 acc[4][2];
#pragma unroll
        for (int m = 0; m < 4; ++m)
#pragma unroll
            for (int n = 0; n < 2; ++n) acc[m][n] = (f32x4){0.f, 0.f, 0.f, 0.f};
#pragma unroll 4
        for (int ks = 0; ks < 8; ++ks) {
            const int kb = w * 256 + ks * 32 + fq * 8;
            bf16x8 a[4], b[2];
#pragma unroll
            for (int m = 0; m < 4; ++m) a[m] = *(const bf16x8*)(xn + (size_t)(row0 + 16 * m + fr) * D_ + kb);
#pragma unroll
            for (int n = 0; n < 2; ++n) b[n] = *(const bf16x8*)(bt + (size_t)(16 * n + fr) * D_ + kb);
#pragma unroll
            for (int m = 0; m < 4; ++m)
#pragma unroll
                for (int n = 0; n < 2; ++n) acc[m][n] = __builtin_amdgcn_mfma_f32_16x16x32_bf16(a[m], b[n], acc[m][n], 0, 0, 0);
        }
#pragma unroll
        for (int m = 0; m < 4; ++m)
#pragma unroll
            for (int n = 0; n < 2; ++n)
#pragma unroll
                for (int j = 0; j < 4; ++j) red[w * 2048 + (16 * m + 4 * fq + j) * 32 + 16 * n + fr] = acc[m][n][j];
        __syncthreads();
        {
            const int idx = tid * 4, r = idx >> 5, c = idx & 31;
            f32x4 s = (f32x4){0.f, 0.f, 0.f, 0.f};
#pragma unroll
            for (int ww = 0; ww < 8; ++ww) s += *(LAS const f32x4*)(red + ww * 2048 + idx);
            const f32x4 bias = *(const f32x4*)(p.ssm_dt_bias + c);
            f32x4 o;
#pragma unroll
            for (int j = 0; j < 4; ++j) { const float v = s[j] + bias[j]; o[j] = v > 20.f ? v : log1pf(expf(v)); }
            *(f32x4*)(dt + (size_t)(row0 + r) * 32 + c) = o;
        }
        __syncthreads();
    }
}

__device__ void bc_conv_phase(const Params& p, LAS unsigned char* lds, int wv) {
    const int tid = wv * 64 + lane_id(), cv = tid & 7, run = tid >> 3;
    bf16_t* proj = (bf16_t*)(p.ws + WS_PROJ);
    LAS u32x4* stash = (LAS u32x4*)lds;
    for (int sq = blockIdx.x; sq < 4 * 32; sq += gridDim.x) {
        const int b = sq >> 5, slab = sq & 31;
        const int xcol = 2048 + slab * 64 + cv * 8;
        float wk[4][8], bs[8];
#pragma unroll
        for (int k = 0; k < 4; ++k) { const f32x4 a = *(const f32x4*)(p.ssm_conv_w + k * 4096 + xcol), c = *(const f32x4*)(p.ssm_conv_w + k * 4096 + xcol + 4);
#pragma unroll
            for (int j = 0; j < 4; ++j) { wk[k][j] = a[j]; wk[k][4 + j] = c[j]; } }
        { const f32x4 a = *(const f32x4*)(p.ssm_conv_b + xcol), c = *(const f32x4*)(p.ssm_conv_b + xcol + 4);
#pragma unroll
          for (int j = 0; j < 4; ++j) { bs[j] = a[j]; bs[4 + j] = c[j]; } }
        __syncthreads();
#pragma unroll 1
        for (int tile = 0; tile < 8; ++tile) {
            bf16_t* base = proj + (size_t)(b * SEQ + tile * 512 + run * 8) * NPROJ + 2048 + xcol;
            u32x4 raw[11];
#pragma unroll
            for (int r = 0; r < 11; ++r) {
                const int row = run * 8 + r - 3;
                if (row >= 0) raw[r] = *(const u32x4*)(base + (long)(r - 3) * NPROJ);
                else raw[r] = (tile == 0) ? (u32x4){0u, 0u, 0u, 0u} : stash[(row + 3) * 8 + cv];
            }
            u32x4 ov[8];
#pragma unroll
            for (int j = 0; j < 8; ++j) {
                float o[8];
#pragma unroll
                for (int q = 0; q < 4; ++q) {
                    const unsigned x0 = raw[j][q], x1 = raw[j + 1][q], x2 = raw[j + 2][q], x3 = raw[j + 3][q];
                    o[2 * q] = silu_f(bs[2 * q] + wk[0][2 * q] * bflo(x0) + wk[1][2 * q] * bflo(x1) + wk[2][2 * q] * bflo(x2) + wk[3][2 * q] * bflo(x3));
                    o[2 * q + 1] = silu_f(bs[2 * q + 1] + wk[0][2 * q + 1] * bfhi(x0) + wk[1][2 * q + 1] * bfhi(x1) + wk[2][2 * q + 1] * bfhi(x2) + wk[3][2 * q + 1] * bfhi(x3));
                }
                ov[j].x = cvt_pk_bf16(o[0], o[1]); ov[j].y = cvt_pk_bf16(o[2], o[3]); ov[j].z = cvt_pk_bf16(o[4], o[5]); ov[j].w = cvt_pk_bf16(o[6], o[7]);
            }
            asm volatile("s_waitcnt vmcnt(0) lgkmcnt(0)" ::: "memory");
            __syncthreads();
            if (run == 63) { stash[0 * 8 + cv] = raw[8]; stash[1 * 8 + cv] = raw[9]; stash[2 * 8 + cv] = raw[10]; }
#pragma unroll
            for (int j = 0; j < 8; ++j) *(u32x4*)(base + (long)j * NPROJ) = ov[j];
            __syncthreads();
        }
    }
}

constexpr int SROW = 272;
constexpr int L_CM = 0, L_BM = 34816, L_BDT = 69632, L_XT = 104448, L_HB = 121856  , L_CS = 156672, L_DT = 157184, L_CW = 157696  ;
__device__ __forceinline__ int swz_off(int row, int kblk) { return row * SROW + ((kblk ^ ((row >> 3) & 7)) << 4); }
__device__ __forceinline__ void ssd_load(u32x4 (&raw)[5], const bf16_t* base, bool first, int l0) {
#pragma unroll
    for (int r = 0; r < 5; ++r) raw[r] = (first && (l0 + r - 3) < 0) ? (u32x4){0u, 0u, 0u, 0u} : *(const u32x4*)(base + (long)(r - 3) * NPROJ);
}
template <int GI>
__device__ __forceinline__ void ssd_conv(LAS unsigned char* lds, const u32x4 (&raw)[5], int cv, int l0, float sa, float sb) {
    LAS const f32x4* cw = (LAS const f32x4*)(lds + L_CW) + cv * 10;
    float o0[8], o1[8];
#pragma unroll
    for (int hq = 0; hq < 2; ++hq) {
        const f32x4 w0 = cw[0 + hq], w1 = cw[2 + hq], w2 = cw[4 + hq], w3 = cw[6 + hq], bs = cw[8 + hq];
#pragma unroll
        for (int e2 = 0; e2 < 2; ++e2) {
            const int q = hq * 2 + e2;
            const unsigned x0 = raw[0][q], x1 = raw[1][q], x2 = raw[2][q], x3 = raw[3][q], x4 = raw[4][q];
            const int ea = e2 * 2, eb = e2 * 2 + 1;
            const float va = bs[ea] + w0[ea] * bflo(x0) + w1[ea] * bflo(x1) + w2[ea] * bflo(x2) + w3[ea] * bflo(x3);
            const float vb = bs[eb] + w0[eb] * bfhi(x0) + w1[eb] * bfhi(x1) + w2[eb] * bfhi(x2) + w3[eb] * bfhi(x3);
            const float ua = bs[ea] + w0[ea] * bflo(x1) + w1[ea] * bflo(x2) + w2[ea] * bflo(x3) + w3[ea] * bflo(x4);
            const float ub = bs[eb] + w0[eb] * bfhi(x1) + w1[eb] * bfhi(x2) + w2[eb] * bfhi(x3) + w3[eb] * bfhi(x4);
            o0[2 * q] = silu_f(va); o0[2 * q + 1] = silu_f(vb); o1[2 * q] = silu_f(ua); o1[2 * q + 1] = silu_f(ub);
        }
    }
    if (GI == 0) {
#pragma unroll
        for (int e = 0; e < 8; ++e) { const int prow = cv * 8 + e;
            *(LAS unsigned*)(lds + L_XT + swz_off(prow, l0 >> 3) + (l0 & 7) * 2) = cvt_pk_bf16(o0[e] * sa, o1[e] * sb); }
    } else {
        u32x4 w0; w0.x = cvt_pk_bf16(o0[0], o0[1]); w0.y = cvt_pk_bf16(o0[2], o0[3]); w0.z = cvt_pk_bf16(o0[4], o0[5]); w0.w = cvt_pk_bf16(o0[6], o0[7]);
        u32x4 w1; w1.x = cvt_pk_bf16(o1[0], o1[1]); w1.y = cvt_pk_bf16(o1[2], o1[3]); w1.z = cvt_pk_bf16(o1[4], o1[5]); w1.w = cvt_pk_bf16(o1[6], o1[7]);
        const int nb = ((GI - 1) & 1) * 64 + cv * 8;
        if (GI < 3) {
            *(LAS u32x4*)(lds + L_BM + l0 * SROW + nb * 2) = w0; *(LAS u32x4*)(lds + L_BM + (l0 + 1) * SROW + nb * 2) = w1;
#pragma unroll
            for (int e = 0; e < 8; ++e) { const int nrow = nb + e;
                *(LAS unsigned*)(lds + L_BDT + swz_off(nrow, l0 >> 3) + (l0 & 7) * 2) = cvt_pk_bf16(o0[e] * sa, o1[e] * sb); }
        } else {
            *(LAS u32x4*)(lds + L_CM + l0 * SROW + nb * 2) = w0; *(LAS u32x4*)(lds + L_CM + (l0 + 1) * SROW + nb * 2) = w1;
        }
    }
}
template <int GI>
__device__ __forceinline__ void ssd_put(LAS unsigned char* lds, const u32x4 (&rw)[2], int cv, int l0, float sa, float sb) {
    const int nb = ((GI - 1) & 1) * 64 + cv * 8;
    if (GI < 3) {
        *(LAS u32x4*)(lds + L_BM + l0 * SROW + nb * 2) = rw[0]; *(LAS u32x4*)(lds + L_BM + (l0 + 1) * SROW + nb * 2) = rw[1];
#pragma unroll
        for (int q = 0; q < 4; ++q) {
            *(LAS unsigned*)(lds + L_BDT + swz_off(nb + 2 * q, l0 >> 3) + (l0 & 7) * 2) = cvt_pk_bf16(bflo(rw[0][q]) * sa, bflo(rw[1][q]) * sb);
            *(LAS unsigned*)(lds + L_BDT + swz_off(nb + 2 * q + 1, l0 >> 3) + (l0 & 7) * 2) = cvt_pk_bf16(bfhi(rw[0][q]) * sa, bfhi(rw[1][q]) * sb);
        }
    } else {
        *(LAS u32x4*)(lds + L_CM + l0 * SROW + nb * 2) = rw[0]; *(LAS u32x4*)(lds + L_CM + (l0 + 1) * SROW + nb * 2) = rw[1];
    }
}
__device__ void ssd_unit(const Params& p, LAS unsigned char* lds, int b, int h, int wv) {
    const int lane = lane_id(), w = wv, tid = wv * 64 + lane, fr = lane & 15, fq = lane >> 4;
    const int g = h >> 2;
    const bf16_t* proj = (const bf16_t*)(p.ws + WS_PROJ);
    const float* dtg = (const float*)((const unsigned char*)p.out + DO_DT);
    bf16_t* ymix = (bf16_t*)(p.ws + WS_YMIX);
    float* ssq1 = (float*)((unsigned char*)p.out + DO_SSQ1);
    LAS float* CSv = (LAS float*)(lds + L_CS);
    LAS float* DTv = (LAS float*)(lds + L_DT);
    LAS float* CW = (LAS float*)(lds + L_CW);
    const float Aneg = -__expf(p.ssm_A_log[h]);
    const float Dh = p.ssm_D[h];
    for (int idx = tid; idx < 320; idx += 512) {
        const int e = idx & 7, k = (idx >> 3) % 5, cvi = idx / 40;
        const int xcol = h * 64 + cvi * 8 + e;
        CW[idx] = (k < 4) ? p.ssm_conv_w[k * 4096 + xcol] : p.ssm_conv_b[xcol];
    }
    for (int idx = tid; idx < 64 * 17; idx += 512) *(LAS u32x4*)(lds + L_HB + idx * 16) = (u32x4){0u, 0u, 0u, 0u};
    f32x4 Hacc[4];
#pragma unroll
    for (int pt = 0; pt < 4; ++pt) Hacc[pt] = (f32x4){0.f, 0.f, 0.f, 0.f};
    __syncthreads();
    const int cv = lane & 7;
    const int l0 = 16 * w + 2 * (lane >> 3);
    const int srcl = (w & 3) * 16 + 2 * (lane >> 3);
    u32x4 r0[5], r1[2], r2[2], r3[2], r4[2];
    const bf16_t* pbase = proj + (size_t)(b * SEQ + l0) * NPROJ + 2048 + cv * 8;
    const int xc0 = h * 64, xc1 = 2048 + g * 128, xc2 = xc1 + 64, xc3 = 3072 + g * 128, xc4 = xc3 + 64;
    ssd_load(r0, pbase + xc0, true, l0);
    r1[0] = *(const u32x4*)(pbase + xc1); r1[1] = *(const u32x4*)(pbase + xc1 + NPROJ); r2[0] = *(const u32x4*)(pbase + xc2); r2[1] = *(const u32x4*)(pbase + xc2 + NPROJ);
    r3[0] = *(const u32x4*)(pbase + xc3); r3[1] = *(const u32x4*)(pbase + xc3 + NPROJ); r4[0] = *(const u32x4*)(pbase + xc4); r4[1] = *(const u32x4*)(pbase + xc4 + NPROJ);
    float dt0n = dtg[(size_t)(b * SEQ + lane) * 32 + h], dt1n = dtg[(size_t)(b * SEQ + 64 + lane) * 32 + h];
    for (int c = 0; c < 32; ++c) {
        const int row0 = b * SEQ + c * 128;
        const float dt0 = dt0n, dt1 = dt1n;
        float a0 = dt0 * Aneg, a1 = dt1 * Aneg;
#pragma unroll
        for (int o = 1; o < 64; o <<= 1) { const float t0 = __shfl_up(a0, o), t1 = __shfl_up(a1, o); if (lane >= o) { a0 += t0; a1 += t1; } }
        a1 += __shfl(a0, 63);
        const float cs_end = __shfl(a1, 63);
        if (w == 0) { CSv[lane] = a0; CSv[64 + lane] = a1; DTv[lane] = dt0; DTv[64 + lane] = dt1; }
        const float csv = (w >= 4) ? a1 : a0, dtv = (w >= 4) ? dt1 : dt0;
        const float cs_l0 = __shfl(csv, srcl), cs_l1 = __shfl(csv, srcl + 1), dt_l0 = __shfl(dtv, srcl), dt_l1 = __shfl(dtv, srcl + 1);
        const float dec0 = __expf(cs_end - cs_l0), dec1 = __expf(cs_end - cs_l1);
        ssd_conv<0>(lds, r0, cv, l0, dt_l0, dt_l1);
        ssd_put<1>(lds, r1, cv, l0, dec0, dec1); ssd_put<2>(lds, r2, cv, l0, dec0, dec1);
        ssd_put<3>(lds, r3, cv, l0, 0.f, 0.f);   ssd_put<4>(lds, r4, cv, l0, 0.f, 0.f);
        __builtin_amdgcn_sched_barrier(0);
        if (c + 1 < 32) {
            const bf16_t* cb = pbase + (size_t)(c + 1) * 128 * NPROJ;
            ssd_load(r0, cb + xc0, false, l0);
            r1[0] = *(const u32x4*)(cb + xc1); r1[1] = *(const u32x4*)(cb + xc1 + NPROJ); r2[0] = *(const u32x4*)(cb + xc2); r2[1] = *(const u32x4*)(cb + xc2 + NPROJ);
            r3[0] = *(const u32x4*)(cb + xc3); r3[1] = *(const u32x4*)(cb + xc3 + NPROJ); r4[0] = *(const u32x4*)(cb + xc4); r4[1] = *(const u32x4*)(cb + xc4 + NPROJ);
            dt0n = dtg[(size_t)(row0 + 128 + lane) * 32 + h]; dt1n = dtg[(size_t)(row0 + 192 + lane) * 32 + h];
        }
        __builtin_amdgcn_sched_barrier(0);
        u32x2 zr[4];
#pragma unroll
        for (int pt = 0; pt < 4; ++pt) zr[pt] = *(const u32x2*)(proj + (size_t)(row0 + 16 * w + fr) * NPROJ + h * 64 + 16 * pt + 4 * fq);
        asm volatile("s_waitcnt lgkmcnt(0)" ::: "memory"); __builtin_amdgcn_s_barrier(); asm volatile("" ::: "memory");
        const int lrow = 16 * w + fr;
        const int hb_cur = L_HB + (c & 1) * 17408, hb_nxt = L_HB + ((c + 1) & 1) * 17408;
        bf16x8 cf[4];
#pragma unroll
        for (int ks = 0; ks < 4; ++ks) cf[ks] = *(LAS const bf16x8*)(lds + L_CM + lrow * SROW + (32 * ks + 8 * fq) * 2);
        const float cs_l = CSv[lrow], dt_l = DTv[lrow];
        asm volatile("" ::: "memory");
        const int dd = fr - 4 * fq; const float ddiag = Dh / dt_l;
        f32x4 y[4];
        { const float el = __expf(cs_l);
#pragma unroll
          for (int pt = 0; pt < 4; ++pt) { f32x4 a = (f32x4){0.f, 0.f, 0.f, 0.f};
#pragma unroll
            for (int ks = 0; ks < 4; ++ks) { const bf16x8 hf = *(LAS const bf16x8*)(lds + hb_cur + (16 * pt + fr) * SROW + (32 * ks + 8 * fq) * 2);
                a = __builtin_amdgcn_mfma_f32_16x16x32_bf16(hf, cf[ks], a, 0, 0, 0); }
            y[pt] = a * el; } }
#pragma unroll
        for (int j = 0; j < 8; ++j) {
            if (j <= w) {
                f32x4 gacc = (f32x4){0.f, 0.f, 0.f, 0.f};
#pragma unroll
                for (int ks = 0; ks < 4; ++ks) { const bf16x8 bf = *(LAS const bf16x8*)(lds + L_BM + (16 * j + fr) * SROW + (32 * ks + 8 * fq) * 2);
                    gacc = __builtin_amdgcn_mfma_f32_16x16x32_bf16(bf, cf[ks], gacc, 0, 0, 0); }
                const f32x4 css = *(LAS const f32x4*)(CSv + 16 * j + 4 * fq);
                float mv[4];
#pragma unroll
                for (int i = 0; i < 4; ++i) { float v = gacc[i] * __expf(cs_l - css[i]);
                    if (j == w) { v = (i <= dd) ? v : 0.f; if (i == dd) v += ddiag; }
                    mv[i] = v; }
                u32x2 wv2; wv2.x = cvt_pk_bf16(mv[0], mv[1]); wv2.y = cvt_pk_bf16(mv[2], mv[3]);
                *(LAS u32x2*)(lds + L_CM + lrow * SROW + (16 * j + 4 * fq) * 2) = wv2;
            } else if (j == w + 1 && (w & 1) == 0) {
                *(LAS u32x2*)(lds + L_CM + lrow * SROW + (16 * j + 4 * fq) * 2) = (u32x2){0u, 0u};
            }
        }
        asm volatile("" ::: "memory");
        { const float de = __expf(cs_end);
#pragma unroll
          for (int pt = 0; pt < 4; ++pt) Hacc[pt] *= de; }
        const int nks2 = (w >> 1) + 1;
#pragma unroll
        for (int ks = 0; ks < 4; ++ks) {
            bf16x8 xf[4];
#pragma unroll
            for (int pt = 0; pt < 4; ++pt) xf[pt] = *(LAS const bf16x8*)(lds + L_XT + swz_off(16 * pt + fr, 4 * ks + fq));
            if (ks < nks2) { const bf16x8 mf = *(LAS const bf16x8*)(lds + L_CM + lrow * SROW + (32 * ks + 8 * fq) * 2);
#pragma unroll
                for (int pt = 0; pt < 4; ++pt) y[pt] = __builtin_amdgcn_mfma_f32_16x16x32_bf16(xf[pt], mf, y[pt], 0, 0, 0); }
            const bf16x8 bdf = *(LAS const bf16x8*)(lds + L_BDT + swz_off(16 * w + fr, 4 * ks + fq));
#pragma unroll
            for (int pt = 0; pt < 4; ++pt) Hacc[pt] = __builtin_amdgcn_mfma_f32_16x16x32_bf16(bdf, xf[pt], Hacc[pt], 0, 0, 0);
        }
#pragma unroll
        for (int pt = 0; pt < 4; ++pt) { u32x2 wv2; wv2.x = cvt_pk_bf16(Hacc[pt][0], Hacc[pt][1]); wv2.y = cvt_pk_bf16(Hacc[pt][2], Hacc[pt][3]);
            *(LAS u32x2*)(lds + hb_nxt + (16 * pt + fr) * SROW + (16 * w + 4 * fq) * 2) = wv2; }
        { float ss = 0.f; const size_t orow = (size_t)(row0 + lrow);
#pragma unroll
          for (int pt = 0; pt < 4; ++pt) {
            const float z0 = bflo(zr[pt].x), z1 = bfhi(zr[pt].x), z2 = bflo(zr[pt].y), z3 = bfhi(zr[pt].y);
            const float v0 = y[pt][0] * silu_f(z0), v1 = y[pt][1] * silu_f(z1), v2 = y[pt][2] * silu_f(z2), v3 = y[pt][3] * silu_f(z3);
            ss += (v0 * v0 + v1 * v1) + (v2 * v2 + v3 * v3);
            u32x2 wv; wv.x = cvt_pk_bf16(v0, v1); wv.y = cvt_pk_bf16(v2, v3);
            *(u32x2*)(ymix + orow * DMIX + h * 64 + 16 * pt + 4 * fq) = wv; }
          ss += __shfl_xor(ss, 16); ss += __shfl_xor(ss, 32);
          if (fq == 0) ssq1[ssq_idx((int)orow, h)] = ss; }
        asm volatile("s_waitcnt lgkmcnt(0)" ::: "memory"); __builtin_amdgcn_s_barrier(); asm volatile("" ::: "memory");
    }
}
__device__ void sc_unit(const Params& p, int unit, int wv) {
    const int tid = wv * 64 + lane_id(), cvx = tid & 255, th = tid >> 8;
    const bf16_t* proj = (const bf16_t*)(p.ws + WS_PROJ);
    bf16_t* ymix = (bf16_t*)(p.ws + WS_YMIX);
    const int t0 = unit * 64 + th * 32, c0 = cvx * 8;
    float w0[8], w1[8], w2[8];
    { const f32x4* a = (const f32x4*)(p.sc_conv_w + c0); const f32x4* bq = (const f32x4*)(p.sc_conv_w + 2048 + c0); const f32x4* cq = (const f32x4*)(p.sc_conv_w + 4096 + c0);
#pragma unroll
      for (int q = 0; q < 2; ++q) { const f32x4 x0 = a[q], x1 = bq[q], x2 = cq[q];
#pragma unroll
        for (int j = 0; j < 4; ++j) { w0[q * 4 + j] = x0[j]; w1[q * 4 + j] = x1[j]; w2[q * 4 + j] = x2[j]; } } }
    float pm1[8], pm2[8];
#pragma unroll
    for (int e = 0; e < 8; ++e) { pm1[e] = 0.f; pm2[e] = 0.f; }
    if ((t0 & (SEQ - 1)) != 0) {
        const bf16_t* r2 = proj + (size_t)(t0 - 2) * NPROJ, * r1 = proj + (size_t)(t0 - 1) * NPROJ;
        const u32x4 c2 = *(const u32x4*)(r2 + 8192 + c0), x2 = *(const u32x4*)(r2 + 10240 + c0), c1 = *(const u32x4*)(r1 + 8192 + c0), x1 = *(const u32x4*)(r1 + 10240 + c0);
#pragma unroll
        for (int q = 0; q < 4; ++q) { pm2[2 * q] = bflo(c2[q]) * bflo(x2[q]); pm2[2 * q + 1] = bfhi(c2[q]) * bfhi(x2[q]); pm1[2 * q] = bflo(c1[q]) * bflo(x1[q]); pm1[2 * q + 1] = bfhi(c1[q]) * bfhi(x1[q]); }
    }
#pragma unroll 4
    for (int i = 0; i < 32; ++i) {
        const bf16_t* r = proj + (size_t)(t0 + i) * NPROJ;
        const u32x4 gb = *(const u32x4*)(r + 6144 + c0), gc = *(const u32x4*)(r + 8192 + c0), gx = *(const u32x4*)(r + 10240 + c0);
        float o[8];
#pragma unroll
        for (int q = 0; q < 4; ++q) {
            const float pa = bflo(gc[q]) * bflo(gx[q]), pb = bfhi(gc[q]) * bfhi(gx[q]);
            o[2 * q] = bflo(gb[q]) * (w0[2 * q] * pm2[2 * q] + w1[2 * q] * pm1[2 * q] + w2[2 * q] * pa);
            o[2 * q + 1] = bfhi(gb[q]) * (w0[2 * q + 1] * pm2[2 * q + 1] + w1[2 * q + 1] * pm1[2 * q + 1] + w2[2 * q + 1] * pb);
            pm2[2 * q] = pm1[2 * q]; pm2[2 * q + 1] = pm1[2 * q + 1]; pm1[2 * q] = pa; pm1[2 * q + 1] = pb;
        }
        u32x4 wv; wv.x = cvt_pk_bf16(o[0], o[1]); wv.y = cvt_pk_bf16(o[2], o[3]); wv.z = cvt_pk_bf16(o[4], o[5]); wv.w = cvt_pk_bf16(o[6], o[7]);
        *(u32x4*)(ymix + (size_t)(t0 + i) * DMIX + 2048 + c0) = wv;
    }
}
__device__ void phase2(const Params& p, LAS unsigned char* lds, int wv) {
    const int G = gridDim.x, bid = blockIdx.x;
    const bool split = G >= 256;
    if (!split || bid < 128) { for (int u = bid; u < 128; u += (split ? 128 : G)) ssd_unit(p, lds, u >> 5, u & 31, wv); }
    if (!split || bid >= 128) { for (int u = (split ? bid - 128 : bid); u < M_ / 64; u += (split ? G - 128 : G)) sc_unit(p, u, wv); }
    if (!split || bid >= 128) wconv_units(p, lds, split ? bid - 128 : bid, split ? G - 128 : G, wv);
}

__device__ void phase6(const Params& p, int wv) {
    const int lane = lane_id(), wave = wv;
    const float* h2 = (const float*)(p.ws + WS_H1F);
    const float* ssq3 = (const float*)(p.ws + WS_SSQ3);
    for (int row = blockIdx.x * 8 + wave; row < M_; row += gridDim.x * 8) {
        float s = (lane < 32) ? ssq3[ssq_idx(row, lane)] : 0.f;
#pragma unroll
        for (int o = 32; o >= 1; o >>= 1) s += __shfl_xor(s, o);
        const float rstd = rsqrtf(s * (1.0f / 2048.0f) + EPS);
        const f32x4* hr = (const f32x4*)(h2 + (size_t)row * D_);
        f32x4* orow = (f32x4*)(p.out + (size_t)row * D_);
#pragma unroll
        for (int i = 0; i < 8; ++i) { const f32x4 v = hr[lane + 64 * i], g4 = ((const f32x4*)p.norm_final_g)[lane + 64 * i]; orow[lane + 64 * i] = v * rstd * g4; }
    }
}


#define XB_TMO      128
#define XB_XCNT(j)  (256  + 64 * (j))
#define XB_XSUB(j)  (1280 + 64 * (j))
#define XB_XGEN(j)  (2304 + 64 * (j))
#define XB_TOP      3328
#define XB_TOPGEN   3392
#define XCD_BAR_WORDS 3456
#define XB_SPIN_CAP (1u << 18)
__device__ __forceinline__ unsigned xb_ld(unsigned* p)              { return __hip_atomic_load(p, __ATOMIC_RELAXED, __HIP_MEMORY_SCOPE_AGENT); }
__device__ __forceinline__ unsigned xb_add(unsigned* p, unsigned v) { return __hip_atomic_fetch_add(p, v, __ATOMIC_RELAXED, __HIP_MEMORY_SCOPE_AGENT); }
__device__ __forceinline__ unsigned xb_xcc_id() { return (unsigned)__builtin_amdgcn_s_getreg((3 << 11) | 20) & 0xFu; }
#define XB_SPIN(cond, bar) do { unsigned _sp = 0; while (cond) { __builtin_amdgcn_s_sleep(1); \
    if ((++_sp & 255u) == 0u) { if (xb_ld(&(bar)[XB_TMO])) break; if (_sp > XB_SPIN_CAP) { atomicAdd(&(bar)[XB_TMO], 1u); break; } } } } while (0)
struct XcdBarrier { unsigned* bar; unsigned x; volatile LAS unsigned* st; };
__device__ __forceinline__ void xcd_barrier_complete(unsigned* bar, unsigned x, unsigned& nloc, unsigned& nx) {
    const unsigned G = gridDim.x * gridDim.y * gridDim.z;
    unsigned sum, cnt, mine, sp = 0u;
    for (;;) {
        sum = 0u; cnt = 0u; mine = 0u;
#pragma unroll
        for (unsigned j = 0; j < 16; ++j) { const unsigned c = xb_ld(&bar[XB_XCNT(j)]); sum += c; cnt += (c > 0u) ? 1u : 0u; mine = (j == x) ? c : mine; }
        if (sum == G) break;
        __builtin_amdgcn_s_sleep(1);
        if ((++sp & 255u) == 0u) { if (xb_ld(&bar[XB_TMO])) break; if (sp > XB_SPIN_CAP) { atomicAdd(&bar[XB_TMO], 1u); break; } }
    }
    nloc = mine > 0u ? mine : 1u; nx = cnt > 0u ? cnt : 1u;
}
__device__ __forceinline__ void xcd_barrier(const XcdBarrier& b, bool leader) {
    asm volatile("s_waitcnt vmcnt(0)" ::: "memory");
    __syncthreads();
    if (leader) {
        unsigned* bar = b.bar;
        __builtin_amdgcn_s_waitcnt(0);
        unsigned nloc = b.st[0], nx = b.st[1];
        if (nloc == 0u) { xcd_barrier_complete(bar, b.x, nloc, nx); b.st[0] = nloc; b.st[1] = nx; }
        const unsigned old = xb_add(&bar[XB_XSUB(b.x)], 1u);
        const unsigned gen = old / nloc;
        if (old + 1u == (gen + 1u) * nloc) {
            __builtin_amdgcn_fence(__ATOMIC_RELEASE, "agent");
            asm volatile("s_waitcnt vmcnt(0)" ::: "memory");
            const unsigned og = xb_add(&bar[XB_TOP], 1u);
            const unsigned tg = og / nx;
            if (og + 1u == (tg + 1u) * nx) xb_add(&bar[XB_TOPGEN], 1u);
            else XB_SPIN(xb_ld(&bar[XB_TOPGEN]) == tg, bar);
            __builtin_amdgcn_fence(__ATOMIC_ACQUIRE, "agent");
            xb_add(&bar[XB_XGEN(b.x)], 1u);
            asm volatile("s_waitcnt vmcnt(0)" ::: "memory");
        } else {
            XB_SPIN(xb_ld(&bar[XB_XGEN(b.x)]) == gen, bar);
            __builtin_amdgcn_fence(__ATOMIC_ACQUIRE, "agent");
            asm volatile("s_waitcnt vmcnt(0)" ::: "memory");
        }
    }
    __syncthreads();
}

__global__ void __launch_bounds__(512) hymba_fwd(Params p) {
    extern __shared__ __attribute__((aligned(16))) unsigned char shm[];
    LAS unsigned char* lds = (LAS unsigned char*)shm;
    cg::grid_group grid = cg::this_grid();
    const int lo = p.ph_lo, hi = p.ph_hi;
    const int wv = __builtin_amdgcn_readfirstlane(threadIdx.x >> 6);
#ifdef DBG_CLEAR
    for (int i = threadIdx.x; i < LDS_BYTES / 16; i += 512) *(LAS u32x4*)(lds + i * 16) = (u32x4){0u, 0u, 0u, 0u};
    __syncthreads();
#endif
#define IN(k) (lo <= (k) && (k) < hi)
#define SEAM(k) do { if (IN(k) && IN((k) + 1)) { \
        asm volatile("s_waitcnt vmcnt(0) lgkmcnt(0)" ::: "memory"); __syncthreads();                 \
        if (wv == 0) { __builtin_amdgcn_fence(__ATOMIC_RELEASE, "agent"); asm volatile("s_waitcnt vmcnt(0)" ::: "memory"); }     \
        grid.sync(); \
        if (wv == 0) { __builtin_amdgcn_fence(__ATOMIC_ACQUIRE, "agent"); asm volatile("s_waitcnt vmcnt(0)" ::: "memory"); }     \
        __syncthreads(); } } while (0)
    volatile LAS unsigned* xst = (volatile LAS unsigned*)(lds + LDS_BYTES - 16);
    const bool xlead = (wv == 0) && (lane_id() == 0);
    if (xlead) { xst[0] = 0u; xst[1] = 0u; }
    __syncthreads();
    XcdBarrier xb; xb.bar = (unsigned*)((unsigned char*)p.out + DO_XBAR); xb.x = xb_xcc_id(); xb.st = xst;
    if (xlead) (void)xb_add(&xb.bar[XB_XCNT(xb.x)], 1u);
#define XSEAM(k) do { if (IN(k) && IN((k) + 1)) xcd_barrier(xb, (wv == 0) && (lane_id() == 0)); } while (0)
    if (IN(0)) for (int rep = 0; rep < NREP(0); ++rep) phase0(p, lds, wv);
    XSEAM(0);
    if (IN(1)) for (int rep = 0; rep < NREP(1); ++rep) {
        pg8::Gemm g{(const bf16_t*)(p.ws + WS_XN), (const bf16_t*)(p.ws + WS_BTIN), M_, NPROJ, D_}; pg8::StaticOrder S; S.init(M_, NPROJ, gridDim.x, blockIdx.x);
        EpiProj E{(bf16_t*)(p.ws + WS_PROJ)};
        pg8::gemm_phase<EpiProj>(lds, g, S, E, wv);
        dt_units(p, lds, wv);
    }
    XSEAM(1);
    if (IN(2)) bc_conv_phase(p, lds, wv);
    XSEAM(2);
    if (IN(3)) for (int rep = 0; rep < NREP(3); ++rep) phase2(p, lds, wv);
    XSEAM(3);
    if (IN(4)) for (int rep = 0; rep < NREP(4); ++rep) {
        pg8::Gemm g{(const bf16_t*)(p.ws + WS_YMIX), (const bf16_t*)((unsigned char*)p.out + DO_BTOUT), M_, D_, DMIX}; pg8::StaticOrder S; S.init(M_, D_, gridDim.x, blockIdx.x);
        EpiOut E{p.x, (float*)(p.ws + WS_H1F), (bf16_t*)(p.ws + WS_H1B), (const float*)((unsigned char*)p.out + DO_SSQ1), (float*)((unsigned char*)p.out + DO_SSQ2)};
        pg8::gemm_phase<EpiOut>(lds, g, S, E, wv);
    }
    XSEAM(4);
    if (IN(5)) for (int rep = 0; rep < NREP(5); ++rep) {
        pg8::Gemm g{(const bf16_t*)(p.ws + WS_H1B), (const bf16_t*)((unsigned char*)p.out + DO_BTGU), M_, NGU, D_}; pg8::StaticOrder S; S.init(M_, NGU, gridDim.x, blockIdx.x);
        EpiGU E{(const float*)((unsigned char*)p.out + DO_SSQ2), (bf16_t*)(p.ws + WS_HFF)};
        pg8::gemm_phase<EpiGU>(lds, g, S, E, wv);
    }
    XSEAM(5);
    if (IN(6)) {
        pg8::Gemm g{(const bf16_t*)(p.ws + WS_HFF), (const bf16_t*)((unsigned char*)p.out + DO_BTDN), M_, D_, DFF}; pg8::StaticOrder S; S.init(M_, D_, gridDim.x, blockIdx.x);
        EpiDown E{(float*)(p.ws + WS_H1F), (float*)(p.ws + WS_SSQ3)};
        pg8::gemm_phase<EpiDown>(lds, g, S, E, wv);
    }
    XSEAM(6);
    if (p.ph_hi > 1000) grid.sync();
    if (IN(7)) for (int rep = 0; rep < NREP(7); ++rep) phase6(p, wv);
#undef IN
#undef SEAM
}

extern "C" void kernel_launch(void* const* d_in, const int* in_sizes, int n_in, void* d_out, int out_size, void* d_ws, size_t ws_size, hipStream_t stream) {
    static int grid = 0;
    if (grid == 0) {
        if (n_in != 16 || out_size != M_ * D_ || ws_size < WS_NEED) { fprintf(stderr, "kernel_launch: unexpected shapes (n_in %d out %d ws %zu, need %zu)\n", n_in, out_size, ws_size, (size_t)WS_NEED); grid = -1; return; }
        int dev = 0, cus = 0, per_cu = 0;
        (void)hipGetDevice(&dev);
        (void)hipDeviceGetAttribute(&cus, hipDeviceAttributeMultiprocessorCount, dev);
        if (hipFuncSetAttribute((const void*)hymba_fwd, hipFuncAttributeMaxDynamicSharedMemorySize, LDS_BYTES) != hipSuccess) { fprintf(stderr, "kernel_launch: hipFuncSetAttribute failed\n"); grid = -1; return; }
        if (hipOccupancyMaxActiveBlocksPerMultiprocessor(&per_cu, (const void*)hymba_fwd, 512, LDS_BYTES) != hipSuccess || per_cu < 1) { fprintf(stderr, "kernel_launch: occupancy query failed (%d)\n", per_cu); (void)hipGetLastError(); per_cu = 1; }
        grid = cus * per_cu;
    }
    if (grid < 0) return;
    Params p{};
    p.x = (const float*)d_in[0]; p.norm_mix_g = (const float*)d_in[1]; p.w_in = (const float*)d_in[2]; p.ssm_conv_w = (const float*)d_in[3]; p.ssm_conv_b = (const float*)d_in[4];
    p.ssm_dt_bias = (const float*)d_in[5]; p.ssm_A_log = (const float*)d_in[6]; p.ssm_D = (const float*)d_in[7]; p.ssm_norm_g = (const float*)d_in[8]; p.sc_conv_w = (const float*)d_in[9];
    p.w_out = (const float*)d_in[10]; p.norm_ffn_g = (const float*)d_in[11]; p.w_gate = (const float*)d_in[12]; p.w_up = (const float*)d_in[13]; p.w_down = (const float*)d_in[14]; p.norm_final_g = (const float*)d_in[15];
    p.out = (float*)d_out; p.ws = (unsigned char*)d_ws;
#ifdef DBG_MEMSET
    (void)hipMemsetAsync(d_ws, 0, WS_NEED, stream); (void)hipMemsetAsync(d_out, 0, (size_t)out_size * 4, stream);
#endif
#ifndef N_CUTS
#define N_CUTS 1
#endif
    for (int li = 0; li < N_CUTS; ++li) {
        p.ph_lo = (N_CUTS == 8) ? li : 0; p.ph_hi = (N_CUTS == 8) ? li + 1 : 8;
        (void)hipMemsetAsync((unsigned char*)d_out + DO_XBAR, 0, XCD_BAR_WORDS * sizeof(unsigned), stream);
    void* args[] = {&p};
        hipError_t e = hipLaunchCooperativeKernel((const void*)hymba_fwd, dim3(grid), dim3(512), args, LDS_BYTES, stream);
        if (e != hipSuccess) fprintf(stderr, "kernel_launch: cooperative launch failed: %s (grid %d)\n", hipGetErrorString(e), grid);
    }
}
```

```cpp
#include <hip/hip_runtime.h>
#include <hip/hip_cooperative_groups.h>
#include <cstdio>
namespace cg = cooperative_groups;

#define LAS __attribute__((address_space(3)))
typedef unsigned short bf16_t;
typedef short bf16x8 __attribute__((ext_vector_type(8)));
typedef float f32x4 __attribute__((ext_vector_type(4)));
typedef unsigned u32x4 __attribute__((ext_vector_type(4)));
typedef unsigned u32x2 __attribute__((ext_vector_type(2)));

constexpr int M_ = 16384, D_ = 2048, DIN = 12320, NPROJ = 12288, DFF = 5632, DMIX = 4096, NGU = 11264;
constexpr int SEQ = 4096;
constexpr float EPS = 1e-5f;
constexpr int LDS_BYTES = 159744;
constexpr int XCD_BAR_WORDS_C = 3456;
#ifndef PROBE_PHASE
#define PROBE_PHASE -1
#endif
#define NREP(k) ((PROBE_PHASE == (k)) ? 1 + (p.ph_hi < 100) : 1)
constexpr int TAB_OFF = 131072;

constexpr size_t WS_PROJ = 0;
constexpr size_t WS_R = (size_t)M_ * NPROJ * 2;
constexpr size_t WS_XN = WS_R;
constexpr size_t WS_BTIN = WS_R + (size_t)M_ * D_ * 2;
constexpr size_t WS_YMIX = WS_R;
constexpr size_t WS_H1F = 0;
constexpr size_t WS_H1B = (size_t)M_ * D_ * 4;
constexpr size_t WS_HFF = WS_H1B + (size_t)M_ * D_ * 2;
constexpr size_t WS_SSQ3 = WS_HFF + (size_t)M_ * DFF * 2;
constexpr size_t WS_NEED = WS_R + (size_t)M_ * DMIX * 2;
constexpr size_t DO_BTOUT = 0;
constexpr size_t DO_BTGU = (size_t)D_ * DMIX * 2;
constexpr size_t DO_BTDN = DO_BTGU + (size_t)NGU * D_ * 2;
constexpr size_t DO_DT = DO_BTDN + (size_t)D_ * DFF * 2;
constexpr size_t DO_SSQ1 = DO_DT + (size_t)M_ * 32 * 4;
constexpr size_t DO_SSQ2 = DO_SSQ1 + (size_t)M_ * 32 * 4;
constexpr size_t DO_XBAR = (size_t)M_ * D_ * 4 - 16384;
constexpr size_t DO_BCFLAG = DO_XBAR - 4096;
static_assert(DO_SSQ2 + (size_t)M_ * 32 * 4 <= DO_BCFLAG && XCD_BAR_WORDS_C * 4 <= 16384, "d_out scratch");

static_assert(WS_SSQ3 + (size_t)M_ * 32 * 4 <= WS_R, "ws overlay");

struct Params {
    const float* x; const float* norm_mix_g; const float* w_in; const float* ssm_conv_w; const float* ssm_conv_b;
    const float* ssm_dt_bias; const float* ssm_A_log; const float* ssm_D; const float* ssm_norm_g; const float* sc_conv_w;
    const float* w_out; const float* norm_ffn_g; const float* w_gate; const float* w_up; const float* w_down; const float* norm_final_g;
    float* out; unsigned char* ws; int ph_lo, ph_hi;
};

typedef float f32x2_t __attribute__((ext_vector_type(2)));
typedef __bf16 bf16x2_t __attribute__((ext_vector_type(2)));
__device__ __forceinline__ unsigned cvt_pk_bf16(float lo, float hi) { const f32x2_t v = {lo, hi}; return __builtin_bit_cast(unsigned, __builtin_convertvector(v, bf16x2_t)); }
__device__ __forceinline__ float bflo(unsigned u) { return __uint_as_float(u << 16); }
__device__ __forceinline__ float bfhi(unsigned u) { return __uint_as_float(u & 0xffff0000u); }
__device__ __forceinline__ int lane_id() { int l; asm volatile("v_mbcnt_lo_u32_b32 %0, -1, 0\n\tv_mbcnt_hi_u32_b32 %0, -1, %0" : "=v"(l)); return l; }
__device__ __forceinline__ float silu_f(float v) { return v * __builtin_amdgcn_rcpf(1.0f + __expf(-v)); }

__device__ __forceinline__ size_t ssq_idx(int row, int part) { return ((size_t)(row >> 5) * 32 + part) * 32 + (row & 31); }

namespace pg8 {
constexpr int BM = 256, BK = 64, HALF = 128, HTB = HALF * BK * 2, STAGE_BYTES = 8 * HTB, NXCD = 8, WGM = 8;
__device__ __forceinline__ int lds_byte(int r, int c) { const int st = (r >> 4) * 2 + (c >> 5), rr = r & 15, cc = c & 31, ob = rr * 64 + cc * 2; return st * 1024 + (ob ^ (((ob >> 9) & 1) << 5)); }
__device__ __forceinline__ void stage_rc(int b, int& R, int& C) { const int st = b / 1024, sb = b % 1024, swz = sb ^ (((sb >> 9) & 1) << 5); R = (st >> 1) * 16 + swz / 64; C = (st & 1) * 32 + (swz % 64) / 2; }
__device__ __forceinline__ int perm32(int rho) { const int n = rho >> 4, i = rho & 15; return 8 * (i >> 2) + 4 * n + (i & 3); }
struct Unit { int pm, pn; };
struct Gemm { const bf16_t* A; const bf16_t* Bt; int M, N, K; };
struct StaticOrder {
    int nM, nN, nwg, G, c;
    __device__ void init(int M, int N, int G_, int c_) { nM = M / BM; nN = N / BM; nwg = nM * nN; G = G_; c = c_; }
    __device__ bool next(int i, Unit& u) const {
        const long L = (long)i * G + c; if (L >= nwg) return false;
        int wgid = (int)L; { const int q = nwg / NXCD, r = nwg % NXCD, xcd = wgid % NXCD, off = wgid / NXCD; wgid = (xcd < r ? xcd * (q + 1) : r * (q + 1) + (xcd - r) * q) + off; }
        const int nig = WGM * nN, gid = wgid / nig, fm = gid * WGM, gsz = (nM - fm) < WGM ? (nM - fm) : WGM;
        u.pm = fm + ((wgid % nig) % gsz); u.pn = (wgid % nig) / gsz; return true;
    }
};
template <class Epi>
__device__ __forceinline__ void gemm_phase(LAS unsigned char* lds, const Gemm g, const StaticOrder& S, const Epi& E, int wv) {
    const int wid = wv, lane = lane_id(), tid = wid * 64 + lane, wr = wid >> 2, wc = wid & 3, fr = lane & 15, fq = lane >> 4;
    const int K = g.K, nt = K / BK;
    unsigned voffA[2], voffB[2];
#pragma unroll
    for (int i = 0; i < 2; ++i) { int R, C; stage_rc(tid * 16 + i * 8192, R, C); const int Rb = (R & ~31) + perm32(R & 31);
        voffA[i] = (unsigned)(R * K + C) * 2u; voffB[i] = (unsigned)(Rb * K + C) * 2u; }
    const size_t kstep = (size_t)(BK * 2);
    const size_t hstep = (size_t)HALF * K * 2;
    const size_t tstep = 2 * hstep;
    const unsigned ldsw = (unsigned)wid * 1024u;
    const int aoff = lds_byte(wr * 64 + fr, fq * 8), boff = lds_byte(wc * 32 + fr, fq * 8);
#define PG8_SA(b, h) (((b) * 2 + (h)) * HTB)
#define PG8_SB(b, h) ((4 + (b) * 2 + (h)) * HTB)
#define PG8_STAGE(bufoff, gbase, voff) do { _Pragma("unroll") for (int _i = 0; _i < 2; ++_i) \
        __builtin_amdgcn_global_load_lds((const unsigned*)((const char*)(gbase) + (voff)[_i]), (LAS unsigned*)(lds + (bufoff) + ldsw + _i * 8192), 16, 0, 0); } while (0)
#define PG8_LDA(dst, b, h) do { _Pragma("unroll") for (int m = 0; m < 4; ++m) _Pragma("unroll") for (int k = 0; k < 2; ++k) dst[m][k] = *(const LAS bf16x8*)(lds + PG8_SA(b, h) + aoff + m * 2048 + k * 1024); } while (0)
#define PG8_LDB(dst, b, h) do { _Pragma("unroll") for (int n = 0; n < 2; ++n) _Pragma("unroll") for (int k = 0; k < 2; ++k) dst[n][k] = *(const LAS bf16x8*)(lds + PG8_SB(b, h) + boff + n * 2048 + k * 1024); } while (0)
#define PG8_MMA(ai, bj, At, Bt) do { __builtin_amdgcn_s_setprio(1); _Pragma("unroll") for (int m = 0; m < 4; ++m) _Pragma("unroll") for (int n = 0; n < 2; ++n) _Pragma("unroll") for (int k = 0; k < 2; ++k) \
        acc[ai][bj][m][n] = __builtin_amdgcn_mfma_f32_16x16x32_bf16(Bt[n][k], At[m][k], acc[ai][bj][m][n], 0, 0, 0); __builtin_amdgcn_s_setprio(0); } while (0)
#define PG8_WAIT_V(n) asm volatile("s_waitcnt vmcnt(" #n ")" ::: "memory")
#define PG8_WAIT_L(n) asm volatile("s_waitcnt lgkmcnt(" #n ")" ::: "memory")
#define PG8_BAR __builtin_amdgcn_s_barrier()
#define PG8_SCHED __builtin_amdgcn_sched_barrier(0)
    Unit cur, nxt; int ui = 0;
    if (!S.next(0, cur)) return;
    f32x4 acc[2][2][4][2];
#pragma unroll
    for (int a = 0; a < 2; ++a)
#pragma unroll
        for (int b = 0; b < 2; ++b)
#pragma unroll
            for (int m = 0; m < 4; ++m)
#pragma unroll
                for (int n = 0; n < 2; ++n) acc[a][b][m][n] = (f32x4){0.f, 0.f, 0.f, 0.f};
    bf16x8 At[4][2], B0[2][2], B1[2][2];
    const char* cA = (const char*)g.A + (size_t)cur.pm * tstep; const char* cB = (const char*)g.Bt + (size_t)cur.pn * tstep;
    if constexpr (Epi::HAS_TAB) {
        Unit uu; for (int i = 0; i < 27 && S.next(i, uu); ++i) E.prep(uu, (LAS float*)(lds + TAB_OFF + i * 1024), tid);
    }
    PG8_STAGE(PG8_SB(0, 0), cB, voffB); PG8_STAGE(PG8_SB(0, 1), cB + hstep, voffB); PG8_STAGE(PG8_SA(0, 0), cA, voffA); PG8_STAGE(PG8_SA(0, 1), cA + hstep, voffA);
    if (wr == 1) PG8_BAR;
    PG8_WAIT_V(2); PG8_BAR;
    PG8_STAGE(PG8_SB(1, 0), cB + kstep, voffB); PG8_STAGE(PG8_SA(1, 0), cA + kstep, voffA); PG8_STAGE(PG8_SB(1, 1), cB + hstep + kstep, voffB);
    PG8_WAIT_V(6); PG8_BAR;
    for (;;) {
        const bool has_next = S.next(ui + 1, nxt);
        const char* nA = has_next ? (const char*)g.A + (size_t)nxt.pm * tstep : cA; const char* nB = has_next ? (const char*)g.Bt + (size_t)nxt.pn * tstep : cB;
        LAS const float* tabc = (LAS const float*)(lds + TAB_OFF + ui * 1024);
        for (int t = 0; t < nt; t += 2) {
            const bool last = (t == nt - 2);
            const char* a1 = cA + (size_t)(t + 1) * kstep;
            const char* a2 = last ? nA : cA + (size_t)(t + 2) * kstep; const char* b2 = last ? nB : cB + (size_t)(t + 2) * kstep;
            const char* a3 = a2 + kstep; const char* b3 = b2 + kstep;
            if constexpr (Epi::MID_T >= 0) { if (t == Epi::MID_T) {
#pragma unroll
                for (int ai = 0; ai < 2; ++ai)
#pragma unroll
                    for (int m = 0; m < 4; ++m) { const float s = tabc[ai * HALF + wr * 64 + m * 16 + fr];
#pragma unroll
                        for (int bj = 0; bj < 2; ++bj)
#pragma unroll
                            for (int n = 0; n < 2; ++n) acc[ai][bj][m][n] *= s; } } }
            PG8_LDB(B0, 0, 0); PG8_LDB(B1, 0, 1); PG8_SCHED; PG8_LDA(At, 0, 0); PG8_STAGE(PG8_SA(1, 1), a1 + hstep, voffA);
            PG8_WAIT_V(8); PG8_WAIT_L(0); PG8_BAR; PG8_MMA(0, 0, At, B0); PG8_MMA(0, 1, At, B1); PG8_BAR; PG8_SCHED;
            PG8_LDA(At, 0, 1); PG8_STAGE(PG8_SB(0, 0), b2, voffB); PG8_STAGE(PG8_SB(0, 1), b2 + hstep, voffB); PG8_STAGE(PG8_SA(0, 0), a2, voffA);
            PG8_WAIT_V(8); PG8_WAIT_L(0); PG8_BAR; PG8_MMA(1, 0, At, B0); PG8_MMA(1, 1, At, B1); PG8_BAR; PG8_SCHED;
            PG8_LDB(B0, 1, 0); PG8_LDB(B1, 1, 1); PG8_SCHED; PG8_LDA(At, 1, 0); PG8_STAGE(PG8_SA(0, 1), a2 + hstep, voffA);
            PG8_WAIT_V(8); PG8_WAIT_L(0); PG8_BAR; PG8_MMA(0, 0, At, B0); PG8_MMA(0, 1, At, B1); PG8_BAR; PG8_SCHED;
            PG8_LDA(At, 1, 1); PG8_STAGE(PG8_SB(1, 0), b3, voffB); PG8_STAGE(PG8_SB(1, 1), b3 + hstep, voffB); PG8_STAGE(PG8_SA(1, 0), a3, voffA);
            PG8_WAIT_V(8); PG8_WAIT_L(0); PG8_BAR; PG8_MMA(1, 0, At, B0); PG8_MMA(1, 1, At, B1); PG8_BAR; PG8_SCHED;
        }
        if (wr == 0) PG8_BAR;
        E(acc, cur, tabc, wr, wc, fr, fq);
        if (!has_next) break;
#pragma unroll
        for (int a = 0; a < 2; ++a)
#pragma unroll
            for (int b = 0; b < 2; ++b)
#pragma unroll
                for (int m = 0; m < 4; ++m)
#pragma unroll
                    for (int n = 0; n < 2; ++n) acc[a][b][m][n] = (f32x4){0.f, 0.f, 0.f, 0.f};
        cur = nxt; cA = nA; cB = nB; ++ui;
        if (wr == 1) PG8_BAR;
    }
    PG8_WAIT_V(0);
    PG8_BAR;
#undef PG8_SA
#undef PG8_SB
#undef PG8_STAGE
#undef PG8_LDA
#undef PG8_LDB
#undef PG8_MMA
#undef PG8_WAIT_V
#undef PG8_WAIT_L
#undef PG8_BAR
#undef PG8_SCHED
}
}

__device__ __forceinline__ void rstd_table(const float* ssq, int row0, LAS float* tab, int t) {
    const int r = t >> 1, hf = t & 1;
    const float* p = ssq + ssq_idx(row0 + r, hf * 16);
    float s = 0.f;
#pragma unroll
    for (int i = 0; i < 16; ++i) s += p[i * 32];
    s += __shfl_xor(s, 1);
    if (!hf) tab[r] = rsqrtf(s * (1.0f / 2048.0f) + EPS);
}

struct EpiProj {
    static constexpr bool HAS_TAB = false; static constexpr int MID_T = -1;
    bf16_t* O;
    __device__ __forceinline__ void prep(const pg8::Unit&, LAS float*, int) const {}
    __device__ __forceinline__ void operator()(const f32x4 (&acc)[2][2][4][2], const pg8::Unit& u, LAS const float*, int wr, int wc, int fr, int fq) const {
        const int row0 = u.pm * 256 + wr * 64 + fr, col0 = u.pn * 256 + wc * 32 + 8 * fq;
#pragma unroll
        for (int ai = 0; ai < 2; ++ai)
#pragma unroll
            for (int m = 0; m < 4; ++m) { bf16_t* rowp = O + (size_t)(row0 + ai * 128 + m * 16) * NPROJ + col0;
#pragma unroll
                for (int bj = 0; bj < 2; ++bj) { const f32x4 v0 = acc[ai][bj][m][0], v1 = acc[ai][bj][m][1];
                    u32x4 w; w.x = cvt_pk_bf16(v0[0], v0[1]); w.y = cvt_pk_bf16(v0[2], v0[3]); w.z = cvt_pk_bf16(v1[0], v1[1]); w.w = cvt_pk_bf16(v1[2], v1[3]);
                    *(u32x4*)(rowp + bj * 128) = w; } }
    }
};
struct EpiOut {
    static constexpr bool HAS_TAB = true; static constexpr int MID_T = 32;
    const float* x; float* h1f; bf16_t* h1b; const float* ssq1; float* ssq2;
    __device__ __forceinline__ void prep(const pg8::Unit& u, LAS float* tab, int t) const { rstd_table(ssq1, u.pm * 256, tab, t); }
    __device__ __forceinline__ void operator()(const f32x4 (&acc)[2][2][4][2], const pg8::Unit& u, LAS const float*, int wr, int wc, int fr, int fq) const {
        const int row0 = u.pm * 256 + wr * 64 + fr, col0 = u.pn * 256 + wc * 32 + 8 * fq;
#pragma unroll
        for (int ai = 0; ai < 2; ++ai)
#pragma unroll
            for (int m = 0; m < 4; ++m) { const int row = row0 + ai * 128 + m * 16; const size_t off = (size_t)row * D_ + col0; float ss = 0.f;
#pragma unroll
                for (int bj = 0; bj < 2; ++bj) {
                    const f32x4 x0 = *(const f32x4*)(x + off + bj * 128), x1 = *(const f32x4*)(x + off + bj * 128 + 4);
                    const f32x4 v0 = acc[ai][bj][m][0] + x0, v1 = acc[ai][bj][m][1] + x1;
                    *(f32x4*)(h1f + off + bj * 128) = v0; *(f32x4*)(h1f + off + bj * 128 + 4) = v1;
                    u32x4 w; w.x = cvt_pk_bf16(v0[0], v0[1]); w.y = cvt_pk_bf16(v0[2], v0[3]); w.z = cvt_pk_bf16(v1[0], v1[1]); w.w = cvt_pk_bf16(v1[2], v1[3]);
                    *(u32x4*)(h1b + off + bj * 128) = w;
                    ss += (v0[0] * v0[0] + v0[1] * v0[1]) + (v0[2] * v0[2] + v0[3] * v0[3]) + (v1[0] * v1[0] + v1[1] * v1[1]) + (v1[2] * v1[2] + v1[3] * v1[3]); }
                ss += __shfl_xor(ss, 16); ss += __shfl_xor(ss, 32);
                if (fq == 0) ssq2[ssq_idx(row, u.pn * 4 + wc)] = ss; }
    }
};
struct EpiGU {
    static constexpr bool HAS_TAB = true; static constexpr int MID_T = -1;
    const float* ssq2; bf16_t* hff;
    __device__ __forceinline__ void prep(const pg8::Unit& u, LAS float* tab, int t) const { rstd_table(ssq2, u.pm * 256, tab, t); }
    __device__ __forceinline__ void operator()(const f32x4 (&acc)[2][2][4][2], const pg8::Unit& u, LAS const float* tab, int wr, int wc, int fr, int fq) const {
        const int row0 = u.pm * 256 + wr * 64 + fr, col0 = u.pn * 128 + wc * 32 + 8 * fq;
#pragma unroll
        for (int ai = 0; ai < 2; ++ai)
#pragma unroll
            for (int m = 0; m < 4; ++m) { const float rs = tab[ai * 128 + wr * 64 + m * 16 + fr];
                float o[8];
#pragma unroll
                for (int n = 0; n < 2; ++n)
#pragma unroll
                    for (int j = 0; j < 4; ++j) { const float gg = acc[ai][0][m][n][j] * rs, uu = acc[ai][1][m][n][j] * rs; o[n * 4 + j] = silu_f(gg) * uu; }
                u32x4 w; w.x = cvt_pk_bf16(o[0], o[1]); w.y = cvt_pk_bf16(o[2], o[3]); w.z = cvt_pk_bf16(o[4], o[5]); w.w = cvt_pk_bf16(o[6], o[7]);
                *(u32x4*)(hff + (size_t)(row0 + ai * 128 + m * 16) * DFF + col0) = w; }
    }
};
struct EpiDown {
    static constexpr bool HAS_TAB = false; static constexpr int MID_T = -1;
    float* h; float* ssq3;
    __device__ __forceinline__ void prep(const pg8::Unit&, LAS float*, int) const {}
    __device__ __forceinline__ void operator()(const f32x4 (&acc)[2][2][4][2], const pg8::Unit& u, LAS const float*, int wr, int wc, int fr, int fq) const {
        const int row0 = u.pm * 256 + wr * 64 + fr, col0 = u.pn * 256 + wc * 32 + 8 * fq;
#pragma unroll
        for (int ai = 0; ai < 2; ++ai)
#pragma unroll
            for (int m = 0; m < 4; ++m) { const int row = row0 + ai * 128 + m * 16; const size_t off = (size_t)row * D_ + col0; float ss = 0.f;
#pragma unroll
                for (int bj = 0; bj < 2; ++bj) {
                    const f32x4 x0 = *(const f32x4*)(h + off + bj * 128), x1 = *(const f32x4*)(h + off + bj * 128 + 4);
                    const f32x4 v0 = acc[ai][bj][m][0] + x0, v1 = acc[ai][bj][m][1] + x1;
                    *(f32x4*)(h + off + bj * 128) = v0; *(f32x4*)(h + off + bj * 128 + 4) = v1;
                    ss += (v0[0] * v0[0] + v0[1] * v0[1]) + (v0[2] * v0[2] + v0[3] * v0[3]) + (v1[0] * v1[0] + v1[1] * v1[1]) + (v1[2] * v1[2] + v1[3] * v1[3]); }
                ss += __shfl_xor(ss, 16); ss += __shfl_xor(ss, 32);
                if (fq == 0) ssq3[ssq_idx(row, u.pn * 4 + wc)] = ss; }
    }
};

__device__ __forceinline__ void p0_tile(LAS float* t, const float* src, int ldsrc, int k0, int c0, int jvalid, bf16_t* dst, int K, int j0, const float* scale, int scale_kmax, int tid) {
    const int jc4 = (tid & 15) * 4, kr0 = tid >> 4;
#pragma unroll
    for (int i = 0; i < 4; ++i) {
        const int kr = kr0 + 32 * i;
        f32x4 v = (f32x4){0.f, 0.f, 0.f, 0.f};
        if (jc4 < jvalid) v = *(const f32x4*)(src + (size_t)(k0 + kr) * ldsrc + c0 + jc4);
        const float s = (scale != nullptr && (k0 + kr) < scale_kmax) ? scale[k0 + kr] : 1.0f;
        t[kr * 65 + jc4 + 0] = v[0] * s; t[kr * 65 + jc4 + 1] = v[1] * s; t[kr * 65 + jc4 + 2] = v[2] * s; t[kr * 65 + jc4 + 3] = v[3] * s;
    }
    __syncthreads();
    const int kp = (tid & 63) * 2, jr0 = tid >> 6;
#pragma unroll
    for (int i = 0; i < 8; ++i) {
        const int j = jr0 + 8 * i;
        if (j < jvalid) { const float a = t[kp * 65 + j], b = t[(kp + 1) * 65 + j];
            *(unsigned*)(dst + (size_t)(j0 + j) * K + k0 + kp) = cvt_pk_bf16(a, b); }
    }
    __syncthreads();
}
struct TileD { const float* src; const float* scale; bf16_t* dst; int ldsrc, k0, c0, jvalid, K, j0, kmax; };
__device__ __forceinline__ TileD tile_decode(const Params& p, int u) {
    constexpr int U_IN = 16 * 193, U_OUT = 32 * 32, U_GU = 16 * 176;
    TileD d;
    if (u < U_IN) { const int kt = u & 15, jt = u >> 4, j0 = jt * 64;
        d.src = p.w_in; d.scale = nullptr; d.dst = (bf16_t*)(p.ws + WS_BTIN); d.ldsrc = DIN; d.k0 = kt * 128; d.c0 = j0 < 6144 ? j0 : (j0 < 12288 ? j0 + 32 : 6144); d.jvalid = (jt == 192) ? 32 : 64; d.K = D_; d.j0 = j0; d.kmax = 0; }
    else if (u < U_IN + U_OUT) { const int v = u - U_IN, kt = v & 31, jt = v >> 5;
        d.src = p.w_out; d.scale = p.ssm_norm_g; d.dst = (bf16_t*)((unsigned char*)p.out + DO_BTOUT); d.ldsrc = D_; d.k0 = kt * 128; d.c0 = jt * 64; d.jvalid = 64; d.K = DMIX; d.j0 = jt * 64; d.kmax = 2048; }
    else if (u < U_IN + U_OUT + U_GU) { const int v = u - U_IN - U_OUT, kt = v & 15, jt = v >> 4, j0 = jt * 64, pn = j0 >> 8, r0 = j0 & 255;
        d.src = r0 < 128 ? p.w_gate : p.w_up; d.scale = p.norm_ffn_g; d.dst = (bf16_t*)((unsigned char*)p.out + DO_BTGU); d.ldsrc = DFF; d.k0 = kt * 128; d.c0 = 128 * pn + (r0 & 127); d.jvalid = 64; d.K = D_; d.j0 = j0; d.kmax = 2048; }
    else { const int v = u - U_IN - U_OUT - U_GU, kt = v % 44, jt = v / 44;
        d.src = p.w_down; d.scale = nullptr; d.dst = (bf16_t*)((unsigned char*)p.out + DO_BTDN); d.ldsrc = D_; d.k0 = kt * 128; d.c0 = jt * 64; d.jvalid = 64; d.K = DFF; d.j0 = jt * 64; d.kmax = 0; }
    return d;
}
__device__ __forceinline__ void tile_load(const TileD& d, int tid, f32x4 (&v)[4], float (&scl)[4]) {
    const int jc4 = (tid & 15) * 4, kr0 = tid >> 4;
#pragma unroll
    for (int i = 0; i < 4; ++i) { const int kr = kr0 + 32 * i;
        f32x4 x = (f32x4){0.f, 0.f, 0.f, 0.f};
        if (jc4 < d.jvalid) x = *(const f32x4*)(d.src + (size_t)(d.k0 + kr) * d.ldsrc + d.c0 + jc4);
        scl[i] = (d.scale != nullptr && (d.k0 + kr) < d.kmax) ? d.scale[d.k0 + kr] : 1.0f;
        v[i] = x; }
}
__device__ __forceinline__ void tile_finish(LAS float* t, const TileD& d, int tid, const f32x4 (&v)[4], const float (&scl)[4]) {
    const int jc4 = (tid & 15) * 4, kr0 = tid >> 4;
#pragma unroll
    for (int i = 0; i < 4; ++i) { const int kr = kr0 + 32 * i;
        t[kr * 65 + jc4 + 0] = v[i][0] * scl[i]; t[kr * 65 + jc4 + 1] = v[i][1] * scl[i]; t[kr * 65 + jc4 + 2] = v[i][2] * scl[i]; t[kr * 65 + jc4 + 3] = v[i][3] * scl[i]; }
    asm volatile("s_waitcnt lgkmcnt(0)" ::: "memory"); __builtin_amdgcn_s_barrier(); asm volatile("" ::: "memory");
    const int kp = (tid & 63) * 2, jr0 = tid >> 6;
#pragma unroll
    for (int i = 0; i < 8; ++i) { const int j = jr0 + 8 * i;
        if (j < d.jvalid) { const float a = t[kp * 65 + j], b = t[(kp + 1) * 65 + j];
            *(unsigned*)(d.dst + (size_t)(d.j0 + j) * d.K + d.k0 + kp) = cvt_pk_bf16(a, b); } }
    asm volatile("s_waitcnt lgkmcnt(0)" ::: "memory"); __builtin_amdgcn_s_barrier(); asm volatile("" ::: "memory");
}
__device__ __forceinline__ void conv_tiles(const Params& p, LAS unsigned char* lds, int u_begin, int u_end, int first, int stride, int tid) {
    LAS float* t = (LAS float*)lds;
    int u = u_begin + first;
    if (u >= u_end) return;
    TileD d = tile_decode(p, u); f32x4 v[4]; float sc[4]; tile_load(d, tid, v, sc);
    for (;;) {
        const int un = u + stride; const bool more = un < u_end;
        TileD dn = d; f32x4 vn[4]; float scn[4];
#pragma unroll
        for (int i = 0; i < 4; ++i) { vn[i] = v[i]; scn[i] = sc[i]; }
        if (more) { dn = tile_decode(p, un); tile_load(dn, tid, vn, scn); }
        tile_finish(t, d, tid, v, sc);
        if (!more) break;
        d = dn; u = un;
#pragma unroll
        for (int i = 0; i < 4; ++i) { v[i] = vn[i]; sc[i] = scn[i]; }
    }
}
__device__ void phase0(const Params& p, LAS unsigned char* lds, int wv) {
    const int lane = lane_id(), wave = wv, tid = wv * 64 + lane, G = gridDim.x;
    LAS float* t = (LAS float*)lds;
    bf16_t* bt_in = (bf16_t*)(p.ws + WS_BTIN);
    bf16_t* xn = (bf16_t*)(p.ws + WS_XN);
    for (int row = blockIdx.x * 8 + wave; row < M_; row += G * 8) {
        const f32x4* xr = (const f32x4*)(p.x + (size_t)row * D_);
        f32x4 v[8]; float ss = 0.f;
#pragma unroll
        for (int i = 0; i < 8; ++i) { v[i] = xr[lane + 64 * i]; ss += (v[i][0] * v[i][0] + v[i][1] * v[i][1]) + (v[i][2] * v[i][2] + v[i][3] * v[i][3]); }
#pragma unroll
        for (int o = 32; o >= 1; o >>= 1) ss += __shfl_xor(ss, o);
        const float rstd = rsqrtf(ss * (1.0f / 2048.0f) + EPS);
#pragma unroll
        for (int i = 0; i < 8; ++i) { const f32x4 g4 = ((const f32x4*)p.norm_mix_g)[lane + 64 * i];
            u32x2 w; w.x = cvt_pk_bf16(v[i][0] * rstd * g4[0], v[i][1] * rstd * g4[1]); w.y = cvt_pk_bf16(v[i][2] * rstd * g4[2], v[i][3] * rstd * g4[3]);
            *(u32x2*)(xn + (size_t)row * D_ + 4 * (lane + 64 * i)) = w; }
    }
    __syncthreads();
    conv_tiles(p, lds, 0, 16 * 193, blockIdx.x, G, tid);
}
__device__ void wconv_units(const Params& p, LAS unsigned char* lds, int first, int stride, int wv) {
    const int tid = wv * 64 + lane_id();
    __syncthreads();
    conv_tiles(p, lds, 16 * 193, 16 * 193 + 32 * 32 + 16 * 176 + 44 * 32, first, stride, tid);
}

__device__ void dt_units(const Params& p, LAS unsigned char* lds, int wv) {
    const int lane = lane_id(), w = wv, tid = wv * 64 + lane, fr = lane & 15, fq = lane >> 4;
    const bf16_t* xn = (const bf16_t*)(p.ws + WS_XN);
    const bf16_t* bt = (const bf16_t*)(p.ws + WS_BTIN) + (size_t)NPROJ * D_;
    float* dt = (float*)((unsigned char*)p.out + DO_DT);
    LAS float* red = (LAS float*)lds;
    for (int rb = blockIdx.x; rb < M_ / 64; rb += gridDim.x) {
        const int row0 = rb * 64;
        f32x4 acc[4][2];
#pragma unroll
        for (int m = 0; m < 4; ++m)
#pragma unroll
            for (int n = 0; n < 2; ++n) acc[m][n] = (f32x4){0.f, 0.f, 0.f, 0.f};
#pragma unroll 4
        for (int ks = 0; ks < 8; ++ks) {
            const int kb = w * 256 + ks * 32 + fq * 8;
            bf16x8 a[4], b[2];
#pragma unroll
            for (int m = 0; m < 4; ++m) a[m] = *(const bf16x8*)(xn + (size_t)(row0 + 16 * m + fr) * D_ + kb);
#pragma unroll
            for (int n = 0; n < 2; ++n) b[n] = *(const bf16x8*)(bt + (size_t)(16 * n + fr) * D_ + kb);
#pragma unroll
            for (int m = 0; m < 4; ++m)
#pragma unroll
                for (int n = 0; n < 2; ++n) acc[m][n] = __builtin_amdgcn_mfma_f32_16x16x32_bf16(a[m], b[n], acc[m][n], 0, 0, 0);
        }
#pragma unroll
        for (int m = 0; m < 4; ++m)
#pragma unroll
            for (int n = 0; n < 2; ++n)
#pragma unroll
                for (int j = 0; j < 4; ++j) red[w * 2048 + (16 * m + 4 * fq + j) * 32 + 16 * n + fr] = acc[m][n][j];
        __syncthreads();
        {
            const int idx = tid * 4, r = idx >> 5, c = idx & 31;
            f32x4 s = (f32x4){0.f, 0.f, 0.f, 0.f};
#pragma unroll
            for (int ww = 0; ww < 8; ++ww) s += *(LAS const f32x4*)(red + ww * 2048 + idx);
            const f32x4 bias = *(const f32x4*)(p.ssm_dt_bias + c);
            f32x4 o;
#pragma unroll
            for (int j = 0; j < 4; ++j) { const float v = s[j] + bias[j]; o[j] = v > 20.f ? v : log1pf(expf(v)); }
            *(f32x4*)(dt + (size_t)(row0 + r) * 32 + c) = o;
        }
        __syncthreads();
    }
}

__device__ void bc_sequences(const Params& p, LAS unsigned char* lds, int first, int stride, int wv) {
    const int tid = wv * 64 + lane_id(), cv = tid & 7, run = tid >> 3;
    bf16_t* proj = (bf16_t*)(p.ws + WS_PROJ);
    LAS u32x4* stash = (LAS u32x4*)lds;
    unsigned* bcflag = (unsigned*)((unsigned char*)p.out + DO_BCFLAG);
    for (int sq = first; sq < 4 * 32; sq += stride) {
        const int b = sq >> 5, slab = sq & 31;
        const int xcol = 2048 + slab * 64 + cv * 8;
        float wk[4][8], bs[8];
#pragma unroll
        for (int k = 0; k < 4; ++k) { const f32x4 a = *(const f32x4*)(p.ssm_conv_w + k * 4096 + xcol), c = *(const f32x4*)(p.ssm_conv_w + k * 4096 + xcol + 4);
#pragma unroll
            for (int j = 0; j < 4; ++j) { wk[k][j] = a[j]; wk[k][4 + j] = c[j]; } }
        { const f32x4 a = *(const f32x4*)(p.ssm_conv_b + xcol), c = *(const f32x4*)(p.ssm_conv_b + xcol + 4);
#pragma unroll
          for (int j = 0; j < 4; ++j) { bs[j] = a[j]; bs[4 + j] = c[j]; } }
        __syncthreads();
#pragma unroll 1
        for (int tile = 0; tile < 8; ++tile) {
            bf16_t* base = proj + (size_t)(b * SEQ + tile * 512 + run * 8) * NPROJ + 2048 + xcol;
            u32x4 raw[11];
#pragma unroll
            for (int r = 0; r < 11; ++r) {
                const int row = run * 8 + r - 3;
                if (row >= 0) raw[r] = *(const u32x4*)(base + (long)(r - 3) * NPROJ);
                else raw[r] = (tile == 0) ? (u32x4){0u, 0u, 0u, 0u} : stash[(row + 3) * 8 + cv];
            }
            u32x4 ov[8];
#pragma unroll
            for (int j = 0; j < 8; ++j) {
                float o[8];
#pragma unroll
                for (int q = 0; q < 4; ++q) {
                    const unsigned x0 = raw[j][q], x1 = raw[j + 1][q], x2 = raw[j + 2][q], x3 = raw[j + 3][q];
                    o[2 * q] = silu_f(bs[2 * q] + wk[0][2 * q] * bflo(x0) + wk[1][2 * q] * bflo(x1) + wk[2][2 * q] * bflo(x2) + wk[3][2 * q] * bflo(x3));
                    o[2 * q + 1] = silu_f(bs[2 * q + 1] + wk[0][2 * q + 1] * bfhi(x0) + wk[1][2 * q + 1] * bfhi(x1) + wk[2][2 * q + 1] * bfhi(x2) + wk[3][2 * q + 1] * bfhi(x3));
                }
                ov[j].x = cvt_pk_bf16(o[0], o[1]); ov[j].y = cvt_pk_bf16(o[2], o[3]); ov[j].z = cvt_pk_bf16(o[4], o[5]); ov[j].w = cvt_pk_bf16(o[6], o[7]);
            }
            asm volatile("s_waitcnt vmcnt(0) lgkmcnt(0)" ::: "memory");
            __syncthreads();
            if (run == 63) { stash[0 * 8 + cv] = raw[8]; stash[1 * 8 + cv] = raw[9]; stash[2 * 8 + cv] = raw[10]; }
#pragma unroll
            for (int j = 0; j < 8; ++j) { const bf16_t* q = base + (long)j * NPROJ;
                asm volatile("global_store_dwordx4 %0, %1, off sc1" :: "v"(q), "v"(ov[j]) : "memory"); }
            asm volatile("s_waitcnt vmcnt(0) lgkmcnt(0)" ::: "memory");
            __syncthreads();
            if (wv == 0) {
                if (lane_id() == 0) __hip_atomic_store(bcflag + sq, (unsigned)(tile + 1), __ATOMIC_RELAXED, __HIP_MEMORY_SCOPE_AGENT);
            }
        }
    }
}

constexpr int SROW = 272;
constexpr int L_CM = 0, L_BM = 34816, L_BDT = 69632, L_XT = 104448, L_HB = 121856  , L_CS = 156672, L_DT = 157184, L_CW = 157696  ;
__device__ __forceinline__ int swz_off(int row, int kblk) { return row * SROW + ((kblk ^ ((row >> 3) & 7)) << 4); }
__device__ __forceinline__ void ssd_load(u32x4 (&raw)[5], const bf16_t* base, bool first, int l0) {
#pragma unroll
    for (int r = 0; r < 5; ++r) raw[r] = (first && (l0 + r - 3) < 0) ? (u32x4){0u, 0u, 0u, 0u} : *(const u32x4*)(base + (long)(r - 3) * NPROJ);
}
template <int GI>
__device__ __forceinline__ void ssd_conv(LAS unsigned char* lds, const u32x4 (&raw)[5], int cv, int l0, float sa, float sb) {
    LAS const f32x4* cw = (LAS const f32x4*)(lds + L_CW) + cv * 10;
    float o0[8], o1[8];
#pragma unroll
    for (int hq = 0; hq < 2; ++hq) {
        const f32x4 w0 = cw[0 + hq], w1 = cw[2 + hq], w2 = cw[4 + hq], w3 = cw[6 + hq], bs = cw[8 + hq];
#pragma unroll
        for (int e2 = 0; e2 < 2; ++e2) {
            const int q = hq * 2 + e2;
            const unsigned x0 = raw[0][q], x1 = raw[1][q], x2 = raw[2][q], x3 = raw[3][q], x4 = raw[4][q];
            const int ea = e2 * 2, eb = e2 * 2 + 1;
            const float va = bs[ea] + w0[ea] * bflo(x0) + w1[ea] * bflo(x1) + w2[ea] * bflo(x2) + w3[ea] * bflo(x3);
            const float vb = bs[eb] + w0[eb] * bfhi(x0) + w1[eb] * bfhi(x1) + w2[eb] * bfhi(x2) + w3[eb] * bfhi(x3);
            const float ua = bs[ea] + w0[ea] * bflo(x1) + w1[ea] * bflo(x2) + w2[ea] * bflo(x3) + w3[ea] * bflo(x4);
            const float ub = bs[eb] + w0[eb] * bfhi(x1) + w1[eb] * bfhi(x2) + w2[eb] * bfhi(x3) + w3[eb] * bfhi(x4);
            o0[2 * q] = silu_f(va); o0[2 * q + 1] = silu_f(vb); o1[2 * q] = silu_f(ua); o1[2 * q + 1] = silu_f(ub);
        }
    }
    if (GI == 0) {
#pragma unroll
        for (int e = 0; e < 8; ++e) { const int prow = cv * 8 + e;
            *(LAS unsigned*)(lds + L_XT + swz_off(prow, l0 >> 3) + (l0 & 7) * 2) = cvt_pk_bf16(o0[e] * sa, o1[e] * sb); }
    } else {
        u32x4 w0; w0.x = cvt_pk_bf16(o0[0], o0[1]); w0.y = cvt_pk_bf16(o0[2], o0[3]); w0.z = cvt_pk_bf16(o0[4], o0[5]); w0.w = cvt_pk_bf16(o0[6], o0[7]);
        u32x4 w1; w1.x = cvt_pk_bf16(o1[0], o1[1]); w1.y = cvt_pk_bf16(o1[2], o1[3]); w1.z = cvt_pk_bf16(o1[4], o1[5]); w1.w = cvt_pk_bf16(o1[6], o1[7]);
        const int nb = ((GI - 1) & 1) * 64 + cv * 8;
        if (GI < 3) {
            *(LAS u32x4*)(lds + L_BM + l0 * SROW + nb * 2) = w0; *(LAS u32x4*)(lds + L_BM + (l0 + 1) * SROW + nb * 2) = w1;
#pragma unroll
            for (int e = 0; e < 8; ++e) { const int nrow = nb + e;
                *(LAS unsigned*)(lds + L_BDT + swz_off(nrow, l0 >> 3) + (l0 & 7) * 2) = cvt_pk_bf16(o0[e] * sa, o1[e] * sb); }
        } else {
            *(LAS u32x4*)(lds + L_CM + l0 * SROW + nb * 2) = w0; *(LAS u32x4*)(lds + L_CM + (l0 + 1) * SROW + nb * 2) = w1;
        }
    }
}
template <int GI>
__device__ __forceinline__ void ssd_put(LAS unsigned char* lds, const u32x4 (&rw)[2], int cv, int l0, float sa, float sb) {
    const int nb = ((GI - 1) & 1) * 64 + cv * 8;
    if (GI < 3) {
        *(LAS u32x4*)(lds + L_BM + l0 * SROW + nb * 2) = rw[0]; *(LAS u32x4*)(lds + L_BM + (l0 + 1) * SROW + nb * 2) = rw[1];
#pragma unroll
        for (int q = 0; q < 4; ++q) {
            *(LAS unsigned*)(lds + L_BDT + swz_off(nb + 2 * q, l0 >> 3) + (l0 & 7) * 2) = cvt_pk_bf16(bflo(rw[0][q]) * sa, bflo(rw[1][q]) * sb);
            *(LAS unsigned*)(lds + L_BDT + swz_off(nb + 2 * q + 1, l0 >> 3) + (l0 & 7) * 2) = cvt_pk_bf16(bfhi(rw[0][q]) * sa, bfhi(rw[1][q]) * sb);
        }
    } else {
        *(LAS u32x4*)(lds + L_CM + l0 * SROW + nb * 2) = rw[0]; *(LAS u32x4*)(lds + L_CM + (l0 + 1) * SROW + nb * 2) = rw[1];
    }
}
__device__ __forceinline__ void bc_wait(unsigned* f, unsigned need, int wv) {
    if (wv == 0) {
    unsigned sp = 0;
    for (;;) {
        const unsigned a = __hip_atomic_load(f, __ATOMIC_RELAXED, __HIP_MEMORY_SCOPE_AGENT), b2 = __hip_atomic_load(f + 1, __ATOMIC_RELAXED, __HIP_MEMORY_SCOPE_AGENT);
        const unsigned c = __hip_atomic_load(f + 16, __ATOMIC_RELAXED, __HIP_MEMORY_SCOPE_AGENT), d = __hip_atomic_load(f + 17, __ATOMIC_RELAXED, __HIP_MEMORY_SCOPE_AGENT);
        const unsigned m = min(min(a, b2), min(c, d));
        if (__builtin_amdgcn_readfirstlane(m) >= need) break;
        __builtin_amdgcn_s_sleep(4);
        if (++sp > (1u << 19)) break;
    }
    __builtin_amdgcn_fence(__ATOMIC_ACQUIRE, "agent"); asm volatile("s_waitcnt vmcnt(0)" ::: "memory");
    }
    asm volatile("s_waitcnt lgkmcnt(0)" ::: "memory"); __builtin_amdgcn_s_barrier(); asm volatile("" ::: "memory");
}
__device__ void ssd_unit(const Params& p, LAS unsigned char* lds, int b, int h, int wv) {
    const int lane = lane_id(), w = wv, tid = wv * 64 + lane, fr = lane & 15, fq = lane >> 4;
    const int g = h >> 2;
    const bf16_t* proj = (const bf16_t*)(p.ws + WS_PROJ);
    const float* dtg = (const float*)((const unsigned char*)p.out + DO_DT);
    bf16_t* ymix = (bf16_t*)(p.ws + WS_YMIX);
    float* ssq1 = (float*)((unsigned char*)p.out + DO_SSQ1);
    LAS float* CSv = (LAS float*)(lds + L_CS);
    LAS float* DTv = (LAS float*)(lds + L_DT);
    LAS float* CW = (LAS float*)(lds + L_CW);
    const float Aneg = -__expf(p.ssm_A_log[h]);
    const float Dh = p.ssm_D[h];
    for (int idx = tid; idx < 320; idx += 512) {
        const int e = idx & 7, k = (idx >> 3) % 5, cvi = idx / 40;
        const int xcol = h * 64 + cvi * 8 + e;
        CW[idx] = (k < 4) ? p.ssm_conv_w[k * 4096 + xcol] : p.ssm_conv_b[xcol];
    }
    for (int idx = tid; idx < 64 * 17; idx += 512) *(LAS u32x4*)(lds + L_HB + idx * 16) = (u32x4){0u, 0u, 0u, 0u};
    f32x4 Hacc[4];
#pragma unroll
    for (int pt = 0; pt < 4; ++pt) Hacc[pt] = (f32x4){0.f, 0.f, 0.f, 0.f};
    __syncthreads();
    const int cv = lane & 7;
    const int l0 = 16 * w + 2 * (lane >> 3);
    const int srcl = (w & 3) * 16 + 2 * (lane >> 3);
    u32x4 r0[5], r1[2], r2[2], r3[2], r4[2];
    const bf16_t* pbase = proj + (size_t)(b * SEQ + l0) * NPROJ + 2048 + cv * 8;
    const int xc0 = h * 64, xc1 = 2048 + g * 128, xc2 = xc1 + 64, xc3 = 3072 + g * 128, xc4 = xc3 + 64;
    unsigned* bcf = (unsigned*)((unsigned char*)p.out + DO_BCFLAG) + b * 32 + 2 * g;
    bc_wait(bcf, 1u, wv);
    ssd_load(r0, pbase + xc0, true, l0);
    r1[0] = *(const u32x4*)(pbase + xc1); r1[1] = *(const u32x4*)(pbase + xc1 + NPROJ); r2[0] = *(const u32x4*)(pbase + xc2); r2[1] = *(const u32x4*)(pbase + xc2 + NPROJ);
    r3[0] = *(const u32x4*)(pbase + xc3); r3[1] = *(const u32x4*)(pbase + xc3 + NPROJ); r4[0] = *(const u32x4*)(pbase + xc4); r4[1] = *(const u32x4*)(pbase + xc4 + NPROJ);
    float dt0n = dtg[(size_t)(b * SEQ + lane) * 32 + h], dt1n = dtg[(size_t)(b * SEQ + 64 + lane) * 32 + h];
    for (int c = 0; c < 32; ++c) {
        const int row0 = b * SEQ + c * 128;
        const float dt0 = dt0n, dt1 = dt1n;
        float a0 = dt0 * Aneg, a1 = dt1 * Aneg;
#pragma unroll
        for (int o = 1; o < 64; o <<= 1) { const float t0 = __shfl_up(a0, o), t1 = __shfl_up(a1, o); if (lane >= o) { a0 += t0; a1 += t1; } }
        a1 += __shfl(a0, 63);
        const float cs_end = __shfl(a1, 63);
        if (w == 0) { CSv[lane] = a0; CSv[64 + lane] = a1; DTv[lane] = dt0; DTv[64 + lane] = dt1; }
        const float csv = (w >= 4) ? a1 : a0, dtv = (w >= 4) ? dt1 : dt0;
        const float cs_l0 = __shfl(csv, srcl), cs_l1 = __shfl(csv, srcl + 1), dt_l0 = __shfl(dtv, srcl), dt_l1 = __shfl(dtv, srcl + 1);
        const float dec0 = __expf(cs_end - cs_l0), dec1 = __expf(cs_end - cs_l1);
        ssd_conv<0>(lds, r0, cv, l0, dt_l0, dt_l1);
        ssd_put<1>(lds, r1, cv, l0, dec0, dec1); ssd_put<2>(lds, r2, cv, l0, dec0, dec1);
        ssd_put<3>(lds, r3, cv, l0, 0.f, 0.f);   ssd_put<4>(lds, r4, cv, l0, 0.f, 0.f);
        __builtin_amdgcn_sched_barrier(0);
        if (c + 1 < 32) {
            if (((c + 1) & 3) == 0) bc_wait(bcf, (unsigned)(((c + 1) >> 2) + 1), wv);
            const bf16_t* cb = pbase + (size_t)(c + 1) * 128 * NPROJ;
            ssd_load(r0, cb + xc0, false, l0);
            r1[0] = *(const u32x4*)(cb + xc1); r1[1] = *(const u32x4*)(cb + xc1 + NPROJ); r2[0] = *(const u32x4*)(cb + xc2); r2[1] = *(const u32x4*)(cb + xc2 + NPROJ);
            r3[0] = *(const u32x4*)(cb + xc3); r3[1] = *(const u32x4*)(cb + xc3 + NPROJ); r4[0] = *(const u32x4*)(cb + xc4); r4[1] = *(const u32x4*)(cb + xc4 + NPROJ);
            dt0n = dtg[(size_t)(row0 + 128 + lane) * 32 + h]; dt1n = dtg[(size_t)(row0 + 192 + lane) * 32 + h];
        }
        __builtin_amdgcn_sched_barrier(0);
        u32x2 zr[4];
#pragma unroll
        for (int pt = 0; pt < 4; ++pt) zr[pt] = *(const u32x2*)(proj + (size_t)(row0 + 16 * w + fr) * NPROJ + h * 64 + 16 * pt + 4 * fq);
        asm volatile("s_waitcnt lgkmcnt(0)" ::: "memory"); __builtin_amdgcn_s_barrier(); asm volatile("" ::: "memory");
        const int lrow = 16 * w + fr;
        const int hb_cur = L_HB + (c & 1) * 17408, hb_nxt = L_HB + ((c + 1) & 1) * 17408;
        bf16x8 cf[4];
#pragma unroll
        for (int ks = 0; ks < 4; ++ks) cf[ks] = *(LAS const bf16x8*)(lds + L_CM + lrow * SROW + (32 * ks + 8 * fq) * 2);
        const float cs_l = CSv[lrow], dt_l = DTv[lrow];
        asm volatile("" ::: "memory");
        const int dd = fr - 4 * fq; const float ddiag = Dh / dt_l;
        f32x4 y[4];
        { const float el = __expf(cs_l);
#pragma unroll
          for (int pt = 0; pt < 4; ++pt) { f32x4 a = (f32x4){0.f, 0.f, 0.f, 0.f};
#pragma unroll
            for (int ks = 0; ks < 4; ++ks) { const bf16x8 hf = *(LAS const bf16x8*)(lds + hb_cur + (16 * pt + fr) * SROW + (32 * ks + 8 * fq) * 2);
                a = __builtin_amdgcn_mfma_f32_16x16x32_bf16(hf, cf[ks], a, 0, 0, 0); }
            y[pt] = a * el; } }
#pragma unroll
        for (int j = 0; j < 8; ++j) {
            if (j <= w) {
                f32x4 gacc = (f32x4){0.f, 0.f, 0.f, 0.f};
#pragma unroll
                for (int ks = 0; ks < 4; ++ks) { const bf16x8 bf = *(LAS const bf16x8*)(lds + L_BM + (16 * j + fr) * SROW + (32 * ks + 8 * fq) * 2);
                    gacc = __builtin_amdgcn_mfma_f32_16x16x32_bf16(bf, cf[ks], gacc, 0, 0, 0); }
                const f32x4 css = *(LAS const f32x4*)(CSv + 16 * j + 4 * fq);
                float mv[4];
#pragma unroll
                for (int i = 0; i < 4; ++i) { float v = gacc[i] * __expf(cs_l - css[i]);
                    if (j == w) { v = (i <= dd) ? v : 0.f; if (i == dd) v += ddiag; }
                    mv[i] = v; }
                u32x2 wv2; wv2.x = cvt_pk_bf16(mv[0], mv[1]); wv2.y = cvt_pk_bf16(mv[2], mv[3]);
                *(LAS u32x2*)(lds + L_CM + lrow * SROW + (16 * j + 4 * fq) * 2) = wv2;
            } else if (j == w + 1 && (w & 1) == 0) {
                *(LAS u32x2*)(lds + L_CM + lrow * SROW + (16 * j + 4 * fq) * 2) = (u32x2){0u, 0u};
            }
        }
        asm volatile("" ::: "memory");
        { const float de = __expf(cs_end);
#pragma unroll
          for (int pt = 0; pt < 4; ++pt) Hacc[pt] *= de; }
        const int nks2 = (w >> 1) + 1;
#pragma unroll
        for (int ks = 0; ks < 4; ++ks) {
            bf16x8 xf[4];
#pragma unroll
            for (int pt = 0; pt < 4; ++pt) xf[pt] = *(LAS const bf16x8*)(lds + L_XT + swz_off(16 * pt + fr, 4 * ks + fq));
            if (ks < nks2) { const bf16x8 mf = *(LAS const bf16x8*)(lds + L_CM + lrow * SROW + (32 * ks + 8 * fq) * 2);
#pragma unroll
                for (int pt = 0; pt < 4; ++pt) y[pt] = __builtin_amdgcn_mfma_f32_16x16x32_bf16(xf[pt], mf, y[pt], 0, 0, 0); }
            const bf16x8 bdf = *(LAS const bf16x8*)(lds + L_BDT + swz_off(16 * w + fr, 4 * ks + fq));
#pragma unroll
            for (int pt = 0; pt < 4; ++pt) Hacc[pt] = __builtin_amdgcn_mfma_f32_16x16x32_bf16(bdf, xf[pt], Hacc[pt], 0, 0, 0);
        }
#pragma unroll
        for (int pt = 0; pt < 4; ++pt) { u32x2 wv2; wv2.x = cvt_pk_bf16(Hacc[pt][0], Hacc[pt][1]); wv2.y = cvt_pk_bf16(Hacc[pt][2], Hacc[pt][3]);
            *(LAS u32x2*)(lds + hb_nxt + (16 * pt + fr) * SROW + (16 * w + 4 * fq) * 2) = wv2; }
        { float ss = 0.f; const size_t orow = (size_t)(row0 + lrow);
#pragma unroll
          for (int pt = 0; pt < 4; ++pt) {
            const float z0 = bflo(zr[pt].x), z1 = bfhi(zr[pt].x), z2 = bflo(zr[pt].y), z3 = bfhi(zr[pt].y);
            const float v0 = y[pt][0] * silu_f(z0), v1 = y[pt][1] * silu_f(z1), v2 = y[pt][2] * silu_f(z2), v3 = y[pt][3] * silu_f(z3);
            ss += (v0 * v0 + v1 * v1) + (v2 * v2 + v3 * v3);
            u32x2 wv; wv.x = cvt_pk_bf16(v0, v1); wv.y = cvt_pk_bf16(v2, v3);
            *(u32x2*)(ymix + orow * DMIX + h * 64 + 16 * pt + 4 * fq) = wv; }
          ss += __shfl_xor(ss, 16); ss += __shfl_xor(ss, 32);
          if (fq == 0) ssq1[ssq_idx((int)orow, h)] = ss; }
        asm volatile("s_waitcnt lgkmcnt(0)" ::: "memory"); __builtin_amdgcn_s_barrier(); asm volatile("" ::: "memory");
    }
}
__device__ void sc_unit(const Params& p, int unit, int wv) {
    const int tid = wv * 64 + lane_id(), cvx = tid & 255, th = tid >> 8;
    const bf16_t* proj = (const bf16_t*)(p.ws + WS_PROJ);
    bf16_t* ymix = (bf16_t*)(p.ws + WS_YMIX);
    const int t0 = unit * 64 + th * 32, c0 = cvx * 8;
    float w0[8], w1[8], w2[8];
    { const f32x4* a = (const f32x4*)(p.sc_conv_w + c0); const f32x4* bq = (const f32x4*)(p.sc_conv_w + 2048 + c0); const f32x4* cq = (const f32x4*)(p.sc_conv_w + 4096 + c0);
#pragma unroll
      for (int q = 0; q < 2; ++q) { const f32x4 x0 = a[q], x1 = bq[q], x2 = cq[q];
#pragma unroll
        for (int j = 0; j < 4; ++j) { w0[q * 4 + j] = x0[j]; w1[q * 4 + j] = x1[j]; w2[q * 4 + j] = x2[j]; } } }
    float pm1[8], pm2[8];
#pragma unroll
    for (int e = 0; e < 8; ++e) { pm1[e] = 0.f; pm2[e] = 0.f; }
    if ((t0 & (SEQ - 1)) != 0) {
        const bf16_t* r2 = proj + (size_t)(t0 - 2) * NPROJ, * r1 = proj + (size_t)(t0 - 1) * NPROJ;
        const u32x4 c2 = *(const u32x4*)(r2 + 8192 + c0), x2 = *(const u32x4*)(r2 + 10240 + c0), c1 = *(const u32x4*)(r1 + 8192 + c0), x1 = *(const u32x4*)(r1 + 10240 + c0);
#pragma unroll
        for (int q = 0; q < 4; ++q) { pm2[2 * q] = bflo(c2[q]) * bflo(x2[q]); pm2[2 * q + 1] = bfhi(c2[q]) * bfhi(x2[q]); pm1[2 * q] = bflo(c1[q]) * bflo(x1[q]); pm1[2 * q + 1] = bfhi(c1[q]) * bfhi(x1[q]); }
    }
#pragma unroll 4
    for (int i = 0; i < 32; ++i) {
        const bf16_t* r = proj + (size_t)(t0 + i) * NPROJ;
        const u32x4 gb = *(const u32x4*)(r + 6144 + c0), gc = *(const u32x4*)(r + 8192 + c0), gx = *(const u32x4*)(r + 10240 + c0);
        float o[8];
#pragma unroll
        for (int q = 0; q < 4; ++q) {
            const float pa = bflo(gc[q]) * bflo(gx[q]), pb = bfhi(gc[q]) * bfhi(gx[q]);
            o[2 * q] = bflo(gb[q]) * (w0[2 * q] * pm2[2 * q] + w1[2 * q] * pm1[2 * q] + w2[2 * q] * pa);
            o[2 * q + 1] = bfhi(gb[q]) * (w0[2 * q + 1] * pm2[2 * q + 1] + w1[2 * q + 1] * pm1[2 * q + 1] + w2[2 * q + 1] * pb);
            pm2[2 * q] = pm1[2 * q]; pm2[2 * q + 1] = pm1[2 * q + 1]; pm1[2 * q] = pa; pm1[2 * q + 1] = pb;
        }
        u32x4 wv; wv.x = cvt_pk_bf16(o[0], o[1]); wv.y = cvt_pk_bf16(o[2], o[3]); wv.z = cvt_pk_bf16(o[4], o[5]); wv.w = cvt_pk_bf16(o[6], o[7]);
        *(u32x4*)(ymix + (size_t)(t0 + i) * DMIX + 2048 + c0) = wv;
    }
}
__device__ void phase2(const Params& p, LAS unsigned char* lds, int wv) {
    const int G = gridDim.x, bid = blockIdx.x;
    const bool split = G >= 256;
    if (!split) bc_sequences(p, lds, bid, G, wv);
    if (!split || bid < 128) { for (int u = bid; u < 128; u += (split ? 128 : G)) ssd_unit(p, lds, u >> 5, u & 31, wv); }
    if (split && bid >= 128) bc_sequences(p, lds, bid - 128, G - 128, wv);
    if (!split || bid >= 128) { for (int u = (split ? bid - 128 : bid); u < M_ / 64; u += (split ? G - 128 : G)) sc_unit(p, u, wv); }
    if (!split || bid >= 128) wconv_units(p, lds, split ? bid - 128 : bid, split ? G - 128 : G, wv);
}

__device__ void phase6(const Params& p, int wv) {
    const int lane = lane_id(), wave = wv;
    const float* h2 = (const float*)(p.ws + WS_H1F);
    const float* ssq3 = (const float*)(p.ws + WS_SSQ3);
    for (int row = blockIdx.x * 8 + wave; row < M_; row += gridDim.x * 8) {
        float s = (lane < 32) ? ssq3[ssq_idx(row, lane)] : 0.f;
#pragma unroll
        for (int o = 32; o >= 1; o >>= 1) s += __shfl_xor(s, o);
        const float rstd = rsqrtf(s * (1.0f / 2048.0f) + EPS);
        const f32x4* hr = (const f32x4*)(h2 + (size_t)row * D_);
        f32x4* orow = (f32x4*)(p.out + (size_t)row * D_);
#pragma unroll
        for (int i = 0; i < 8; ++i) { const f32x4 v = hr[lane + 64 * i], g4 = ((const f32x4*)p.norm_final_g)[lane + 64 * i]; orow[lane + 64 * i] = v * rstd * g4; }
    }
}


#define XB_TMO      128
#define XB_XCNT(j)  (256  + 64 * (j))
#define XB_XSUB(j)  (1280 + 64 * (j))
#define XB_XGEN(j)  (2304 + 64 * (j))
#define XB_TOP      3328
#define XB_TOPGEN   3392
#define XCD_BAR_WORDS 3456
#define XB_SPIN_CAP (1u << 18)
__device__ __forceinline__ unsigned xb_ld(unsigned* p)              { return __hip_atomic_load(p, __ATOMIC_RELAXED, __HIP_MEMORY_SCOPE_AGENT); }
__device__ __forceinline__ unsigned xb_add(unsigned* p, unsigned v) { return __hip_atomic_fetch_add(p, v, __ATOMIC_RELAXED, __HIP_MEMORY_SCOPE_AGENT); }
__device__ __forceinline__ unsigned xb_xcc_id() { return (unsigned)__builtin_amdgcn_s_getreg((3 << 11) | 20) & 0xFu; }
#define XB_SPIN(cond, bar) do { unsigned _sp = 0; while (cond) { __builtin_amdgcn_s_sleep(1); \
    if ((++_sp & 255u) == 0u) { if (xb_ld(&(bar)[XB_TMO])) break; if (_sp > XB_SPIN_CAP) { atomicAdd(&(bar)[XB_TMO], 1u); break; } } } } while (0)
struct XcdBarrier { unsigned* bar; unsigned x; volatile LAS unsigned* st; };
__device__ __forceinline__ void xcd_barrier_complete(unsigned* bar, unsigned x, unsigned& nloc, unsigned& nx) {
    const unsigned G = gridDim.x * gridDim.y * gridDim.z;
    unsigned sum, cnt, mine, sp = 0u;
    for (;;) {
        sum = 0u; cnt = 0u; mine = 0u;
#pragma unroll
        for (unsigned j = 0; j < 16; ++j) { const unsigned c = xb_ld(&bar[XB_XCNT(j)]); sum += c; cnt += (c > 0u) ? 1u : 0u; mine = (j == x) ? c : mine; }
        if (sum == G) break;
        __builtin_amdgcn_s_sleep(1);
        if ((++sp & 255u) == 0u) { if (xb_ld(&bar[XB_TMO])) break; if (sp > XB_SPIN_CAP) { atomicAdd(&bar[XB_TMO], 1u); break; } }
    }
    nloc = mine > 0u ? mine : 1u; nx = cnt > 0u ? cnt : 1u;
}
__device__ __forceinline__ void xcd_barrier(const XcdBarrier& b, bool leader) {
    asm volatile("s_waitcnt vmcnt(0)" ::: "memory");
    __syncthreads();
    if (leader) {
        unsigned* bar = b.bar;
        __builtin_amdgcn_s_waitcnt(0);
        unsigned nloc = b.st[0], nx = b.st[1];
        if (nloc == 0u) { xcd_barrier_complete(bar, b.x, nloc, nx); b.st[0] = nloc; b.st[1] = nx; }
        const unsigned old = xb_add(&bar[XB_XSUB(b.x)], 1u);
        const unsigned gen = old / nloc;
        if (old + 1u == (gen + 1u) * nloc) {
            __builtin_amdgcn_fence(__ATOMIC_RELEASE, "agent");
            asm volatile("s_waitcnt vmcnt(0)" ::: "memory");
            const unsigned og = xb_add(&bar[XB_TOP], 1u);
            const unsigned tg = og / nx;
            if (og + 1u == (tg + 1u) * nx) xb_add(&bar[XB_TOPGEN], 1u);
            else XB_SPIN(xb_ld(&bar[XB_TOPGEN]) == tg, bar);
            __builtin_amdgcn_fence(__ATOMIC_ACQUIRE, "agent");
            xb_add(&bar[XB_XGEN(b.x)], 1u);
            asm volatile("s_waitcnt vmcnt(0)" ::: "memory");
        } else {
            XB_SPIN(xb_ld(&bar[XB_XGEN(b.x)]) == gen, bar);
            __builtin_amdgcn_fence(__ATOMIC_ACQUIRE, "agent");
            asm volatile("s_waitcnt vmcnt(0)" ::: "memory");
        }
    }
    __syncthreads();
}

__global__ void __launch_bounds__(512) hymba_fwd(Params p) {
    extern __shared__ __attribute__((aligned(16))) unsigned char shm[];
    LAS unsigned char* lds = (LAS unsigned char*)shm;
    cg::grid_group grid = cg::this_grid();
    const int lo = p.ph_lo, hi = p.ph_hi;
    const int wv = __builtin_amdgcn_readfirstlane(threadIdx.x >> 6);
#ifdef DBG_CLEAR
    for (int i = threadIdx.x; i < LDS_BYTES / 16; i += 512) *(LAS u32x4*)(lds + i * 16) = (u32x4){0u, 0u, 0u, 0u};
    __syncthreads();
#endif
#define IN(k) (lo <= (k) && (k) < hi)
#define SEAM(k) do { if (IN(k) && IN((k) + 1)) { \
        asm volatile("s_waitcnt vmcnt(0) lgkmcnt(0)" ::: "memory"); __syncthreads();                 \
        if (wv == 0) { __builtin_amdgcn_fence(__ATOMIC_RELEASE, "agent"); asm volatile("s_waitcnt vmcnt(0)" ::: "memory"); }     \
        grid.sync(); \
        if (wv == 0) { __builtin_amdgcn_fence(__ATOMIC_ACQUIRE, "agent"); asm volatile("s_waitcnt vmcnt(0)" ::: "memory"); }     \
        __syncthreads(); } } while (0)
    volatile LAS unsigned* xst = (volatile LAS unsigned*)(lds + LDS_BYTES - 16);
    const bool xlead = (wv == 0) && (lane_id() == 0);
    if (xlead) { xst[0] = 0u; xst[1] = 0u; }
    __syncthreads();
    XcdBarrier xb; xb.bar = (unsigned*)((unsigned char*)p.out + DO_XBAR); xb.x = xb_xcc_id(); xb.st = xst;
    if (xlead) (void)xb_add(&xb.bar[XB_XCNT(xb.x)], 1u);
#define XSEAM(k) do { if (IN(k) && IN((k) + 1)) xcd_barrier(xb, (wv == 0) && (lane_id() == 0)); } while (0)
    if (IN(0)) for (int rep = 0; rep < NREP(0); ++rep) phase0(p, lds, wv);
    XSEAM(0);
    if (IN(1)) for (int rep = 0; rep < NREP(1); ++rep) {
        pg8::Gemm g{(const bf16_t*)(p.ws + WS_XN), (const bf16_t*)(p.ws + WS_BTIN), M_, NPROJ, D_}; pg8::StaticOrder S; S.init(M_, NPROJ, gridDim.x, blockIdx.x);
        EpiProj E{(bf16_t*)(p.ws + WS_PROJ)};
        pg8::gemm_phase<EpiProj>(lds, g, S, E, wv);
        dt_units(p, lds, wv);
    }
    XSEAM(1);
    if (IN(3)) for (int rep = 0; rep < NREP(3); ++rep) phase2(p, lds, wv);
    XSEAM(3);
    if (IN(4)) for (int rep = 0; rep < NREP(4); ++rep) {
        pg8::Gemm g{(const bf16_t*)(p.ws + WS_YMIX), (const bf16_t*)((unsigned char*)p.out + DO_BTOUT), M_, D_, DMIX}; pg8::StaticOrder S; S.init(M_, D_, gridDim.x, blockIdx.x);
        EpiOut E{p.x, (float*)(p.ws + WS_H1F), (bf16_t*)(p.ws + WS_H1B), (const float*)((unsigned char*)p.out + DO_SSQ1), (float*)((unsigned char*)p.out + DO_SSQ2)};
        pg8::gemm_phase<EpiOut>(lds, g, S, E, wv);
    }
    XSEAM(4);
    if (IN(5)) for (int rep = 0; rep < NREP(5); ++rep) {
        pg8::Gemm g{(const bf16_t*)(p.ws + WS_H1B), (const bf16_t*)((unsigned char*)p.out + DO_BTGU), M_, NGU, D_}; pg8::StaticOrder S; S.init(M_, NGU, gridDim.x, blockIdx.x);
        EpiGU E{(const float*)((unsigned char*)p.out + DO_SSQ2), (bf16_t*)(p.ws + WS_HFF)};
        pg8::gemm_phase<EpiGU>(lds, g, S, E, wv);
    }
    XSEAM(5);
    if (IN(6)) {
        pg8::Gemm g{(const bf16_t*)(p.ws + WS_HFF), (const bf16_t*)((unsigned char*)p.out + DO_BTDN), M_, D_, DFF}; pg8::StaticOrder S; S.init(M_, D_, gridDim.x, blockIdx.x);
        EpiDown E{(float*)(p.ws + WS_H1F), (float*)(p.ws + WS_SSQ3)};
        pg8::gemm_phase<EpiDown>(lds, g, S, E, wv);
    }
    XSEAM(6);
    if (p.ph_hi > 1000) grid.sync();
    if (IN(7)) for (int rep = 0; rep < NREP(7); ++rep) phase6(p, wv);
#undef IN
#undef SEAM
}

extern "C" void kernel_launch(void* const* d_in, const int* in_sizes, int n_in, void* d_out, int out_size, void* d_ws, size_t ws_size, hipStream_t stream) {
    static int grid = 0;
    if (grid == 0) {
        if (n_in != 16 || out_size != M_ * D_ || ws_size < WS_NEED) { fprintf(stderr, "kernel_launch: unexpected shapes (n_in %d out %d ws %zu, need %zu)\n", n_in, out_size, ws_size, (size_t)WS_NEED); grid = -1; return; }
        int dev = 0, cus = 0, per_cu = 0;
        (void)hipGetDevice(&dev);
        (void)hipDeviceGetAttribute(&cus, hipDeviceAttributeMultiprocessorCount, dev);
        if (hipFuncSetAttribute((const void*)hymba_fwd, hipFuncAttributeMaxDynamicSharedMemorySize, LDS_BYTES) != hipSuccess) { fprintf(stderr, "kernel_launch: hipFuncSetAttribute failed\n"); grid = -1; return; }
        if (hipOccupancyMaxActiveBlocksPerMultiprocessor(&per_cu, (const void*)hymba_fwd, 512, LDS_BYTES) != hipSuccess || per_cu < 1) { fprintf(stderr, "kernel_launch: occupancy query failed (%d)\n", per_cu); (void)hipGetLastError(); per_cu = 1; }
        grid = cus * per_cu;
    }
    if (grid < 0) return;
    Params p{};
    p.x = (const float*)d_in[0]; p.norm_mix_g = (const float*)d_in[1]; p.w_in = (const float*)d_in[2]; p.ssm_conv_w = (const float*)d_in[3]; p.ssm_conv_b = (const float*)d_in[4];
    p.ssm_dt_bias = (const float*)d_in[5]; p.ssm_A_log = (const float*)d_in[6]; p.ssm_D = (const float*)d_in[7]; p.ssm_norm_g = (const float*)d_in[8]; p.sc_conv_w = (const float*)d_in[9];
    p.w_out = (const float*)d_in[10]; p.norm_ffn_g = (const float*)d_in[11]; p.w_gate = (const float*)d_in[12]; p.w_up = (const float*)d_in[13]; p.w_down = (const float*)d_in[14]; p.norm_final_g = (const float*)d_in[15];
    p.out = (float*)d_out; p.ws = (unsigned char*)d_ws;
#ifdef DBG_MEMSET
    (void)hipMemsetAsync(d_ws, 0, WS_NEED, stream); (void)hipMemsetAsync(d_out, 0, (size_t)out_size * 4, stream);
#endif
#ifndef N_CUTS
#define N_CUTS 1
#endif
    for (int li = 0; li < N_CUTS; ++li) {
        p.ph_lo = (N_CUTS == 8) ? li : 0; p.ph_hi = (N_CUTS == 8) ? li + 1 : 8;
        (void)hipMemsetAsync((unsigned char*)d_out + DO_BCFLAG, 0, 4096 + XCD_BAR_WORDS * sizeof(unsigned), stream);
    void* args[] = {&p};
        hipError_t e = hipLaunchCooperativeKernel((const void*)hymba_fwd, dim3(grid), dim3(512), args, LDS_BYTES, stream);
        if (e != hipSuccess) fprintf(stderr, "kernel_launch: cooperative launch failed: %s (grid %d)\n", hipGetErrorString(e), grid);
    }
}
```

```cpp
#include <hip/hip_runtime.h>
#include <hip/hip_cooperative_groups.h>
#include <cstdio>
namespace cg = cooperative_groups;

#define LAS __attribute__((address_space(3)))
typedef unsigned short bf16_t;
typedef short bf16x8 __attribute__((ext_vector_type(8)));
typedef float f32x4 __attribute__((ext_vector_type(4)));
typedef unsigned u32x4 __attribute__((ext_vector_type(4)));
typedef unsigned u32x2 __attribute__((ext_vector_type(2)));

constexpr int M_ = 16384, D_ = 2048, DIN = 12320, NPROJ = 12288, DFF = 5632, DMIX = 4096, NGU = 11264;
constexpr int SEQ = 4096;
constexpr float EPS = 1e-5f;
constexpr int LDS_BYTES = 159744;
constexpr int XCD_BAR_WORDS_C = 3456;
#ifndef PROBE_PHASE
#define PROBE_PHASE -1
#endif
#define NREP(k) ((PROBE_PHASE == (k)) ? 1 + (p.ph_hi < 100) : 1)
constexpr int TAB_OFF = 131072;

constexpr size_t WS_PROJ = 0;
constexpr size_t WS_R = (size_t)M_ * NPROJ * 2;
constexpr size_t WS_XN = WS_R;
constexpr size_t WS_BTIN = WS_R + (size_t)M_ * D_ * 2;
constexpr size_t WS_YMIX = WS_R;
constexpr size_t WS_H1F = 0;
constexpr size_t WS_H1B = (size_t)M_ * D_ * 4;
constexpr size_t WS_HFF = WS_H1B + (size_t)M_ * D_ * 2;
constexpr size_t WS_SSQ3 = WS_HFF + (size_t)M_ * DFF * 2;
constexpr size_t WS_NEED = WS_R + (size_t)M_ * DMIX * 2;
constexpr size_t DO_BTOUT = 0;
constexpr size_t DO_BTGU = (size_t)D_ * DMIX * 2;
constexpr size_t DO_BTDN = DO_BTGU + (size_t)NGU * D_ * 2;
constexpr size_t DO_DT = DO_BTDN + (size_t)D_ * DFF * 2;
constexpr size_t DO_SSQ1 = DO_DT + (size_t)M_ * 32 * 4;
constexpr size_t DO_SSQ2 = DO_SSQ1 + (size_t)M_ * 32 * 4;
constexpr size_t DO_XBAR = (size_t)M_ * D_ * 4 - 16384;
constexpr size_t DO_BCFLAG = DO_XBAR - 4096;
static_assert(DO_SSQ2 + (size_t)M_ * 32 * 4 <= DO_BCFLAG && XCD_BAR_WORDS_C * 4 <= 16384, "d_out scratch");

static_assert(WS_SSQ3 + (size_t)M_ * 32 * 4 <= WS_R, "ws overlay");

struct Params {
    const float* x; const float* norm_mix_g; const float* w_in; const float* ssm_conv_w; const float* ssm_conv_b;
    const float* ssm_dt_bias; const float* ssm_A_log; const float* ssm_D; const float* ssm_norm_g; const float* sc_conv_w;
    const float* w_out; const float* norm_ffn_g; const float* w_gate; const float* w_up; const float* w_down; const float* norm_final_g;
    float* out; unsigned char* ws; int ph_lo, ph_hi;
};

typedef float f32x2_t __attribute__((ext_vector_type(2)));
typedef __bf16 bf16x2_t __attribute__((ext_vector_type(2)));
__device__ __forceinline__ unsigned cvt_pk_bf16(float lo, float hi) { const f32x2_t v = {lo, hi}; return __builtin_bit_cast(unsigned, __builtin_convertvector(v, bf16x2_t)); }
__device__ __forceinline__ float bflo(unsigned u) { return __uint_as_float(u << 16); }
__device__ __forceinline__ float bfhi(unsigned u) { return __uint_as_float(u & 0xffff0000u); }
__device__ __forceinline__ int lane_id() { int l; asm volatile("v_mbcnt_lo_u32_b32 %0, -1, 0\n\tv_mbcnt_hi_u32_b32 %0, -1, %0" : "=v"(l)); return l; }
__device__ __forceinline__ float silu_f(float v) { return v * __builtin_amdgcn_rcpf(1.0f + __expf(-v)); }

__device__ __forceinline__ size_t ssq_idx(int row, int part) { return ((size_t)(row >> 5) * 32 + part) * 32 + (row & 31); }

namespace pg8 {
constexpr int BM = 256, BK = 64, HALF = 128, HTB = HALF * BK * 2, STAGE_BYTES = 8 * HTB, NXCD = 8, WGM = 8;
__device__ __forceinline__ int lds_byte(int r, int c) { const int st = (r >> 4) * 2 + (c >> 5), rr = r & 15, cc = c & 31, ob = rr * 64 + cc * 2; return st * 1024 + (ob ^ (((ob >> 9) & 1) << 5)); }
__device__ __forceinline__ void stage_rc(int b, int& R, int& C) { const int st = b / 1024, sb = b % 1024, swz = sb ^ (((sb >> 9) & 1) << 5); R = (st >> 1) * 16 + swz / 64; C = (st & 1) * 32 + (swz % 64) / 2; }
__device__ __forceinline__ int perm32(int rho) { const int n = rho >> 4, i = rho & 15; return 8 * (i >> 2) + 4 * n + (i & 3); }
struct Unit { int pm, pn; };
struct Gemm { const bf16_t* A; const bf16_t* Bt; int M, N, K; };
struct StaticOrder {
    int nM, nN, nwg, G, c;
    __device__ void init(int M, int N, int G_, int c_) { nM = M / BM; nN = N / BM; nwg = nM * nN; G = G_; c = c_; }
    __device__ bool next(int i, Unit& u) const {
        const long L = (long)i * G + c; if (L >= nwg) return false;
        int wgid = (int)L; { const int q = nwg / NXCD, r = nwg % NXCD, xcd = wgid % NXCD, off = wgid / NXCD; wgid = (xcd < r ? xcd * (q + 1) : r * (q + 1) + (xcd - r) * q) + off; }
        const int nig = WGM * nN, gid = wgid / nig, fm = gid * WGM, gsz = (nM - fm) < WGM ? (nM - fm) : WGM;
        u.pm = fm + ((wgid % nig) % gsz); u.pn = (wgid % nig) / gsz; return true;
    }
};
template <class Epi>
__device__ __forceinline__ void gemm_phase(LAS unsigned char* lds, const Gemm g, const StaticOrder& S, const Epi& E, int wv) {
    const int wid = wv, lane = lane_id(), tid = wid * 64 + lane, wr = wid >> 2, wc = wid & 3, fr = lane & 15, fq = lane >> 4;
    const int K = g.K, nt = K / BK;
    unsigned voffA[2], voffB[2];
#pragma unroll
    for (int i = 0; i < 2; ++i) { int R, C; stage_rc(tid * 16 + i * 8192, R, C); const int Rb = (R & ~31) + perm32(R & 31);
        voffA[i] = (unsigned)(R * K + C) * 2u; voffB[i] = (unsigned)(Rb * K + C) * 2u; }
    const size_t kstep = (size_t)(BK * 2);
    const size_t hstep = (size_t)HALF * K * 2;
    const size_t tstep = 2 * hstep;
    const unsigned ldsw = (unsigned)wid * 1024u;
    const int aoff = lds_byte(wr * 64 + fr, fq * 8), boff = lds_byte(wc * 32 + fr, fq * 8);
#define PG8_SA(b, h) (((b) * 2 + (h)) * HTB)
#define PG8_SB(b, h) ((4 + (b) * 2 + (h)) * HTB)
#define PG8_STAGE(bufoff, gbase, voff) do { _Pragma("unroll") for (int _i = 0; _i < 2; ++_i) \
        __builtin_amdgcn_global_load_lds((const unsigned*)((const char*)(gbase) + (voff)[_i]), (LAS unsigned*)(lds + (bufoff) + ldsw + _i * 8192), 16, 0, 0); } while (0)
#define PG8_LDA(dst, b, h) do { _Pragma("unroll") for (int m = 0; m < 4; ++m) _Pragma("unroll") for (int k = 0; k < 2; ++k) dst[m][k] = *(const LAS bf16x8*)(lds + PG8_SA(b, h) + aoff + m * 2048 + k * 1024); } while (0)
#define PG8_LDB(dst, b, h) do { _Pragma("unroll") for (int n = 0; n < 2; ++n) _Pragma("unroll") for (int k = 0; k < 2; ++k) dst[n][k] = *(const LAS bf16x8*)(lds + PG8_SB(b, h) + boff + n * 2048 + k * 1024); } while (0)
#define PG8_MMA(ai, bj, At, Bt) do { __builtin_amdgcn_s_setprio(1); _Pragma("unroll") for (int m = 0; m < 4; ++m) _Pragma("unroll") for (int n = 0; n < 2; ++n) _Pragma("unroll") for (int k = 0; k < 2; ++k) \
        acc[ai][bj][m][n] = __builtin_amdgcn_mfma_f32_16x16x32_bf16(Bt[n][k], At[m][k], acc[ai][bj][m][n], 0, 0, 0); __builtin_amdgcn_s_setprio(0); } while (0)
#define PG8_WAIT_V(n) asm volatile("s_waitcnt vmcnt(" #n ")" ::: "memory")
#define PG8_WAIT_L(n) asm volatile("s_waitcnt lgkmcnt(" #n ")" ::: "memory")
#define PG8_BAR __builtin_amdgcn_s_barrier()
#define PG8_SCHED __builtin_amdgcn_sched_barrier(0)
    Unit cur, nxt; int ui = 0;
    if (!S.next(0, cur)) return;
    f32x4 acc[2][2][4][2];
#pragma unroll
    for (int a = 0; a < 2; ++a)
#pragma unroll
        for (int b = 0; b < 2; ++b)
#pragma unroll
            for (int m = 0; m < 4; ++m)
#pragma unroll
                for (int n = 0; n < 2; ++n) acc[a][b][m][n] = (f32x4){0.f, 0.f, 0.f, 0.f};
    bf16x8 At[4][2], B0[2][2], B1[2][2];
    const char* cA = (const char*)g.A + (size_t)cur.pm * tstep; const char* cB = (const char*)g.Bt + (size_t)cur.pn * tstep;
    if constexpr (Epi::HAS_TAB) {
        Unit uu; for (int i = 0; i < 27 && S.next(i, uu); ++i) E.prep(uu, (LAS float*)(lds + TAB_OFF + i * 1024), tid);
    }
    PG8_STAGE(PG8_SB(0, 0), cB, voffB); PG8_STAGE(PG8_SB(0, 1), cB + hstep, voffB); PG8_STAGE(PG8_SA(0, 0), cA, voffA); PG8_STAGE(PG8_SA(0, 1), cA + hstep, voffA);
    if (wr == 1) PG8_BAR;
    PG8_WAIT_V(2); PG8_BAR;
    PG8_STAGE(PG8_SB(1, 0), cB + kstep, voffB); PG8_STAGE(PG8_SA(1, 0), cA + kstep, voffA); PG8_STAGE(PG8_SB(1, 1), cB + hstep + kstep, voffB);
    PG8_WAIT_V(6); PG8_BAR;
    for (;;) {
        const bool has_next = S.next(ui + 1, nxt);
        const char* nA = has_next ? (const char*)g.A + (size_t)nxt.pm * tstep : cA; const char* nB = has_next ? (const char*)g.Bt + (size_t)nxt.pn * tstep : cB;
        LAS const float* tabc = (LAS const float*)(lds + TAB_OFF + ui * 1024);
        for (int t = 0; t < nt; t += 2) {
            const bool last = (t == nt - 2);
            const char* a1 = cA + (size_t)(t + 1) * kstep;
            const char* a2 = last ? nA : cA + (size_t)(t + 2) * kstep; const char* b2 = last ? nB : cB + (size_t)(t + 2) * kstep;
            const char* a3 = a2 + kstep; const char* b3 = b2 + kstep;
            if constexpr (Epi::MID_T >= 0) { if (t == Epi::MID_T) {
#pragma unroll
                for (int ai = 0; ai < 2; ++ai)
#pragma unroll
                    for (int m = 0; m < 4; ++m) { const float s = tabc[ai * HALF + wr * 64 + m * 16 + fr];
#pragma unroll
                        for (int bj = 0; bj < 2; ++bj)
#pragma unroll
                            for (int n = 0; n < 2; ++n) acc[ai][bj][m][n] *= s; } } }
            PG8_LDB(B0, 0, 0); PG8_LDB(B1, 0, 1); PG8_SCHED; PG8_LDA(At, 0, 0); PG8_STAGE(PG8_SA(1, 1), a1 + hstep, voffA);
            PG8_WAIT_V(8); PG8_WAIT_L(0); PG8_BAR; PG8_MMA(0, 0, At, B0); PG8_MMA(0, 1, At, B1); PG8_BAR; PG8_SCHED;
            PG8_LDA(At, 0, 1); PG8_STAGE(PG8_SB(0, 0), b2, voffB); PG8_STAGE(PG8_SB(0, 1), b2 + hstep, voffB); PG8_STAGE(PG8_SA(0, 0), a2, voffA);
            PG8_WAIT_V(8); PG8_WAIT_L(0); PG8_BAR; PG8_MMA(1, 0, At, B0); PG8_MMA(1, 1, At, B1); PG8_BAR; PG8_SCHED;
            PG8_LDB(B0, 1, 0); PG8_LDB(B1, 1, 1); PG8_SCHED; PG8_LDA(At, 1, 0); PG8_STAGE(PG8_SA(0, 1), a2 + hstep, voffA);
            PG8_WAIT_V(8); PG8_WAIT_L(0); PG8_BAR; PG8_MMA(0, 0, At, B0); PG8_MMA(0, 1, At, B1); PG8_BAR; PG8_SCHED;
            PG8_LDA(At, 1, 1); PG8_STAGE(PG8_SB(1, 0), b3, voffB); PG8_STAGE(PG8_SB(1, 1), b3 + hstep, voffB); PG8_STAGE(PG8_SA(1, 0), a3, voffA);
            PG8_WAIT_V(8); PG8_WAIT_L(0); PG8_BAR; PG8_MMA(1, 0, At, B0); PG8_MMA(1, 1, At, B1); PG8_BAR; PG8_SCHED;
        }
        if (wr == 0) PG8_BAR;
        E(acc, cur, tabc, wr, wc, fr, fq);
        if (!has_next) break;
#pragma unroll
        for (int a = 0; a < 2; ++a)
#pragma unroll
            for (int b = 0; b < 2; ++b)
#pragma unroll
                for (int m = 0; m < 4; ++m)
#pragma unroll
                    for (int n = 0; n < 2; ++n) acc[a][b][m][n] = (f32x4){0.f, 0.f, 0.f, 0.f};
        cur = nxt; cA = nA; cB = nB; ++ui;
        if (wr == 1) PG8_BAR;
    }
    PG8_WAIT_V(0);
    PG8_BAR;
#undef PG8_SA
#undef PG8_SB
#undef PG8_STAGE
#undef PG8_LDA
#undef PG8_LDB
#undef PG8_MMA
#undef PG8_WAIT_V
#undef PG8_WAIT_L
#undef PG8_BAR
#undef PG8_SCHED
}
}

__device__ __forceinline__ void rstd_table(const float* ssq, int row0, LAS float* tab, int t) {
    const int r = t >> 1, hf = t & 1;
    const float* p = ssq + ssq_idx(row0 + r, hf * 16);
    float s = 0.f;
#pragma unroll
    for (int i = 0; i < 16; ++i) s += p[i * 32];
    s += __shfl_xor(s, 1);
    if (!hf) tab[r] = rsqrtf(s * (1.0f / 2048.0f) + EPS);
}

struct EpiProj {
    static constexpr bool HAS_TAB = false; static constexpr int MID_T = -1;
    bf16_t* O;
    __device__ __forceinline__ void prep(const pg8::Unit&, LAS float*, int) const {}
    __device__ __forceinline__ void operator()(const f32x4 (&acc)[2][2][4][2], const pg8::Unit& u, LAS const float*, int wr, int wc, int fr, int fq) const {
        const int row0 = u.pm * 256 + wr * 64 + fr, col0 = u.pn * 256 + wc * 32 + 8 * fq;
#pragma unroll
        for (int ai = 0; ai < 2; ++ai)
#pragma unroll
            for (int m = 0; m < 4; ++m) { bf16_t* rowp = O + (size_t)(row0 + ai * 128 + m * 16) * NPROJ + col0;
#pragma unroll
                for (int bj = 0; bj < 2; ++bj) { const f32x4 v0 = acc[ai][bj][m][0], v1 = acc[ai][bj][m][1];
                    u32x4 w; w.x = cvt_pk_bf16(v0[0], v0[1]); w.y = cvt_pk_bf16(v0[2], v0[3]); w.z = cvt_pk_bf16(v1[0], v1[1]); w.w = cvt_pk_bf16(v1[2], v1[3]);
                    *(u32x4*)(rowp + bj * 128) = w; } }
    }
};
struct EpiOut {
    static constexpr bool HAS_TAB = true; static constexpr int MID_T = 32;
    const float* x; bf16_t* h1b; const float* ssq1; float* ssq2;
    __device__ __forceinline__ void prep(const pg8::Unit& u, LAS float* tab, int t) const { rstd_table(ssq1, u.pm * 256, tab, t); }
    __device__ __forceinline__ void operator()(const f32x4 (&acc)[2][2][4][2], const pg8::Unit& u, LAS const float*, int wr, int wc, int fr, int fq) const {
        const int row0 = u.pm * 256 + wr * 64 + fr, col0 = u.pn * 256 + wc * 32 + 8 * fq;
#pragma unroll
        for (int ai = 0; ai < 2; ++ai)
#pragma unroll
            for (int m = 0; m < 4; ++m) { const int row = row0 + ai * 128 + m * 16; const size_t off = (size_t)row * D_ + col0; float ss = 0.f;
#pragma unroll
                for (int bj = 0; bj < 2; ++bj) {
                    const f32x4 x0 = *(const f32x4*)(x + off + bj * 128), x1 = *(const f32x4*)(x + off + bj * 128 + 4);
                    const f32x4 v0 = acc[ai][bj][m][0] + x0, v1 = acc[ai][bj][m][1] + x1;
                    u32x4 w; w.x = cvt_pk_bf16(v0[0], v0[1]); w.y = cvt_pk_bf16(v0[2], v0[3]); w.z = cvt_pk_bf16(v1[0], v1[1]); w.w = cvt_pk_bf16(v1[2], v1[3]);
                    *(u32x4*)(h1b + off + bj * 128) = w;
                    ss += (v0[0] * v0[0] + v0[1] * v0[1]) + (v0[2] * v0[2] + v0[3] * v0[3]) + (v1[0] * v1[0] + v1[1] * v1[1]) + (v1[2] * v1[2] + v1[3] * v1[3]); }
                ss += __shfl_xor(ss, 16); ss += __shfl_xor(ss, 32);
                if (fq == 0) ssq2[ssq_idx(row, u.pn * 4 + wc)] = ss; }
    }
};
struct EpiGU {
    static constexpr bool HAS_TAB = true; static constexpr int MID_T = -1;
    const float* ssq2; bf16_t* hff;
    __device__ __forceinline__ void prep(const pg8::Unit& u, LAS float* tab, int t) const { rstd_table(ssq2, u.pm * 256, tab, t); }
    __device__ __forceinline__ void operator()(const f32x4 (&acc)[2][2][4][2], const pg8::Unit& u, LAS const float* tab, int wr, int wc, int fr, int fq) const {
        const int row0 = u.pm * 256 + wr * 64 + fr, col0 = u.pn * 128 + wc * 32 + 8 * fq;
#pragma unroll
        for (int ai = 0; ai < 2; ++ai)
#pragma unroll
            for (int m = 0; m < 4; ++m) { const float rs = tab[ai * 128 + wr * 64 + m * 16 + fr];
                float o[8];
#pragma unroll
                for (int n = 0; n < 2; ++n)
#pragma unroll
                    for (int j = 0; j < 4; ++j) { const float gg = acc[ai][0][m][n][j] * rs, uu = acc[ai][1][m][n][j] * rs; o[n * 4 + j] = silu_f(gg) * uu; }
                u32x4 w; w.x = cvt_pk_bf16(o[0], o[1]); w.y = cvt_pk_bf16(o[2], o[3]); w.z = cvt_pk_bf16(o[4], o[5]); w.w = cvt_pk_bf16(o[6], o[7]);
                *(u32x4*)(hff + (size_t)(row0 + ai * 128 + m * 16) * DFF + col0) = w; }
    }
};
struct EpiDown {
    static constexpr bool HAS_TAB = false; static constexpr int MID_T = -1;
    bf16_t* h; float* ssq3;
    __device__ __forceinline__ void prep(const pg8::Unit&, LAS float*, int) const {}
    __device__ __forceinline__ void operator()(const f32x4 (&acc)[2][2][4][2], const pg8::Unit& u, LAS const float*, int wr, int wc, int fr, int fq) const {
        const int row0 = u.pm * 256 + wr * 64 + fr, col0 = u.pn * 256 + wc * 32 + 8 * fq;
#pragma unroll
        for (int ai = 0; ai < 2; ++ai)
#pragma unroll
            for (int m = 0; m < 4; ++m) { const int row = row0 + ai * 128 + m * 16; const size_t off = (size_t)row * D_ + col0; float ss = 0.f;
#pragma unroll
                for (int bj = 0; bj < 2; ++bj) {
                    const u32x4 xb = *(const u32x4*)(h + off + bj * 128);
                    const f32x4 x0 = (f32x4){bflo(xb.x), bfhi(xb.x), bflo(xb.y), bfhi(xb.y)}, x1 = (f32x4){bflo(xb.z), bfhi(xb.z), bflo(xb.w), bfhi(xb.w)};
                    const f32x4 v0 = acc[ai][bj][m][0] + x0, v1 = acc[ai][bj][m][1] + x1;
                    u32x4 w; w.x = cvt_pk_bf16(v0[0], v0[1]); w.y = cvt_pk_bf16(v0[2], v0[3]); w.z = cvt_pk_bf16(v1[0], v1[1]); w.w = cvt_pk_bf16(v1[2], v1[3]);
                    *(u32x4*)(h + off + bj * 128) = w;
                    ss += (v0[0] * v0[0] + v0[1] * v0[1]) + (v0[2] * v0[2] + v0[3] * v0[3]) + (v1[0] * v1[0] + v1[1] * v1[1]) + (v1[2] * v1[2] + v1[3] * v1[3]); }
                ss += __shfl_xor(ss, 16); ss += __shfl_xor(ss, 32);
                if (fq == 0) ssq3[ssq_idx(row, u.pn * 4 + wc)] = ss; }
    }
};

__device__ __forceinline__ void p0_tile(LAS float* t, const float* src, int ldsrc, int k0, int c0, int jvalid, bf16_t* dst, int K, int j0, const float* scale, int scale_kmax, int tid) {
    const int jc4 = (tid & 15) * 4, kr0 = tid >> 4;
#pragma unroll
    for (int i = 0; i < 4; ++i) {
        const int kr = kr0 + 32 * i;
        f32x4 v = (f32x4){0.f, 0.f, 0.f, 0.f};
        if (jc4 < jvalid) v = *(const f32x4*)(src + (size_t)(k0 + kr) * ldsrc + c0 + jc4);
        const float s = (scale != nullptr && (k0 + kr) < scale_kmax) ? scale[k0 + kr] : 1.0f;
        t[kr * 65 + jc4 + 0] = v[0] * s; t[kr * 65 + jc4 + 1] = v[1] * s; t[kr * 65 + jc4 + 2] = v[2] * s; t[kr * 65 + jc4 + 3] = v[3] * s;
    }
    __syncthreads();
    const int kp = (tid & 63) * 2, jr0 = tid >> 6;
#pragma unroll
    for (int i = 0; i < 8; ++i) {
        const int j = jr0 + 8 * i;
        if (j < jvalid) { const float a = t[kp * 65 + j], b = t[(kp + 1) * 65 + j];
            *(unsigned*)(dst + (size_t)(j0 + j) * K + k0 + kp) = cvt_pk_bf16(a, b); }
    }
    __syncthreads();
}
struct TileD { const float* src; const float* scale; bf16_t* dst; int ldsrc, k0, c0, jvalid, K, j0, kmax; };
__device__ __forceinline__ TileD tile_decode(const Params& p, int u) {
    constexpr int U_IN = 16 * 193, U_OUT = 32 * 32, U_GU = 16 * 176;
    TileD d;
    if (u < U_IN) { const int kt = u & 15, jt = u >> 4, j0 = jt * 64;
        d.src = p.w_in; d.scale = nullptr; d.dst = (bf16_t*)(p.ws + WS_BTIN); d.ldsrc = DIN; d.k0 = kt * 128; d.c0 = j0 < 6144 ? j0 : (j0 < 12288 ? j0 + 32 : 6144); d.jvalid = (jt == 192) ? 32 : 64; d.K = D_; d.j0 = j0; d.kmax = 0; }
    else if (u < U_IN + U_OUT) { const int v = u - U_IN, kt = v & 31, jt = v >> 5;
        d.src = p.w_out; d.scale = p.ssm_norm_g; d.dst = (bf16_t*)((unsigned char*)p.out + DO_BTOUT); d.ldsrc = D_; d.k0 = kt * 128; d.c0 = jt * 64; d.jvalid = 64; d.K = DMIX; d.j0 = jt * 64; d.kmax = 2048; }
    else if (u < U_IN + U_OUT + U_GU) { const int v = u - U_IN - U_OUT, kt = v & 15, jt = v >> 4, j0 = jt * 64, pn = j0 >> 8, r0 = j0 & 255;
        d.src = r0 < 128 ? p.w_gate : p.w_up; d.scale = p.norm_ffn_g; d.dst = (bf16_t*)((unsigned char*)p.out + DO_BTGU); d.ldsrc = DFF; d.k0 = kt * 128; d.c0 = 128 * pn + (r0 & 127); d.jvalid = 64; d.K = D_; d.j0 = j0; d.kmax = 2048; }
    else { const int v = u - U_IN - U_OUT - U_GU, kt = v % 44, jt = v / 44;
        d.src = p.w_down; d.scale = nullptr; d.dst = (bf16_t*)((unsigned char*)p.out + DO_BTDN); d.ldsrc = D_; d.k0 = kt * 128; d.c0 = jt * 64; d.jvalid = 64; d.K = DFF; d.j0 = jt * 64; d.kmax = 0; }
    return d;
}
__device__ __forceinline__ void tile_load(const TileD& d, int tid, f32x4 (&v)[4], float (&scl)[4]) {
    const int jc4 = (tid & 15) * 4, kr0 = tid >> 4;
#pragma unroll
    for (int i = 0; i < 4; ++i) { const int kr = kr0 + 32 * i;
        f32x4 x = (f32x4){0.f, 0.f, 0.f, 0.f};
        if (jc4 < d.jvalid) x = *(const f32x4*)(d.src + (size_t)(d.k0 + kr) * d.ldsrc + d.c0 + jc4);
        scl[i] = (d.scale != nullptr && (d.k0 + kr) < d.kmax) ? d.scale[d.k0 + kr] : 1.0f;
        v[i] = x; }
}
__device__ __forceinline__ void tile_finish(LAS float* t, const TileD& d, int tid, const f32x4 (&v)[4], const float (&scl)[4]) {
    const int jc4 = (tid & 15) * 4, kr0 = tid >> 4;
#pragma unroll
    for (int i = 0; i < 4; ++i) { const int kr = kr0 + 32 * i;
        t[kr * 65 + jc4 + 0] = v[i][0] * scl[i]; t[kr * 65 + jc4 + 1] = v[i][1] * scl[i]; t[kr * 65 + jc4 + 2] = v[i][2] * scl[i]; t[kr * 65 + jc4 + 3] = v[i][3] * scl[i]; }
    asm volatile("s_waitcnt lgkmcnt(0)" ::: "memory"); __builtin_amdgcn_s_barrier(); asm volatile("" ::: "memory");
    const int kp = (tid & 63) * 2, jr0 = tid >> 6;
#pragma unroll
    for (int i = 0; i < 8; ++i) { const int j = jr0 + 8 * i;
        if (j < d.jvalid) { const float a = t[kp * 65 + j], b = t[(kp + 1) * 65 + j];
            *(unsigned*)(d.dst + (size_t)(d.j0 + j) * d.K + d.k0 + kp) = cvt_pk_bf16(a, b); } }
    asm volatile("s_waitcnt lgkmcnt(0)" ::: "memory"); __builtin_amdgcn_s_barrier(); asm volatile("" ::: "memory");
}
__device__ __forceinline__ void conv_tiles(const Params& p, LAS unsigned char* lds, int u_begin, int u_end, int first, int stride, int tid) {
    LAS float* t = (LAS float*)lds;
    int u = u_begin + first;
    if (u >= u_end) return;
    TileD d = tile_decode(p, u); f32x4 v[4]; float sc[4]; tile_load(d, tid, v, sc);
    for (;;) {
        const int un = u + stride; const bool more = un < u_end;
        TileD dn = d; f32x4 vn[4]; float scn[4];
#pragma unroll
        for (int i = 0; i < 4; ++i) { vn[i] = v[i]; scn[i] = sc[i]; }
        if (more) { dn = tile_decode(p, un); tile_load(dn, tid, vn, scn); }
        tile_finish(t, d, tid, v, sc);
        if (!more) break;
        d = dn; u = un;
#pragma unroll
        for (int i = 0; i < 4; ++i) { v[i] = vn[i]; sc[i] = scn[i]; }
    }
}
__device__ void phase0(const Params& p, LAS unsigned char* lds, int wv) {
    const int lane = lane_id(), wave = wv, tid = wv * 64 + lane, G = gridDim.x;
    LAS float* t = (LAS float*)lds;
    bf16_t* bt_in = (bf16_t*)(p.ws + WS_BTIN);
    bf16_t* xn = (bf16_t*)(p.ws + WS_XN);
    for (int row = blockIdx.x * 8 + wave; row < M_; row += G * 8) {
        const f32x4* xr = (const f32x4*)(p.x + (size_t)row * D_);
        f32x4 v[8]; float ss = 0.f;
#pragma unroll
        for (int i = 0; i < 8; ++i) { v[i] = xr[lane + 64 * i]; ss += (v[i][0] * v[i][0] + v[i][1] * v[i][1]) + (v[i][2] * v[i][2] + v[i][3] * v[i][3]); }
#pragma unroll
        for (int o = 32; o >= 1; o >>= 1) ss += __shfl_xor(ss, o);
        const float rstd = rsqrtf(ss * (1.0f / 2048.0f) + EPS);
#pragma unroll
        for (int i = 0; i < 8; ++i) { const f32x4 g4 = ((const f32x4*)p.norm_mix_g)[lane + 64 * i];
            u32x2 w; w.x = cvt_pk_bf16(v[i][0] * rstd * g4[0], v[i][1] * rstd * g4[1]); w.y = cvt_pk_bf16(v[i][2] * rstd * g4[2], v[i][3] * rstd * g4[3]);
            *(u32x2*)(xn + (size_t)row * D_ + 4 * (lane + 64 * i)) = w; }
    }
    __syncthreads();
    conv_tiles(p, lds, 0, 16 * 193, blockIdx.x, G, tid);
}
__device__ void wconv_units(const Params& p, LAS unsigned char* lds, int first, int stride, int wv) {
    const int tid = wv * 64 + lane_id();
    __syncthreads();
    conv_tiles(p, lds, 16 * 193, 16 * 193 + 32 * 32 + 16 * 176 + 44 * 32, first, stride, tid);
}

__device__ void dt_units(const Params& p, LAS unsigned char* lds, int wv) {
    const int lane = lane_id(), w = wv, tid = wv * 64 + lane, fr = lane & 15, fq = lane >> 4;
    const bf16_t* xn = (const bf16_t*)(p.ws + WS_XN);
    const bf16_t* bt = (const bf16_t*)(p.ws + WS_BTIN) + (size_t)NPROJ * D_;
    float* dt = (float*)((unsigned char*)p.out + DO_DT);
    LAS float* red = (LAS float*)lds;
    for (int rb = blockIdx.x; rb < M_ / 64; rb += gridDim.x) {
        const int row0 = rb * 64;
        f32x4 acc[4][2];
#pragma unroll
        for (int m = 0; m < 4; ++m)
#pragma unroll
            for (int n = 0; n < 2; ++n) acc[m][n] = (f32x4){0.f, 0.f, 0.f, 0.f};
#pragma unroll 4
        for (int ks = 0; ks < 8; ++ks) {
            const int kb = w * 256 + ks * 32 + fq * 8;
            bf16x8 a[4], b[2];
#pragma unroll
            for (int m = 0; m < 4; ++m) a[m] = *(const bf16x8*)(xn + (size_t)(row0 + 16 * m + fr) * D_ + kb);
#pragma unroll
            for (int n = 0; n < 2; ++n) b[n] = *(const bf16x8*)(bt + (size_t)(16 * n + fr) * D_ + kb);
#pragma unroll
            for (int m = 0; m < 4; ++m)
#pragma unroll
                for (int n = 0; n < 2; ++n) acc[m][n] = __builtin_amdgcn_mfma_f32_16x16x32_bf16(a[m], b[n], acc[m][n], 0, 0, 0);
        }
#pragma unroll
        for (int m = 0; m < 4; ++m)
#pragma unroll
            for (int n = 0; n < 2; ++n)
#pragma unroll
                for (int j = 0; j < 4; ++j) red[w * 2048 + (16 * m + 4 * fq + j) * 32 + 16 * n + fr] = acc[m][n][j];
        __syncthreads();
        {
            const int idx = tid * 4, r = idx >> 5, c = idx & 31;
            f32x4 s = (f32x4){0.f, 0.f, 0.f, 0.f};
#pragma unroll
            for (int ww = 0; ww < 8; ++ww) s += *(LAS const f32x4*)(red + ww * 2048 + idx);
            const f32x4 bias = *(const f32x4*)(p.ssm_dt_bias + c);
            f32x4 o;
#pragma unroll
            for (int j = 0; j < 4; ++j) { const float v = s[j] + bias[j]; o[j] = v > 20.f ? v : log1pf(expf(v)); }
            *(f32x4*)(dt + (size_t)(row0 + r) * 32 + c) = o;
        }
        __syncthreads();
    }
}

__device__ void bc_sequences(const Params& p, LAS unsigned char* lds, int first, int stride, int wv) {
    const int tid = wv * 64 + lane_id(), cv = tid & 7, run = tid >> 3;
    bf16_t* proj = (bf16_t*)(p.ws + WS_PROJ);
    LAS u32x4* stash = (LAS u32x4*)lds;
    unsigned* bcflag = (unsigned*)((unsigned char*)p.out + DO_BCFLAG);
    for (int sq = first; sq < 4 * 32; sq += stride) {
        const int b = sq >> 5, slab = sq & 31;
        const int xcol = 2048 + slab * 64 + cv * 8;
        float wk[4][8], bs[8];
#pragma unroll
        for (int k = 0; k < 4; ++k) { const f32x4 a = *(const f32x4*)(p.ssm_conv_w + k * 4096 + xcol), c = *(const f32x4*)(p.ssm_conv_w + k * 4096 + xcol + 4);
#pragma unroll
            for (int j = 0; j < 4; ++j) { wk[k][j] = a[j]; wk[k][4 + j] = c[j]; } }
        { const f32x4 a = *(const f32x4*)(p.ssm_conv_b + xcol), c = *(const f32x4*)(p.ssm_conv_b + xcol + 4);
#pragma unroll
          for (int j = 0; j < 4; ++j) { bs[j] = a[j]; bs[4 + j] = c[j]; } }
        __syncthreads();
#pragma unroll 1
        for (int tile = 0; tile < 8; ++tile) {
            bf16_t* base = proj + (size_t)(b * SEQ + tile * 512 + run * 8) * NPROJ + 2048 + xcol;
            u32x4 raw[11];
#pragma unroll
            for (int r = 0; r < 11; ++r) {
                const int row = run * 8 + r - 3;
                if (row >= 0) raw[r] = *(const u32x4*)(base + (long)(r - 3) * NPROJ);
                else raw[r] = (tile == 0) ? (u32x4){0u, 0u, 0u, 0u} : stash[(row + 3) * 8 + cv];
            }
            u32x4 ov[8];
#pragma unroll
            for (int j = 0; j < 8; ++j) {
                float o[8];
#pragma unroll
                for (int q = 0; q < 4; ++q) {
                    const unsigned x0 = raw[j][q], x1 = raw[j + 1][q], x2 = raw[j + 2][q], x3 = raw[j + 3][q];
                    o[2 * q] = silu_f(bs[2 * q] + wk[0][2 * q] * bflo(x0) + wk[1][2 * q] * bflo(x1) + wk[2][2 * q] * bflo(x2) + wk[3][2 * q] * bflo(x3));
                    o[2 * q + 1] = silu_f(bs[2 * q + 1] + wk[0][2 * q + 1] * bfhi(x0) + wk[1][2 * q + 1] * bfhi(x1) + wk[2][2 * q + 1] * bfhi(x2) + wk[3][2 * q + 1] * bfhi(x3));
                }
                ov[j].x = cvt_pk_bf16(o[0], o[1]); ov[j].y = cvt_pk_bf16(o[2], o[3]); ov[j].z = cvt_pk_bf16(o[4], o[5]); ov[j].w = cvt_pk_bf16(o[6], o[7]);
            }
            asm volatile("s_waitcnt vmcnt(0) lgkmcnt(0)" ::: "memory");
            __syncthreads();
            if (run == 63) { stash[0 * 8 + cv] = raw[8]; stash[1 * 8 + cv] = raw[9]; stash[2 * 8 + cv] = raw[10]; }
#pragma unroll
            for (int j = 0; j < 8; ++j) { const bf16_t* q = base + (long)j * NPROJ;
                asm volatile("global_store_dwordx4 %0, %1, off sc1" :: "v"(q), "v"(ov[j]) : "memory"); }
            asm volatile("s_waitcnt vmcnt(0) lgkmcnt(0)" ::: "memory");
            __syncthreads();
            if (wv == 0) {
                if (lane_id() == 0) __hip_atomic_store(bcflag + sq, (unsigned)(tile + 1), __ATOMIC_RELAXED, __HIP_MEMORY_SCOPE_AGENT);
            }
        }
    }
}

constexpr int SROW = 272;
constexpr int L_CM = 0, L_BM = 34816, L_BDT = 69632, L_XT = 104448, L_HB = 121856  , L_CS = 156672, L_DT = 157184, L_CW = 157696  ;
__device__ __forceinline__ int swz_off(int row, int kblk) { return row * SROW + ((kblk ^ ((row >> 3) & 7)) << 4); }
__device__ __forceinline__ void ssd_load(u32x4 (&raw)[5], const bf16_t* base, bool first, int l0) {
#pragma unroll
    for (int r = 0; r < 5; ++r) raw[r] = (first && (l0 + r - 3) < 0) ? (u32x4){0u, 0u, 0u, 0u} : *(const u32x4*)(base + (long)(r - 3) * NPROJ);
}
template <int GI>
__device__ __forceinline__ void ssd_conv(LAS unsigned char* lds, const u32x4 (&raw)[5], int cv, int l0, float sa, float sb) {
    LAS const f32x4* cw = (LAS const f32x4*)(lds + L_CW) + cv * 10;
    float o0[8], o1[8];
#pragma unroll
    for (int hq = 0; hq < 2; ++hq) {
        const f32x4 w0 = cw[0 + hq], w1 = cw[2 + hq], w2 = cw[4 + hq], w3 = cw[6 + hq], bs = cw[8 + hq];
#pragma unroll
        for (int e2 = 0; e2 < 2; ++e2) {
            const int q = hq * 2 + e2;
            const unsigned x0 = raw[0][q], x1 = raw[1][q], x2 = raw[2][q], x3 = raw[3][q], x4 = raw[4][q];
            const int ea = e2 * 2, eb = e2 * 2 + 1;
            const float va = bs[ea] + w0[ea] * bflo(x0) + w1[ea] * bflo(x1) + w2[ea] * bflo(x2) + w3[ea] * bflo(x3);
            const float vb = bs[eb] + w0[eb] * bfhi(x0) + w1[eb] * bfhi(x1) + w2[eb] * bfhi(x2) + w3[eb] * bfhi(x3);
            const float ua = bs[ea] + w0[ea] * bflo(x1) + w1[ea] * bflo(x2) + w2[ea] * bflo(x3) + w3[ea] * bflo(x4);
            const float ub = bs[eb] + w0[eb] * bfhi(x1) + w1[eb] * bfhi(x2) + w2[eb] * bfhi(x3) + w3[eb] * bfhi(x4);
            o0[2 * q] = silu_f(va); o0[2 * q + 1] = silu_f(vb); o1[2 * q] = silu_f(ua); o1[2 * q + 1] = silu_f(ub);
        }
    }
    if (GI == 0) {
#pragma unroll
        for (int e = 0; e < 8; ++e) { const int prow = cv * 8 + e;
            *(LAS unsigned*)(lds + L_XT + swz_off(prow, l0 >> 3) + (l0 & 7) * 2) = cvt_pk_bf16(o0[e] * sa, o1[e] * sb); }
    } else {
        u32x4 w0; w0.x = cvt_pk_bf16(o0[0], o0[1]); w0.y = cvt_pk_bf16(o0[2], o0[3]); w0.z = cvt_pk_bf16(o0[4], o0[5]); w0.w = cvt_pk_bf16(o0[6], o0[7]);
        u32x4 w1; w1.x = cvt_pk_bf16(o1[0], o1[1]); w1.y = cvt_pk_bf16(o1[2], o1[3]); w1.z = cvt_pk_bf16(o1[4], o1[5]); w1.w = cvt_pk_bf16(o1[6], o1[7]);
        const int nb = ((GI - 1) & 1) * 64 + cv * 8;
        if (GI < 3) {
            *(LAS u32x4*)(lds + L_BM + l0 * SROW + nb * 2) = w0; *(LAS u32x4*)(lds + L_BM + (l0 + 1) * SROW + nb * 2) = w1;
#pragma unroll
            for (int e = 0; e < 8; ++e) { const int nrow = nb + e;
                *(LAS unsigned*)(lds + L_BDT + swz_off(nrow, l0 >> 3) + (l0 & 7) * 2) = cvt_pk_bf16(o0[e] * sa, o1[e] * sb); }
        } else {
            *(LAS u32x4*)(lds + L_CM + l0 * SROW + nb * 2) = w0; *(LAS u32x4*)(lds + L_CM + (l0 + 1) * SROW + nb * 2) = w1;
        }
    }
}
template <int GI>
__device__ __forceinline__ void ssd_put(LAS unsigned char* lds, const u32x4 (&rw)[2], int cv, int l0, float sa, float sb) {
    const int nb = ((GI - 1) & 1) * 64 + cv * 8;
    if (GI < 3) {
        *(LAS u32x4*)(lds + L_BM + l0 * SROW + nb * 2) = rw[0]; *(LAS u32x4*)(lds + L_BM + (l0 + 1) * SROW + nb * 2) = rw[1];
#pragma unroll
        for (int q = 0; q < 4; ++q) {
            *(LAS unsigned*)(lds + L_BDT + swz_off(nb + 2 * q, l0 >> 3) + (l0 & 7) * 2) = cvt_pk_bf16(bflo(rw[0][q]) * sa, bflo(rw[1][q]) * sb);
            *(LAS unsigned*)(lds + L_BDT + swz_off(nb + 2 * q + 1, l0 >> 3) + (l0 & 7) * 2) = cvt_pk_bf16(bfhi(rw[0][q]) * sa, bfhi(rw[1][q]) * sb);
        }
    } else {
        *(LAS u32x4*)(lds + L_CM + l0 * SROW + nb * 2) = rw[0]; *(LAS u32x4*)(lds + L_CM + (l0 + 1) * SROW + nb * 2) = rw[1];
    }
}
__device__ __forceinline__ void bc_wait(unsigned* f, unsigned need, int wv) {
    if (wv == 0) {
    unsigned sp = 0;
    for (;;) {
        const unsigned a = __hip_atomic_load(f, __ATOMIC_RELAXED, __HIP_MEMORY_SCOPE_AGENT), b2 = __hip_atomic_load(f + 1, __ATOMIC_RELAXED, __HIP_MEMORY_SCOPE_AGENT);
        const unsigned c = __hip_atomic_load(f + 16, __ATOMIC_RELAXED, __HIP_MEMORY_SCOPE_AGENT), d = __hip_atomic_load(f + 17, __ATOMIC_RELAXED, __HIP_MEMORY_SCOPE_AGENT);
        const unsigned m = min(min(a, b2), min(c, d));
        if (__builtin_amdgcn_readfirstlane(m) >= need) break;
        __builtin_amdgcn_s_sleep(4);
        if (++sp > (1u << 19)) break;
    }
    __builtin_amdgcn_fence(__ATOMIC_ACQUIRE, "agent"); asm volatile("s_waitcnt vmcnt(0)" ::: "memory");
    }
    asm volatile("s_waitcnt lgkmcnt(0)" ::: "memory"); __builtin_amdgcn_s_barrier(); asm volatile("" ::: "memory");
}
__device__ void ssd_unit(const Params& p, LAS unsigned char* lds, int b, int h, int wv) {
    const int lane = lane_id(), w = wv, tid = wv * 64 + lane, fr = lane & 15, fq = lane >> 4;
    const int g = h >> 2;
    const bf16_t* proj = (const bf16_t*)(p.ws + WS_PROJ);
    const float* dtg = (const float*)((const unsigned char*)p.out + DO_DT);
    bf16_t* ymix = (bf16_t*)(p.ws + WS_YMIX);
    float* ssq1 = (float*)((unsigned char*)p.out + DO_SSQ1);
    LAS float* CSv = (LAS float*)(lds + L_CS);
    LAS float* DTv = (LAS float*)(lds + L_DT);
    LAS float* CW = (LAS float*)(lds + L_CW);
    const float Aneg = -__expf(p.ssm_A_log[h]);
    const float Dh = p.ssm_D[h];
    for (int idx = tid; idx < 320; idx += 512) {
        const int e = idx & 7, k = (idx >> 3) % 5, cvi = idx / 40;
        const int xcol = h * 64 + cvi * 8 + e;
        CW[idx] = (k < 4) ? p.ssm_conv_w[k * 4096 + xcol] : p.ssm_conv_b[xcol];
    }
    for (int idx = tid; idx < 64 * 17; idx += 512) *(LAS u32x4*)(lds + L_HB + idx * 16) = (u32x4){0u, 0u, 0u, 0u};
    f32x4 Hacc[4];
#pragma unroll
    for (int pt = 0; pt < 4; ++pt) Hacc[pt] = (f32x4){0.f, 0.f, 0.f, 0.f};
    __syncthreads();
    const int cv = lane & 7;
    const int l0 = 16 * w + 2 * (lane >> 3);
    const int srcl = (w & 3) * 16 + 2 * (lane >> 3);
    u32x4 r0[5], r1[2], r2[2], r3[2], r4[2];
    const bf16_t* pbase = proj + (size_t)(b * SEQ + l0) * NPROJ + 2048 + cv * 8;
    const int xc0 = h * 64, xc1 = 2048 + g * 128, xc2 = xc1 + 64, xc3 = 3072 + g * 128, xc4 = xc3 + 64;
    unsigned* bcf = (unsigned*)((unsigned char*)p.out + DO_BCFLAG) + b * 32 + 2 * g;
    bc_wait(bcf, 1u, wv);
    ssd_load(r0, pbase + xc0, true, l0);
    r1[0] = *(const u32x4*)(pbase + xc1); r1[1] = *(const u32x4*)(pbase + xc1 + NPROJ); r2[0] = *(const u32x4*)(pbase + xc2); r2[1] = *(const u32x4*)(pbase + xc2 + NPROJ);
    r3[0] = *(const u32x4*)(pbase + xc3); r3[1] = *(const u32x4*)(pbase + xc3 + NPROJ); r4[0] = *(const u32x4*)(pbase + xc4); r4[1] = *(const u32x4*)(pbase + xc4 + NPROJ);
    float dt0n = dtg[(size_t)(b * SEQ + lane) * 32 + h], dt1n = dtg[(size_t)(b * SEQ + 64 + lane) * 32 + h];
    for (int c = 0; c < 32; ++c) {
        const int row0 = b * SEQ + c * 128;
        const float dt0 = dt0n, dt1 = dt1n;
        float a0 = dt0 * Aneg, a1 = dt1 * Aneg;
#pragma unroll
        for (int o = 1; o < 64; o <<= 1) { const float t0 = __shfl_up(a0, o), t1 = __shfl_up(a1, o); if (lane >= o) { a0 += t0; a1 += t1; } }
        a1 += __shfl(a0, 63);
        const float cs_end = __shfl(a1, 63);
        if (w == 0) { CSv[lane] = a0; CSv[64 + lane] = a1; DTv[lane] = dt0; DTv[64 + lane] = dt1; }
        const float csv = (w >= 4) ? a1 : a0, dtv = (w >= 4) ? dt1 : dt0;
        const float cs_l0 = __shfl(csv, srcl), cs_l1 = __shfl(csv, srcl + 1), dt_l0 = __shfl(dtv, srcl), dt_l1 = __shfl(dtv, srcl + 1);
        const float dec0 = __expf(cs_end - cs_l0), dec1 = __expf(cs_end - cs_l1);
        ssd_conv<0>(lds, r0, cv, l0, dt_l0, dt_l1);
        ssd_put<1>(lds, r1, cv, l0, dec0, dec1); ssd_put<2>(lds, r2, cv, l0, dec0, dec1);
        ssd_put<3>(lds, r3, cv, l0, 0.f, 0.f);   ssd_put<4>(lds, r4, cv, l0, 0.f, 0.f);
        __builtin_amdgcn_sched_barrier(0);
        if (c + 1 < 32) {
            if (((c + 1) & 3) == 0) bc_wait(bcf, (unsigned)(((c + 1) >> 2) + 1), wv);
            const bf16_t* cb = pbase + (size_t)(c + 1) * 128 * NPROJ;
            ssd_load(r0, cb + xc0, false, l0);
            r1[0] = *(const u32x4*)(cb + xc1); r1[1] = *(const u32x4*)(cb + xc1 + NPROJ); r2[0] = *(const u32x4*)(cb + xc2); r2[1] = *(const u32x4*)(cb + xc2 + NPROJ);
            r3[0] = *(const u32x4*)(cb + xc3); r3[1] = *(const u32x4*)(cb + xc3 + NPROJ); r4[0] = *(const u32x4*)(cb + xc4); r4[1] = *(const u32x4*)(cb + xc4 + NPROJ);
            dt0n = dtg[(size_t)(row0 + 128 + lane) * 32 + h]; dt1n = dtg[(size_t)(row0 + 192 + lane) * 32 + h];
        }
        __builtin_amdgcn_sched_barrier(0);
        u32x2 zr[4];
#pragma unroll
        for (int pt = 0; pt < 4; ++pt) zr[pt] = *(const u32x2*)(proj + (size_t)(row0 + 16 * w + fr) * NPROJ + h * 64 + 16 * pt + 4 * fq);
        asm volatile("s_waitcnt lgkmcnt(0)" ::: "memory"); __builtin_amdgcn_s_barrier(); asm volatile("" ::: "memory");
        const int lrow = 16 * w + fr;
        const int hb_cur = L_HB + (c & 1) * 17408, hb_nxt = L_HB + ((c + 1) & 1) * 17408;
        bf16x8 cf[4];
#pragma unroll
        for (int ks = 0; ks < 4; ++ks) cf[ks] = *(LAS const bf16x8*)(lds + L_CM + lrow * SROW + (32 * ks + 8 * fq) * 2);
        const float cs_l = CSv[lrow], dt_l = DTv[lrow];
        asm volatile("" ::: "memory");
        const int dd = fr - 4 * fq; const float ddiag = Dh / dt_l;
        f32x4 y[4];
        { const float el = __expf(cs_l);
#pragma unroll
          for (int pt = 0; pt < 4; ++pt) { f32x4 a = (f32x4){0.f, 0.f, 0.f, 0.f};
#pragma unroll
            for (int ks = 0; ks < 4; ++ks) { const bf16x8 hf = *(LAS const bf16x8*)(lds + hb_cur + (16 * pt + fr) * SROW + (32 * ks + 8 * fq) * 2);
                a = __builtin_amdgcn_mfma_f32_16x16x32_bf16(hf, cf[ks], a, 0, 0, 0); }
            y[pt] = a * el; } }
#pragma unroll
        for (int j = 0; j < 8; ++j) {
            if (j <= w) {
                f32x4 gacc = (f32x4){0.f, 0.f, 0.f, 0.f};
#pragma unroll
                for (int ks = 0; ks < 4; ++ks) { const bf16x8 bf = *(LAS const bf16x8*)(lds + L_BM + (16 * j + fr) * SROW + (32 * ks + 8 * fq) * 2);
                    gacc = __builtin_amdgcn_mfma_f32_16x16x32_bf16(bf, cf[ks], gacc, 0, 0, 0); }
                const f32x4 css = *(LAS const f32x4*)(CSv + 16 * j + 4 * fq);
                float mv[4];
#pragma unroll
                for (int i = 0; i < 4; ++i) { float v = gacc[i] * __expf(cs_l - css[i]);
                    if (j == w) { v = (i <= dd) ? v : 0.f; if (i == dd) v += ddiag; }
                    mv[i] = v; }
                u32x2 wv2; wv2.x = cvt_pk_bf16(mv[0], mv[1]); wv2.y = cvt_pk_bf16(mv[2], mv[3]);
                *(LAS u32x2*)(lds + L_CM + lrow * SROW + (16 * j + 4 * fq) * 2) = wv2;
            } else if (j == w + 1 && (w & 1) == 0) {
                *(LAS u32x2*)(lds + L_CM + lrow * SROW + (16 * j + 4 * fq) * 2) = (u32x2){0u, 0u};
            }
        }
        asm volatile("" ::: "memory");
        { const float de = __expf(cs_end);
#pragma unroll
          for (int pt = 0; pt < 4; ++pt) Hacc[pt] *= de; }
        const int nks2 = (w >> 1) + 1;
#pragma unroll
        for (int ks = 0; ks < 4; ++ks) {
            bf16x8 xf[4];
#pragma unroll
            for (int pt = 0; pt < 4; ++pt) xf[pt] = *(LAS const bf16x8*)(lds + L_XT + swz_off(16 * pt + fr, 4 * ks + fq));
            if (ks < nks2) { const bf16x8 mf = *(LAS const bf16x8*)(lds + L_CM + lrow * SROW + (32 * ks + 8 * fq) * 2);
#pragma unroll
                for (int pt = 0; pt < 4; ++pt) y[pt] = __builtin_amdgcn_mfma_f32_16x16x32_bf16(xf[pt], mf, y[pt], 0, 0, 0); }
            const bf16x8 bdf = *(LAS const bf16x8*)(lds + L_BDT + swz_off(16 * w + fr, 4 * ks + fq));
#pragma unroll
            for (int pt = 0; pt < 4; ++pt) Hacc[pt] = __builtin_amdgcn_mfma_f32_16x16x32_bf16(bdf, xf[pt], Hacc[pt], 0, 0, 0);
        }
#pragma unroll
        for (int pt = 0; pt < 4; ++pt) { u32x2 wv2; wv2.x = cvt_pk_bf16(Hacc[pt][0], Hacc[pt][1]); wv2.y = cvt_pk_bf16(Hacc[pt][2], Hacc[pt][3]);
            *(LAS u32x2*)(lds + hb_nxt + (16 * pt + fr) * SROW + (16 * w + 4 * fq) * 2) = wv2; }
        { float ss = 0.f; const size_t orow = (size_t)(row0 + lrow);
#pragma unroll
          for (int pt = 0; pt < 4; ++pt) {
            const float z0 = bflo(zr[pt].x), z1 = bfhi(zr[pt].x), z2 = bflo(zr[pt].y), z3 = bfhi(zr[pt].y);
            const float v0 = y[pt][0] * silu_f(z0), v1 = y[pt][1] * silu_f(z1), v2 = y[pt][2] * silu_f(z2), v3 = y[pt][3] * silu_f(z3);
            ss += (v0 * v0 + v1 * v1) + (v2 * v2 + v3 * v3);
            u32x2 wv; wv.x = cvt_pk_bf16(v0, v1); wv.y = cvt_pk_bf16(v2, v3);
            *(u32x2*)(ymix + orow * DMIX + h * 64 + 16 * pt + 4 * fq) = wv; }
          ss += __shfl_xor(ss, 16); ss += __shfl_xor(ss, 32);
          if (fq == 0) ssq1[ssq_idx((int)orow, h)] = ss; }
        asm volatile("s_waitcnt lgkmcnt(0)" ::: "memory"); __builtin_amdgcn_s_barrier(); asm volatile("" ::: "memory");
    }
}
__device__ void sc_unit(const Params& p, int unit, int wv) {
    const int tid = wv * 64 + lane_id(), cvx = tid & 255, th = tid >> 8;
    const bf16_t* proj = (const bf16_t*)(p.ws + WS_PROJ);
    bf16_t* ymix = (bf16_t*)(p.ws + WS_YMIX);
    const int t0 = unit * 64 + th * 32, c0 = cvx * 8;
    float w0[8], w1[8], w2[8];
    { const f32x4* a = (const f32x4*)(p.sc_conv_w + c0); const f32x4* bq = (const f32x4*)(p.sc_conv_w + 2048 + c0); const f32x4* cq = (const f32x4*)(p.sc_conv_w + 4096 + c0);
#pragma unroll
      for (int q = 0; q < 2; ++q) { const f32x4 x0 = a[q], x1 = bq[q], x2 = cq[q];
#pragma unroll
        for (int j = 0; j < 4; ++j) { w0[q * 4 + j] = x0[j]; w1[q * 4 + j] = x1[j]; w2[q * 4 + j] = x2[j]; } } }
    float pm1[8], pm2[8];
#pragma unroll
    for (int e = 0; e < 8; ++e) { pm1[e] = 0.f; pm2[e] = 0.f; }
    if ((t0 & (SEQ - 1)) != 0) {
        const bf16_t* r2 = proj + (size_t)(t0 - 2) * NPROJ, * r1 = proj + (size_t)(t0 - 1) * NPROJ;
        const u32x4 c2 = *(const u32x4*)(r2 + 8192 + c0), x2 = *(const u32x4*)(r2 + 10240 + c0), c1 = *(const u32x4*)(r1 + 8192 + c0), x1 = *(const u32x4*)(r1 + 10240 + c0);
#pragma unroll
        for (int q = 0; q < 4; ++q) { pm2[2 * q] = bflo(c2[q]) * bflo(x2[q]); pm2[2 * q + 1] = bfhi(c2[q]) * bfhi(x2[q]); pm1[2 * q] = bflo(c1[q]) * bflo(x1[q]); pm1[2 * q + 1] = bfhi(c1[q]) * bfhi(x1[q]); }
    }
#pragma unroll 4
    for (int i = 0; i < 32; ++i) {
        const bf16_t* r = proj + (size_t)(t0 + i) * NPROJ;
        const u32x4 gb = *(const u32x4*)(r + 6144 + c0), gc = *(const u32x4*)(r + 8192 + c0), gx = *(const u32x4*)(r + 10240 + c0);
        float o[8];
#pragma unroll
        for (int q = 0; q < 4; ++q) {
            const float pa = bflo(gc[q]) * bflo(gx[q]), pb = bfhi(gc[q]) * bfhi(gx[q]);
            o[2 * q] = bflo(gb[q]) * (w0[2 * q] * pm2[2 * q] + w1[2 * q] * pm1[2 * q] + w2[2 * q] * pa);
            o[2 * q + 1] = bfhi(gb[q]) * (w0[2 * q + 1] * pm2[2 * q + 1] + w1[2 * q + 1] * pm1[2 * q + 1] + w2[2 * q + 1] * pb);
            pm2[2 * q] = pm1[2 * q]; pm2[2 * q + 1] = pm1[2 * q + 1]; pm1[2 * q] = pa; pm1[2 * q + 1] = pb;
        }
        u32x4 wv; wv.x = cvt_pk_bf16(o[0], o[1]); wv.y = cvt_pk_bf16(o[2], o[3]); wv.z = cvt_pk_bf16(o[4], o[5]); wv.w = cvt_pk_bf16(o[6], o[7]);
        *(u32x4*)(ymix + (size_t)(t0 + i) * DMIX + 2048 + c0) = wv;
    }
}
__device__ void phase2(const Params& p, LAS unsigned char* lds, int wv) {
    const int G = gridDim.x, bid = blockIdx.x;
    const bool split = G >= 256;
    if (!split) bc_sequences(p, lds, bid, G, wv);
    if (!split || bid < 128) { for (int u = bid; u < 128; u += (split ? 128 : G)) ssd_unit(p, lds, u >> 5, u & 31, wv); }
    if (split && bid >= 128) bc_sequences(p, lds, bid - 128, G - 128, wv);
    if (!split || bid >= 128) { for (int u = (split ? bid - 128 : bid); u < M_ / 64; u += (split ? G - 128 : G)) sc_unit(p, u, wv); }
    if (!split || bid >= 128) wconv_units(p, lds, split ? bid - 128 : bid, split ? G - 128 : G, wv);
}

__device__ void phase6(const Params& p, int wv) {
    const int lane = lane_id(), wave = wv;
    const bf16_t* h2 = (const bf16_t*)(p.ws + WS_H1B);
    const float* ssq3 = (const float*)(p.ws + WS_SSQ3);
    for (int row = blockIdx.x * 8 + wave; row < M_; row += gridDim.x * 8) {
        float s = (lane < 32) ? ssq3[ssq_idx(row, lane)] : 0.f;
#pragma unroll
        for (int o = 32; o >= 1; o >>= 1) s += __shfl_xor(s, o);
        const float rstd = rsqrtf(s * (1.0f / 2048.0f) + EPS);
        const u32x2* hr = (const u32x2*)(h2 + (size_t)row * D_);
        f32x4* orow = (f32x4*)(p.out + (size_t)row * D_);
#pragma unroll
        for (int i = 0; i < 8; ++i) { const u32x2 hv = hr[lane + 64 * i]; const f32x4 v = (f32x4){bflo(hv.x), bfhi(hv.x), bflo(hv.y), bfhi(hv.y)}, g4 = ((const f32x4*)p.norm_final_g)[lane + 64 * i]; orow[lane + 64 * i] = v * rstd * g4; }
    }
}


#define XB_TMO      128
#define XB_XCNT(j)  (256  + 64 * (j))
#define XB_XSUB(j)  (1280 + 64 * (j))
#define XB_XGEN(j)  (2304 + 64 * (j))
#define XB_TOP      3328
#define XB_TOPGEN   3392
#define XCD_BAR_WORDS 3456
#define XB_SPIN_CAP (1u << 18)
__device__ __forceinline__ unsigned xb_ld(unsigned* p)              { return __hip_atomic_load(p, __ATOMIC_RELAXED, __HIP_MEMORY_SCOPE_AGENT); }
__device__ __forceinline__ unsigned xb_add(unsigned* p, unsigned v) { return __hip_atomic_fetch_add(p, v, __ATOMIC_RELAXED, __HIP_MEMORY_SCOPE_AGENT); }
__device__ __forceinline__ unsigned xb_xcc_id() { return (unsigned)__builtin_amdgcn_s_getreg((3 << 11) | 20) & 0xFu; }
#define XB_SPIN(cond, bar) do { unsigned _sp = 0; while (cond) { __builtin_amdgcn_s_sleep(1); \
    if ((++_sp & 255u) == 0u) { if (xb_ld(&(bar)[XB_TMO])) break; if (_sp > XB_SPIN_CAP) { atomicAdd(&(bar)[XB_TMO], 1u); break; } } } } while (0)
struct XcdBarrier { unsigned* bar; unsigned x; volatile LAS unsigned* st; };
__device__ __forceinline__ void xcd_barrier_complete(unsigned* bar, unsigned x, unsigned& nloc, unsigned& nx) {
    const unsigned G = gridDim.x * gridDim.y * gridDim.z;
    unsigned sum, cnt, mine, sp = 0u;
    for (;;) {
        sum = 0u; cnt = 0u; mine = 0u;
#pragma unroll
        for (unsigned j = 0; j < 16; ++j) { const unsigned c = xb_ld(&bar[XB_XCNT(j)]); sum += c; cnt += (c > 0u) ? 1u : 0u; mine = (j == x) ? c : mine; }
        if (sum == G) break;
        __builtin_amdgcn_s_sleep(1);
        if ((++sp & 255u) == 0u) { if (xb_ld(&bar[XB_TMO])) break; if (sp > XB_SPIN_CAP) { atomicAdd(&bar[XB_TMO], 1u); break; } }
    }
    nloc = mine > 0u ? mine : 1u; nx = cnt > 0u ? cnt : 1u;
}
__device__ __forceinline__ void xcd_barrier(const XcdBarrier& b, bool leader) {
    asm volatile("s_waitcnt vmcnt(0)" ::: "memory");
    __syncthreads();
    if (leader) {
        unsigned* bar = b.bar;
        __builtin_amdgcn_s_waitcnt(0);
        unsigned nloc = b.st[0], nx = b.st[1];
        if (nloc == 0u) { xcd_barrier_complete(bar, b.x, nloc, nx); b.st[0] = nloc; b.st[1] = nx; }
        const unsigned old = xb_add(&bar[XB_XSUB(b.x)], 1u);
        const unsigned gen = old / nloc;
        if (old + 1u == (gen + 1u) * nloc) {
            __builtin_amdgcn_fence(__ATOMIC_RELEASE, "agent");
            asm volatile("s_waitcnt vmcnt(0)" ::: "memory");
            const unsigned og = xb_add(&bar[XB_TOP], 1u);
            const unsigned tg = og / nx;
            if (og + 1u == (tg + 1u) * nx) xb_add(&bar[XB_TOPGEN], 1u);
            else XB_SPIN(xb_ld(&bar[XB_TOPGEN]) == tg, bar);
            __builtin_amdgcn_fence(__ATOMIC_ACQUIRE, "agent");
            xb_add(&bar[XB_XGEN(b.x)], 1u);
            asm volatile("s_waitcnt vmcnt(0)" ::: "memory");
        } else {
            XB_SPIN(xb_ld(&bar[XB_XGEN(b.x)]) == gen, bar);
            __builtin_amdgcn_fence(__ATOMIC_ACQUIRE, "agent");
            asm volatile("s_waitcnt vmcnt(0)" ::: "memory");
        }
    }
    __syncthreads();
}

__global__ void __launch_bounds__(512) hymba_fwd(Params p) {
    extern __shared__ __attribute__((aligned(16))) unsigned char shm[];
    LAS unsigned char* lds = (LAS unsigned char*)shm;
    cg::grid_group grid = cg::this_grid();
    const int lo = p.ph_lo, hi = p.ph_hi;
    const int wv = __builtin_amdgcn_readfirstlane(threadIdx.x >> 6);
#ifdef DBG_CLEAR
    for (int i = threadIdx.x; i < LDS_BYTES / 16; i += 512) *(LAS u32x4*)(lds + i * 16) = (u32x4){0u, 0u, 0u, 0u};
    __syncthreads();
#endif
#define IN(k) (lo <= (k) && (k) < hi)
#define SEAM(k) do { if (IN(k) && IN((k) + 1)) { \
        asm volatile("s_waitcnt vmcnt(0) lgkmcnt(0)" ::: "memory"); __syncthreads();                 \
        if (wv == 0) { __builtin_amdgcn_fence(__ATOMIC_RELEASE, "agent"); asm volatile("s_waitcnt vmcnt(0)" ::: "memory"); }     \
        grid.sync(); \
        if (wv == 0) { __builtin_amdgcn_fence(__ATOMIC_ACQUIRE, "agent"); asm volatile("s_waitcnt vmcnt(0)" ::: "memory"); }     \
        __syncthreads(); } } while (0)
    volatile LAS unsigned* xst = (volatile LAS unsigned*)(lds + LDS_BYTES - 16);
    const bool xlead = (wv == 0) && (lane_id() == 0);
    if (xlead) { xst[0] = 0u; xst[1] = 0u; }
    __syncthreads();
    XcdBarrier xb; xb.bar = (unsigned*)((unsigned char*)p.out + DO_XBAR); xb.x = xb_xcc_id(); xb.st = xst;
    if (xlead) (void)xb_add(&xb.bar[XB_XCNT(xb.x)], 1u);
#define XSEAM(k) do { if (IN(k) && IN((k) + 1)) xcd_barrier(xb, (wv == 0) && (lane_id() == 0)); } while (0)
    if (IN(0)) for (int rep = 0; rep < NREP(0); ++rep) phase0(p, lds, wv);
    XSEAM(0);
    if (IN(1)) for (int rep = 0; rep < NREP(1); ++rep) {
        pg8::Gemm g{(const bf16_t*)(p.ws + WS_XN), (const bf16_t*)(p.ws + WS_BTIN), M_, NPROJ, D_}; pg8::StaticOrder S; S.init(M_, NPROJ, gridDim.x, blockIdx.x);
        EpiProj E{(bf16_t*)(p.ws + WS_PROJ)};
        pg8::gemm_phase<EpiProj>(lds, g, S, E, wv);
        dt_units(p, lds, wv);
    }
    XSEAM(1);
    if (IN(3)) for (int rep = 0; rep < NREP(3); ++rep) phase2(p, lds, wv);
    XSEAM(3);
    if (IN(4)) for (int rep = 0; rep < NREP(4); ++rep) {
        pg8::Gemm g{(const bf16_t*)(p.ws + WS_YMIX), (const bf16_t*)((unsigned char*)p.out + DO_BTOUT), M_, D_, DMIX}; pg8::StaticOrder S; S.init(M_, D_, gridDim.x, blockIdx.x);
        EpiOut E{p.x, (bf16_t*)(p.ws + WS_H1B), (const float*)((unsigned char*)p.out + DO_SSQ1), (float*)((unsigned char*)p.out + DO_SSQ2)};
        pg8::gemm_phase<EpiOut>(lds, g, S, E, wv);
    }
    XSEAM(4);
    if (IN(5)) for (int rep = 0; rep < NREP(5); ++rep) {
        pg8::Gemm g{(const bf16_t*)(p.ws + WS_H1B), (const bf16_t*)((unsigned char*)p.out + DO_BTGU), M_, NGU, D_}; pg8::StaticOrder S; S.init(M_, NGU, gridDim.x, blockIdx.x);
        EpiGU E{(const float*)((unsigned char*)p.out + DO_SSQ2), (bf16_t*)(p.ws + WS_HFF)};
        pg8::gemm_phase<EpiGU>(lds, g, S, E, wv);
    }
    XSEAM(5);
    if (IN(6)) {
        pg8::Gemm g{(const bf16_t*)(p.ws + WS_HFF), (const bf16_t*)((unsigned char*)p.out + DO_BTDN), M_, D_, DFF}; pg8::StaticOrder S; S.init(M_, D_, gridDim.x, blockIdx.x);
        EpiDown E{(bf16_t*)(p.ws + WS_H1B), (float*)(p.ws + WS_SSQ3)};
        pg8::gemm_phase<EpiDown>(lds, g, S, E, wv);
    }
    XSEAM(6);
    if (p.ph_hi > 1000) grid.sync();
    if (IN(7)) for (int rep = 0; rep < NREP(7); ++rep) phase6(p, wv);
#undef IN
#undef SEAM
}

extern "C" void kernel_launch(void* const* d_in, const int* in_sizes, int n_in, void* d_out, int out_size, void* d_ws, size_t ws_size, hipStream_t stream) {
    static int grid = 0;
    if (grid == 0) {
        if (n_in != 16 || out_size != M_ * D_ || ws_size < WS_NEED) { fprintf(stderr, "kernel_launch: unexpected shapes (n_in %d out %d ws %zu, need %zu)\n", n_in, out_size, ws_size, (size_t)WS_NEED); grid = -1; return; }
        int dev = 0, cus = 0, per_cu = 0;
        (void)hipGetDevice(&dev);
        (void)hipDeviceGetAttribute(&cus, hipDeviceAttributeMultiprocessorCount, dev);
        if (hipFuncSetAttribute((const void*)hymba_fwd, hipFuncAttributeMaxDynamicSharedMemorySize, LDS_BYTES) != hipSuccess) { fprintf(stderr, "kernel_launch: hipFuncSetAttribute failed\n"); grid = -1; return; }
        if (hipOccupancyMaxActiveBlocksPerMultiprocessor(&per_cu, (const void*)hymba_fwd, 512, LDS_BYTES) != hipSuccess || per_cu < 1) { fprintf(stderr, "kernel_launch: occupancy query failed (%d)\n", per_cu); (void)hipGetLastError(); per_cu = 1; }
        grid = cus * per_cu;
    }
    if (grid < 0) return;
    Params p{};
    p.x = (const float*)d_in[0]; p.norm_mix_g = (const float*)d_in[1]; p.w_in = (const float*)d_in[2]; p.ssm_conv_w = (const float*)d_in[3]; p.ssm_conv_b = (const float*)d_in[4];
    p.ssm_dt_bias = (const float*)d_in[5]; p.ssm_A_log = (const float*)d_in[6]; p.ssm_D = (const float*)d_in[7]; p.ssm_norm_g = (const float*)d_in[8]; p.sc_conv_w = (const float*)d_in[9];
    p.w_out = (const float*)d_in[10]; p.norm_ffn_g = (const float*)d_in[11]; p.w_gate = (const float*)d_in[12]; p.w_up = (const float*)d_in[13]; p.w_down = (const float*)d_in[14]; p.norm_final_g = (const float*)d_in[15];
    p.out = (float*)d_out; p.ws = (unsigned char*)d_ws;
#ifdef DBG_MEMSET
    (void)hipMemsetAsync(d_ws, 0, WS_NEED, stream); (void)hipMemsetAsync(d_out, 0, (size_t)out_size * 4, stream);
#endif
#ifndef N_CUTS
#define N_CUTS 1
#endif
    for (int li = 0; li < N_CUTS; ++li) {
        p.ph_lo = (N_CUTS == 8) ? li : 0; p.ph_hi = (N_CUTS == 8) ? li + 1 : 8;
        (void)hipMemsetAsync((unsigned char*)d_out + DO_BCFLAG, 0, 4096 + XCD_BAR_WORDS * sizeof(unsigned), stream);
    void* args[] = {&p};
        hipError_t e = hipLaunchCooperativeKernel((const void*)hymba_fwd, dim3(grid), dim3(512), args, LDS_BYTES, stream);
        if (e != hipSuccess) fprintf(stderr, "kernel_launch: cooperative launch failed: %s (grid %d)\n", hipGetErrorString(e), grid);
    }
}
```

```cpp
#include <hip/hip_runtime.h>
#include <hip/hip_cooperative_groups.h>
#include <cstdio>
namespace cg = cooperative_groups;

#define LAS __attribute__((address_space(3)))
typedef unsigned short bf16_t;
typedef short bf16x8 __attribute__((ext_vector_type(8)));
typedef float f32x4 __attribute__((ext_vector_type(4)));
typedef unsigned u32x4 __attribute__((ext_vector_type(4)));
typedef unsigned u32x2 __attribute__((ext_vector_type(2)));

constexpr int M_ = 16384, D_ = 2048, DIN = 12320, NPROJ = 12288, DFF = 5632, DMIX = 4096, NGU = 11264;
constexpr int SEQ = 4096;
constexpr float EPS = 1e-5f;
constexpr int LDS_BYTES = 159744;
constexpr int XCD_BAR_WORDS_C = 3456;
#ifndef PROBE_PHASE
#define PROBE_PHASE -1
#endif
#define NREP(k) ((PROBE_PHASE == (k)) ? 1 + (p.ph_hi < 100) : 1)
constexpr int TAB_OFF = 131072;

constexpr size_t WS_PROJ = 0;
constexpr size_t WS_R = (size_t)M_ * NPROJ * 2;
constexpr size_t WS_XN = WS_R;
constexpr size_t WS_BTIN = WS_R + (size_t)M_ * D_ * 2;
constexpr size_t WS_YMIX = WS_R;
constexpr size_t WS_H1F = 0;
constexpr size_t WS_H1B = (size_t)M_ * D_ * 4;
constexpr size_t WS_HFF = WS_H1B + (size_t)M_ * D_ * 2;
constexpr size_t WS_SSQ3 = WS_HFF + (size_t)M_ * DFF * 2;
constexpr size_t WS_NEED = WS_R + (size_t)M_ * DMIX * 2;
constexpr size_t DO_BTOUT = 0;
constexpr size_t DO_BTGU = (size_t)D_ * DMIX * 2;
constexpr size_t DO_BTDN = DO_BTGU + (size_t)NGU * D_ * 2;
constexpr size_t DO_DT = DO_BTDN + (size_t)D_ * DFF * 2;
constexpr size_t DO_SSQ1 = DO_DT + (size_t)M_ * 32 * 4;
constexpr size_t DO_SSQ2 = DO_SSQ1 + (size_t)M_ * 32 * 4;
constexpr size_t DO_XBAR = (size_t)M_ * D_ * 4 - 16384;
constexpr size_t DO_BCFLAG = DO_XBAR - 4096;
static_assert(DO_SSQ2 + (size_t)M_ * 32 * 4 <= DO_BCFLAG && XCD_BAR_WORDS_C * 4 <= 16384, "d_out scratch");

static_assert(WS_SSQ3 + (size_t)M_ * 32 * 4 <= WS_R, "ws overlay");

struct Params {
    const float* x; const float* norm_mix_g; const float* w_in; const float* ssm_conv_w; const float* ssm_conv_b;
    const float* ssm_dt_bias; const float* ssm_A_log; const float* ssm_D; const float* ssm_norm_g; const float* sc_conv_w;
    const float* w_out; const float* norm_ffn_g; const float* w_gate; const float* w_up; const float* w_down; const float* norm_final_g;
    float* out; unsigned char* ws; int ph_lo, ph_hi;
};

typedef float f32x2_t __attribute__((ext_vector_type(2)));
typedef __bf16 bf16x2_t __attribute__((ext_vector_type(2)));
__device__ __forceinline__ unsigned cvt_pk_bf16(float lo, float hi) { const f32x2_t v = {lo, hi}; return __builtin_bit_cast(unsigned, __builtin_convertvector(v, bf16x2_t)); }
__device__ __forceinline__ float bflo(unsigned u) { return __uint_as_float(u << 16); }
__device__ __forceinline__ float bfhi(unsigned u) { return __uint_as_float(u & 0xffff0000u); }
__device__ __forceinline__ int lane_id() { int l; asm volatile("v_mbcnt_lo_u32_b32 %0, -1, 0\n\tv_mbcnt_hi_u32_b32 %0, -1, %0" : "=v"(l)); return l; }
__device__ __forceinline__ float silu_f(float v) { return v * __builtin_amdgcn_rcpf(1.0f + __expf(-v)); }

__device__ __forceinline__ size_t ssq_idx(int row, int part) { return ((size_t)(row >> 5) * 32 + part) * 32 + (row & 31); }

namespace pg8 {
constexpr int BM = 256, BK = 64, HALF = 128, HTB = HALF * BK * 2, STAGE_BYTES = 8 * HTB, NXCD = 8, WGM = 8;
__device__ __forceinline__ int lds_byte(int r, int c) { const int st = (r >> 4) * 2 + (c >> 5), rr = r & 15, cc = c & 31, ob = rr * 64 + cc * 2; return st * 1024 + (ob ^ (((ob >> 9) & 1) << 5)); }
__device__ __forceinline__ void stage_rc(int b, int& R, int& C) { const int st = b / 1024, sb = b % 1024, swz = sb ^ (((sb >> 9) & 1) << 5); R = (st >> 1) * 16 + swz / 64; C = (st & 1) * 32 + (swz % 64) / 2; }
__device__ __forceinline__ int perm32(int rho) { const int n = rho >> 4, i = rho & 15; return 8 * (i >> 2) + 4 * n + (i & 3); }
struct Unit { int pm, pn; };
struct Gemm { const bf16_t* A; const bf16_t* Bt; int M, N, K; };
struct StaticOrder {
    int nM, nN, nwg, G, c;
    __device__ void init(int M, int N, int G_, int c_) { nM = M / BM; nN = N / BM; nwg = nM * nN; G = G_; c = c_; }
    __device__ bool next(int i, Unit& u) const {
        const long L = (long)i * G + c; if (L >= nwg) return false;
        int wgid = (int)L; { const int q = nwg / NXCD, r = nwg % NXCD, xcd = wgid % NXCD, off = wgid / NXCD; wgid = (xcd < r ? xcd * (q + 1) : r * (q + 1) + (xcd - r) * q) + off; }
        const int nig = WGM * nN, gid = wgid / nig, fm = gid * WGM, gsz = (nM - fm) < WGM ? (nM - fm) : WGM;
        u.pm = fm + ((wgid % nig) % gsz); u.pn = (wgid % nig) / gsz; return true;
    }
};
template <class Epi>
__device__ __forceinline__ void gemm_phase(LAS unsigned char* lds, const Gemm g, const StaticOrder& S, const Epi& E, int wv) {
    const int wid = wv, lane = lane_id(), tid = wid * 64 + lane, wr = wid >> 2, wc = wid & 3, fr = lane & 15, fq = lane >> 4;
    const int K = g.K, nt = K / BK;
    unsigned voffA[2], voffB[2];
#pragma unroll
    for (int i = 0; i < 2; ++i) { int R, C; stage_rc(tid * 16 + i * 8192, R, C); const int Rb = (R & ~31) + perm32(R & 31);
        voffA[i] = (unsigned)(R * K + C) * 2u; voffB[i] = (unsigned)(Rb * K + C) * 2u; }
    const size_t kstep = (size_t)(BK * 2);
    const size_t hstep = (size_t)HALF * K * 2;
    const size_t tstep = 2 * hstep;
    const unsigned ldsw = (unsigned)wid * 1024u;
    const int aoff = lds_byte(wr * 64 + fr, fq * 8), boff = lds_byte(wc * 32 + fr, fq * 8);
#define PG8_SA(b, h) (((b) * 2 + (h)) * HTB)
#define PG8_SB(b, h) ((4 + (b) * 2 + (h)) * HTB)
#define PG8_STAGE(bufoff, gbase, voff) do { _Pragma("unroll") for (int _i = 0; _i < 2; ++_i) \
        __builtin_amdgcn_global_load_lds((const unsigned*)((const char*)(gbase) + (voff)[_i]), (LAS unsigned*)(lds + (bufoff) + ldsw + _i * 8192), 16, 0, 0); } while (0)
#define PG8_LDA(dst, b, h) do { _Pragma("unroll") for (int m = 0; m < 4; ++m) _Pragma("unroll") for (int k = 0; k < 2; ++k) dst[m][k] = *(const LAS bf16x8*)(lds + PG8_SA(b, h) + aoff + m * 2048 + k * 1024); } while (0)
#define PG8_LDB(dst, b, h) do { _Pragma("unroll") for (int n = 0; n < 2; ++n) _Pragma("unroll") for (int k = 0; k < 2; ++k) dst[n][k] = *(const LAS bf16x8*)(lds + PG8_SB(b, h) + boff + n * 2048 + k * 1024); } while (0)
#define PG8_MMA(ai, bj, At, Bt) do { __builtin_amdgcn_s_setprio(1); _Pragma("unroll") for (int m = 0; m < 4; ++m) _Pragma("unroll") for (int n = 0; n < 2; ++n) _Pragma("unroll") for (int k = 0; k < 2; ++k) \
        acc[ai][bj][m][n] = __builtin_amdgcn_mfma_f32_16x16x32_bf16(Bt[n][k], At[m][k], acc[ai][bj][m][n], 0, 0, 0); __builtin_amdgcn_s_setprio(0); } while (0)
#define PG8_WAIT_V(n) asm volatile("s_waitcnt vmcnt(" #n ")" ::: "memory")
#define PG8_WAIT_L(n) asm volatile("s_waitcnt lgkmcnt(" #n ")" ::: "memory")
#define PG8_BAR __builtin_amdgcn_s_barrier()
#define PG8_SCHED __builtin_amdgcn_sched_barrier(0)
    Unit cur, nxt; int ui = 0;
    if (!S.next(0, cur)) return;
    f32x4 acc[2][2][4][2];
#pragma unroll
    for (int a = 0; a < 2; ++a)
#pragma unroll
        for (int b = 0; b < 2; ++b)
#pragma unroll
            for (int m = 0; m < 4; ++m)
#pragma unroll
                for (int n = 0; n < 2; ++n) acc[a][b][m][n] = (f32x4){0.f, 0.f, 0.f, 0.f};
    bf16x8 At[4][2], B0[2][2], B1[2][2];
    const char* cA = (const char*)g.A + (size_t)cur.pm * tstep; const char* cB = (const char*)g.Bt + (size_t)cur.pn * tstep;
    if constexpr (Epi::HAS_TAB) {
        Unit uu; for (int i = 0; i < 27 && S.next(i, uu); ++i) E.prep(uu, (LAS float*)(lds + TAB_OFF + i * 1024), tid);
    }
    PG8_STAGE(PG8_SB(0, 0), cB, voffB); PG8_STAGE(PG8_SB(0, 1), cB + hstep, voffB); PG8_STAGE(PG8_SA(0, 0), cA, voffA); PG8_STAGE(PG8_SA(0, 1), cA + hstep, voffA);
    if (wr == 1) PG8_BAR;
    PG8_WAIT_V(2); PG8_BAR;
    PG8_STAGE(PG8_SB(1, 0), cB + kstep, voffB); PG8_STAGE(PG8_SA(1, 0), cA + kstep, voffA); PG8_STAGE(PG8_SB(1, 1), cB + hstep + kstep, voffB);
    PG8_WAIT_V(6); PG8_BAR;
    for (;;) {
        const bool has_next = S.next(ui + 1, nxt);
        const char* nA = has_next ? (const char*)g.A + (size_t)nxt.pm * tstep : cA; const char* nB = has_next ? (const char*)g.Bt + (size_t)nxt.pn * tstep : cB;
        LAS const float* tabc = (LAS const float*)(lds + TAB_OFF + ui * 1024);
        for (int t = 0; t < nt; t += 2) {
            const bool last = (t == nt - 2);
            const char* a1 = cA + (size_t)(t + 1) * kstep;
            const char* a2 = last ? nA : cA + (size_t)(t + 2) * kstep; const char* b2 = last ? nB : cB + (size_t)(t + 2) * kstep;
            const char* a3 = a2 + kstep; const char* b3 = b2 + kstep;
            if constexpr (Epi::MID_T >= 0) { if (t == Epi::MID_T) {
#pragma unroll
                for (int ai = 0; ai < 2; ++ai)
#pragma unroll
                    for (int m = 0; m < 4; ++m) { const float s = tabc[ai * HALF + wr * 64 + m * 16 + fr];
#pragma unroll
                        for (int bj = 0; bj < 2; ++bj)
#pragma unroll
                            for (int n = 0; n < 2; ++n) acc[ai][bj][m][n] *= s; } } }
            PG8_LDB(B0, 0, 0); PG8_LDB(B1, 0, 1); PG8_SCHED; PG8_LDA(At, 0, 0); PG8_STAGE(PG8_SA(1, 1), a1 + hstep, voffA);
            PG8_WAIT_V(8); PG8_WAIT_L(0); PG8_BAR; PG8_MMA(0, 0, At, B0); PG8_MMA(0, 1, At, B1); PG8_BAR; PG8_SCHED;
            PG8_LDA(At, 0, 1); PG8_STAGE(PG8_SB(0, 0), b2, voffB); PG8_STAGE(PG8_SB(0, 1), b2 + hstep, voffB); PG8_STAGE(PG8_SA(0, 0), a2, voffA);
            PG8_WAIT_V(8); PG8_WAIT_L(0); PG8_BAR; PG8_MMA(1, 0, At, B0); PG8_MMA(1, 1, At, B1); PG8_BAR; PG8_SCHED;
            PG8_LDB(B0, 1, 0); PG8_LDB(B1, 1, 1); PG8_SCHED; PG8_LDA(At, 1, 0); PG8_STAGE(PG8_SA(0, 1), a2 + hstep, voffA);
            PG8_WAIT_V(8); PG8_WAIT_L(0); PG8_BAR; PG8_MMA(0, 0, At, B0); PG8_MMA(0, 1, At, B1); PG8_BAR; PG8_SCHED;
            PG8_LDA(At, 1, 1); PG8_STAGE(PG8_SB(1, 0), b3, voffB); PG8_STAGE(PG8_SB(1, 1), b3 + hstep, voffB); PG8_STAGE(PG8_SA(1, 0), a3, voffA);
            PG8_WAIT_V(8); PG8_WAIT_L(0); PG8_BAR; PG8_MMA(1, 0, At, B0); PG8_MMA(1, 1, At, B1); PG8_BAR; PG8_SCHED;
        }
        if (wr == 0) PG8_BAR;
        E(acc, cur, tabc, wr, wc, fr, fq);
        if (!has_next) break;
#pragma unroll
        for (int a = 0; a < 2; ++a)
#pragma unroll
            for (int b = 0; b < 2; ++b)
#pragma unroll
                for (int m = 0; m < 4; ++m)
#pragma unroll
                    for (int n = 0; n < 2; ++n) acc[a][b][m][n] = (f32x4){0.f, 0.f, 0.f, 0.f};
        cur = nxt; cA = nA; cB = nB; ++ui;
        if (wr == 1) PG8_BAR;
    }
    PG8_WAIT_V(0);
    PG8_BAR;
#undef PG8_SA
#undef PG8_SB
#undef PG8_STAGE
#undef PG8_LDA
#undef PG8_LDB
#undef PG8_MMA
#undef PG8_WAIT_V
#undef PG8_WAIT_L
#undef PG8_BAR
#undef PG8_SCHED
}
}

__device__ __forceinline__ void rstd_table(const float* ssq, int row0, LAS float* tab, int t) {
    const int r = t >> 1, hf = t & 1;
    const float* p = ssq + ssq_idx(row0 + r, hf * 16);
    float s = 0.f;
#pragma unroll
    for (int i = 0; i < 16; ++i) s += p[i * 32];
    s += __shfl_xor(s, 1);
    if (!hf) tab[r] = rsqrtf(s * (1.0f / 2048.0f) + EPS);
}

struct EpiProj {
    static constexpr bool HAS_TAB = false; static constexpr int MID_T = -1;
    bf16_t* O;
    __device__ __forceinline__ void prep(const pg8::Unit&, LAS float*, int) const {}
    __device__ __forceinline__ void operator()(const f32x4 (&acc)[2][2][4][2], const pg8::Unit& u, LAS const float*, int wr, int wc, int fr, int fq) const {
        const int row0 = u.pm * 256 + wr * 64 + fr, col0 = u.pn * 256 + wc * 32 + 8 * fq;
        if (u.pn >= 32) {
            const int pcol = 8192 + (u.pn - 32) * 128 + wc * 32 + 8 * fq;
#pragma unroll
            for (int ai = 0; ai < 2; ++ai)
#pragma unroll
                for (int m = 0; m < 4; ++m) { const f32x4 v0 = acc[ai][0][m][0] * acc[ai][1][m][0], v1 = acc[ai][0][m][1] * acc[ai][1][m][1];
                    u32x4 w; w.x = cvt_pk_bf16(v0[0], v0[1]); w.y = cvt_pk_bf16(v0[2], v0[3]); w.z = cvt_pk_bf16(v1[0], v1[1]); w.w = cvt_pk_bf16(v1[2], v1[3]);
                    *(u32x4*)(O + (size_t)(row0 + ai * 128 + m * 16) * NPROJ + pcol) = w; }
            return;
        }
#pragma unroll
        for (int ai = 0; ai < 2; ++ai)
#pragma unroll
            for (int m = 0; m < 4; ++m) { bf16_t* rowp = O + (size_t)(row0 + ai * 128 + m * 16) * NPROJ + col0;
#pragma unroll
                for (int bj = 0; bj < 2; ++bj) { const f32x4 v0 = acc[ai][bj][m][0], v1 = acc[ai][bj][m][1];
                    u32x4 w; w.x = cvt_pk_bf16(v0[0], v0[1]); w.y = cvt_pk_bf16(v0[2], v0[3]); w.z = cvt_pk_bf16(v1[0], v1[1]); w.w = cvt_pk_bf16(v1[2], v1[3]);
                    *(u32x4*)(rowp + bj * 128) = w; } }
    }
};
struct EpiOut {
    static constexpr bool HAS_TAB = true; static constexpr int MID_T = 32;
    const float* x; bf16_t* h1b; const float* ssq1; float* ssq2;
    __device__ __forceinline__ void prep(const pg8::Unit& u, LAS float* tab, int t) const { rstd_table(ssq1, u.pm * 256, tab, t); }
    __device__ __forceinline__ void operator()(const f32x4 (&acc)[2][2][4][2], const pg8::Unit& u, LAS const float*, int wr, int wc, int fr, int fq) const {
        const int row0 = u.pm * 256 + wr * 64 + fr, col0 = u.pn * 256 + wc * 32 + 8 * fq;
#pragma unroll
        for (int ai = 0; ai < 2; ++ai)
#pragma unroll
            for (int m = 0; m < 4; ++m) { const int row = row0 + ai * 128 + m * 16; const size_t off = (size_t)row * D_ + col0; float ss = 0.f;
#pragma unroll
                for (int bj = 0; bj < 2; ++bj) {
                    const f32x4 x0 = *(const f32x4*)(x + off + bj * 128), x1 = *(const f32x4*)(x + off + bj * 128 + 4);
                    const f32x4 v0 = acc[ai][bj][m][0] + x0, v1 = acc[ai][bj][m][1] + x1;
                    u32x4 w; w.x = cvt_pk_bf16(v0[0], v0[1]); w.y = cvt_pk_bf16(v0[2], v0[3]); w.z = cvt_pk_bf16(v1[0], v1[1]); w.w = cvt_pk_bf16(v1[2], v1[3]);
                    *(u32x4*)(h1b + off + bj * 128) = w;
                    ss += (v0[0] * v0[0] + v0[1] * v0[1]) + (v0[2] * v0[2] + v0[3] * v0[3]) + (v1[0] * v1[0] + v1[1] * v1[1]) + (v1[2] * v1[2] + v1[3] * v1[3]); }
                ss += __shfl_xor(ss, 16); ss += __shfl_xor(ss, 32);
                if (fq == 0) ssq2[ssq_idx(row, u.pn * 4 + wc)] = ss; }
    }
};
struct EpiGU {
    static constexpr bool HAS_TAB = true; static constexpr int MID_T = -1;
    const float* ssq2; bf16_t* hff;
    __device__ __forceinline__ void prep(const pg8::Unit& u, LAS float* tab, int t) const { rstd_table(ssq2, u.pm * 256, tab, t); }
    __device__ __forceinline__ void operator()(const f32x4 (&acc)[2][2][4][2], const pg8::Unit& u, LAS const float* tab, int wr, int wc, int fr, int fq) const {
        const int row0 = u.pm * 256 + wr * 64 + fr, col0 = u.pn * 128 + wc * 32 + 8 * fq;
#pragma unroll
        for (int ai = 0; ai < 2; ++ai)
#pragma unroll
            for (int m = 0; m < 4; ++m) { const float rs = tab[ai * 128 + wr * 64 + m * 16 + fr];
                float o[8];
#pragma unroll
                for (int n = 0; n < 2; ++n)
#pragma unroll
                    for (int j = 0; j < 4; ++j) { const float gg = acc[ai][0][m][n][j] * rs, uu = acc[ai][1][m][n][j] * rs; o[n * 4 + j] = silu_f(gg) * uu; }
                u32x4 w; w.x = cvt_pk_bf16(o[0], o[1]); w.y = cvt_pk_bf16(o[2], o[3]); w.z = cvt_pk_bf16(o[4], o[5]); w.w = cvt_pk_bf16(o[6], o[7]);
                *(u32x4*)(hff + (size_t)(row0 + ai * 128 + m * 16) * DFF + col0) = w; }
    }
};
struct EpiDown {
    static constexpr bool HAS_TAB = false; static constexpr int MID_T = -1;
    bf16_t* h; float* ssq3;
    __device__ __forceinline__ void prep(const pg8::Unit&, LAS float*, int) const {}
    __device__ __forceinline__ void operator()(const f32x4 (&acc)[2][2][4][2], const pg8::Unit& u, LAS const float*, int wr, int wc, int fr, int fq) const {
        const int row0 = u.pm * 256 + wr * 64 + fr, col0 = u.pn * 256 + wc * 32 + 8 * fq;
#pragma unroll
        for (int ai = 0; ai < 2; ++ai)
#pragma unroll
            for (int m = 0; m < 4; ++m) { const int row = row0 + ai * 128 + m * 16; const size_t off = (size_t)row * D_ + col0; float ss = 0.f;
#pragma unroll
                for (int bj = 0; bj < 2; ++bj) {
                    const u32x4 xb = *(const u32x4*)(h + off + bj * 128);
                    const f32x4 x0 = (f32x4){bflo(xb.x), bfhi(xb.x), bflo(xb.y), bfhi(xb.y)}, x1 = (f32x4){bflo(xb.z), bfhi(xb.z), bflo(xb.w), bfhi(xb.w)};
                    const f32x4 v0 = acc[ai][bj][m][0] + x0, v1 = acc[ai][bj][m][1] + x1;
                    u32x4 w; w.x = cvt_pk_bf16(v0[0], v0[1]); w.y = cvt_pk_bf16(v0[2], v0[3]); w.z = cvt_pk_bf16(v1[0], v1[1]); w.w = cvt_pk_bf16(v1[2], v1[3]);
                    *(u32x4*)(h + off + bj * 128) = w;
                    ss += (v0[0] * v0[0] + v0[1] * v0[1]) + (v0[2] * v0[2] + v0[3] * v0[3]) + (v1[0] * v1[0] + v1[1] * v1[1]) + (v1[2] * v1[2] + v1[3] * v1[3]); }
                ss += __shfl_xor(ss, 16); ss += __shfl_xor(ss, 32);
                if (fq == 0) ssq3[ssq_idx(row, u.pn * 4 + wc)] = ss; }
    }
};

__device__ __forceinline__ void p0_tile(LAS float* t, const float* src, int ldsrc, int k0, int c0, int jvalid, bf16_t* dst, int K, int j0, const float* scale, int scale_kmax, int tid) {
    const int jc4 = (tid & 15) * 4, kr0 = tid >> 4;
#pragma unroll
    for (int i = 0; i < 4; ++i) {
        const int kr = kr0 + 32 * i;
        f32x4 v = (f32x4){0.f, 0.f, 0.f, 0.f};
        if (jc4 < jvalid) v = *(const f32x4*)(src + (size_t)(k0 + kr) * ldsrc + c0 + jc4);
        const float s = (scale != nullptr && (k0 + kr) < scale_kmax) ? scale[k0 + kr] : 1.0f;
        t[kr * 65 + jc4 + 0] = v[0] * s; t[kr * 65 + jc4 + 1] = v[1] * s; t[kr * 65 + jc4 + 2] = v[2] * s; t[kr * 65 + jc4 + 3] = v[3] * s;
    }
    __syncthreads();
    const int kp = (tid & 63) * 2, jr0 = tid >> 6;
#pragma unroll
    for (int i = 0; i < 8; ++i) {
        const int j = jr0 + 8 * i;
        if (j < jvalid) { const float a = t[kp * 65 + j], b = t[(kp + 1) * 65 + j];
            *(unsigned*)(dst + (size_t)(j0 + j) * K + k0 + kp) = cvt_pk_bf16(a, b); }
    }
    __syncthreads();
}
struct TileD { const float* src; const float* scale; bf16_t* dst; int ldsrc, k0, c0, jvalid, K, j0, kmax; };
__device__ __forceinline__ TileD tile_decode(const Params& p, int u) {
    constexpr int U_IN = 16 * 193, U_OUT = 32 * 32, U_GU = 16 * 176;
    TileD d;
    if (u < U_IN) { const int kt = u & 15, jt = u >> 4, j0 = jt * 64;
        d.src = p.w_in; d.scale = nullptr; d.dst = (bf16_t*)(p.ws + WS_BTIN); d.ldsrc = DIN; d.k0 = kt * 128; d.c0 = j0 < 6144 ? j0 : (j0 < 8192 ? j0 + 32 : (j0 < 12288 ? (((j0 & 255) < 128 ? 8224 : 10272 - 128) + 128 * ((j0 - 8192) >> 8) + (j0 & 255)) : 6144));     d.jvalid = (jt == 192) ? 32 : 64; d.K = D_; d.j0 = j0; d.kmax = 0; }
    else if (u < U_IN + U_OUT) { const int v = u - U_IN, kt = v & 31, jt = v >> 5;
        d.src = p.w_out; d.scale = p.ssm_norm_g; d.dst = (bf16_t*)((unsigned char*)p.out + DO_BTOUT); d.ldsrc = D_; d.k0 = kt * 128; d.c0 = jt * 64; d.jvalid = 64; d.K = DMIX; d.j0 = jt * 64; d.kmax = 2048; }
    else if (u < U_IN + U_OUT + U_GU) { const int v = u - U_IN - U_OUT, kt = v & 15, jt = v >> 4, j0 = jt * 64, pn = j0 >> 8, r0 = j0 & 255;
        d.src = r0 < 128 ? p.w_gate : p.w_up; d.scale = p.norm_ffn_g; d.dst = (bf16_t*)((unsigned char*)p.out + DO_BTGU); d.ldsrc = DFF; d.k0 = kt * 128; d.c0 = 128 * pn + (r0 & 127); d.jvalid = 64; d.K = D_; d.j0 = j0; d.kmax = 2048; }
    else { const int v = u - U_IN - U_OUT - U_GU, kt = v % 44, jt = v / 44;
        d.src = p.w_down; d.scale = nullptr; d.dst = (bf16_t*)((unsigned char*)p.out + DO_BTDN); d.ldsrc = D_; d.k0 = kt * 128; d.c0 = jt * 64; d.jvalid = 64; d.K = DFF; d.j0 = jt * 64; d.kmax = 0; }
    return d;
}
__device__ __forceinline__ void tile_load(const TileD& d, int tid, f32x4 (&v)[4], float (&scl)[4]) {
    const int jc4 = (tid & 15) * 4, kr0 = tid >> 4;
#pragma unroll
    for (int i = 0; i < 4; ++i) { const int kr = kr0 + 32 * i;
        f32x4 x = (f32x4){0.f, 0.f, 0.f, 0.f};
        if (jc4 < d.jvalid) x = *(const f32x4*)(d.src + (size_t)(d.k0 + kr) * d.ldsrc + d.c0 + jc4);
        scl[i] = (d.scale != nullptr && (d.k0 + kr) < d.kmax) ? d.scale[d.k0 + kr] : 1.0f;
        v[i] = x; }
}
__device__ __forceinline__ void tile_finish(LAS float* t, const TileD& d, int tid, const f32x4 (&v)[4], const float (&scl)[4]) {
    const int jc4 = (tid & 15) * 4, kr0 = tid >> 4;
#pragma unroll
    for (int i = 0; i < 4; ++i) { const int kr = kr0 + 32 * i;
        t[kr * 65 + jc4 + 0] = v[i][0] * scl[i]; t[kr * 65 + jc4 + 1] = v[i][1] * scl[i]; t[kr * 65 + jc4 + 2] = v[i][2] * scl[i]; t[kr * 65 + jc4 + 3] = v[i][3] * scl[i]; }
    asm volatile("s_waitcnt lgkmcnt(0)" ::: "memory"); __builtin_amdgcn_s_barrier(); asm volatile("" ::: "memory");
    const int kp = (tid & 63) * 2, jr0 = tid >> 6;
#pragma unroll
    for (int i = 0; i < 8; ++i) { const int j = jr0 + 8 * i;
        if (j < d.jvalid) { const float a = t[kp * 65 + j], b = t[(kp + 1) * 65 + j];
            *(unsigned*)(d.dst + (size_t)(d.j0 + j) * d.K + d.k0 + kp) = cvt_pk_bf16(a, b); } }
    asm volatile("s_waitcnt lgkmcnt(0)" ::: "memory"); __builtin_amdgcn_s_barrier(); asm volatile("" ::: "memory");
}
__device__ __forceinline__ void conv_tiles(const Params& p, LAS unsigned char* lds, int u_begin, int u_end, int first, int stride, int tid) {
    LAS float* t = (LAS float*)lds;
    int u = u_begin + first;
    if (u >= u_end) return;
    TileD d = tile_decode(p, u); f32x4 v[4]; float sc[4]; tile_load(d, tid, v, sc);
    for (;;) {
        const int un = u + stride; const bool more = un < u_end;
        TileD dn = d; f32x4 vn[4]; float scn[4];
#pragma unroll
        for (int i = 0; i < 4; ++i) { vn[i] = v[i]; scn[i] = sc[i]; }
        if (more) { dn = tile_decode(p, un); tile_load(dn, tid, vn, scn); }
        tile_finish(t, d, tid, v, sc);
        if (!more) break;
        d = dn; u = un;
#pragma unroll
        for (int i = 0; i < 4; ++i) { v[i] = vn[i]; sc[i] = scn[i]; }
    }
}
__device__ void phase0(const Params& p, LAS unsigned char* lds, int wv) {
    const int lane = lane_id(), wave = wv, tid = wv * 64 + lane, G = gridDim.x;
    LAS float* t = (LAS float*)lds;
    bf16_t* bt_in = (bf16_t*)(p.ws + WS_BTIN);
    bf16_t* xn = (bf16_t*)(p.ws + WS_XN);
    for (int row = blockIdx.x * 8 + wave; row < M_; row += G * 8) {
        const f32x4* xr = (const f32x4*)(p.x + (size_t)row * D_);
        f32x4 v[8]; float ss = 0.f;
#pragma unroll
        for (int i = 0; i < 8; ++i) { v[i] = xr[lane + 64 * i]; ss += (v[i][0] * v[i][0] + v[i][1] * v[i][1]) + (v[i][2] * v[i][2] + v[i][3] * v[i][3]); }
#pragma unroll
        for (int o = 32; o >= 1; o >>= 1) ss += __shfl_xor(ss, o);
        const float rstd = rsqrtf(ss * (1.0f / 2048.0f) + EPS);
#pragma unroll
        for (int i = 0; i < 8; ++i) { const f32x4 g4 = ((const f32x4*)p.norm_mix_g)[lane + 64 * i];
            u32x2 w; w.x = cvt_pk_bf16(v[i][0] * rstd * g4[0], v[i][1] * rstd * g4[1]); w.y = cvt_pk_bf16(v[i][2] * rstd * g4[2], v[i][3] * rstd * g4[3]);
            *(u32x2*)(xn + (size_t)row * D_ + 4 * (lane + 64 * i)) = w; }
    }
    __syncthreads();
    conv_tiles(p, lds, 0, 16 * 193, blockIdx.x, G, tid);
}
__device__ void wconv_units(const Params& p, LAS unsigned char* lds, int first, int stride, int wv) {
    const int tid = wv * 64 + lane_id();
    __syncthreads();
    conv_tiles(p, lds, 16 * 193, 16 * 193 + 32 * 32 + 16 * 176 + 44 * 32, first, stride, tid);
}

__device__ void dt_units(const Params& p, LAS unsigned char* lds, int wv) {
    const int lane = lane_id(), w = wv, tid = wv * 64 + lane, fr = lane & 15, fq = lane >> 4;
    const bf16_t* xn = (const bf16_t*)(p.ws + WS_XN);
    const bf16_t* bt = (const bf16_t*)(p.ws + WS_BTIN) + (size_t)NPROJ * D_;
    float* dt = (float*)((unsigned char*)p.out + DO_DT);
    LAS float* red = (LAS float*)lds;
    for (int rb = blockIdx.x; rb < M_ / 64; rb += gridDim.x) {
        const int row0 = rb * 64;
        f32x4 acc[4][2];
#pragma unroll
        for (int m = 0; m < 4; ++m)
#pragma unroll
            for (int n = 0; n < 2; ++n) acc[m][n] = (f32x4){0.f, 0.f, 0.f, 0.f};
#pragma unroll 4
        for (int ks = 0; ks < 8; ++ks) {
            const int kb = w * 256 + ks * 32 + fq * 8;
            bf16x8 a[4], b[2];
#pragma unroll
            for (int m = 0; m < 4; ++m) a[m] = *(const bf16x8*)(xn + (size_t)(row0 + 16 * m + fr) * D_ + kb);
#pragma unroll
            for (int n = 0; n < 2; ++n) b[n] = *(const bf16x8*)(bt + (size_t)(16 * n + fr) * D_ + kb);
#pragma unroll
            for (int m = 0; m < 4; ++m)
#pragma unroll
                for (int n = 0; n < 2; ++n) acc[m][n] = __builtin_amdgcn_mfma_f32_16x16x32_bf16(a[m], b[n], acc[m][n], 0, 0, 0);
        }
#pragma unroll
        for (int m = 0; m < 4; ++m)
#pragma unroll
            for (int n = 0; n < 2; ++n)
#pragma unroll
                for (int j = 0; j < 4; ++j) red[w * 2048 + (16 * m + 4 * fq + j) * 32 + 16 * n + fr] = acc[m][n][j];
        __syncthreads();
        {
            const int idx = tid * 4, r = idx >> 5, c = idx & 31;
            f32x4 s = (f32x4){0.f, 0.f, 0.f, 0.f};
#pragma unroll
            for (int ww = 0; ww < 8; ++ww) s += *(LAS const f32x4*)(red + ww * 2048 + idx);
            const f32x4 bias = *(const f32x4*)(p.ssm_dt_bias + c);
            f32x4 o;
#pragma unroll
            for (int j = 0; j < 4; ++j) { const float v = s[j] + bias[j]; o[j] = v > 20.f ? v : log1pf(expf(v)); }
            *(f32x4*)(dt + (size_t)(row0 + r) * 32 + c) = o;
        }
        __syncthreads();
    }
}

__device__ void bc_sequences(const Params& p, LAS unsigned char* lds, int first, int stride, int wv) {
    const int tid = wv * 64 + lane_id(), cv = tid & 7, run = tid >> 3;
    bf16_t* proj = (bf16_t*)(p.ws + WS_PROJ);
    LAS u32x4* stash = (LAS u32x4*)lds;
    unsigned* bcflag = (unsigned*)((unsigned char*)p.out + DO_BCFLAG);
    for (int sq = first; sq < 4 * 32; sq += stride) {
        const int b = sq >> 5, slab = sq & 31;
        const int xcol = 2048 + slab * 64 + cv * 8;
        float wk[4][8], bs[8];
#pragma unroll
        for (int k = 0; k < 4; ++k) { const f32x4 a = *(const f32x4*)(p.ssm_conv_w + k * 4096 + xcol), c = *(const f32x4*)(p.ssm_conv_w + k * 4096 + xcol + 4);
#pragma unroll
            for (int j = 0; j < 4; ++j) { wk[k][j] = a[j]; wk[k][4 + j] = c[j]; } }
        { const f32x4 a = *(const f32x4*)(p.ssm_conv_b + xcol), c = *(const f32x4*)(p.ssm_conv_b + xcol + 4);
#pragma unroll
          for (int j = 0; j < 4; ++j) { bs[j] = a[j]; bs[4 + j] = c[j]; } }
        __syncthreads();
#pragma unroll 1
        for (int tile = 0; tile < 8; ++tile) {
            bf16_t* base = proj + (size_t)(b * SEQ + tile * 512 + run * 8) * NPROJ + 2048 + xcol;
            u32x4 raw[11];
#pragma unroll
            for (int r = 0; r < 11; ++r) {
                const int row = run * 8 + r - 3;
                if (row >= 0) raw[r] = *(const u32x4*)(base + (long)(r - 3) * NPROJ);
                else raw[r] = (tile == 0) ? (u32x4){0u, 0u, 0u, 0u} : stash[(row + 3) * 8 + cv];
            }
            u32x4 ov[8];
#pragma unroll
            for (int j = 0; j < 8; ++j) {
                float o[8];
#pragma unroll
                for (int q = 0; q < 4; ++q) {
                    const unsigned x0 = raw[j][q], x1 = raw[j + 1][q], x2 = raw[j + 2][q], x3 = raw[j + 3][q];
                    o[2 * q] = silu_f(bs[2 * q] + wk[0][2 * q] * bflo(x0) + wk[1][2 * q] * bflo(x1) + wk[2][2 * q] * bflo(x2) + wk[3][2 * q] * bflo(x3));
                    o[2 * q + 1] = silu_f(bs[2 * q + 1] + wk[0][2 * q + 1] * bfhi(x0) + wk[1][2 * q + 1] * bfhi(x1) + wk[2][2 * q + 1] * bfhi(x2) + wk[3][2 * q + 1] * bfhi(x3));
                }
                ov[j].x = cvt_pk_bf16(o[0], o[1]); ov[j].y = cvt_pk_bf16(o[2], o[3]); ov[j].z = cvt_pk_bf16(o[4], o[5]); ov[j].w = cvt_pk_bf16(o[6], o[7]);
            }
            asm volatile("s_waitcnt vmcnt(0) lgkmcnt(0)" ::: "memory");
            __syncthreads();
            if (run == 63) { stash[0 * 8 + cv] = raw[8]; stash[1 * 8 + cv] = raw[9]; stash[2 * 8 + cv] = raw[10]; }
#pragma unroll
            for (int j = 0; j < 8; ++j) { const bf16_t* q = base + (long)j * NPROJ;
                asm volatile("global_store_dwordx4 %0, %1, off sc1" :: "v"(q), "v"(ov[j]) : "memory"); }
            asm volatile("s_waitcnt vmcnt(0) lgkmcnt(0)" ::: "memory");
            __syncthreads();
            if (wv == 0) {
                if (lane_id() == 0) __hip_atomic_store(bcflag + sq, (unsigned)(tile + 1), __ATOMIC_RELAXED, __HIP_MEMORY_SCOPE_AGENT);
            }
        }
    }
}

constexpr int SROW = 272;
constexpr int L_CM = 0, L_BM = 34816, L_BDT = 69632, L_XT = 104448, L_HB = 121856  , L_CS = 156672, L_DT = 157184, L_CW = 157696  ;
__device__ __forceinline__ int swz_off(int row, int kblk) { return row * SROW + ((kblk ^ ((row >> 3) & 7)) << 4); }
__device__ __forceinline__ void ssd_load(u32x4 (&raw)[5], const bf16_t* base, bool first, int l0) {
#pragma unroll
    for (int r = 0; r < 5; ++r) raw[r] = (first && (l0 + r - 3) < 0) ? (u32x4){0u, 0u, 0u, 0u} : *(const u32x4*)(base + (long)(r - 3) * NPROJ);
}
template <int GI>
__device__ __forceinline__ void ssd_conv(LAS unsigned char* lds, const u32x4 (&raw)[5], int cv, int l0, float sa, float sb) {
    LAS const f32x4* cw = (LAS const f32x4*)(lds + L_CW) + cv * 10;
    float o0[8], o1[8];
#pragma unroll
    for (int hq = 0; hq < 2; ++hq) {
        const f32x4 w0 = cw[0 + hq], w1 = cw[2 + hq], w2 = cw[4 + hq], w3 = cw[6 + hq], bs = cw[8 + hq];
#pragma unroll
        for (int e2 = 0; e2 < 2; ++e2) {
            const int q = hq * 2 + e2;
            const unsigned x0 = raw[0][q], x1 = raw[1][q], x2 = raw[2][q], x3 = raw[3][q], x4 = raw[4][q];
            const int ea = e2 * 2, eb = e2 * 2 + 1;
            const float va = bs[ea] + w0[ea] * bflo(x0) + w1[ea] * bflo(x1) + w2[ea] * bflo(x2) + w3[ea] * bflo(x3);
            const float vb = bs[eb] + w0[eb] * bfhi(x0) + w1[eb] * bfhi(x1) + w2[eb] * bfhi(x2) + w3[eb] * bfhi(x3);
            const float ua = bs[ea] + w0[ea] * bflo(x1) + w1[ea] * bflo(x2) + w2[ea] * bflo(x3) + w3[ea] * bflo(x4);
            const float ub = bs[eb] + w0[eb] * bfhi(x1) + w1[eb] * bfhi(x2) + w2[eb] * bfhi(x3) + w3[eb] * bfhi(x4);
            o0[2 * q] = silu_f(va); o0[2 * q + 1] = silu_f(vb); o1[2 * q] = silu_f(ua); o1[2 * q + 1] = silu_f(ub);
        }
    }
    if (GI == 0) {
#pragma unroll
        for (int e = 0; e < 8; ++e) { const int prow = cv * 8 + e;
            *(LAS unsigned*)(lds + L_XT + swz_off(prow, l0 >> 3) + (l0 & 7) * 2) = cvt_pk_bf16(o0[e] * sa, o1[e] * sb); }
    } else {
        u32x4 w0; w0.x = cvt_pk_bf16(o0[0], o0[1]); w0.y = cvt_pk_bf16(o0[2], o0[3]); w0.z = cvt_pk_bf16(o0[4], o0[5]); w0.w = cvt_pk_bf16(o0[6], o0[7]);
        u32x4 w1; w1.x = cvt_pk_bf16(o1[0], o1[1]); w1.y = cvt_pk_bf16(o1[2], o1[3]); w1.z = cvt_pk_bf16(o1[4], o1[5]); w1.w = cvt_pk_bf16(o1[6], o1[7]);
        const int nb = ((GI - 1) & 1) * 64 + cv * 8;
        if (GI < 3) {
            *(LAS u32x4*)(lds + L_BM + l0 * SROW + nb * 2) = w0; *(LAS u32x4*)(lds + L_BM + (l0 + 1) * SROW + nb * 2) = w1;
#pragma unroll
            for (int e = 0; e < 8; ++e) { const int nrow = nb + e;
                *(LAS unsigned*)(lds + L_BDT + swz_off(nrow, l0 >> 3) + (l0 & 7) * 2) = cvt_pk_bf16(o0[e] * sa, o1[e] * sb); }
        } else {
            *(LAS u32x4*)(lds + L_CM + l0 * SROW + nb * 2) = w0; *(LAS u32x4*)(lds + L_CM + (l0 + 1) * SROW + nb * 2) = w1;
        }
    }
}
template <int GI>
__device__ __forceinline__ void ssd_put(LAS unsigned char* lds, const u32x4 (&rw)[2], int cv, int l0, float sa, float sb) {
    const int nb = ((GI - 1) & 1) * 64 + cv * 8;
    if (GI < 3) {
        *(LAS u32x4*)(lds + L_BM + l0 * SROW + nb * 2) = rw[0]; *(LAS u32x4*)(lds + L_BM + (l0 + 1) * SROW + nb * 2) = rw[1];
#pragma unroll
        for (int q = 0; q < 4; ++q) {
            *(LAS unsigned*)(lds + L_BDT + swz_off(nb + 2 * q, l0 >> 3) + (l0 & 7) * 2) = cvt_pk_bf16(bflo(rw[0][q]) * sa, bflo(rw[1][q]) * sb);
            *(LAS unsigned*)(lds + L_BDT + swz_off(nb + 2 * q + 1, l0 >> 3) + (l0 & 7) * 2) = cvt_pk_bf16(bfhi(rw[0][q]) * sa, bfhi(rw[1][q]) * sb);
        }
    } else {
        *(LAS u32x4*)(lds + L_CM + l0 * SROW + nb * 2) = rw[0]; *(LAS u32x4*)(lds + L_CM + (l0 + 1) * SROW + nb * 2) = rw[1];
    }
}
__device__ __forceinline__ void bc_wait(unsigned* f, unsigned need, int wv) {
    if (wv == 0) {
    unsigned sp = 0;
    for (;;) {
        const unsigned a = __hip_atomic_load(f, __ATOMIC_RELAXED, __HIP_MEMORY_SCOPE_AGENT), b2 = __hip_atomic_load(f + 1, __ATOMIC_RELAXED, __HIP_MEMORY_SCOPE_AGENT);
        const unsigned c = __hip_atomic_load(f + 16, __ATOMIC_RELAXED, __HIP_MEMORY_SCOPE_AGENT), d = __hip_atomic_load(f + 17, __ATOMIC_RELAXED, __HIP_MEMORY_SCOPE_AGENT);
        const unsigned m = min(min(a, b2), min(c, d));
        if (__builtin_amdgcn_readfirstlane(m) >= need) break;
        __builtin_amdgcn_s_sleep(4);
        if (++sp > (1u << 19)) break;
    }
    __builtin_amdgcn_fence(__ATOMIC_ACQUIRE, "agent"); asm volatile("s_waitcnt vmcnt(0)" ::: "memory");
    }
    asm volatile("s_waitcnt lgkmcnt(0)" ::: "memory"); __builtin_amdgcn_s_barrier(); asm volatile("" ::: "memory");
}
__device__ void ssd_unit(const Params& p, LAS unsigned char* lds, int b, int h, int wv) {
    const int lane = lane_id(), w = wv, tid = wv * 64 + lane, fr = lane & 15, fq = lane >> 4;
    const int g = h >> 2;
    const bf16_t* proj = (const bf16_t*)(p.ws + WS_PROJ);
    const float* dtg = (const float*)((const unsigned char*)p.out + DO_DT);
    bf16_t* ymix = (bf16_t*)(p.ws + WS_YMIX);
    float* ssq1 = (float*)((unsigned char*)p.out + DO_SSQ1);
    LAS float* CSv = (LAS float*)(lds + L_CS);
    LAS float* DTv = (LAS float*)(lds + L_DT);
    LAS float* CW = (LAS float*)(lds + L_CW);
    const float Aneg = -__expf(p.ssm_A_log[h]);
    const float Dh = p.ssm_D[h];
    for (int idx = tid; idx < 320; idx += 512) {
        const int e = idx & 7, k = (idx >> 3) % 5, cvi = idx / 40;
        const int xcol = h * 64 + cvi * 8 + e;
        CW[idx] = (k < 4) ? p.ssm_conv_w[k * 4096 + xcol] : p.ssm_conv_b[xcol];
    }
    for (int idx = tid; idx < 64 * 17; idx += 512) *(LAS u32x4*)(lds + L_HB + idx * 16) = (u32x4){0u, 0u, 0u, 0u};
    f32x4 Hacc[4];
#pragma unroll
    for (int pt = 0; pt < 4; ++pt) Hacc[pt] = (f32x4){0.f, 0.f, 0.f, 0.f};
    __syncthreads();
    const int cv = lane & 7;
    const int l0 = 16 * w + 2 * (lane >> 3);
    const int srcl = (w & 3) * 16 + 2 * (lane >> 3);
    u32x4 r0[5], r1[2], r2[2], r3[2], r4[2];
    const bf16_t* pbase = proj + (size_t)(b * SEQ + l0) * NPROJ + 2048 + cv * 8;
    const int xc0 = h * 64, xc1 = 2048 + g * 128, xc2 = xc1 + 64, xc3 = 3072 + g * 128, xc4 = xc3 + 64;
    unsigned* bcf = (unsigned*)((unsigned char*)p.out + DO_BCFLAG) + b * 32 + 2 * g;
    bc_wait(bcf, 1u, wv);
    ssd_load(r0, pbase + xc0, true, l0);
    r1[0] = *(const u32x4*)(pbase + xc1); r1[1] = *(const u32x4*)(pbase + xc1 + NPROJ); r2[0] = *(const u32x4*)(pbase + xc2); r2[1] = *(const u32x4*)(pbase + xc2 + NPROJ);
    r3[0] = *(const u32x4*)(pbase + xc3); r3[1] = *(const u32x4*)(pbase + xc3 + NPROJ); r4[0] = *(const u32x4*)(pbase + xc4); r4[1] = *(const u32x4*)(pbase + xc4 + NPROJ);
    float dt0n = dtg[(size_t)(b * SEQ + lane) * 32 + h], dt1n = dtg[(size_t)(b * SEQ + 64 + lane) * 32 + h];
    for (int c = 0; c < 32; ++c) {
        const int row0 = b * SEQ + c * 128;
        const float dt0 = dt0n, dt1 = dt1n;
        float a0 = dt0 * Aneg, a1 = dt1 * Aneg;
#pragma unroll
        for (int o = 1; o < 64; o <<= 1) { const float t0 = __shfl_up(a0, o), t1 = __shfl_up(a1, o); if (lane >= o) { a0 += t0; a1 += t1; } }
        a1 += __shfl(a0, 63);
        const float cs_end = __shfl(a1, 63);
        if (w == 0) { CSv[lane] = a0; CSv[64 + lane] = a1; DTv[lane] = dt0; DTv[64 + lane] = dt1; }
        const float csv = (w >= 4) ? a1 : a0, dtv = (w >= 4) ? dt1 : dt0;
        const float cs_l0 = __shfl(csv, srcl), cs_l1 = __shfl(csv, srcl + 1), dt_l0 = __shfl(dtv, srcl), dt_l1 = __shfl(dtv, srcl + 1);
        const float dec0 = __expf(cs_end - cs_l0), dec1 = __expf(cs_end - cs_l1);
        ssd_conv<0>(lds, r0, cv, l0, dt_l0, dt_l1);
        ssd_put<1>(lds, r1, cv, l0, dec0, dec1); ssd_put<2>(lds, r2, cv, l0, dec0, dec1);
        ssd_put<3>(lds, r3, cv, l0, 0.f, 0.f);   ssd_put<4>(lds, r4, cv, l0, 0.f, 0.f);
        __builtin_amdgcn_sched_barrier(0);
        if (c + 1 < 32) {
            if (((c + 1) & 3) == 0) bc_wait(bcf, (unsigned)(((c + 1) >> 2) + 1), wv);
            const bf16_t* cb = pbase + (size_t)(c + 1) * 128 * NPROJ;
            ssd_load(r0, cb + xc0, false, l0);
            r1[0] = *(const u32x4*)(cb + xc1); r1[1] = *(const u32x4*)(cb + xc1 + NPROJ); r2[0] = *(const u32x4*)(cb + xc2); r2[1] = *(const u32x4*)(cb + xc2 + NPROJ);
            r3[0] = *(const u32x4*)(cb + xc3); r3[1] = *(const u32x4*)(cb + xc3 + NPROJ); r4[0] = *(const u32x4*)(cb + xc4); r4[1] = *(const u32x4*)(cb + xc4 + NPROJ);
            dt0n = dtg[(size_t)(row0 + 128 + lane) * 32 + h]; dt1n = dtg[(size_t)(row0 + 192 + lane) * 32 + h];
        }
        __builtin_amdgcn_sched_barrier(0);
        u32x2 zr[4];
#pragma unroll
        for (int pt = 0; pt < 4; ++pt) zr[pt] = *(const u32x2*)(proj + (size_t)(row0 + 16 * w + fr) * NPROJ + h * 64 + 16 * pt + 4 * fq);
        asm volatile("s_waitcnt lgkmcnt(0)" ::: "memory"); __builtin_amdgcn_s_barrier(); asm volatile("" ::: "memory");
        const int lrow = 16 * w + fr;
        const int hb_cur = L_HB + (c & 1) * 17408, hb_nxt = L_HB + ((c + 1) & 1) * 17408;
        bf16x8 cf[4];
#pragma unroll
        for (int ks = 0; ks < 4; ++ks) cf[ks] = *(LAS const bf16x8*)(lds + L_CM + lrow * SROW + (32 * ks + 8 * fq) * 2);
        const float cs_l = CSv[lrow], dt_l = DTv[lrow];
        asm volatile("" ::: "memory");
        const int dd = fr - 4 * fq; const float ddiag = Dh / dt_l;
        f32x4 y[4];
        { const float el = __expf(cs_l);
#pragma unroll
          for (int pt = 0; pt < 4; ++pt) { f32x4 a = (f32x4){0.f, 0.f, 0.f, 0.f};
#pragma unroll
            for (int ks = 0; ks < 4; ++ks) { const bf16x8 hf = *(LAS const bf16x8*)(lds + hb_cur + (16 * pt + fr) * SROW + (32 * ks + 8 * fq) * 2);
                a = __builtin_amdgcn_mfma_f32_16x16x32_bf16(hf, cf[ks], a, 0, 0, 0); }
            y[pt] = a * el; } }
#pragma unroll
        for (int j = 0; j < 8; ++j) {
            if (j <= w) {
                f32x4 gacc = (f32x4){0.f, 0.f, 0.f, 0.f};
#pragma unroll
                for (int ks = 0; ks < 4; ++ks) { const bf16x8 bf = *(LAS const bf16x8*)(lds + L_BM + (16 * j + fr) * SROW + (32 * ks + 8 * fq) * 2);
                    gacc = __builtin_amdgcn_mfma_f32_16x16x32_bf16(bf, cf[ks], gacc, 0, 0, 0); }
                const f32x4 css = *(LAS const f32x4*)(CSv + 16 * j + 4 * fq);
                float mv[4];
#pragma unroll
                for (int i = 0; i < 4; ++i) { float v = gacc[i] * __expf(cs_l - css[i]);
                    if (j == w) { v = (i <= dd) ? v : 0.f; if (i == dd) v += ddiag; }
                    mv[i] = v; }
                u32x2 wv2; wv2.x = cvt_pk_bf16(mv[0], mv[1]); wv2.y = cvt_pk_bf16(mv[2], mv[3]);
                *(LAS u32x2*)(lds + L_CM + lrow * SROW + (16 * j + 4 * fq) * 2) = wv2;
            } else if (j == w + 1 && (w & 1) == 0) {
                *(LAS u32x2*)(lds + L_CM + lrow * SROW + (16 * j + 4 * fq) * 2) = (u32x2){0u, 0u};
            }
        }
        asm volatile("" ::: "memory");
        { const float de = __expf(cs_end);
#pragma unroll
          for (int pt = 0; pt < 4; ++pt) Hacc[pt] *= de; }
        const int nks2 = (w >> 1) + 1;
#pragma unroll
        for (int ks = 0; ks < 4; ++ks) {
            bf16x8 xf[4];
#pragma unroll
            for (int pt = 0; pt < 4; ++pt) xf[pt] = *(LAS const bf16x8*)(lds + L_XT + swz_off(16 * pt + fr, 4 * ks + fq));
            if (ks < nks2) { const bf16x8 mf = *(LAS const bf16x8*)(lds + L_CM + lrow * SROW + (32 * ks + 8 * fq) * 2);
#pragma unroll
                for (int pt = 0; pt < 4; ++pt) y[pt] = __builtin_amdgcn_mfma_f32_16x16x32_bf16(xf[pt], mf, y[pt], 0, 0, 0); }
            const bf16x8 bdf = *(LAS const bf16x8*)(lds + L_BDT + swz_off(16 * w + fr, 4 * ks + fq));
#pragma unroll
            for (int pt = 0; pt < 4; ++pt) Hacc[pt] = __builtin_amdgcn_mfma_f32_16x16x32_bf16(bdf, xf[pt], Hacc[pt], 0, 0, 0);
        }
#pragma unroll
        for (int pt = 0; pt < 4; ++pt) { u32x2 wv2; wv2.x = cvt_pk_bf16(Hacc[pt][0], Hacc[pt][1]); wv2.y = cvt_pk_bf16(Hacc[pt][2], Hacc[pt][3]);
            *(LAS u32x2*)(lds + hb_nxt + (16 * pt + fr) * SROW + (16 * w + 4 * fq) * 2) = wv2; }
        { float ss = 0.f; const size_t orow = (size_t)(row0 + lrow);
#pragma unroll
          for (int pt = 0; pt < 4; ++pt) {
            const float z0 = bflo(zr[pt].x), z1 = bfhi(zr[pt].x), z2 = bflo(zr[pt].y), z3 = bfhi(zr[pt].y);
            const float v0 = y[pt][0] * silu_f(z0), v1 = y[pt][1] * silu_f(z1), v2 = y[pt][2] * silu_f(z2), v3 = y[pt][3] * silu_f(z3);
            ss += (v0 * v0 + v1 * v1) + (v2 * v2 + v3 * v3);
            u32x2 wv; wv.x = cvt_pk_bf16(v0, v1); wv.y = cvt_pk_bf16(v2, v3);
            *(u32x2*)(ymix + orow * DMIX + h * 64 + 16 * pt + 4 * fq) = wv; }
          ss += __shfl_xor(ss, 16); ss += __shfl_xor(ss, 32);
          if (fq == 0) ssq1[ssq_idx((int)orow, h)] = ss; }
        asm volatile("s_waitcnt lgkmcnt(0)" ::: "memory"); __builtin_amdgcn_s_barrier(); asm volatile("" ::: "memory");
    }
}
__device__ void sc_unit(const Params& p, int unit, int wv) {
    const int tid = wv * 64 + lane_id(), cvx = tid & 255, th = tid >> 8;
    const bf16_t* proj = (const bf16_t*)(p.ws + WS_PROJ);
    bf16_t* ymix = (bf16_t*)(p.ws + WS_YMIX);
    const int t0 = unit * 64 + th * 32, c0 = cvx * 8;
    float w0[8], w1[8], w2[8];
    { const f32x4* a = (const f32x4*)(p.sc_conv_w + c0); const f32x4* bq = (const f32x4*)(p.sc_conv_w + 2048 + c0); const f32x4* cq = (const f32x4*)(p.sc_conv_w + 4096 + c0);
#pragma unroll
      for (int q = 0; q < 2; ++q) { const f32x4 x0 = a[q], x1 = bq[q], x2 = cq[q];
#pragma unroll
        for (int j = 0; j < 4; ++j) { w0[q * 4 + j] = x0[j]; w1[q * 4 + j] = x1[j]; w2[q * 4 + j] = x2[j]; } } }
    float pm1[8], pm2[8];
#pragma unroll
    for (int e = 0; e < 8; ++e) { pm1[e] = 0.f; pm2[e] = 0.f; }
    if ((t0 & (SEQ - 1)) != 0) {
        const bf16_t* r2 = proj + (size_t)(t0 - 2) * NPROJ, * r1 = proj + (size_t)(t0 - 1) * NPROJ;
        const u32x4 c2 = *(const u32x4*)(r2 + 8192 + c0), c1 = *(const u32x4*)(r1 + 8192 + c0);
#pragma unroll
        for (int q = 0; q < 4; ++q) { pm2[2 * q] = bflo(c2[q]); pm2[2 * q + 1] = bfhi(c2[q]); pm1[2 * q] = bflo(c1[q]); pm1[2 * q + 1] = bfhi(c1[q]); }
    }
#pragma unroll 4
    for (int i = 0; i < 32; ++i) {
        const bf16_t* r = proj + (size_t)(t0 + i) * NPROJ;
        const u32x4 gb = *(const u32x4*)(r + 6144 + c0), gp = *(const u32x4*)(r + 8192 + c0);
        float o[8];
#pragma unroll
        for (int q = 0; q < 4; ++q) {
            const float pa = bflo(gp[q]), pb = bfhi(gp[q]);
            o[2 * q] = bflo(gb[q]) * (w0[2 * q] * pm2[2 * q] + w1[2 * q] * pm1[2 * q] + w2[2 * q] * pa);
            o[2 * q + 1] = bfhi(gb[q]) * (w0[2 * q + 1] * pm2[2 * q + 1] + w1[2 * q + 1] * pm1[2 * q + 1] + w2[2 * q + 1] * pb);
            pm2[2 * q] = pm1[2 * q]; pm2[2 * q + 1] = pm1[2 * q + 1]; pm1[2 * q] = pa; pm1[2 * q + 1] = pb;
        }
        u32x4 wv; wv.x = cvt_pk_bf16(o[0], o[1]); wv.y = cvt_pk_bf16(o[2], o[3]); wv.z = cvt_pk_bf16(o[4], o[5]); wv.w = cvt_pk_bf16(o[6], o[7]);
        *(u32x4*)(ymix + (size_t)(t0 + i) * DMIX + 2048 + c0) = wv;
    }
}
__device__ void phase2(const Params& p, LAS unsigned char* lds, int wv) {
    const int G = gridDim.x, bid = blockIdx.x;
    const bool split = G >= 256;
    if (!split) bc_sequences(p, lds, bid, G, wv);
    if (!split || bid < 128) { for (int u = bid; u < 128; u += (split ? 128 : G)) ssd_unit(p, lds, u >> 5, u & 31, wv); }
    if (split && bid >= 128) bc_sequences(p, lds, bid - 128, G - 128, wv);
    if (!split || bid >= 128) { for (int u = (split ? bid - 128 : bid); u < M_ / 64; u += (split ? G - 128 : G)) sc_unit(p, u, wv); }
    if (!split || bid >= 128) wconv_units(p, lds, split ? bid - 128 : bid, split ? G - 128 : G, wv);
}

__device__ void phase6(const Params& p, int wv) {
    const int lane = lane_id(), wave = wv;
    const bf16_t* h2 = (const bf16_t*)(p.ws + WS_H1B);
    const float* ssq3 = (const float*)(p.ws + WS_SSQ3);
    for (int row = blockIdx.x * 8 + wave; row < M_; row += gridDim.x * 8) {
        float s = (lane < 32) ? ssq3[ssq_idx(row, lane)] : 0.f;
#pragma unroll
        for (int o = 32; o >= 1; o >>= 1) s += __shfl_xor(s, o);
        const float rstd = rsqrtf(s * (1.0f / 2048.0f) + EPS);
        const u32x2* hr = (const u32x2*)(h2 + (size_t)row * D_);
        f32x4* orow = (f32x4*)(p.out + (size_t)row * D_);
#pragma unroll
        for (int i = 0; i < 8; ++i) { const u32x2 hv = hr[lane + 64 * i]; const f32x4 v = (f32x4){bflo(hv.x), bfhi(hv.x), bflo(hv.y), bfhi(hv.y)}, g4 = ((const f32x4*)p.norm_final_g)[lane + 64 * i]; orow[lane + 64 * i] = v * rstd * g4; }
    }
}


#define XB_TMO      128
#define XB_XCNT(j)  (256  + 64 * (j))
#define XB_XSUB(j)  (1280 + 64 * (j))
#define XB_XGEN(j)  (2304 + 64 * (j))
#define XB_TOP      3328
#define XB_TOPGEN   3392
#define XCD_BAR_WORDS 3456
#define XB_SPIN_CAP (1u << 18)
__device__ __forceinline__ unsigned xb_ld(unsigned* p)              { return __hip_atomic_load(p, __ATOMIC_RELAXED, __HIP_MEMORY_SCOPE_AGENT); }
__device__ __forceinline__ unsigned xb_add(unsigned* p, unsigned v) { return __hip_atomic_fetch_add(p, v, __ATOMIC_RELAXED, __HIP_MEMORY_SCOPE_AGENT); }
__device__ __forceinline__ unsigned xb_xcc_id() { return (unsigned)__builtin_amdgcn_s_getreg((3 << 11) | 20) & 0xFu; }
#define XB_SPIN(cond, bar) do { unsigned _sp = 0; while (cond) { __builtin_amdgcn_s_sleep(1); \
    if ((++_sp & 255u) == 0u) { if (xb_ld(&(bar)[XB_TMO])) break; if (_sp > XB_SPIN_CAP) { atomicAdd(&(bar)[XB_TMO], 1u); break; } } } } while (0)
struct XcdBarrier { unsigned* bar; unsigned x; volatile LAS unsigned* st; };
__device__ __forceinline__ void xcd_barrier_complete(unsigned* bar, unsigned x, unsigned& nloc, unsigned& nx) {
    const unsigned G = gridDim.x * gridDim.y * gridDim.z;
    unsigned sum, cnt, mine, sp = 0u;
    for (;;) {
        sum = 0u; cnt = 0u; mine = 0u;
#pragma unroll
        for (unsigned j = 0; j < 16; ++j) { const unsigned c = xb_ld(&bar[XB_XCNT(j)]); sum += c; cnt += (c > 0u) ? 1u : 0u; mine = (j == x) ? c : mine; }
        if (sum == G) break;
        __builtin_amdgcn_s_sleep(1);
        if ((++sp & 255u) == 0u) { if (xb_ld(&bar[XB_TMO])) break; if (sp > XB_SPIN_CAP) { atomicAdd(&bar[XB_TMO], 1u); break; } }
    }
    nloc = mine > 0u ? mine : 1u; nx = cnt > 0u ? cnt : 1u;
}
__device__ __forceinline__ void xcd_barrier(const XcdBarrier& b, bool leader) {
    asm volatile("s_waitcnt vmcnt(0)" ::: "memory");
    __syncthreads();
    if (leader) {
        unsigned* bar = b.bar;
        __builtin_amdgcn_s_waitcnt(0);
        unsigned nloc = b.st[0], nx = b.st[1];
        if (nloc == 0u) { xcd_barrier_complete(bar, b.x, nloc, nx); b.st[0] = nloc; b.st[1] = nx; }
        const unsigned old = xb_add(&bar[XB_XSUB(b.x)], 1u);
        const unsigned gen = old / nloc;
        if (old + 1u == (gen + 1u) * nloc) {
            __builtin_amdgcn_fence(__ATOMIC_RELEASE, "agent");
            asm volatile("s_waitcnt vmcnt(0)" ::: "memory");
            const unsigned og = xb_add(&bar[XB_TOP], 1u);
            const unsigned tg = og / nx;
            if (og + 1u == (tg + 1u) * nx) xb_add(&bar[XB_TOPGEN], 1u);
            else XB_SPIN(xb_ld(&bar[XB_TOPGEN]) == tg, bar);
            __builtin_amdgcn_fence(__ATOMIC_ACQUIRE, "agent");
            xb_add(&bar[XB_XGEN(b.x)], 1u);
            asm volatile("s_waitcnt vmcnt(0)" ::: "memory");
        } else {
            XB_SPIN(xb_ld(&bar[XB_XGEN(b.x)]) == gen, bar);
            __builtin_amdgcn_fence(__ATOMIC_ACQUIRE, "agent");
            asm volatile("s_waitcnt vmcnt(0)" ::: "memory");
        }
    }
    __syncthreads();
}

__global__ void __launch_bounds__(512) hymba_fwd(Params p) {
    extern __shared__ __attribute__((aligned(16))) unsigned char shm[];
    LAS unsigned char* lds = (LAS unsigned char*)shm;
    cg::grid_group grid = cg::this_grid();
    const int lo = p.ph_lo, hi = p.ph_hi;
    const int wv = __builtin_amdgcn_readfirstlane(threadIdx.x >> 6);
#ifdef DBG_CLEAR
    for (int i = threadIdx.x; i < LDS_BYTES / 16; i += 512) *(LAS u32x4*)(lds + i * 16) = (u32x4){0u, 0u, 0u, 0u};
    __syncthreads();
#endif
#define IN(k) (lo <= (k) && (k) < hi)
#define SEAM(k) do { if (IN(k) && IN((k) + 1)) { \
        asm volatile("s_waitcnt vmcnt(0) lgkmcnt(0)" ::: "memory"); __syncthreads();                 \
        if (wv == 0) { __builtin_amdgcn_fence(__ATOMIC_RELEASE, "agent"); asm volatile("s_waitcnt vmcnt(0)" ::: "memory"); }     \
        grid.sync(); \
        if (wv == 0) { __builtin_amdgcn_fence(__ATOMIC_ACQUIRE, "agent"); asm volatile("s_waitcnt vmcnt(0)" ::: "memory"); }     \
        __syncthreads(); } } while (0)
    volatile LAS unsigned* xst = (volatile LAS unsigned*)(lds + LDS_BYTES - 16);
    const bool xlead = (wv == 0) && (lane_id() == 0);
    if (xlead) { xst[0] = 0u; xst[1] = 0u; }
    __syncthreads();
    XcdBarrier xb; xb.bar = (unsigned*)((unsigned char*)p.out + DO_XBAR); xb.x = xb_xcc_id(); xb.st = xst;
    if (xlead) (void)xb_add(&xb.bar[XB_XCNT(xb.x)], 1u);
#define XSEAM(k) do { if (IN(k) && IN((k) + 1)) xcd_barrier(xb, (wv == 0) && (lane_id() == 0)); } while (0)
    if (IN(0)) for (int rep = 0; rep < NREP(0); ++rep) phase0(p, lds, wv);
    XSEAM(0);
    if (IN(1)) for (int rep = 0; rep < NREP(1); ++rep) {
        pg8::Gemm g{(const bf16_t*)(p.ws + WS_XN), (const bf16_t*)(p.ws + WS_BTIN), M_, NPROJ, D_}; pg8::StaticOrder S; S.init(M_, NPROJ, gridDim.x, blockIdx.x);
        EpiProj E{(bf16_t*)(p.ws + WS_PROJ)};
        pg8::gemm_phase<EpiProj>(lds, g, S, E, wv);
        dt_units(p, lds, wv);
    }
    XSEAM(1);
    if (IN(3)) for (int rep = 0; rep < NREP(3); ++rep) phase2(p, lds, wv);
    XSEAM(3);
    if (IN(4)) for (int rep = 0; rep < NREP(4); ++rep) {
        pg8::Gemm g{(const bf16_t*)(p.ws + WS_YMIX), (const bf16_t*)((unsigned char*)p.out + DO_BTOUT), M_, D_, DMIX}; pg8::StaticOrder S; S.init(M_, D_, gridDim.x, blockIdx.x);
        EpiOut E{p.x, (bf16_t*)(p.ws + WS_H1B), (const float*)((unsigned char*)p.out + DO_SSQ1), (float*)((unsigned char*)p.out + DO_SSQ2)};
        pg8::gemm_phase<EpiOut>(lds, g, S, E, wv);
    }
    XSEAM(4);
    if (IN(5)) for (int rep = 0; rep < NREP(5); ++rep) {
        pg8::Gemm g{(const bf16_t*)(p.ws + WS_H1B), (const bf16_t*)((unsigned char*)p.out + DO_BTGU), M_, NGU, D_}; pg8::StaticOrder S; S.init(M_, NGU, gridDim.x, blockIdx.x);
        EpiGU E{(const float*)((unsigned char*)p.out + DO_SSQ2), (bf16_t*)(p.ws + WS_HFF)};
        pg8::gemm_phase<EpiGU>(lds, g, S, E, wv);
    }
    XSEAM(5);
    if (IN(6)) {
        pg8::Gemm g{(const bf16_t*)(p.ws + WS_HFF), (const bf16_t*)((unsigned char*)p.out + DO_BTDN), M_, D_, DFF}; pg8::StaticOrder S; S.init(M_, D_, gridDim.x, blockIdx.x);
        EpiDown E{(bf16_t*)(p.ws + WS_H1B), (float*)(p.ws + WS_SSQ3)};
        pg8::gemm_phase<EpiDown>(lds, g, S, E, wv);
    }
    XSEAM(6);
    if (p.ph_hi > 1000) grid.sync();
    if (IN(7)) for (int rep = 0; rep < NREP(7); ++rep) phase6(p, wv);
#undef IN
#undef SEAM
}

extern "C" void kernel_launch(void* const* d_in, const int* in_sizes, int n_in, void* d_out, int out_size, void* d_ws, size_t ws_size, hipStream_t stream) {
    static int grid = 0;
    if (grid == 0) {
        if (n_in != 16 || out_size != M_ * D_ || ws_size < WS_NEED) { fprintf(stderr, "kernel_launch: unexpected shapes (n_in %d out %d ws %zu, need %zu)\n", n_in, out_size, ws_size, (size_t)WS_NEED); grid = -1; return; }
        int dev = 0, cus = 0, per_cu = 0;
        (void)hipGetDevice(&dev);
        (void)hipDeviceGetAttribute(&cus, hipDeviceAttributeMultiprocessorCount, dev);
        if (hipFuncSetAttribute((const void*)hymba_fwd, hipFuncAttributeMaxDynamicSharedMemorySize, LDS_BYTES) != hipSuccess) { fprintf(stderr, "kernel_launch: hipFuncSetAttribute failed\n"); grid = -1; return; }
        if (hipOccupancyMaxActiveBlocksPerMultiprocessor(&per_cu, (const void*)hymba_fwd, 512, LDS_BYTES) != hipSuccess || per_cu < 1) { fprintf(stderr, "kernel_launch: occupancy query failed (%d)\n", per_cu); (void)hipGetLastError(); per_cu = 1; }
        grid = cus * per_cu;
    }
    if (grid < 0) return;
    Params p{};
    p.x = (const float*)d_in[0]; p.norm_mix_g = (const float*)d_in[1]; p.w_in = (const float*)d_in[2]; p.ssm_conv_w = (const float*)d_in[3]; p.ssm_conv_b = (const float*)d_in[4];
    p.ssm_dt_bias = (const float*)d_in[5]; p.ssm_A_log = (const float*)d_in[6]; p.ssm_D = (const float*)d_in[7]; p.ssm_norm_g = (const float*)d_in[8]; p.sc_conv_w = (const float*)d_in[9];
    p.w_out = (const float*)d_in[10]; p.norm_ffn_g = (const float*)d_in[11]; p.w_gate = (const float*)d_in[12]; p.w_up = (const float*)d_in[13]; p.w_down = (const float*)d_in[14]; p.norm_final_g = (const float*)d_in[15];
    p.out = (float*)d_out; p.ws = (unsigned char*)d_ws;
#ifdef DBG_MEMSET
    (void)hipMemsetAsync(d_ws, 0, WS_NEED, stream); (void)hipMemsetAsync(d_out, 0, (size_t)out_size * 4, stream);
#endif
#ifndef N_CUTS
#define N_CUTS 1
#endif
    for (int li = 0; li < N_CUTS; ++li) {
        p.ph_lo = (N_CUTS == 8) ? li : 0; p.ph_hi = (N_CUTS == 8) ? li + 1 : 8;
        (void)hipMemsetAsync((unsigned char*)d_out + DO_BCFLAG, 0, 4096 + XCD_BAR_WORDS * sizeof(unsigned), stream);
    void* args[] = {&p};
        hipError_t e = hipLaunchCooperativeKernel((const void*)hymba_fwd, dim3(grid), dim3(512), args, LDS_BYTES, stream);
        if (e != hipSuccess) fprintf(stderr, "kernel_launch: cooperative launch failed: %s (grid %d)\n", hipGetErrorString(e), grid);
    }
}
```

```cpp
#include <hip/hip_runtime.h>
#include <hip/hip_cooperative_groups.h>
#include <cstdio>
namespace cg = cooperative_groups;

#define LAS __attribute__((address_space(3)))
typedef unsigned short bf16_t;
typedef short bf16x8 __attribute__((ext_vector_type(8)));
typedef float f32x4 __attribute__((ext_vector_type(4)));
typedef unsigned u32x4 __attribute__((ext_vector_type(4)));
typedef unsigned u32x2 __attribute__((ext_vector_type(2)));

constexpr int M_ = 16384, D_ = 2048, DIN = 12320, NPROJ = 12288, DFF = 5632, DMIX = 4096, NGU = 11264;
constexpr int SEQ = 4096;
constexpr float EPS = 1e-5f;
constexpr int LDS_BYTES = 159744;
constexpr int XCD_BAR_WORDS_C = 3456;
#ifndef PROBE_PHASE
#define PROBE_PHASE -1
#endif
#define NREP(k) ((PROBE_PHASE == (k)) ? 1 + (p.ph_hi < 100) : 1)
constexpr int TAB_OFF = 131072;

constexpr size_t WS_PROJ = 0;
constexpr size_t WS_R = (size_t)M_ * NPROJ * 2;
constexpr size_t WS_XN = WS_R;
constexpr size_t WS_BTIN = WS_R + (size_t)M_ * D_ * 2;
constexpr size_t WS_YMIX = WS_R;
constexpr size_t WS_H1F = 0;
constexpr size_t WS_H1B = (size_t)M_ * D_ * 4;
constexpr size_t WS_HFF = WS_H1B + (size_t)M_ * D_ * 2;
constexpr size_t WS_SSQ3 = WS_HFF + (size_t)M_ * DFF * 2;
constexpr size_t WS_NEED = WS_R + (size_t)M_ * DMIX * 2;
constexpr size_t DO_BTOUT = 0;
constexpr size_t DO_BTGU = (size_t)D_ * DMIX * 2;
constexpr size_t DO_BTDN = DO_BTGU + (size_t)NGU * D_ * 2;
constexpr size_t DO_DT = DO_BTDN + (size_t)D_ * DFF * 2;
constexpr size_t DO_SSQ1 = DO_DT + (size_t)M_ * 32 * 4;
constexpr size_t DO_SSQ2 = DO_SSQ1 + (size_t)M_ * 32 * 4;
constexpr size_t DO_XBAR = (size_t)M_ * D_ * 4 - 16384;
constexpr size_t DO_BCFLAG = DO_XBAR - 4096;
static_assert(DO_SSQ2 + (size_t)M_ * 32 * 4 <= DO_BCFLAG && XCD_BAR_WORDS_C * 4 <= 16384, "d_out scratch");

static_assert(WS_SSQ3 + (size_t)M_ * 32 * 4 <= WS_R, "ws overlay");

struct Params {
    const float* x; const float* norm_mix_g; const float* w_in; const float* ssm_conv_w; const float* ssm_conv_b;
    const float* ssm_dt_bias; const float* ssm_A_log; const float* ssm_D; const float* ssm_norm_g; const float* sc_conv_w;
    const float* w_out; const float* norm_ffn_g; const float* w_gate; const float* w_up; const float* w_down; const float* norm_final_g;
    float* out; unsigned char* ws; int ph_lo, ph_hi;
};

typedef float f32x2_t __attribute__((ext_vector_type(2)));
typedef __bf16 bf16x2_t __attribute__((ext_vector_type(2)));
__device__ __forceinline__ unsigned cvt_pk_bf16(float lo, float hi) { const f32x2_t v = {lo, hi}; return __builtin_bit_cast(unsigned, __builtin_convertvector(v, bf16x2_t)); }
__device__ __forceinline__ float bflo(unsigned u) { return __uint_as_float(u << 16); }
__device__ __forceinline__ float bfhi(unsigned u) { return __uint_as_float(u & 0xffff0000u); }
__device__ __forceinline__ int lane_id() { int l; asm volatile("v_mbcnt_lo_u32_b32 %0, -1, 0\n\tv_mbcnt_hi_u32_b32 %0, -1, %0" : "=v"(l)); return l; }
__device__ __forceinline__ float silu_f(float v) { return v * __builtin_amdgcn_rcpf(1.0f + __expf(-v)); }

__device__ __forceinline__ size_t ssq_idx(int row, int part) { return ((size_t)(row >> 5) * 32 + part) * 32 + (row & 31); }

namespace pg8 {
constexpr int BM = 256, BK = 64, HALF = 128, HTB = HALF * BK * 2, STAGE_BYTES = 8 * HTB, NXCD = 8, WGM = 8;
__device__ __forceinline__ int lds_byte(int r, int c) { const int st = (r >> 4) * 2 + (c >> 5), rr = r & 15, cc = c & 31, ob = rr * 64 + cc * 2; return st * 1024 + (ob ^ (((ob >> 9) & 1) << 5)); }
__device__ __forceinline__ void stage_rc(int b, int& R, int& C) { const int st = b / 1024, sb = b % 1024, swz = sb ^ (((sb >> 9) & 1) << 5); R = (st >> 1) * 16 + swz / 64; C = (st & 1) * 32 + (swz % 64) / 2; }
__device__ __forceinline__ int perm32(int rho) { const int n = rho >> 4, i = rho & 15; return 8 * (i >> 2) + 4 * n + (i & 3); }
struct Unit { int pm, pn; };
struct Gemm { const bf16_t* A; const bf16_t* Bt; int M, N, K; };
struct StaticOrder {
    int nM, nN, nwg, G, c, rot = 0, nrounds = 1;
    __device__ void init(int M, int N, int G_, int c_) { nM = M / BM; nN = N / BM; nwg = nM * nN; G = G_; c = c_; }
    __device__ bool next(int i, Unit& u) const {
        if (rot != 0 && i < nrounds) i = (i + rot) % nrounds;
        const long L = (long)i * G + c; if (L >= nwg) return false;
        int wgid = (int)L; { const int q = nwg / NXCD, r = nwg % NXCD, xcd = wgid % NXCD, off = wgid / NXCD; wgid = (xcd < r ? xcd * (q + 1) : r * (q + 1) + (xcd - r) * q) + off; }
        const int nig = WGM * nN, gid = wgid / nig, fm = gid * WGM, gsz = (nM - fm) < WGM ? (nM - fm) : WGM;
        u.pm = fm + ((wgid % nig) % gsz); u.pn = (wgid % nig) / gsz; return true;
    }
};
template <class Epi>
__device__ __forceinline__ void gemm_phase(LAS unsigned char* lds, const Gemm g, const StaticOrder& S, const Epi& E, int wv) {
    const int wid = wv, lane = lane_id(), tid = wid * 64 + lane, wr = wid >> 2, wc = wid & 3, fr = lane & 15, fq = lane >> 4;
    const int K = g.K, nt = K / BK;
    unsigned voffA[2], voffB[2];
#pragma unroll
    for (int i = 0; i < 2; ++i) { int R, C; stage_rc(tid * 16 + i * 8192, R, C); const int Rb = (R & ~31) + perm32(R & 31);
        voffA[i] = (unsigned)(R * K + C) * 2u; voffB[i] = (unsigned)(Rb * K + C) * 2u; }
    const size_t kstep = (size_t)(BK * 2);
    const size_t hstep = (size_t)HALF * K * 2;
    const size_t tstep = 2 * hstep;
    const unsigned ldsw = (unsigned)wid * 1024u;
    const int aoff = lds_byte(wr * 64 + fr, fq * 8), boff = lds_byte(wc * 32 + fr, fq * 8);
#define PG8_SA(b, h) (((b) * 2 + (h)) * HTB)
#define PG8_SB(b, h) ((4 + (b) * 2 + (h)) * HTB)
#define PG8_STAGE(bufoff, gbase, voff) do { _Pragma("unroll") for (int _i = 0; _i < 2; ++_i) \
        __builtin_amdgcn_global_load_lds((const unsigned*)((const char*)(gbase) + (voff)[_i]), (LAS unsigned*)(lds + (bufoff) + ldsw + _i * 8192), 16, 0, 0); } while (0)
#define PG8_LDA(dst, b, h) do { _Pragma("unroll") for (int m = 0; m < 4; ++m) _Pragma("unroll") for (int k = 0; k < 2; ++k) dst[m][k] = *(const LAS bf16x8*)(lds + PG8_SA(b, h) + aoff + m * 2048 + k * 1024); } while (0)
#define PG8_LDB(dst, b, h) do { _Pragma("unroll") for (int n = 0; n < 2; ++n) _Pragma("unroll") for (int k = 0; k < 2; ++k) dst[n][k] = *(const LAS bf16x8*)(lds + PG8_SB(b, h) + boff + n * 2048 + k * 1024); } while (0)
#define PG8_MMA(ai, bj, At, Bt) do { __builtin_amdgcn_s_setprio(1); _Pragma("unroll") for (int m = 0; m < 4; ++m) _Pragma("unroll") for (int n = 0; n < 2; ++n) _Pragma("unroll") for (int k = 0; k < 2; ++k) \
        acc[ai][bj][m][n] = __builtin_amdgcn_mfma_f32_16x16x32_bf16(Bt[n][k], At[m][k], acc[ai][bj][m][n], 0, 0, 0); __builtin_amdgcn_s_setprio(0); } while (0)
#define PG8_WAIT_V(n) asm volatile("s_waitcnt vmcnt(" #n ")" ::: "memory")
#define PG8_WAIT_L(n) asm volatile("s_waitcnt lgkmcnt(" #n ")" ::: "memory")
#define PG8_BAR __builtin_amdgcn_s_barrier()
#define PG8_SCHED __builtin_amdgcn_sched_barrier(0)
    Unit cur, nxt; int ui = 0;
    if (!S.next(0, cur)) return;
    f32x4 acc[2][2][4][2];
#pragma unroll
    for (int a = 0; a < 2; ++a)
#pragma unroll
        for (int b = 0; b < 2; ++b)
#pragma unroll
            for (int m = 0; m < 4; ++m)
#pragma unroll
                for (int n = 0; n < 2; ++n) acc[a][b][m][n] = (f32x4){0.f, 0.f, 0.f, 0.f};
    bf16x8 At[4][2], B0[2][2], B1[2][2];
    const char* cA = (const char*)g.A + (size_t)cur.pm * tstep; const char* cB = (const char*)g.Bt + (size_t)cur.pn * tstep;
    if constexpr (Epi::HAS_TAB) {
        Unit uu; for (int i = 0; i < 27 && S.next(i, uu); ++i) E.prep(uu, (LAS float*)(lds + TAB_OFF + i * 1024), tid);
    }
    PG8_STAGE(PG8_SB(0, 0), cB, voffB); PG8_STAGE(PG8_SB(0, 1), cB + hstep, voffB); PG8_STAGE(PG8_SA(0, 0), cA, voffA); PG8_STAGE(PG8_SA(0, 1), cA + hstep, voffA);
    if (wr == 1) PG8_BAR;
    PG8_WAIT_V(2); PG8_BAR;
    PG8_STAGE(PG8_SB(1, 0), cB + kstep, voffB); PG8_STAGE(PG8_SA(1, 0), cA + kstep, voffA); PG8_STAGE(PG8_SB(1, 1), cB + hstep + kstep, voffB);
    PG8_WAIT_V(6); PG8_BAR;
    for (;;) {
        const bool has_next = S.next(ui + 1, nxt);
        const char* nA = has_next ? (const char*)g.A + (size_t)nxt.pm * tstep : cA; const char* nB = has_next ? (const char*)g.Bt + (size_t)nxt.pn * tstep : cB;
        LAS const float* tabc = (LAS const float*)(lds + TAB_OFF + ui * 1024);
        for (int t = 0; t < nt; t += 2) {
            const bool last = (t == nt - 2);
            const char* a1 = cA + (size_t)(t + 1) * kstep;
            const char* a2 = last ? nA : cA + (size_t)(t + 2) * kstep; const char* b2 = last ? nB : cB + (size_t)(t + 2) * kstep;
            const char* a3 = a2 + kstep; const char* b3 = b2 + kstep;
            if constexpr (Epi::MID_T >= 0) { if (t == Epi::MID_T) {
#pragma unroll
                for (int ai = 0; ai < 2; ++ai)
#pragma unroll
                    for (int m = 0; m < 4; ++m) { const float s = tabc[ai * HALF + wr * 64 + m * 16 + fr];
#pragma unroll
                        for (int bj = 0; bj < 2; ++bj)
#pragma unroll
                            for (int n = 0; n < 2; ++n) acc[ai][bj][m][n] *= s; } } }
            PG8_LDB(B0, 0, 0); PG8_LDB(B1, 0, 1); PG8_SCHED; PG8_LDA(At, 0, 0); PG8_STAGE(PG8_SA(1, 1), a1 + hstep, voffA);
            PG8_WAIT_V(8); PG8_WAIT_L(0); PG8_BAR; PG8_MMA(0, 0, At, B0); PG8_MMA(0, 1, At, B1); PG8_BAR; PG8_SCHED;
            PG8_LDA(At, 0, 1); PG8_STAGE(PG8_SB(0, 0), b2, voffB); PG8_STAGE(PG8_SB(0, 1), b2 + hstep, voffB); PG8_STAGE(PG8_SA(0, 0), a2, voffA);
            PG8_WAIT_V(8); PG8_WAIT_L(0); PG8_BAR; PG8_MMA(1, 0, At, B0); PG8_MMA(1, 1, At, B1); PG8_BAR; PG8_SCHED;
            PG8_LDB(B0, 1, 0); PG8_LDB(B1, 1, 1); PG8_SCHED; PG8_LDA(At, 1, 0); PG8_STAGE(PG8_SA(0, 1), a2 + hstep, voffA);
            PG8_WAIT_V(8); PG8_WAIT_L(0); PG8_BAR; PG8_MMA(0, 0, At, B0); PG8_MMA(0, 1, At, B1); PG8_BAR; PG8_SCHED;
            PG8_LDA(At, 1, 1); PG8_STAGE(PG8_SB(1, 0), b3, voffB); PG8_STAGE(PG8_SB(1, 1), b3 + hstep, voffB); PG8_STAGE(PG8_SA(1, 0), a3, voffA);
            PG8_WAIT_V(8); PG8_WAIT_L(0); PG8_BAR; PG8_MMA(1, 0, At, B0); PG8_MMA(1, 1, At, B1); PG8_BAR; PG8_SCHED;
        }
        if (wr == 0) PG8_BAR;
        E(acc, cur, tabc, wr, wc, fr, fq);
        if (!has_next) break;
#pragma unroll
        for (int a = 0; a < 2; ++a)
#pragma unroll
            for (int b = 0; b < 2; ++b)
#pragma unroll
                for (int m = 0; m < 4; ++m)
#pragma unroll
                    for (int n = 0; n < 2; ++n) acc[a][b][m][n] = (f32x4){0.f, 0.f, 0.f, 0.f};
        cur = nxt; cA = nA; cB = nB; ++ui;
        if (wr == 1) PG8_BAR;
    }
    PG8_WAIT_V(0);
    PG8_BAR;
#undef PG8_SA
#undef PG8_SB
#undef PG8_STAGE
#undef PG8_LDA
#undef PG8_LDB
#undef PG8_MMA
#undef PG8_WAIT_V
#undef PG8_WAIT_L
#undef PG8_BAR
#undef PG8_SCHED
}
}

__device__ __forceinline__ void rstd_table(const float* ssq, int row0, LAS float* tab, int t) {
    const int r = t >> 1, hf = t & 1;
    const float* p = ssq + ssq_idx(row0 + r, hf * 16);
    float s = 0.f;
#pragma unroll
    for (int i = 0; i < 16; ++i) s += p[i * 32];
    s += __shfl_xor(s, 1);
    if (!hf) tab[r] = rsqrtf(s * (1.0f / 2048.0f) + EPS);
}

struct EpiProj {
    static constexpr bool HAS_TAB = false; static constexpr int MID_T = -1;
    bf16_t* O;
    __device__ __forceinline__ void prep(const pg8::Unit&, LAS float*, int) const {}
    __device__ __forceinline__ void operator()(const f32x4 (&acc)[2][2][4][2], const pg8::Unit& u, LAS const float*, int wr, int wc, int fr, int fq) const {
        const int row0 = u.pm * 256 + wr * 64 + fr, col0 = u.pn * 256 + wc * 32 + 8 * fq;
        if (u.pn >= 32) {
            const int pcol = 8192 + (u.pn - 32) * 128 + wc * 32 + 8 * fq;
#pragma unroll
            for (int ai = 0; ai < 2; ++ai)
#pragma unroll
                for (int m = 0; m < 4; ++m) { const f32x4 v0 = acc[ai][0][m][0] * acc[ai][1][m][0], v1 = acc[ai][0][m][1] * acc[ai][1][m][1];
                    u32x4 w; w.x = cvt_pk_bf16(v0[0], v0[1]); w.y = cvt_pk_bf16(v0[2], v0[3]); w.z = cvt_pk_bf16(v1[0], v1[1]); w.w = cvt_pk_bf16(v1[2], v1[3]);
                    *(u32x4*)(O + (size_t)(row0 + ai * 128 + m * 16) * NPROJ + pcol) = w; }
            return;
        }
#pragma unroll
        for (int ai = 0; ai < 2; ++ai)
#pragma unroll
            for (int m = 0; m < 4; ++m) { bf16_t* rowp = O + (size_t)(row0 + ai * 128 + m * 16) * NPROJ + col0;
#pragma unroll
                for (int bj = 0; bj < 2; ++bj) { const f32x4 v0 = acc[ai][bj][m][0], v1 = acc[ai][bj][m][1];
                    u32x4 w; w.x = cvt_pk_bf16(v0[0], v0[1]); w.y = cvt_pk_bf16(v0[2], v0[3]); w.z = cvt_pk_bf16(v1[0], v1[1]); w.w = cvt_pk_bf16(v1[2], v1[3]);
                    *(u32x4*)(rowp + bj * 128) = w; } }
    }
};
struct EpiOut {
    static constexpr bool HAS_TAB = true; static constexpr int MID_T = 32;
    const float* x; bf16_t* h1b; const float* ssq1; float* ssq2;
    __device__ __forceinline__ void prep(const pg8::Unit& u, LAS float* tab, int t) const { rstd_table(ssq1, u.pm * 256, tab, t); }
    __device__ __forceinline__ void operator()(const f32x4 (&acc)[2][2][4][2], const pg8::Unit& u, LAS const float*, int wr, int wc, int fr, int fq) const {
        const int row0 = u.pm * 256 + wr * 64 + fr, col0 = u.pn * 256 + wc * 32 + 8 * fq;
#pragma unroll
        for (int ai = 0; ai < 2; ++ai)
#pragma unroll
            for (int m = 0; m < 4; ++m) { const int row = row0 + ai * 128 + m * 16; const size_t off = (size_t)row * D_ + col0; float ss = 0.f;
#pragma unroll
                for (int bj = 0; bj < 2; ++bj) {
                    const f32x4 x0 = *(const f32x4*)(x + off + bj * 128), x1 = *(const f32x4*)(x + off + bj * 128 + 4);
                    const f32x4 v0 = acc[ai][bj][m][0] + x0, v1 = acc[ai][bj][m][1] + x1;
                    u32x4 w; w.x = cvt_pk_bf16(v0[0], v0[1]); w.y = cvt_pk_bf16(v0[2], v0[3]); w.z = cvt_pk_bf16(v1[0], v1[1]); w.w = cvt_pk_bf16(v1[2], v1[3]);
                    *(u32x4*)(h1b + off + bj * 128) = w;
                    ss += (v0[0] * v0[0] + v0[1] * v0[1]) + (v0[2] * v0[2] + v0[3] * v0[3]) + (v1[0] * v1[0] + v1[1] * v1[1]) + (v1[2] * v1[2] + v1[3] * v1[3]); }
                ss += __shfl_xor(ss, 16); ss += __shfl_xor(ss, 32);
                if (fq == 0) ssq2[ssq_idx(row, u.pn * 4 + wc)] = ss; }
    }
};
struct EpiGU {
    static constexpr bool HAS_TAB = true; static constexpr int MID_T = -1;
    const float* ssq2; bf16_t* hff;
    __device__ __forceinline__ void prep(const pg8::Unit& u, LAS float* tab, int t) const { rstd_table(ssq2, u.pm * 256, tab, t); }
    __device__ __forceinline__ void operator()(const f32x4 (&acc)[2][2][4][2], const pg8::Unit& u, LAS const float* tab, int wr, int wc, int fr, int fq) const {
        const int row0 = u.pm * 256 + wr * 64 + fr, col0 = u.pn * 128 + wc * 32 + 8 * fq;
#pragma unroll
        for (int ai = 0; ai < 2; ++ai)
#pragma unroll
            for (int m = 0; m < 4; ++m) { const float rs = tab[ai * 128 + wr * 64 + m * 16 + fr];
                float o[8];
#pragma unroll
                for (int n = 0; n < 2; ++n)
#pragma unroll
                    for (int j = 0; j < 4; ++j) { const float gg = acc[ai][0][m][n][j] * rs, uu = acc[ai][1][m][n][j] * rs; o[n * 4 + j] = silu_f(gg) * uu; }
                u32x4 w; w.x = cvt_pk_bf16(o[0], o[1]); w.y = cvt_pk_bf16(o[2], o[3]); w.z = cvt_pk_bf16(o[4], o[5]); w.w = cvt_pk_bf16(o[6], o[7]);
                *(u32x4*)(hff + (size_t)(row0 + ai * 128 + m * 16) * DFF + col0) = w; }
    }
};
struct EpiDown {
    static constexpr bool HAS_TAB = false; static constexpr int MID_T = -1;
    bf16_t* h; float* ssq3;
    __device__ __forceinline__ void prep(const pg8::Unit&, LAS float*, int) const {}
    __device__ __forceinline__ void operator()(const f32x4 (&acc)[2][2][4][2], const pg8::Unit& u, LAS const float*, int wr, int wc, int fr, int fq) const {
        const int row0 = u.pm * 256 + wr * 64 + fr, col0 = u.pn * 256 + wc * 32 + 8 * fq;
#pragma unroll
        for (int ai = 0; ai < 2; ++ai)
#pragma unroll
            for (int m = 0; m < 4; ++m) { const int row = row0 + ai * 128 + m * 16; const size_t off = (size_t)row * D_ + col0; float ss = 0.f;
#pragma unroll
                for (int bj = 0; bj < 2; ++bj) {
                    const u32x4 xb = *(const u32x4*)(h + off + bj * 128);
                    const f32x4 x0 = (f32x4){bflo(xb.x), bfhi(xb.x), bflo(xb.y), bfhi(xb.y)}, x1 = (f32x4){bflo(xb.z), bfhi(xb.z), bflo(xb.w), bfhi(xb.w)};
                    const f32x4 v0 = acc[ai][bj][m][0] + x0, v1 = acc[ai][bj][m][1] + x1;
                    u32x4 w; w.x = cvt_pk_bf16(v0[0], v0[1]); w.y = cvt_pk_bf16(v0[2], v0[3]); w.z = cvt_pk_bf16(v1[0], v1[1]); w.w = cvt_pk_bf16(v1[2], v1[3]);
                    *(u32x4*)(h + off + bj * 128) = w;
                    ss += (v0[0] * v0[0] + v0[1] * v0[1]) + (v0[2] * v0[2] + v0[3] * v0[3]) + (v1[0] * v1[0] + v1[1] * v1[1]) + (v1[2] * v1[2] + v1[3] * v1[3]); }
                ss += __shfl_xor(ss, 16); ss += __shfl_xor(ss, 32);
                if (fq == 0) ssq3[ssq_idx(row, u.pn * 4 + wc)] = ss; }
    }
};

__device__ __forceinline__ void p0_tile(LAS float* t, const float* src, int ldsrc, int k0, int c0, int jvalid, bf16_t* dst, int K, int j0, const float* scale, int scale_kmax, int tid) {
    const int jc4 = (tid & 15) * 4, kr0 = tid >> 4;
#pragma unroll
    for (int i = 0; i < 4; ++i) {
        const int kr = kr0 + 32 * i;
        f32x4 v = (f32x4){0.f, 0.f, 0.f, 0.f};
        if (jc4 < jvalid) v = *(const f32x4*)(src + (size_t)(k0 + kr) * ldsrc + c0 + jc4);
        const float s = (scale != nullptr && (k0 + kr) < scale_kmax) ? scale[k0 + kr] : 1.0f;
        t[kr * 65 + jc4 + 0] = v[0] * s; t[kr * 65 + jc4 + 1] = v[1] * s; t[kr * 65 + jc4 + 2] = v[2] * s; t[kr * 65 + jc4 + 3] = v[3] * s;
    }
    __syncthreads();
    const int kp = (tid & 63) * 2, jr0 = tid >> 6;
#pragma unroll
    for (int i = 0; i < 8; ++i) {
        const int j = jr0 + 8 * i;
        if (j < jvalid) { const float a = t[kp * 65 + j], b = t[(kp + 1) * 65 + j];
            *(unsigned*)(dst + (size_t)(j0 + j) * K + k0 + kp) = cvt_pk_bf16(a, b); }
    }
    __syncthreads();
}
struct TileD { const float* src; const float* scale; bf16_t* dst; int ldsrc, k0, c0, jvalid, K, j0, kmax; };
__device__ __forceinline__ TileD tile_decode(const Params& p, int u) {
    constexpr int U_IN = 16 * 193, U_OUT = 32 * 32, U_GU = 16 * 176;
    TileD d;
    if (u < U_IN) { const int kt = u & 15, jt = u >> 4, j0 = jt * 64;
        d.src = p.w_in; d.scale = nullptr; d.dst = (bf16_t*)(p.ws + WS_BTIN); d.ldsrc = DIN; d.k0 = kt * 128; d.c0 = j0 < 6144 ? j0 : (j0 < 8192 ? j0 + 32 : (j0 < 12288 ? (((j0 & 255) < 128 ? 8224 : 10272 - 128) + 128 * ((j0 - 8192) >> 8) + (j0 & 255)) : 6144));     d.jvalid = (jt == 192) ? 32 : 64; d.K = D_; d.j0 = j0; d.kmax = 0; }
    else if (u < U_IN + U_OUT) { const int v = u - U_IN, kt = v & 31, jt = v >> 5;
        d.src = p.w_out; d.scale = p.ssm_norm_g; d.dst = (bf16_t*)((unsigned char*)p.out + DO_BTOUT); d.ldsrc = D_; d.k0 = kt * 128; d.c0 = jt * 64; d.jvalid = 64; d.K = DMIX; d.j0 = jt * 64; d.kmax = 2048; }
    else if (u < U_IN + U_OUT + U_GU) { const int v = u - U_IN - U_OUT, kt = v & 15, jt = v >> 4, j0 = jt * 64, pn = j0 >> 8, r0 = j0 & 255;
        d.src = r0 < 128 ? p.w_gate : p.w_up; d.scale = p.norm_ffn_g; d.dst = (bf16_t*)((unsigned char*)p.out + DO_BTGU); d.ldsrc = DFF; d.k0 = kt * 128; d.c0 = 128 * pn + (r0 & 127); d.jvalid = 64; d.K = D_; d.j0 = j0; d.kmax = 2048; }
    else { const int v = u - U_IN - U_OUT - U_GU, kt = v % 44, jt = v / 44;
        d.src = p.w_down; d.scale = nullptr; d.dst = (bf16_t*)((unsigned char*)p.out + DO_BTDN); d.ldsrc = D_; d.k0 = kt * 128; d.c0 = jt * 64; d.jvalid = 64; d.K = DFF; d.j0 = jt * 64; d.kmax = 0; }
    return d;
}
__device__ __forceinline__ void tile_load(const TileD& d, int tid, f32x4 (&v)[4], float (&scl)[4]) {
    const int jc4 = (tid & 15) * 4, kr0 = tid >> 4;
#pragma unroll
    for (int i = 0; i < 4; ++i) { const int kr = kr0 + 32 * i;
        f32x4 x = (f32x4){0.f, 0.f, 0.f, 0.f};
        if (jc4 < d.jvalid) x = *(const f32x4*)(d.src + (size_t)(d.k0 + kr) * d.ldsrc + d.c0 + jc4);
        scl[i] = (d.scale != nullptr && (d.k0 + kr) < d.kmax) ? d.scale[d.k0 + kr] : 1.0f;
        v[i] = x; }
}
__device__ __forceinline__ void tile_finish(LAS float* t, const TileD& d, int tid, const f32x4 (&v)[4], const float (&scl)[4]) {
    const int jc4 = (tid & 15) * 4, kr0 = tid >> 4;
#pragma unroll
    for (int i = 0; i < 4; ++i) { const int kr = kr0 + 32 * i;
        t[kr * 65 + jc4 + 0] = v[i][0] * scl[i]; t[kr * 65 + jc4 + 1] = v[i][1] * scl[i]; t[kr * 65 + jc4 + 2] = v[i][2] * scl[i]; t[kr * 65 + jc4 + 3] = v[i][3] * scl[i]; }
    asm volatile("s_waitcnt lgkmcnt(0)" ::: "memory"); __builtin_amdgcn_s_barrier(); asm volatile("" ::: "memory");
    const int kp = (tid & 63) * 2, jr0 = tid >> 6;
#pragma unroll
    for (int i = 0; i < 8; ++i) { const int j = jr0 + 8 * i;
        if (j < d.jvalid) { const float a = t[kp * 65 + j], b = t[(kp + 1) * 65 + j];
            *(unsigned*)(d.dst + (size_t)(d.j0 + j) * d.K + d.k0 + kp) = cvt_pk_bf16(a, b); } }
    asm volatile("s_waitcnt lgkmcnt(0)" ::: "memory"); __builtin_amdgcn_s_barrier(); asm volatile("" ::: "memory");
}
__device__ __forceinline__ void conv_tiles(const Params& p, LAS unsigned char* lds, int u_begin, int u_end, int first, int stride, int tid) {
    LAS float* t = (LAS float*)lds;
    int u = u_begin + first;
    if (u >= u_end) return;
    TileD d = tile_decode(p, u); f32x4 v[4]; float sc[4]; tile_load(d, tid, v, sc);
    for (;;) {
        const int un = u + stride; const bool more = un < u_end;
        TileD dn = d; f32x4 vn[4]; float scn[4];
#pragma unroll
        for (int i = 0; i < 4; ++i) { vn[i] = v[i]; scn[i] = sc[i]; }
        if (more) { dn = tile_decode(p, un); tile_load(dn, tid, vn, scn); }
        tile_finish(t, d, tid, v, sc);
        if (!more) break;
        d = dn; u = un;
#pragma unroll
        for (int i = 0; i < 4; ++i) { v[i] = vn[i]; sc[i] = scn[i]; }
    }
}
__device__ void phase0(const Params& p, LAS unsigned char* lds, int wv) {
    const int lane = lane_id(), wave = wv, tid = wv * 64 + lane, G = gridDim.x;
    LAS float* t = (LAS float*)lds;
    bf16_t* bt_in = (bf16_t*)(p.ws + WS_BTIN);
    bf16_t* xn = (bf16_t*)(p.ws + WS_XN);
    for (int row = blockIdx.x * 8 + wave; row < M_; row += G * 8) {
        const f32x4* xr = (const f32x4*)(p.x + (size_t)row * D_);
        f32x4 v[8]; float ss = 0.f;
#pragma unroll
        for (int i = 0; i < 8; ++i) { v[i] = xr[lane + 64 * i]; ss += (v[i][0] * v[i][0] + v[i][1] * v[i][1]) + (v[i][2] * v[i][2] + v[i][3] * v[i][3]); }
#pragma unroll
        for (int o = 32; o >= 1; o >>= 1) ss += __shfl_xor(ss, o);
        const float rstd = rsqrtf(ss * (1.0f / 2048.0f) + EPS);
#pragma unroll
        for (int i = 0; i < 8; ++i) { const f32x4 g4 = ((const f32x4*)p.norm_mix_g)[lane + 64 * i];
            u32x2 w; w.x = cvt_pk_bf16(v[i][0] * rstd * g4[0], v[i][1] * rstd * g4[1]); w.y = cvt_pk_bf16(v[i][2] * rstd * g4[2], v[i][3] * rstd * g4[3]);
            *(u32x2*)(xn + (size_t)row * D_ + 4 * (lane + 64 * i)) = w; }
    }
    __syncthreads();
    conv_tiles(p, lds, 0, 16 * 193, blockIdx.x, G, tid);
}
__device__ void wconv_units(const Params& p, LAS unsigned char* lds, int first, int stride, int wv) {
    const int tid = wv * 64 + lane_id();
    __syncthreads();
    conv_tiles(p, lds, 16 * 193, 16 * 193 + 32 * 32 + 16 * 176 + 44 * 32, first, stride, tid);
}

__device__ void dt_units(const Params& p, LAS unsigned char* lds, int wv) {
    const int lane = lane_id(), w = wv, tid = wv * 64 + lane, fr = lane & 15, fq = lane >> 4;
    const bf16_t* xn = (const bf16_t*)(p.ws + WS_XN);
    const bf16_t* bt = (const bf16_t*)(p.ws + WS_BTIN) + (size_t)NPROJ * D_;
    float* dt = (float*)((unsigned char*)p.out + DO_DT);
    LAS float* red = (LAS float*)lds;
    for (int rb = blockIdx.x; rb < M_ / 64; rb += gridDim.x) {
        const int row0 = rb * 64;
        f32x4 acc[4][2];
#pragma unroll
        for (int m = 0; m < 4; ++m)
#pragma unroll
            for (int n = 0; n < 2; ++n) acc[m][n] = (f32x4){0.f, 0.f, 0.f, 0.f};
#pragma unroll 4
        for (int ks = 0; ks < 8; ++ks) {
            const int kb = w * 256 + ks * 32 + fq * 8;
            bf16x8 a[4], b[2];
#pragma unroll
            for (int m = 0; m < 4; ++m) a[m] = *(const bf16x8*)(xn + (size_t)(row0 + 16 * m + fr) * D_ + kb);
#pragma unroll
            for (int n = 0; n < 2; ++n) b[n] = *(const bf16x8*)(bt + (size_t)(16 * n + fr) * D_ + kb);
#pragma unroll
            for (int m = 0; m < 4; ++m)
#pragma unroll
                for (int n = 0; n < 2; ++n) acc[m][n] = __builtin_amdgcn_mfma_f32_16x16x32_bf16(a[m], b[n], acc[m][n], 0, 0, 0);
        }
#pragma unroll
        for (int m = 0; m < 4; ++m)
#pragma unroll
            for (int n = 0; n < 2; ++n)
#pragma unroll
                for (int j = 0; j < 4; ++j) red[w * 2048 + (16 * m + 4 * fq + j) * 32 + 16 * n + fr] = acc[m][n][j];
        __syncthreads();
        {
            const int idx = tid * 4, r = idx >> 5, c = idx & 31;
            f32x4 s = (f32x4){0.f, 0.f, 0.f, 0.f};
#pragma unroll
            for (int ww = 0; ww < 8; ++ww) s += *(LAS const f32x4*)(red + ww * 2048 + idx);
            const f32x4 bias = *(const f32x4*)(p.ssm_dt_bias + c);
            f32x4 o;
#pragma unroll
            for (int j = 0; j < 4; ++j) { const float v = s[j] + bias[j]; o[j] = v > 20.f ? v : log1pf(expf(v)); }
            *(f32x4*)(dt + (size_t)(row0 + r) * 32 + c) = o;
        }
        __syncthreads();
    }
}

__device__ void bc_sequences(const Params& p, LAS unsigned char* lds, int first, int stride, int wv) {
    const int tid = wv * 64 + lane_id(), cv = tid & 7, run = tid >> 3;
    bf16_t* proj = (bf16_t*)(p.ws + WS_PROJ);
    LAS u32x4* stash = (LAS u32x4*)lds;
    unsigned* bcflag = (unsigned*)((unsigned char*)p.out + DO_BCFLAG);
    for (int sq = first; sq < 4 * 32; sq += stride) {
        const int b = sq >> 5, slab = sq & 31;
        const int xcol = 2048 + slab * 64 + cv * 8;
        float wk[4][8], bs[8];
#pragma unroll
        for (int k = 0; k < 4; ++k) { const f32x4 a = *(const f32x4*)(p.ssm_conv_w + k * 4096 + xcol), c = *(const f32x4*)(p.ssm_conv_w + k * 4096 + xcol + 4);
#pragma unroll
            for (int j = 0; j < 4; ++j) { wk[k][j] = a[j]; wk[k][4 + j] = c[j]; } }
        { const f32x4 a = *(const f32x4*)(p.ssm_conv_b + xcol), c = *(const f32x4*)(p.ssm_conv_b + xcol + 4);
#pragma unroll
          for (int j = 0; j < 4; ++j) { bs[j] = a[j]; bs[4 + j] = c[j]; } }
        __syncthreads();
#pragma unroll 1
        for (int tile = 0; tile < 8; ++tile) {
            bf16_t* base = proj + (size_t)(b * SEQ + tile * 512 + run * 8) * NPROJ + 2048 + xcol;
            u32x4 raw[11];
#pragma unroll
            for (int r = 0; r < 11; ++r) {
                const int row = run * 8 + r - 3;
                if (row >= 0) raw[r] = *(const u32x4*)(base + (long)(r - 3) * NPROJ);
                else raw[r] = (tile == 0) ? (u32x4){0u, 0u, 0u, 0u} : stash[(row + 3) * 8 + cv];
            }
            u32x4 ov[8];
#pragma unroll
            for (int j = 0; j < 8; ++j) {
                float o[8];
#pragma unroll
                for (int q = 0; q < 4; ++q) {
                    const unsigned x0 = raw[j][q], x1 = raw[j + 1][q], x2 = raw[j + 2][q], x3 = raw[j + 3][q];
                    o[2 * q] = silu_f(bs[2 * q] + wk[0][2 * q] * bflo(x0) + wk[1][2 * q] * bflo(x1) + wk[2][2 * q] * bflo(x2) + wk[3][2 * q] * bflo(x3));
                    o[2 * q + 1] = silu_f(bs[2 * q + 1] + wk[0][2 * q + 1] * bfhi(x0) + wk[1][2 * q + 1] * bfhi(x1) + wk[2][2 * q + 1] * bfhi(x2) + wk[3][2 * q + 1] * bfhi(x3));
                }
                ov[j].x = cvt_pk_bf16(o[0], o[1]); ov[j].y = cvt_pk_bf16(o[2], o[3]); ov[j].z = cvt_pk_bf16(o[4], o[5]); ov[j].w = cvt_pk_bf16(o[6], o[7]);
            }
            asm volatile("s_waitcnt vmcnt(0) lgkmcnt(0)" ::: "memory");
            __syncthreads();
            if (run == 63) { stash[0 * 8 + cv] = raw[8]; stash[1 * 8 + cv] = raw[9]; stash[2 * 8 + cv] = raw[10]; }
#pragma unroll
            for (int j = 0; j < 8; ++j) { const bf16_t* q = base + (long)j * NPROJ;
                asm volatile("global_store_dwordx4 %0, %1, off sc1" :: "v"(q), "v"(ov[j]) : "memory"); }
            asm volatile("s_waitcnt vmcnt(0) lgkmcnt(0)" ::: "memory");
            __syncthreads();
            if (wv == 0) {
                if (lane_id() == 0) __hip_atomic_store(bcflag + sq, (unsigned)(tile + 1), __ATOMIC_RELAXED, __HIP_MEMORY_SCOPE_AGENT);
            }
        }
    }
}

constexpr int SROW = 272;
constexpr int L_CM = 0, L_BM = 34816, L_BDT = 69632, L_XT = 104448, L_HB = 121856  , L_CS = 156672, L_DT = 157184, L_CW = 157696  ;
__device__ __forceinline__ int swz_off(int row, int kblk) { return row * SROW + ((kblk ^ ((row >> 3) & 7)) << 4); }
__device__ __forceinline__ void ssd_load(u32x4 (&raw)[5], const bf16_t* base, bool first, int l0) {
#pragma unroll
    for (int r = 0; r < 5; ++r) raw[r] = (first && (l0 + r - 3) < 0) ? (u32x4){0u, 0u, 0u, 0u} : *(const u32x4*)(base + (long)(r - 3) * NPROJ);
}
template <int GI>
__device__ __forceinline__ void ssd_conv(LAS unsigned char* lds, const u32x4 (&raw)[5], int cv, int l0, float sa, float sb) {
    LAS const f32x4* cw = (LAS const f32x4*)(lds + L_CW) + cv * 10;
    float o0[8], o1[8];
#pragma unroll
    for (int hq = 0; hq < 2; ++hq) {
        const f32x4 w0 = cw[0 + hq], w1 = cw[2 + hq], w2 = cw[4 + hq], w3 = cw[6 + hq], bs = cw[8 + hq];
#pragma unroll
        for (int e2 = 0; e2 < 2; ++e2) {
            const int q = hq * 2 + e2;
            const unsigned x0 = raw[0][q], x1 = raw[1][q], x2 = raw[2][q], x3 = raw[3][q], x4 = raw[4][q];
            const int ea = e2 * 2, eb = e2 * 2 + 1;
            const float va = bs[ea] + w0[ea] * bflo(x0) + w1[ea] * bflo(x1) + w2[ea] * bflo(x2) + w3[ea] * bflo(x3);
            const float vb = bs[eb] + w0[eb] * bfhi(x0) + w1[eb] * bfhi(x1) + w2[eb] * bfhi(x2) + w3[eb] * bfhi(x3);
            const float ua = bs[ea] + w0[ea] * bflo(x1) + w1[ea] * bflo(x2) + w2[ea] * bflo(x3) + w3[ea] * bflo(x4);
            const float ub = bs[eb] + w0[eb] * bfhi(x1) + w1[eb] * bfhi(x2) + w2[eb] * bfhi(x3) + w3[eb] * bfhi(x4);
            o0[2 * q] = silu_f(va); o0[2 * q + 1] = silu_f(vb); o1[2 * q] = silu_f(ua); o1[2 * q + 1] = silu_f(ub);
        }
    }
    if (GI == 0) {
#pragma unroll
        for (int e = 0; e < 8; ++e) { const int prow = cv * 8 + e;
            *(LAS unsigned*)(lds + L_XT + swz_off(prow, l0 >> 3) + (l0 & 7) * 2) = cvt_pk_bf16(o0[e] * sa, o1[e] * sb); }
    } else {
        u32x4 w0; w0.x = cvt_pk_bf16(o0[0], o0[1]); w0.y = cvt_pk_bf16(o0[2], o0[3]); w0.z = cvt_pk_bf16(o0[4], o0[5]); w0.w = cvt_pk_bf16(o0[6], o0[7]);
        u32x4 w1; w1.x = cvt_pk_bf16(o1[0], o1[1]); w1.y = cvt_pk_bf16(o1[2], o1[3]); w1.z = cvt_pk_bf16(o1[4], o1[5]); w1.w = cvt_pk_bf16(o1[6], o1[7]);
        const int nb = ((GI - 1) & 1) * 64 + cv * 8;
        if (GI < 3) {
            *(LAS u32x4*)(lds + L_BM + l0 * SROW + nb * 2) = w0; *(LAS u32x4*)(lds + L_BM + (l0 + 1) * SROW + nb * 2) = w1;
#pragma unroll
            for (int e = 0; e < 8; ++e) { const int nrow = nb + e;
                *(LAS unsigned*)(lds + L_BDT + swz_off(nrow, l0 >> 3) + (l0 & 7) * 2) = cvt_pk_bf16(o0[e] * sa, o1[e] * sb); }
        } else {
            *(LAS u32x4*)(lds + L_CM + l0 * SROW + nb * 2) = w0; *(LAS u32x4*)(lds + L_CM + (l0 + 1) * SROW + nb * 2) = w1;
        }
    }
}
template <int GI>
__device__ __forceinline__ void ssd_put(LAS unsigned char* lds, const u32x4 (&rw)[2], int cv, int l0, float sa, float sb) {
    const int nb = ((GI - 1) & 1) * 64 + cv * 8;
    if (GI < 3) {
        *(LAS u32x4*)(lds + L_BM + l0 * SROW + nb * 2) = rw[0]; *(LAS u32x4*)(lds + L_BM + (l0 + 1) * SROW + nb * 2) = rw[1];
#pragma unroll
        for (int q = 0; q < 4; ++q) {
            *(LAS unsigned*)(lds + L_BDT + swz_off(nb + 2 * q, l0 >> 3) + (l0 & 7) * 2) = cvt_pk_bf16(bflo(rw[0][q]) * sa, bflo(rw[1][q]) * sb);
            *(LAS unsigned*)(lds + L_BDT + swz_off(nb + 2 * q + 1, l0 >> 3) + (l0 & 7) * 2) = cvt_pk_bf16(bfhi(rw[0][q]) * sa, bfhi(rw[1][q]) * sb);
        }
    } else {
        *(LAS u32x4*)(lds + L_CM + l0 * SROW + nb * 2) = rw[0]; *(LAS u32x4*)(lds + L_CM + (l0 + 1) * SROW + nb * 2) = rw[1];
    }
}
__device__ __forceinline__ void bc_wait(unsigned* f, unsigned need, int wv) {
    if (wv == 0) {
    unsigned sp = 0;
    for (;;) {
        const unsigned a = __hip_atomic_load(f, __ATOMIC_RELAXED, __HIP_MEMORY_SCOPE_AGENT), b2 = __hip_atomic_load(f + 1, __ATOMIC_RELAXED, __HIP_MEMORY_SCOPE_AGENT);
        const unsigned c = __hip_atomic_load(f + 16, __ATOMIC_RELAXED, __HIP_MEMORY_SCOPE_AGENT), d = __hip_atomic_load(f + 17, __ATOMIC_RELAXED, __HIP_MEMORY_SCOPE_AGENT);
        const unsigned m = min(min(a, b2), min(c, d));
        if (__builtin_amdgcn_readfirstlane(m) >= need) break;
        __builtin_amdgcn_s_sleep(4);
        if (++sp > (1u << 19)) break;
    }
    __builtin_amdgcn_fence(__ATOMIC_ACQUIRE, "agent"); asm volatile("s_waitcnt vmcnt(0)" ::: "memory");
    }
    asm volatile("s_waitcnt lgkmcnt(0)" ::: "memory"); __builtin_amdgcn_s_barrier(); asm volatile("" ::: "memory");
}
__device__ void ssd_unit(const Params& p, LAS unsigned char* lds, int b, int h, int wv) {
    const int lane = lane_id(), w = wv, tid = wv * 64 + lane, fr = lane & 15, fq = lane >> 4;
    const int g = h >> 2;
    const bf16_t* proj = (const bf16_t*)(p.ws + WS_PROJ);
    const float* dtg = (const float*)((const unsigned char*)p.out + DO_DT);
    bf16_t* ymix = (bf16_t*)(p.ws + WS_YMIX);
    float* ssq1 = (float*)((unsigned char*)p.out + DO_SSQ1);
    LAS float* CSv = (LAS float*)(lds + L_CS);
    LAS float* DTv = (LAS float*)(lds + L_DT);
    LAS float* CW = (LAS float*)(lds + L_CW);
    const float Aneg = -__expf(p.ssm_A_log[h]);
    const float Dh = p.ssm_D[h];
    for (int idx = tid; idx < 320; idx += 512) {
        const int e = idx & 7, k = (idx >> 3) % 5, cvi = idx / 40;
        const int xcol = h * 64 + cvi * 8 + e;
        CW[idx] = (k < 4) ? p.ssm_conv_w[k * 4096 + xcol] : p.ssm_conv_b[xcol];
    }
    for (int idx = tid; idx < 64 * 17; idx += 512) *(LAS u32x4*)(lds + L_HB + idx * 16) = (u32x4){0u, 0u, 0u, 0u};
    f32x4 Hacc[4];
#pragma unroll
    for (int pt = 0; pt < 4; ++pt) Hacc[pt] = (f32x4){0.f, 0.f, 0.f, 0.f};
    __syncthreads();
    const int cv = lane & 7;
    const int l0 = 16 * w + 2 * (lane >> 3);
    const int srcl = (w & 3) * 16 + 2 * (lane >> 3);
    u32x4 r0[5], r1[2], r2[2], r3[2], r4[2];
    const bf16_t* pbase = proj + (size_t)(b * SEQ + l0) * NPROJ + 2048 + cv * 8;
    const int xc0 = h * 64, xc1 = 2048 + g * 128, xc2 = xc1 + 64, xc3 = 3072 + g * 128, xc4 = xc3 + 64;
    unsigned* bcf = (unsigned*)((unsigned char*)p.out + DO_BCFLAG) + b * 32 + 2 * g;
    bc_wait(bcf, 1u, wv);
    ssd_load(r0, pbase + xc0, true, l0);
    r1[0] = *(const u32x4*)(pbase + xc1); r1[1] = *(const u32x4*)(pbase + xc1 + NPROJ); r2[0] = *(const u32x4*)(pbase + xc2); r2[1] = *(const u32x4*)(pbase + xc2 + NPROJ);
    r3[0] = *(const u32x4*)(pbase + xc3); r3[1] = *(const u32x4*)(pbase + xc3 + NPROJ); r4[0] = *(const u32x4*)(pbase + xc4); r4[1] = *(const u32x4*)(pbase + xc4 + NPROJ);
    float dt0n = dtg[(size_t)(b * SEQ + lane) * 32 + h], dt1n = dtg[(size_t)(b * SEQ + 64 + lane) * 32 + h];
    for (int c = 0; c < 32; ++c) {
        const int row0 = b * SEQ + c * 128;
        const float dt0 = dt0n, dt1 = dt1n;
        float a0 = dt0 * Aneg, a1 = dt1 * Aneg;
#pragma unroll
        for (int o = 1; o < 64; o <<= 1) { const float t0 = __shfl_up(a0, o), t1 = __shfl_up(a1, o); if (lane >= o) { a0 += t0; a1 += t1; } }
        a1 += __shfl(a0, 63);
        const float cs_end = __shfl(a1, 63);
        if (w == 0) { CSv[lane] = a0; CSv[64 + lane] = a1; DTv[lane] = dt0; DTv[64 + lane] = dt1; }
        const float csv = (w >= 4) ? a1 : a0, dtv = (w >= 4) ? dt1 : dt0;
        const float cs_l0 = __shfl(csv, srcl), cs_l1 = __shfl(csv, srcl + 1), dt_l0 = __shfl(dtv, srcl), dt_l1 = __shfl(dtv, srcl + 1);
        const float dec0 = __expf(cs_end - cs_l0), dec1 = __expf(cs_end - cs_l1);
        ssd_conv<0>(lds, r0, cv, l0, dt_l0, dt_l1);
        ssd_put<1>(lds, r1, cv, l0, dec0, dec1); ssd_put<2>(lds, r2, cv, l0, dec0, dec1);
        ssd_put<3>(lds, r3, cv, l0, 0.f, 0.f);   ssd_put<4>(lds, r4, cv, l0, 0.f, 0.f);
        __builtin_amdgcn_sched_barrier(0);
        if (c + 1 < 32) {
            if (((c + 1) & 3) == 0) bc_wait(bcf, (unsigned)(((c + 1) >> 2) + 1), wv);
            const bf16_t* cb = pbase + (size_t)(c + 1) * 128 * NPROJ;
            ssd_load(r0, cb + xc0, false, l0);
            r1[0] = *(const u32x4*)(cb + xc1); r1[1] = *(const u32x4*)(cb + xc1 + NPROJ); r2[0] = *(const u32x4*)(cb + xc2); r2[1] = *(const u32x4*)(cb + xc2 + NPROJ);
            r3[0] = *(const u32x4*)(cb + xc3); r3[1] = *(const u32x4*)(cb + xc3 + NPROJ); r4[0] = *(const u32x4*)(cb + xc4); r4[1] = *(const u32x4*)(cb + xc4 + NPROJ);
            dt0n = dtg[(size_t)(row0 + 128 + lane) * 32 + h]; dt1n = dtg[(size_t)(row0 + 192 + lane) * 32 + h];
        }
        __builtin_amdgcn_sched_barrier(0);
        u32x2 zr[4];
#pragma unroll
        for (int pt = 0; pt < 4; ++pt) zr[pt] = *(const u32x2*)(proj + (size_t)(row0 + 16 * w + fr) * NPROJ + h * 64 + 16 * pt + 4 * fq);
        asm volatile("s_waitcnt lgkmcnt(0)" ::: "memory"); __builtin_amdgcn_s_barrier(); asm volatile("" ::: "memory");
        const int lrow = 16 * w + fr;
        const int hb_cur = L_HB + (c & 1) * 17408, hb_nxt = L_HB + ((c + 1) & 1) * 17408;
        bf16x8 cf[4];
#pragma unroll
        for (int ks = 0; ks < 4; ++ks) cf[ks] = *(LAS const bf16x8*)(lds + L_CM + lrow * SROW + (32 * ks + 8 * fq) * 2);
        const float cs_l = CSv[lrow], dt_l = DTv[lrow];
        asm volatile("" ::: "memory");
        const int dd = fr - 4 * fq; const float ddiag = Dh / dt_l;
        f32x4 y[4];
        { const float el = __expf(cs_l);
#pragma unroll
          for (int pt = 0; pt < 4; ++pt) { f32x4 a = (f32x4){0.f, 0.f, 0.f, 0.f};
#pragma unroll
            for (int ks = 0; ks < 4; ++ks) { const bf16x8 hf = *(LAS const bf16x8*)(lds + hb_cur + (16 * pt + fr) * SROW + (32 * ks + 8 * fq) * 2);
                a = __builtin_amdgcn_mfma_f32_16x16x32_bf16(hf, cf[ks], a, 0, 0, 0); }
            y[pt] = a * el; } }
#pragma unroll
        for (int j = 0; j < 8; ++j) {
            if (j <= w) {
                f32x4 gacc = (f32x4){0.f, 0.f, 0.f, 0.f};
#pragma unroll
                for (int ks = 0; ks < 4; ++ks) { const bf16x8 bf = *(LAS const bf16x8*)(lds + L_BM + (16 * j + fr) * SROW + (32 * ks + 8 * fq) * 2);
                    gacc = __builtin_amdgcn_mfma_f32_16x16x32_bf16(bf, cf[ks], gacc, 0, 0, 0); }
                const f32x4 css = *(LAS const f32x4*)(CSv + 16 * j + 4 * fq);
                float mv[4];
#pragma unroll
                for (int i = 0; i < 4; ++i) { float v = gacc[i] * __expf(cs_l - css[i]);
                    if (j == w) { v = (i <= dd) ? v : 0.f; if (i == dd) v += ddiag; }
                    mv[i] = v; }
                u32x2 wv2; wv2.x = cvt_pk_bf16(mv[0], mv[1]); wv2.y = cvt_pk_bf16(mv[2], mv[3]);
                *(LAS u32x2*)(lds + L_CM + lrow * SROW + (16 * j + 4 * fq) * 2) = wv2;
            } else if (j == w + 1 && (w & 1) == 0) {
                *(LAS u32x2*)(lds + L_CM + lrow * SROW + (16 * j + 4 * fq) * 2) = (u32x2){0u, 0u};
            }
        }
        asm volatile("" ::: "memory");
        { const float de = __expf(cs_end);
#pragma unroll
          for (int pt = 0; pt < 4; ++pt) Hacc[pt] *= de; }
        const int nks2 = (w >> 1) + 1;
#pragma unroll
        for (int ks = 0; ks < 4; ++ks) {
            bf16x8 xf[4];
#pragma unroll
            for (int pt = 0; pt < 4; ++pt) xf[pt] = *(LAS const bf16x8*)(lds + L_XT + swz_off(16 * pt + fr, 4 * ks + fq));
            if (ks < nks2) { const bf16x8 mf = *(LAS const bf16x8*)(lds + L_CM + lrow * SROW + (32 * ks + 8 * fq) * 2);
#pragma unroll
                for (int pt = 0; pt < 4; ++pt) y[pt] = __builtin_amdgcn_mfma_f32_16x16x32_bf16(xf[pt], mf, y[pt], 0, 0, 0); }
            const bf16x8 bdf = *(LAS const bf16x8*)(lds + L_BDT + swz_off(16 * w + fr, 4 * ks + fq));
#pragma unroll
            for (int pt = 0; pt < 4; ++pt) Hacc[pt] = __builtin_amdgcn_mfma_f32_16x16x32_bf16(bdf, xf[pt], Hacc[pt], 0, 0, 0);
        }
#pragma unroll
        for (int pt = 0; pt < 4; ++pt) { u32x2 wv2; wv2.x = cvt_pk_bf16(Hacc[pt][0], Hacc[pt][1]); wv2.y = cvt_pk_bf16(Hacc[pt][2], Hacc[pt][3]);
            *(LAS u32x2*)(lds + hb_nxt + (16 * pt + fr) * SROW + (16 * w + 4 * fq) * 2) = wv2; }
        { float ss = 0.f; const size_t orow = (size_t)(row0 + lrow);
#pragma unroll
          for (int pt = 0; pt < 4; ++pt) {
            const float z0 = bflo(zr[pt].x), z1 = bfhi(zr[pt].x), z2 = bflo(zr[pt].y), z3 = bfhi(zr[pt].y);
            const float v0 = y[pt][0] * silu_f(z0), v1 = y[pt][1] * silu_f(z1), v2 = y[pt][2] * silu_f(z2), v3 = y[pt][3] * silu_f(z3);
            ss += (v0 * v0 + v1 * v1) + (v2 * v2 + v3 * v3);
            u32x2 wv; wv.x = cvt_pk_bf16(v0, v1); wv.y = cvt_pk_bf16(v2, v3);
            *(u32x2*)(ymix + orow * DMIX + h * 64 + 16 * pt + 4 * fq) = wv; }
          ss += __shfl_xor(ss, 16); ss += __shfl_xor(ss, 32);
          if (fq == 0) ssq1[ssq_idx((int)orow, h)] = ss; }
        asm volatile("s_waitcnt lgkmcnt(0)" ::: "memory"); __builtin_amdgcn_s_barrier(); asm volatile("" ::: "memory");
    }
}
__device__ void sc_unit(const Params& p, int unit, int wv) {
    const int tid = wv * 64 + lane_id(), cvx = tid & 255, th = tid >> 8;
    const bf16_t* proj = (const bf16_t*)(p.ws + WS_PROJ);
    bf16_t* ymix = (bf16_t*)(p.ws + WS_YMIX);
    const int t0 = unit * 64 + th * 32, c0 = cvx * 8;
    float w0[8], w1[8], w2[8];
    { const f32x4* a = (const f32x4*)(p.sc_conv_w + c0); const f32x4* bq = (const f32x4*)(p.sc_conv_w + 2048 + c0); const f32x4* cq = (const f32x4*)(p.sc_conv_w + 4096 + c0);
#pragma unroll
      for (int q = 0; q < 2; ++q) { const f32x4 x0 = a[q], x1 = bq[q], x2 = cq[q];
#pragma unroll
        for (int j = 0; j < 4; ++j) { w0[q * 4 + j] = x0[j]; w1[q * 4 + j] = x1[j]; w2[q * 4 + j] = x2[j]; } } }
    float pm1[8], pm2[8];
#pragma unroll
    for (int e = 0; e < 8; ++e) { pm1[e] = 0.f; pm2[e] = 0.f; }
    if ((t0 & (SEQ - 1)) != 0) {
        const bf16_t* r2 = proj + (size_t)(t0 - 2) * NPROJ, * r1 = proj + (size_t)(t0 - 1) * NPROJ;
        const u32x4 c2 = *(const u32x4*)(r2 + 8192 + c0), c1 = *(const u32x4*)(r1 + 8192 + c0);
#pragma unroll
        for (int q = 0; q < 4; ++q) { pm2[2 * q] = bflo(c2[q]); pm2[2 * q + 1] = bfhi(c2[q]); pm1[2 * q] = bflo(c1[q]); pm1[2 * q + 1] = bfhi(c1[q]); }
    }
#pragma unroll 4
    for (int i = 0; i < 32; ++i) {
        const bf16_t* r = proj + (size_t)(t0 + i) * NPROJ;
        const u32x4 gb = *(const u32x4*)(r + 6144 + c0), gp = *(const u32x4*)(r + 8192 + c0);
        float o[8];
#pragma unroll
        for (int q = 0; q < 4; ++q) {
            const float pa = bflo(gp[q]), pb = bfhi(gp[q]);
            o[2 * q] = bflo(gb[q]) * (w0[2 * q] * pm2[2 * q] + w1[2 * q] * pm1[2 * q] + w2[2 * q] * pa);
            o[2 * q + 1] = bfhi(gb[q]) * (w0[2 * q + 1] * pm2[2 * q + 1] + w1[2 * q + 1] * pm1[2 * q + 1] + w2[2 * q + 1] * pb);
            pm2[2 * q] = pm1[2 * q]; pm2[2 * q + 1] = pm1[2 * q + 1]; pm1[2 * q] = pa; pm1[2 * q + 1] = pb;
        }
        u32x4 wv; wv.x = cvt_pk_bf16(o[0], o[1]); wv.y = cvt_pk_bf16(o[2], o[3]); wv.z = cvt_pk_bf16(o[4], o[5]); wv.w = cvt_pk_bf16(o[6], o[7]);
        *(u32x4*)(ymix + (size_t)(t0 + i) * DMIX + 2048 + c0) = wv;
    }
}
__device__ void phase2(const Params& p, LAS unsigned char* lds, int wv) {
    const int G = gridDim.x, bid = blockIdx.x;
    const bool split = G >= 256;
    if (!split) bc_sequences(p, lds, bid, G, wv);
    if (!split || bid < 128) { for (int u = bid; u < 128; u += (split ? 128 : G)) ssd_unit(p, lds, u >> 5, u & 31, wv); }
    if (split && bid >= 128) bc_sequences(p, lds, bid - 128, G - 128, wv);
    if (!split || bid >= 128) { for (int u = (split ? bid - 128 : bid); u < M_ / 64; u += (split ? G - 128 : G)) sc_unit(p, u, wv); }
    if (!split || bid >= 128) wconv_units(p, lds, split ? bid - 128 : bid, split ? G - 128 : G, wv);
}

__device__ void phase6(const Params& p, int wv) {
    const int lane = lane_id(), wave = wv;
    const bf16_t* h2 = (const bf16_t*)(p.ws + WS_H1B);
    const float* ssq3 = (const float*)(p.ws + WS_SSQ3);
    for (int row = blockIdx.x * 8 + wave; row < M_; row += gridDim.x * 8) {
        float s = (lane < 32) ? ssq3[ssq_idx(row, lane)] : 0.f;
#pragma unroll
        for (int o = 32; o >= 1; o >>= 1) s += __shfl_xor(s, o);
        const float rstd = rsqrtf(s * (1.0f / 2048.0f) + EPS);
        const u32x2* hr = (const u32x2*)(h2 + (size_t)row * D_);
        f32x4* orow = (f32x4*)(p.out + (size_t)row * D_);
#pragma unroll
        for (int i = 0; i < 8; ++i) { const u32x2 hv = hr[lane + 64 * i]; const f32x4 v = (f32x4){bflo(hv.x), bfhi(hv.x), bflo(hv.y), bfhi(hv.y)}, g4 = ((const f32x4*)p.norm_final_g)[lane + 64 * i]; orow[lane + 64 * i] = v * rstd * g4; }
    }
}


#define XB_TMO      128
#define XB_XCNT(j)  (256  + 64 * (j))
#define XB_XSUB(j)  (1280 + 64 * (j))
#define XB_XGEN(j)  (2304 + 64 * (j))
#define XB_TOP      3328
#define XB_TOPGEN   3392
#define XCD_BAR_WORDS 3456
#define XB_SPIN_CAP (1u << 18)
__device__ __forceinline__ unsigned xb_ld(unsigned* p)              { return __hip_atomic_load(p, __ATOMIC_RELAXED, __HIP_MEMORY_SCOPE_AGENT); }
__device__ __forceinline__ unsigned xb_add(unsigned* p, unsigned v) { return __hip_atomic_fetch_add(p, v, __ATOMIC_RELAXED, __HIP_MEMORY_SCOPE_AGENT); }
__device__ __forceinline__ unsigned xb_xcc_id() { return (unsigned)__builtin_amdgcn_s_getreg((3 << 11) | 20) & 0xFu; }
#define XB_SPIN(cond, bar) do { unsigned _sp = 0; while (cond) { __builtin_amdgcn_s_sleep(1); \
    if ((++_sp & 255u) == 0u) { if (xb_ld(&(bar)[XB_TMO])) break; if (_sp > XB_SPIN_CAP) { atomicAdd(&(bar)[XB_TMO], 1u); break; } } } } while (0)
struct XcdBarrier { unsigned* bar; unsigned x; volatile LAS unsigned* st; };
__device__ __forceinline__ void xcd_barrier_complete(unsigned* bar, unsigned x, unsigned& nloc, unsigned& nx) {
    const unsigned G = gridDim.x * gridDim.y * gridDim.z;
    unsigned sum, cnt, mine, sp = 0u;
    for (;;) {
        sum = 0u; cnt = 0u; mine = 0u;
#pragma unroll
        for (unsigned j = 0; j < 16; ++j) { const unsigned c = xb_ld(&bar[XB_XCNT(j)]); sum += c; cnt += (c > 0u) ? 1u : 0u; mine = (j == x) ? c : mine; }
        if (sum == G) break;
        __builtin_amdgcn_s_sleep(1);
        if ((++sp & 255u) == 0u) { if (xb_ld(&bar[XB_TMO])) break; if (sp > XB_SPIN_CAP) { atomicAdd(&bar[XB_TMO], 1u); break; } }
    }
    nloc = mine > 0u ? mine : 1u; nx = cnt > 0u ? cnt : 1u;
}
__device__ __forceinline__ void xcd_barrier(const XcdBarrier& b, bool leader) {
    asm volatile("s_waitcnt vmcnt(0)" ::: "memory");
    __syncthreads();
    if (leader) {
        unsigned* bar = b.bar;
        __builtin_amdgcn_s_waitcnt(0);
        unsigned nloc = b.st[0], nx = b.st[1];
        if (nloc == 0u) { xcd_barrier_complete(bar, b.x, nloc, nx); b.st[0] = nloc; b.st[1] = nx; }
        const unsigned old = xb_add(&bar[XB_XSUB(b.x)], 1u);
        const unsigned gen = old / nloc;
        if (old + 1u == (gen + 1u) * nloc) {
            __builtin_amdgcn_fence(__ATOMIC_RELEASE, "agent");
            asm volatile("s_waitcnt vmcnt(0)" ::: "memory");
            const unsigned og = xb_add(&bar[XB_TOP], 1u);
            const unsigned tg = og / nx;
            if (og + 1u == (tg + 1u) * nx) xb_add(&bar[XB_TOPGEN], 1u);
            else XB_SPIN(xb_ld(&bar[XB_TOPGEN]) == tg, bar);
            __builtin_amdgcn_fence(__ATOMIC_ACQUIRE, "agent");
            xb_add(&bar[XB_XGEN(b.x)], 1u);
            asm volatile("s_waitcnt vmcnt(0)" ::: "memory");
        } else {
            XB_SPIN(xb_ld(&bar[XB_XGEN(b.x)]) == gen, bar);
            __builtin_amdgcn_fence(__ATOMIC_ACQUIRE, "agent");
            asm volatile("s_waitcnt vmcnt(0)" ::: "memory");
        }
    }
    __syncthreads();
}

__global__ void __launch_bounds__(512) hymba_fwd(Params p) {
    extern __shared__ __attribute__((aligned(16))) unsigned char shm[];
    LAS unsigned char* lds = (LAS unsigned char*)shm;
    cg::grid_group grid = cg::this_grid();
    const int lo = p.ph_lo, hi = p.ph_hi;
    const int wv = __builtin_amdgcn_readfirstlane(threadIdx.x >> 6);
#ifdef DBG_CLEAR
    for (int i = threadIdx.x; i < LDS_BYTES / 16; i += 512) *(LAS u32x4*)(lds + i * 16) = (u32x4){0u, 0u, 0u, 0u};
    __syncthreads();
#endif
#define IN(k) (lo <= (k) && (k) < hi)
#define SEAM(k) do { if (IN(k) && IN((k) + 1)) { \
        asm volatile("s_waitcnt vmcnt(0) lgkmcnt(0)" ::: "memory"); __syncthreads();                 \
        if (wv == 0) { __builtin_amdgcn_fence(__ATOMIC_RELEASE, "agent"); asm volatile("s_waitcnt vmcnt(0)" ::: "memory"); }     \
        grid.sync(); \
        if (wv == 0) { __builtin_amdgcn_fence(__ATOMIC_ACQUIRE, "agent"); asm volatile("s_waitcnt vmcnt(0)" ::: "memory"); }     \
        __syncthreads(); } } while (0)
    volatile LAS unsigned* xst = (volatile LAS unsigned*)(lds + LDS_BYTES - 16);
    const bool xlead = (wv == 0) && (lane_id() == 0);
    if (xlead) { xst[0] = 0u; xst[1] = 0u; }
    __syncthreads();
    XcdBarrier xb; xb.bar = (unsigned*)((unsigned char*)p.out + DO_XBAR); xb.x = xb_xcc_id(); xb.st = xst;
    if (xlead) (void)xb_add(&xb.bar[XB_XCNT(xb.x)], 1u);
#define XSEAM(k) do { if (IN(k) && IN((k) + 1)) xcd_barrier(xb, (wv == 0) && (lane_id() == 0)); } while (0)
    if (IN(0)) for (int rep = 0; rep < NREP(0); ++rep) phase0(p, lds, wv);
    XSEAM(0);
    if (IN(1)) for (int rep = 0; rep < NREP(1); ++rep) {
        pg8::Gemm g{(const bf16_t*)(p.ws + WS_XN), (const bf16_t*)(p.ws + WS_BTIN), M_, NPROJ, D_}; pg8::StaticOrder S; S.init(M_, NPROJ, gridDim.x, blockIdx.x);
        if (gridDim.x == 256) { S.nrounds = 12; S.rot = 3 * ((blockIdx.x >> 6) & 3); }
        EpiProj E{(bf16_t*)(p.ws + WS_PROJ)};
        pg8::gemm_phase<EpiProj>(lds, g, S, E, wv);
        dt_units(p, lds, wv);
    }
    XSEAM(1);
    if (IN(3)) for (int rep = 0; rep < NREP(3); ++rep) phase2(p, lds, wv);
    XSEAM(3);
    if (IN(4)) for (int rep = 0; rep < NREP(4); ++rep) {
        pg8::Gemm g{(const bf16_t*)(p.ws + WS_YMIX), (const bf16_t*)((unsigned char*)p.out + DO_BTOUT), M_, D_, DMIX}; pg8::StaticOrder S; S.init(M_, D_, gridDim.x, blockIdx.x);
        EpiOut E{p.x, (bf16_t*)(p.ws + WS_H1B), (const float*)((unsigned char*)p.out + DO_SSQ1), (float*)((unsigned char*)p.out + DO_SSQ2)};
        pg8::gemm_phase<EpiOut>(lds, g, S, E, wv);
    }
    XSEAM(4);
    if (IN(5)) for (int rep = 0; rep < NREP(5); ++rep) {
        pg8::Gemm g{(const bf16_t*)(p.ws + WS_H1B), (const bf16_t*)((unsigned char*)p.out + DO_BTGU), M_, NGU, D_}; pg8::StaticOrder S; S.init(M_, NGU, gridDim.x, blockIdx.x);
        EpiGU E{(const float*)((unsigned char*)p.out + DO_SSQ2), (bf16_t*)(p.ws + WS_HFF)};
        pg8::gemm_phase<EpiGU>(lds, g, S, E, wv);
    }
    XSEAM(5);
    if (IN(6)) {
        pg8::Gemm g{(const bf16_t*)(p.ws + WS_HFF), (const bf16_t*)((unsigned char*)p.out + DO_BTDN), M_, D_, DFF}; pg8::StaticOrder S; S.init(M_, D_, gridDim.x, blockIdx.x);
        EpiDown E{(bf16_t*)(p.ws + WS_H1B), (float*)(p.ws + WS_SSQ3)};
        pg8::gemm_phase<EpiDown>(lds, g, S, E, wv);
    }
    XSEAM(6);
    if (p.ph_hi > 1000) grid.sync();
    if (IN(7)) for (int rep = 0; rep < NREP(7); ++rep) phase6(p, wv);
#undef IN
#undef SEAM
}

extern "C" void kernel_launch(void* const* d_in, const int* in_sizes, int n_in, void* d_out, int out_size, void* d_ws, size_t ws_size, hipStream_t stream) {
    static int grid = 0;
    if (grid == 0) {
        if (n_in != 16 || out_size != M_ * D_ || ws_size < WS_NEED) { fprintf(stderr, "kernel_launch: unexpected shapes (n_in %d out %d ws %zu, need %zu)\n", n_in, out_size, ws_size, (size_t)WS_NEED); grid = -1; return; }
        int dev = 0, cus = 0, per_cu = 0;
        (void)hipGetDevice(&dev);
        (void)hipDeviceGetAttribute(&cus, hipDeviceAttributeMultiprocessorCount, dev);
        if (hipFuncSetAttribute((const void*)hymba_fwd, hipFuncAttributeMaxDynamicSharedMemorySize, LDS_BYTES) != hipSuccess) { fprintf(stderr, "kernel_launch: hipFuncSetAttribute failed\n"); grid = -1; return; }
        if (hipOccupancyMaxActiveBlocksPerMultiprocessor(&per_cu, (const void*)hymba_fwd, 512, LDS_BYTES) != hipSuccess || per_cu < 1) { fprintf(stderr, "kernel_launch: occupancy query failed (%d)\n", per_cu); (void)hipGetLastError(); per_cu = 1; }
        grid = cus * per_cu;
    }
    if (grid < 0) return;
    Params p{};
    p.x = (const float*)d_in[0]; p.norm_mix_g = (const float*)d_in[1]; p.w_in = (const float*)d_in[2]; p.ssm_conv_w = (const float*)d_in[3]; p.ssm_conv_b = (const float*)d_in[4];
    p.ssm_dt_bias = (const float*)d_in[5]; p.ssm_A_log = (const float*)d_in[6]; p.ssm_D = (const float*)d_in[7]; p.ssm_norm_g = (const float*)d_in[8]; p.sc_conv_w = (const float*)d_in[9];
    p.w_out = (const float*)d_in[10]; p.norm_ffn_g = (const float*)d_in[11]; p.w_gate = (const float*)d_in[12]; p.w_up = (const float*)d_in[13]; p.w_down = (const float*)d_in[14]; p.norm_final_g = (const float*)d_in[15];
    p.out = (float*)d_out; p.ws = (unsigned char*)d_ws;
#ifdef DBG_MEMSET
    (void)hipMemsetAsync(d_ws, 0, WS_NEED, stream); (void)hipMemsetAsync(d_out, 0, (size_t)out_size * 4, stream);
#endif
#ifndef N_CUTS
#define N_CUTS 1
#endif
    for (int li = 0; li < N_CUTS; ++li) {
        p.ph_lo = (N_CUTS == 8) ? li : 0; p.ph_hi = (N_CUTS == 8) ? li + 1 : 8;
        (void)hipMemsetAsync((unsigned char*)d_out + DO_BCFLAG, 0, 4096 + XCD_BAR_WORDS * sizeof(unsigned), stream);
    void* args[] = {&p};
        hipError_t e = hipLaunchCooperativeKernel((const void*)hymba_fwd, dim3(grid), dim3(512), args, LDS_BYTES, stream);
        if (e != hipSuccess) fprintf(stderr, "kernel_launch: cooperative launch failed: %s (grid %d)\n", hipGetErrorString(e), grid);
    }
}
```

```cpp
#include <hip/hip_runtime.h>
#include <hip/hip_cooperative_groups.h>
#include <cstdio>
namespace cg = cooperative_groups;

#define LAS __attribute__((address_space(3)))
typedef unsigned short bf16_t;
typedef short bf16x8 __attribute__((ext_vector_type(8)));
typedef float f32x4 __attribute__((ext_vector_type(4)));
typedef unsigned u32x4 __attribute__((ext_vector_type(4)));
typedef unsigned u32x2 __attribute__((ext_vector_type(2)));

constexpr int M_ = 16384, D_ = 2048, DIN = 12320, NPROJ = 12288, DFF = 5632, DMIX = 4096, NGU = 11264;
constexpr int SEQ = 4096;
constexpr float EPS = 1e-5f;
constexpr int LDS_BYTES = 159744;
constexpr int XCD_BAR_WORDS_C = 3456;
#ifndef PROBE_PHASE
#define PROBE_PHASE -1
#endif
#define NREP(k) ((PROBE_PHASE == (k)) ? 1 + (p.ph_hi < 100) : 1)
constexpr int TAB_OFF = 131072;

constexpr size_t WS_PROJ = 0;
constexpr size_t WS_R = (size_t)M_ * NPROJ * 2;
constexpr size_t WS_XN = WS_R;
constexpr size_t WS_BTIN = WS_R + (size_t)M_ * D_ * 2;
constexpr size_t WS_YMIX = WS_R;
constexpr size_t WS_H1F = 0;
constexpr size_t WS_H1B = (size_t)M_ * D_ * 4;
constexpr size_t WS_HFF = WS_H1B + (size_t)M_ * D_ * 2;
constexpr size_t WS_SSQ3 = WS_HFF + (size_t)M_ * DFF * 2;
constexpr size_t WS_NEED = WS_R + (size_t)M_ * DMIX * 2;
constexpr size_t DO_BTOUT = 0;
constexpr size_t DO_BTGU = (size_t)D_ * DMIX * 2;
constexpr size_t DO_BTDN = DO_BTGU + (size_t)NGU * D_ * 2;
constexpr size_t DO_DT = DO_BTDN + (size_t)D_ * DFF * 2;
constexpr size_t DO_SSQ1 = DO_DT + (size_t)M_ * 32 * 4;
constexpr size_t DO_SSQ2 = DO_SSQ1 + (size_t)M_ * 32 * 4;
constexpr size_t DO_XBAR = (size_t)M_ * D_ * 4 - 16384;
constexpr size_t DO_BCFLAG = DO_XBAR - 4096;
static_assert(DO_SSQ2 + (size_t)M_ * 32 * 4 <= DO_BCFLAG && XCD_BAR_WORDS_C * 4 <= 16384, "d_out scratch");

static_assert(WS_SSQ3 + (size_t)M_ * 32 * 4 <= WS_R, "ws overlay");

struct Params {
    const float* x; const float* norm_mix_g; const float* w_in; const float* ssm_conv_w; const float* ssm_conv_b;
    const float* ssm_dt_bias; const float* ssm_A_log; const float* ssm_D; const float* ssm_norm_g; const float* sc_conv_w;
    const float* w_out; const float* norm_ffn_g; const float* w_gate; const float* w_up; const float* w_down; const float* norm_final_g;
    float* out; unsigned char* ws; int ph_lo, ph_hi;
};

typedef float f32x2_t __attribute__((ext_vector_type(2)));
typedef __bf16 bf16x2_t __attribute__((ext_vector_type(2)));
__device__ __forceinline__ unsigned cvt_pk_bf16(float lo, float hi) { const f32x2_t v = {lo, hi}; return __builtin_bit_cast(unsigned, __builtin_convertvector(v, bf16x2_t)); }
__device__ __forceinline__ float bflo(unsigned u) { return __uint_as_float(u << 16); }
__device__ __forceinline__ float bfhi(unsigned u) { return __uint_as_float(u & 0xffff0000u); }
__device__ __forceinline__ int lane_id() { int l; asm volatile("v_mbcnt_lo_u32_b32 %0, -1, 0\n\tv_mbcnt_hi_u32_b32 %0, -1, %0" : "=v"(l)); return l; }
__device__ __forceinline__ float silu_f(float v) { return v * __builtin_amdgcn_rcpf(1.0f + __expf(-v)); }

__device__ __forceinline__ size_t ssq_idx(int row, int part) { return ((size_t)(row >> 5) * 32 + part) * 32 + (row & 31); }

namespace pg8 {
constexpr int BM = 256, BK = 64, HALF = 128, HTB = HALF * BK * 2, STAGE_BYTES = 8 * HTB, NXCD = 8, WGM = 8;
__device__ __forceinline__ int lds_byte(int r, int c) { const int st = (r >> 4) * 2 + (c >> 5), rr = r & 15, cc = c & 31, ob = rr * 64 + cc * 2; return st * 1024 + (ob ^ (((ob >> 9) & 1) << 5)); }
__device__ __forceinline__ void stage_rc(int b, int& R, int& C) { const int st = b / 1024, sb = b % 1024, swz = sb ^ (((sb >> 9) & 1) << 5); R = (st >> 1) * 16 + swz / 64; C = (st & 1) * 32 + (swz % 64) / 2; }
__device__ __forceinline__ int perm32(int rho) { const int n = rho >> 4, i = rho & 15; return 8 * (i >> 2) + 4 * n + (i & 3); }
struct Unit { int pm, pn; };
struct Gemm { const bf16_t* A; const bf16_t* Bt; int M, N, K; };
struct StaticOrder {
    int nM, nN, nwg, G, c, rot = 0, nrounds = 1;
    __device__ void init(int M, int N, int G_, int c_) { nM = M / BM; nN = N / BM; nwg = nM * nN; G = G_; c = c_; }
    __device__ bool next(int i, Unit& u) const {
        if (rot != 0 && i < nrounds) i = (i + rot) % nrounds;
        const long L = (long)i * G + c; if (L >= nwg) return false;
        int wgid = (int)L; { const int q = nwg / NXCD, r = nwg % NXCD, xcd = wgid % NXCD, off = wgid / NXCD; wgid = (xcd < r ? xcd * (q + 1) : r * (q + 1) + (xcd - r) * q) + off; }
        const int nig = WGM * nN, gid = wgid / nig, fm = gid * WGM, gsz = (nM - fm) < WGM ? (nM - fm) : WGM;
        u.pm = fm + ((wgid % nig) % gsz); u.pn = (wgid % nig) / gsz; return true;
    }
};
template <class Epi>
__device__ __forceinline__ void gemm_phase(LAS unsigned char* lds, const Gemm g, const StaticOrder& S, const Epi& E, int wv) {
    const int wid = wv, lane = lane_id(), tid = wid * 64 + lane, wr = wid >> 2, wc = wid & 3, fr = lane & 15, fq = lane >> 4;
    const int K = g.K, nt = K / BK;
    unsigned voffA[2], voffB[2];
#pragma unroll
    for (int i = 0; i < 2; ++i) { int R, C; stage_rc(tid * 16 + i * 8192, R, C); const int Rb = (R & ~31) + perm32(R & 31);
        voffA[i] = (unsigned)(R * K + C) * 2u; voffB[i] = (unsigned)(Rb * K + C) * 2u; }
    const size_t kstep = (size_t)(BK * 2);
    const size_t hstep = (size_t)HALF * K * 2;
    const size_t tstep = 2 * hstep;
    const unsigned ldsw = (unsigned)wid * 1024u;
    const int aoff = lds_byte(wr * 64 + fr, fq * 8), boff = lds_byte(wc * 32 + fr, fq * 8);
#define PG8_SA(b, h) (((b) * 2 + (h)) * HTB)
#define PG8_SB(b, h) ((4 + (b) * 2 + (h)) * HTB)
#define PG8_STAGE(bufoff, gbase, voff) do { _Pragma("unroll") for (int _i = 0; _i < 2; ++_i) \
        __builtin_amdgcn_global_load_lds((const unsigned*)((const char*)(gbase) + (voff)[_i]), (LAS unsigned*)(lds + (bufoff) + ldsw + _i * 8192), 16, 0, 0); } while (0)
#define PG8_LDA(dst, b, h) do { _Pragma("unroll") for (int m = 0; m < 4; ++m) _Pragma("unroll") for (int k = 0; k < 2; ++k) dst[m][k] = *(const LAS bf16x8*)(lds + PG8_SA(b, h) + aoff + m * 2048 + k * 1024); } while (0)
#define PG8_LDB(dst, b, h) do { _Pragma("unroll") for (int n = 0; n < 2; ++n) _Pragma("unroll") for (int k = 0; k < 2; ++k) dst[n][k] = *(const LAS bf16x8*)(lds + PG8_SB(b, h) + boff + n * 2048 + k * 1024); } while (0)
#define PG8_MMA(ai, bj, At, Bt) do { __builtin_amdgcn_s_setprio(1); _Pragma("unroll") for (int m = 0; m < 4; ++m) _Pragma("unroll") for (int n = 0; n < 2; ++n) _Pragma("unroll") for (int k = 0; k < 2; ++k) \
        acc[ai][bj][m][n] = __builtin_amdgcn_mfma_f32_16x16x32_bf16(Bt[n][k], At[m][k], acc[ai][bj][m][n], 0, 0, 0); __builtin_amdgcn_s_setprio(0); } while (0)
#define PG8_WAIT_V(n) asm volatile("s_waitcnt vmcnt(" #n ")" ::: "memory")
#define PG8_WAIT_L(n) asm volatile("s_waitcnt lgkmcnt(" #n ")" ::: "memory")
#define PG8_BAR __builtin_amdgcn_s_barrier()
#define PG8_SCHED __builtin_amdgcn_sched_barrier(0)
    Unit cur, nxt; int ui = 0;
    if (!S.next(0, cur)) return;
    f32x4 acc[2][2][4][2];
#pragma unroll
    for (int a = 0; a < 2; ++a)
#pragma unroll
        for (int b = 0; b < 2; ++b)
#pragma unroll
            for (int m = 0; m < 4; ++m)
#pragma unroll
                for (int n = 0; n < 2; ++n) acc[a][b][m][n] = (f32x4){0.f, 0.f, 0.f, 0.f};
    bf16x8 At[4][2], B0[2][2], B1[2][2];
    const char* cA = (const char*)g.A + (size_t)cur.pm * tstep; const char* cB = (const char*)g.Bt + (size_t)cur.pn * tstep;
    if constexpr (Epi::HAS_TAB) {
        Unit uu; for (int i = 0; i < 27 && S.next(i, uu); ++i) E.prep(uu, (LAS float*)(lds + TAB_OFF + i * 1024), tid);
    }
    PG8_STAGE(PG8_SB(0, 0), cB, voffB); PG8_STAGE(PG8_SB(0, 1), cB + hstep, voffB); PG8_STAGE(PG8_SA(0, 0), cA, voffA); PG8_STAGE(PG8_SA(0, 1), cA + hstep, voffA);
    if (wr == 1) PG8_BAR;
    PG8_WAIT_V(2); PG8_BAR;
    PG8_STAGE(PG8_SB(1, 0), cB + kstep, voffB); PG8_STAGE(PG8_SA(1, 0), cA + kstep, voffA); PG8_STAGE(PG8_SB(1, 1), cB + hstep + kstep, voffB);
    PG8_WAIT_V(6); PG8_BAR;
    for (;;) {
        const bool has_next = S.next(ui + 1, nxt);
        const char* nA = has_next ? (const char*)g.A + (size_t)nxt.pm * tstep : cA; const char* nB = has_next ? (const char*)g.Bt + (size_t)nxt.pn * tstep : cB;
        LAS const float* tabc = (LAS const float*)(lds + TAB_OFF + ui * 1024);
        for (int t = 0; t < nt; t += 2) {
            const bool last = (t == nt - 2);
            const char* a1 = cA + (size_t)(t + 1) * kstep;
            const char* a2 = last ? nA : cA + (size_t)(t + 2) * kstep; const char* b2 = last ? nB : cB + (size_t)(t + 2) * kstep;
            const char* a3 = a2 + kstep; const char* b3 = b2 + kstep;
            if constexpr (Epi::MID_T >= 0) { if (t == Epi::MID_T) {
#pragma unroll
                for (int ai = 0; ai < 2; ++ai)
#pragma unroll
                    for (int m = 0; m < 4; ++m) { const float s = tabc[ai * HALF + wr * 64 + m * 16 + fr];
#pragma unroll
                        for (int bj = 0; bj < 2; ++bj)
#pragma unroll
                            for (int n = 0; n < 2; ++n) acc[ai][bj][m][n] *= s; } } }
            PG8_LDB(B0, 0, 0); PG8_LDB(B1, 0, 1); PG8_SCHED; PG8_LDA(At, 0, 0); PG8_STAGE(PG8_SA(1, 1), a1 + hstep, voffA);
            PG8_WAIT_V(8); PG8_WAIT_L(0); PG8_BAR; PG8_MMA(0, 0, At, B0); PG8_MMA(0, 1, At, B1); PG8_BAR; PG8_SCHED;
            PG8_LDA(At, 0, 1); PG8_STAGE(PG8_SB(0, 0), b2, voffB); PG8_STAGE(PG8_SB(0, 1), b2 + hstep, voffB); PG8_STAGE(PG8_SA(0, 0), a2, voffA);
            PG8_WAIT_V(8); PG8_WAIT_L(0); PG8_BAR; PG8_MMA(1, 0, At, B0); PG8_MMA(1, 1, At, B1); PG8_BAR; PG8_SCHED;
            PG8_LDB(B0, 1, 0); PG8_LDB(B1, 1, 1); PG8_SCHED; PG8_LDA(At, 1, 0); PG8_STAGE(PG8_SA(0, 1), a2 + hstep, voffA);
            PG8_WAIT_V(8); PG8_WAIT_L(0); PG8_BAR; PG8_MMA(0, 0, At, B0); PG8_MMA(0, 1, At, B1); PG8_BAR; PG8_SCHED;
            PG8_LDA(At, 1, 1); PG8_STAGE(PG8_SB(1, 0), b3, voffB); PG8_STAGE(PG8_SB(1, 1), b3 + hstep, voffB); PG8_STAGE(PG8_SA(1, 0), a3, voffA);
            PG8_WAIT_V(8); PG8_WAIT_L(0); PG8_BAR; PG8_MMA(1, 0, At, B0); PG8_MMA(1, 1, At, B1); PG8_BAR; PG8_SCHED;
        }
        if (wr == 0) PG8_BAR;
        E(acc, cur, tabc, wr, wc, fr, fq);
        if (!has_next) break;
#pragma unroll
        for (int a = 0; a < 2; ++a)
#pragma unroll
            for (int b = 0; b < 2; ++b)
#pragma unroll
                for (int m = 0; m < 4; ++m)
#pragma unroll
                    for (int n = 0; n < 2; ++n) acc[a][b][m][n] = (f32x4){0.f, 0.f, 0.f, 0.f};
        cur = nxt; cA = nA; cB = nB; ++ui;
        if (wr == 1) PG8_BAR;
    }
    PG8_WAIT_V(0);
    PG8_BAR;
#undef PG8_SA
#undef PG8_SB
#undef PG8_STAGE
#undef PG8_LDA
#undef PG8_LDB
#undef PG8_MMA
#undef PG8_WAIT_V
#undef PG8_WAIT_L
#undef PG8_BAR
#undef PG8_SCHED
}
}

__device__ __forceinline__ void rstd_table(const float* ssq, int row0, LAS float* tab, int t) {
    const int r = t >> 1, hf = t & 1;
    const float* p = ssq + ssq_idx(row0 + r, hf * 16);
    float s = 0.f;
#pragma unroll
    for (int i = 0; i < 16; ++i) s += p[i * 32];
    s += __shfl_xor(s, 1);
    if (!hf) tab[r] = rsqrtf(s * (1.0f / 2048.0f) + EPS);
}

struct EpiProj {
    static constexpr bool HAS_TAB = false; static constexpr int MID_T = -1;
    bf16_t* O;
    __device__ __forceinline__ void prep(const pg8::Unit&, LAS float*, int) const {}
    __device__ __forceinline__ void operator()(const f32x4 (&acc)[2][2][4][2], const pg8::Unit& u, LAS const float*, int wr, int wc, int fr, int fq) const {
        const int row0 = u.pm * 256 + wr * 64 + fr, col0 = u.pn * 256 + wc * 32 + 8 * fq;
        if (u.pn >= 32) {
            const int pcol = 8192 + (u.pn - 32) * 128 + wc * 32 + 8 * fq;
#pragma unroll
            for (int ai = 0; ai < 2; ++ai)
#pragma unroll
                for (int m = 0; m < 4; ++m) { const f32x4 v0 = acc[ai][0][m][0] * acc[ai][1][m][0], v1 = acc[ai][0][m][1] * acc[ai][1][m][1];
                    u32x4 w; w.x = cvt_pk_bf16(v0[0], v0[1]); w.y = cvt_pk_bf16(v0[2], v0[3]); w.z = cvt_pk_bf16(v1[0], v1[1]); w.w = cvt_pk_bf16(v1[2], v1[3]);
                    *(u32x4*)(O + (size_t)(row0 + ai * 128 + m * 16) * NPROJ + pcol) = w; }
            return;
        }
#pragma unroll
        for (int ai = 0; ai < 2; ++ai)
#pragma unroll
            for (int m = 0; m < 4; ++m) { bf16_t* rowp = O + (size_t)(row0 + ai * 128 + m * 16) * NPROJ + col0;
#pragma unroll
                for (int bj = 0; bj < 2; ++bj) { const f32x4 v0 = acc[ai][bj][m][0], v1 = acc[ai][bj][m][1];
                    u32x4 w; w.x = cvt_pk_bf16(v0[0], v0[1]); w.y = cvt_pk_bf16(v0[2], v0[3]); w.z = cvt_pk_bf16(v1[0], v1[1]); w.w = cvt_pk_bf16(v1[2], v1[3]);
                    *(u32x4*)(rowp + bj * 128) = w; } }
    }
};
struct EpiOut {
    static constexpr bool HAS_TAB = true; static constexpr int MID_T = 32;
    const float* x; bf16_t* h1b; const float* ssq1; float* ssq2;
    __device__ __forceinline__ void prep(const pg8::Unit& u, LAS float* tab, int t) const { rstd_table(ssq1, u.pm * 256, tab, t); }
    __device__ __forceinline__ void operator()(const f32x4 (&acc)[2][2][4][2], const pg8::Unit& u, LAS const float*, int wr, int wc, int fr, int fq) const {
        const int row0 = u.pm * 256 + wr * 64 + fr, col0 = u.pn * 256 + wc * 32 + 8 * fq;
#pragma unroll
        for (int ai = 0; ai < 2; ++ai)
#pragma unroll
            for (int m = 0; m < 4; ++m) { const int row = row0 + ai * 128 + m * 16; const size_t off = (size_t)row * D_ + col0; float ss = 0.f;
#pragma unroll
                for (int bj = 0; bj < 2; ++bj) {
                    const f32x4 x0 = *(const f32x4*)(x + off + bj * 128), x1 = *(const f32x4*)(x + off + bj * 128 + 4);
                    const f32x4 v0 = acc[ai][bj][m][0] + x0, v1 = acc[ai][bj][m][1] + x1;
                    u32x4 w; w.x = cvt_pk_bf16(v0[0], v0[1]); w.y = cvt_pk_bf16(v0[2], v0[3]); w.z = cvt_pk_bf16(v1[0], v1[1]); w.w = cvt_pk_bf16(v1[2], v1[3]);
                    *(u32x4*)(h1b + off + bj * 128) = w;
                    ss += (v0[0] * v0[0] + v0[1] * v0[1]) + (v0[2] * v0[2] + v0[3] * v0[3]) + (v1[0] * v1[0] + v1[1] * v1[1]) + (v1[2] * v1[2] + v1[3] * v1[3]); }
                ss += __shfl_xor(ss, 16); ss += __shfl_xor(ss, 32);
                if (fq == 0) ssq2[ssq_idx(row, u.pn * 4 + wc)] = ss; }
    }
};
struct EpiGU {
    static constexpr bool HAS_TAB = true; static constexpr int MID_T = -1;
    const float* ssq2; bf16_t* hff;
    __device__ __forceinline__ void prep(const pg8::Unit& u, LAS float* tab, int t) const { rstd_table(ssq2, u.pm * 256, tab, t); }
    __device__ __forceinline__ void operator()(const f32x4 (&acc)[2][2][4][2], const pg8::Unit& u, LAS const float* tab, int wr, int wc, int fr, int fq) const {
        const int row0 = u.pm * 256 + wr * 64 + fr, col0 = u.pn * 128 + wc * 32 + 8 * fq;
#pragma unroll
        for (int ai = 0; ai < 2; ++ai)
#pragma unroll
            for (int m = 0; m < 4; ++m) { const float rs = tab[ai * 128 + wr * 64 + m * 16 + fr];
                float o[8];
#pragma unroll
                for (int n = 0; n < 2; ++n)
#pragma unroll
                    for (int j = 0; j < 4; ++j) { const float gg = acc[ai][0][m][n][j] * rs, uu = acc[ai][1][m][n][j] * rs; o[n * 4 + j] = silu_f(gg) * uu; }
                u32x4 w; w.x = cvt_pk_bf16(o[0], o[1]); w.y = cvt_pk_bf16(o[2], o[3]); w.z = cvt_pk_bf16(o[4], o[5]); w.w = cvt_pk_bf16(o[6], o[7]);
                *(u32x4*)(hff + (size_t)(row0 + ai * 128 + m * 16) * DFF + col0) = w; }
    }
};
struct EpiDown {
    static constexpr bool HAS_TAB = false; static constexpr int MID_T = -1;
    bf16_t* h; float* ssq3;
    __device__ __forceinline__ void prep(const pg8::Unit&, LAS float*, int) const {}
    __device__ __forceinline__ void operator()(const f32x4 (&acc)[2][2][4][2], const pg8::Unit& u, LAS const float*, int wr, int wc, int fr, int fq) const {
        const int row0 = u.pm * 256 + wr * 64 + fr, col0 = u.pn * 256 + wc * 32 + 8 * fq;
#pragma unroll
        for (int ai = 0; ai < 2; ++ai)
#pragma unroll
            for (int m = 0; m < 4; ++m) { const int row = row0 + ai * 128 + m * 16; const size_t off = (size_t)row * D_ + col0; float ss = 0.f;
#pragma unroll
                for (int bj = 0; bj < 2; ++bj) {
                    const u32x4 xb = *(const u32x4*)(h + off + bj * 128);
                    const f32x4 x0 = (f32x4){bflo(xb.x), bfhi(xb.x), bflo(xb.y), bfhi(xb.y)}, x1 = (f32x4){bflo(xb.z), bfhi(xb.z), bflo(xb.w), bfhi(xb.w)};
                    const f32x4 v0 = acc[ai][bj][m][0] + x0, v1 = acc[ai][bj][m][1] + x1;
                    u32x4 w; w.x = cvt_pk_bf16(v0[0], v0[1]); w.y = cvt_pk_bf16(v0[2], v0[3]); w.z = cvt_pk_bf16(v1[0], v1[1]); w.w = cvt_pk_bf16(v1[2], v1[3]);
                    *(u32x4*)(h + off + bj * 128) = w;
                    ss += (v0[0] * v0[0] + v0[1] * v0[1]) + (v0[2] * v0[2] + v0[3] * v0[3]) + (v1[0] * v1[0] + v1[1] * v1[1]) + (v1[2] * v1[2] + v1[3] * v1[3]); }
                ss += __shfl_xor(ss, 16); ss += __shfl_xor(ss, 32);
                if (fq == 0) ssq3[ssq_idx(row, u.pn * 4 + wc)] = ss; }
    }
};

__device__ __forceinline__ void p0_tile(LAS float* t, const float* src, int ldsrc, int k0, int c0, int jvalid, bf16_t* dst, int K, int j0, const float* scale, int scale_kmax, int tid) {
    const int jc4 = (tid & 15) * 4, kr0 = tid >> 4;
#pragma unroll
    for (int i = 0; i < 4; ++i) {
        const int kr = kr0 + 32 * i;
        f32x4 v = (f32x4){0.f, 0.f, 0.f, 0.f};
        if (jc4 < jvalid) v = *(const f32x4*)(src + (size_t)(k0 + kr) * ldsrc + c0 + jc4);
        const float s = (scale != nullptr && (k0 + kr) < scale_kmax) ? scale[k0 + kr] : 1.0f;
        t[kr * 65 + jc4 + 0] = v[0] * s; t[kr * 65 + jc4 + 1] = v[1] * s; t[kr * 65 + jc4 + 2] = v[2] * s; t[kr * 65 + jc4 + 3] = v[3] * s;
    }
    __syncthreads();
    const int kp = (tid & 63) * 2, jr0 = tid >> 6;
#pragma unroll
    for (int i = 0; i < 8; ++i) {
        const int j = jr0 + 8 * i;
        if (j < jvalid) { const float a = t[kp * 65 + j], b = t[(kp + 1) * 65 + j];
            *(unsigned*)(dst + (size_t)(j0 + j) * K + k0 + kp) = cvt_pk_bf16(a, b); }
    }
    __syncthreads();
}
struct TileD { const float* src; const float* scale; bf16_t* dst; int ldsrc, k0, c0, jvalid, K, j0, kmax; };
__device__ __forceinline__ TileD tile_decode(const Params& p, int u) {
    constexpr int U_IN = 16 * 193, U_OUT = 32 * 32, U_GU = 16 * 176;
    TileD d;
    if (u < U_IN) { const int kt = u & 15, jt = u >> 4, j0 = jt * 64;
        d.src = p.w_in; d.scale = nullptr; d.dst = (bf16_t*)(p.ws + WS_BTIN); d.ldsrc = DIN; d.k0 = kt * 128; d.c0 = j0 < 6144 ? j0 : (j0 < 8192 ? j0 + 32 : (j0 < 12288 ? (((j0 & 255) < 128 ? 8224 : 10272 - 128) + 128 * ((j0 - 8192) >> 8) + (j0 & 255)) : 6144));     d.jvalid = (jt == 192) ? 32 : 64; d.K = D_; d.j0 = j0; d.kmax = 0; }
    else if (u < U_IN + U_OUT) { const int v = u - U_IN, kt = v & 31, jt = v >> 5;
        d.src = p.w_out; d.scale = p.ssm_norm_g; d.dst = (bf16_t*)((unsigned char*)p.out + DO_BTOUT); d.ldsrc = D_; d.k0 = kt * 128; d.c0 = jt * 64; d.jvalid = 64; d.K = DMIX; d.j0 = jt * 64; d.kmax = 2048; }
    else if (u < U_IN + U_OUT + U_GU) { const int v = u - U_IN - U_OUT, kt = v & 15, jt = v >> 4, j0 = jt * 64, pn = j0 >> 8, r0 = j0 & 255;
        d.src = r0 < 128 ? p.w_gate : p.w_up; d.scale = p.norm_ffn_g; d.dst = (bf16_t*)((unsigned char*)p.out + DO_BTGU); d.ldsrc = DFF; d.k0 = kt * 128; d.c0 = 128 * pn + (r0 & 127); d.jvalid = 64; d.K = D_; d.j0 = j0; d.kmax = 2048; }
    else { const int v = u - U_IN - U_OUT - U_GU, kt = v % 44, jt = v / 44;
        d.src = p.w_down; d.scale = nullptr; d.dst = (bf16_t*)((unsigned char*)p.out + DO_BTDN); d.ldsrc = D_; d.k0 = kt * 128; d.c0 = jt * 64; d.jvalid = 64; d.K = DFF; d.j0 = jt * 64; d.kmax = 0; }
    return d;
}
__device__ __forceinline__ void tile_load(const TileD& d, int tid, f32x4 (&v)[4], float (&scl)[4]) {
    const int jc4 = (tid & 15) * 4, kr0 = tid >> 4;
#pragma unroll
    for (int i = 0; i < 4; ++i) { const int kr = kr0 + 32 * i;
        f32x4 x = (f32x4){0.f, 0.f, 0.f, 0.f};
        if (jc4 < d.jvalid) x = *(const f32x4*)(d.src + (size_t)(d.k0 + kr) * d.ldsrc + d.c0 + jc4);
        scl[i] = (d.scale != nullptr && (d.k0 + kr) < d.kmax) ? d.scale[d.k0 + kr] : 1.0f;
        v[i] = x; }
}
__device__ __forceinline__ void tile_finish(LAS float* t, const TileD& d, int tid, const f32x4 (&v)[4], const float (&scl)[4]) {
    const int jc4 = (tid & 15) * 4, kr0 = tid >> 4;
#pragma unroll
    for (int i = 0; i < 4; ++i) { const int kr = kr0 + 32 * i;
        t[kr * 65 + jc4 + 0] = v[i][0] * scl[i]; t[kr * 65 + jc4 + 1] = v[i][1] * scl[i]; t[kr * 65 + jc4 + 2] = v[i][2] * scl[i]; t[kr * 65 + jc4 + 3] = v[i][3] * scl[i]; }
    asm volatile("s_waitcnt lgkmcnt(0)" ::: "memory"); __builtin_amdgcn_s_barrier(); asm volatile("" ::: "memory");
    const int kp = (tid & 63) * 2, jr0 = tid >> 6;
#pragma unroll
    for (int i = 0; i < 8; ++i) { const int j = jr0 + 8 * i;
        if (j < d.jvalid) { const float a = t[kp * 65 + j], b = t[(kp + 1) * 65 + j];
            *(unsigned*)(d.dst + (size_t)(d.j0 + j) * d.K + d.k0 + kp) = cvt_pk_bf16(a, b); } }
    asm volatile("s_waitcnt lgkmcnt(0)" ::: "memory"); __builtin_amdgcn_s_barrier(); asm volatile("" ::: "memory");
}
__device__ __forceinline__ void conv_tiles(const Params& p, LAS unsigned char* lds, int u_begin, int u_end, int first, int stride, int tid) {
    LAS float* t = (LAS float*)lds;
    int u = u_begin + first;
    if (u >= u_end) return;
    TileD d = tile_decode(p, u); f32x4 v[4]; float sc[4]; tile_load(d, tid, v, sc);
    for (;;) {
        const int un = u + stride; const bool more = un < u_end;
        TileD dn = d; f32x4 vn[4]; float scn[4];
#pragma unroll
        for (int i = 0; i < 4; ++i) { vn[i] = v[i]; scn[i] = sc[i]; }
        if (more) { dn = tile_decode(p, un); tile_load(dn, tid, vn, scn); }
        tile_finish(t, d, tid, v, sc);
        if (!more) break;
        d = dn; u = un;
#pragma unroll
        for (int i = 0; i < 4; ++i) { v[i] = vn[i]; sc[i] = scn[i]; }
    }
}
__device__ void phase0(const Params& p, LAS unsigned char* lds, int wv) {
    const int lane = lane_id(), wave = wv, tid = wv * 64 + lane, G = gridDim.x;
    LAS float* t = (LAS float*)lds;
    bf16_t* bt_in = (bf16_t*)(p.ws + WS_BTIN);
    bf16_t* xn = (bf16_t*)(p.ws + WS_XN);
    for (int row = blockIdx.x * 8 + wave; row < M_; row += G * 8) {
        const f32x4* xr = (const f32x4*)(p.x + (size_t)row * D_);
        f32x4 v[8]; float ss = 0.f;
#pragma unroll
        for (int i = 0; i < 8; ++i) { v[i] = xr[lane + 64 * i]; ss += (v[i][0] * v[i][0] + v[i][1] * v[i][1]) + (v[i][2] * v[i][2] + v[i][3] * v[i][3]); }
#pragma unroll
        for (int o = 32; o >= 1; o >>= 1) ss += __shfl_xor(ss, o);
        const float rstd = rsqrtf(ss * (1.0f / 2048.0f) + EPS);
#pragma unroll
        for (int i = 0; i < 8; ++i) { const f32x4 g4 = ((const f32x4*)p.norm_mix_g)[lane + 64 * i];
            u32x2 w; w.x = cvt_pk_bf16(v[i][0] * rstd * g4[0], v[i][1] * rstd * g4[1]); w.y = cvt_pk_bf16(v[i][2] * rstd * g4[2], v[i][3] * rstd * g4[3]);
            *(u32x2*)(xn + (size_t)row * D_ + 4 * (lane + 64 * i)) = w; }
    }
    __syncthreads();
    conv_tiles(p, lds, 0, 16 * 193, blockIdx.x, G, tid);
}
__device__ void wconv_units(const Params& p, LAS unsigned char* lds, int first, int stride, int wv) {
    const int tid = wv * 64 + lane_id();
    __syncthreads();
    conv_tiles(p, lds, 16 * 193, 16 * 193 + 32 * 32 + 16 * 176 + 44 * 32, first, stride, tid);
}

__device__ void dt_units(const Params& p, LAS unsigned char* lds, int wv) {
    const int lane = lane_id(), w = wv, tid = wv * 64 + lane, fr = lane & 15, fq = lane >> 4;
    const bf16_t* xn = (const bf16_t*)(p.ws + WS_XN);
    const bf16_t* bt = (const bf16_t*)(p.ws + WS_BTIN) + (size_t)NPROJ * D_;
    float* dt = (float*)((unsigned char*)p.out + DO_DT);
    LAS float* red = (LAS float*)lds;
    for (int rb = blockIdx.x; rb < M_ / 64; rb += gridDim.x) {
        const int row0 = rb * 64;
        f32x4 acc[4][2];
#pragma unroll
        for (int m = 0; m < 4; ++m)
#pragma unroll
            for (int n = 0; n < 2; ++n) acc[m][n] = (f32x4){0.f, 0.f, 0.f, 0.f};
#pragma unroll 4
        for (int ks = 0; ks < 8; ++ks) {
            const int kb = w * 256 + ks * 32 + fq * 8;
            bf16x8 a[4], b[2];
#pragma unroll
            for (int m = 0; m < 4; ++m) a[m] = *(const bf16x8*)(xn + (size_t)(row0 + 16 * m + fr) * D_ + kb);
#pragma unroll
            for (int n = 0; n < 2; ++n) b[n] = *(const bf16x8*)(bt + (size_t)(16 * n + fr) * D_ + kb);
#pragma unroll
            for (int m = 0; m < 4; ++m)
#pragma unroll
                for (int n = 0; n < 2; ++n) acc[m][n] = __builtin_amdgcn_mfma_f32_16x16x32_bf16(a[m], b[n], acc[m][n], 0, 0, 0);
        }
#pragma unroll
        for (int m = 0; m < 4; ++m)
#pragma unroll
            for (int n = 0; n < 2; ++n)
#pragma unroll
                for (int j = 0; j < 4; ++j) red[w * 2048 + (16 * m + 4 * fq + j) * 32 + 16 * n + fr] = acc[m][n][j];
        __syncthreads();
        {
            const int idx = tid * 4, r = idx >> 5, c = idx & 31;
            f32x4 s = (f32x4){0.f, 0.f, 0.f, 0.f};
#pragma unroll
            for (int ww = 0; ww < 8; ++ww) s += *(LAS const f32x4*)(red + ww * 2048 + idx);
            const f32x4 bias = *(const f32x4*)(p.ssm_dt_bias + c);
            f32x4 o;
#pragma unroll
            for (int j = 0; j < 4; ++j) { const float v = s[j] + bias[j]; o[j] = v > 20.f ? v : log1pf(expf(v)); }
            *(f32x4*)(dt + (size_t)(row0 + r) * 32 + c) = o;
        }
        __syncthreads();
    }
}

__device__ void bc_sequences(const Params& p, LAS unsigned char* lds, int first, int stride, int wv) {
    const int tid = wv * 64 + lane_id(), cv = tid & 7, run = tid >> 3;
    bf16_t* proj = (bf16_t*)(p.ws + WS_PROJ);
    LAS u32x4* stash = (LAS u32x4*)lds;
    unsigned* bcflag = (unsigned*)((unsigned char*)p.out + DO_BCFLAG);
    for (int sq = first; sq < 4 * 32; sq += stride) {
        const int b = sq >> 5, slab = sq & 31;
        const int xcol = 2048 + slab * 64 + cv * 8;
        float wk[4][8], bs[8];
#pragma unroll
        for (int k = 0; k < 4; ++k) { const f32x4 a = *(const f32x4*)(p.ssm_conv_w + k * 4096 + xcol), c = *(const f32x4*)(p.ssm_conv_w + k * 4096 + xcol + 4);
#pragma unroll
            for (int j = 0; j < 4; ++j) { wk[k][j] = a[j]; wk[k][4 + j] = c[j]; } }
        { const f32x4 a = *(const f32x4*)(p.ssm_conv_b + xcol), c = *(const f32x4*)(p.ssm_conv_b + xcol + 4);
#pragma unroll
          for (int j = 0; j < 4; ++j) { bs[j] = a[j]; bs[4 + j] = c[j]; } }
        __syncthreads();
#pragma unroll 1
        for (int tile = 0; tile < 8; ++tile) {
            bf16_t* base = proj + (size_t)(b * SEQ + tile * 512 + run * 8) * NPROJ + 2048 + xcol;
            u32x4 raw[11];
#pragma unroll
            for (int r = 0; r < 11; ++r) {
                const int row = run * 8 + r - 3;
                if (row >= 0) raw[r] = *(const u32x4*)(base + (long)(r - 3) * NPROJ);
                else raw[r] = (tile == 0) ? (u32x4){0u, 0u, 0u, 0u} : stash[(row + 3) * 8 + cv];
            }
            u32x4 ov[8];
#pragma unroll
            for (int j = 0; j < 8; ++j) {
                float o[8];
#pragma unroll
                for (int q = 0; q < 4; ++q) {
                    const unsigned x0 = raw[j][q], x1 = raw[j + 1][q], x2 = raw[j + 2][q], x3 = raw[j + 3][q];
                    o[2 * q] = silu_f(bs[2 * q] + wk[0][2 * q] * bflo(x0) + wk[1][2 * q] * bflo(x1) + wk[2][2 * q] * bflo(x2) + wk[3][2 * q] * bflo(x3));
                    o[2 * q + 1] = silu_f(bs[2 * q + 1] + wk[0][2 * q + 1] * bfhi(x0) + wk[1][2 * q + 1] * bfhi(x1) + wk[2][2 * q + 1] * bfhi(x2) + wk[3][2 * q + 1] * bfhi(x3));
                }
                ov[j].x = cvt_pk_bf16(o[0], o[1]); ov[j].y = cvt_pk_bf16(o[2], o[3]); ov[j].z = cvt_pk_bf16(o[4], o[5]); ov[j].w = cvt_pk_bf16(o[6], o[7]);
            }
            asm volatile("s_waitcnt vmcnt(0) lgkmcnt(0)" ::: "memory");
            __syncthreads();
            if (run == 63) { stash[0 * 8 + cv] = raw[8]; stash[1 * 8 + cv] = raw[9]; stash[2 * 8 + cv] = raw[10]; }
#pragma unroll
            for (int j = 0; j < 8; ++j) { const bf16_t* q = base + (long)j * NPROJ;
                asm volatile("global_store_dwordx4 %0, %1, off sc1" :: "v"(q), "v"(ov[j]) : "memory"); }
            asm volatile("s_waitcnt vmcnt(0) lgkmcnt(0)" ::: "memory");
            __syncthreads();
            if (wv == 0) {
                if (lane_id() == 0) __hip_atomic_store(bcflag + sq, (unsigned)(tile + 1), __ATOMIC_RELAXED, __HIP_MEMORY_SCOPE_AGENT);
            }
        }
    }
}

constexpr int SROW = 272;
constexpr int L_CM = 0, L_BM = 34816, L_BDT = 69632, L_XT = 104448, L_HB = 121856  , L_CS = 156672, L_DT = 157184, L_CW = 157696  ;
__device__ __forceinline__ int swz_off(int row, int kblk) { return row * SROW + ((kblk ^ ((row >> 3) & 7)) << 4); }
__device__ __forceinline__ void ssd_load(u32x4 (&raw)[5], const bf16_t* base, bool first, int l0) {
#pragma unroll
    for (int r = 0; r < 5; ++r) raw[r] = (first && (l0 + r - 3) < 0) ? (u32x4){0u, 0u, 0u, 0u} : *(const u32x4*)(base + (long)(r - 3) * NPROJ);
}
template <int GI>
__device__ __forceinline__ void ssd_conv(LAS unsigned char* lds, const u32x4 (&raw)[5], int cv, int l0, float sa, float sb) {
    LAS const f32x4* cw = (LAS const f32x4*)(lds + L_CW) + cv * 10;
    float o0[8], o1[8];
#pragma unroll
    for (int hq = 0; hq < 2; ++hq) {
        const f32x4 w0 = cw[0 + hq], w1 = cw[2 + hq], w2 = cw[4 + hq], w3 = cw[6 + hq], bs = cw[8 + hq];
#pragma unroll
        for (int e2 = 0; e2 < 2; ++e2) {
            const int q = hq * 2 + e2;
            const unsigned x0 = raw[0][q], x1 = raw[1][q], x2 = raw[2][q], x3 = raw[3][q], x4 = raw[4][q];
            const int ea = e2 * 2, eb = e2 * 2 + 1;
            const float va = bs[ea] + w0[ea] * bflo(x0) + w1[ea] * bflo(x1) + w2[ea] * bflo(x2) + w3[ea] * bflo(x3);
            const float vb = bs[eb] + w0[eb] * bfhi(x0) + w1[eb] * bfhi(x1) + w2[eb] * bfhi(x2) + w3[eb] * bfhi(x3);
            const float ua = bs[ea] + w0[ea] * bflo(x1) + w1[ea] * bflo(x2) + w2[ea] * bflo(x3) + w3[ea] * bflo(x4);
            const float ub = bs[eb] + w0[eb] * bfhi(x1) + w1[eb] * bfhi(x2) + w2[eb] * bfhi(x3) + w3[eb] * bfhi(x4);
            o0[2 * q] = silu_f(va); o0[2 * q + 1] = silu_f(vb); o1[2 * q] = silu_f(ua); o1[2 * q + 1] = silu_f(ub);
        }
    }
    if (GI == 0) {
#pragma unroll
        for (int e = 0; e < 8; ++e) { const int prow = cv * 8 + e;
            *(LAS unsigned*)(lds + L_XT + swz_off(prow, l0 >> 3) + (l0 & 7) * 2) = cvt_pk_bf16(o0[e] * sa, o1[e] * sb); }
    } else {
        u32x4 w0; w0.x = cvt_pk_bf16(o0[0], o0[1]); w0.y = cvt_pk_bf16(o0[2], o0[3]); w0.z = cvt_pk_bf16(o0[4], o0[5]); w0.w = cvt_pk_bf16(o0[6], o0[7]);
        u32x4 w1; w1.x = cvt_pk_bf16(o1[0], o1[1]); w1.y = cvt_pk_bf16(o1[2], o1[3]); w1.z = cvt_pk_bf16(o1[4], o1[5]); w1.w = cvt_pk_bf16(o1[6], o1[7]);
        const int nb = ((GI - 1) & 1) * 64 + cv * 8;
        if (GI < 3) {
            *(LAS u32x4*)(lds + L_BM + l0 * SROW + nb * 2) = w0; *(LAS u32x4*)(lds + L_BM + (l0 + 1) * SROW + nb * 2) = w1;
#pragma unroll
            for (int e = 0; e < 8; ++e) { const int nrow = nb + e;
                *(LAS unsigned*)(lds + L_BDT + swz_off(nrow, l0 >> 3) + (l0 & 7) * 2) = cvt_pk_bf16(o0[e] * sa, o1[e] * sb); }
        } else {
            *(LAS u32x4*)(lds + L_CM + l0 * SROW + nb * 2) = w0; *(LAS u32x4*)(lds + L_CM + (l0 + 1) * SROW + nb * 2) = w1;
        }
    }
}
template <int GI>
__device__ __forceinline__ void ssd_put(LAS unsigned char* lds, const u32x4 (&rw)[2], int cv, int l0, float sa, float sb) {
    const int nb = ((GI - 1) & 1) * 64 + cv * 8;
    if (GI < 3) {
        *(LAS u32x4*)(lds + L_BM + l0 * SROW + nb * 2) = rw[0]; *(LAS u32x4*)(lds + L_BM + (l0 + 1) * SROW + nb * 2) = rw[1];
#pragma unroll
        for (int q = 0; q < 4; ++q) {
            *(LAS unsigned*)(lds + L_BDT + swz_off(nb + 2 * q, l0 >> 3) + (l0 & 7) * 2) = cvt_pk_bf16(bflo(rw[0][q]) * sa, bflo(rw[1][q]) * sb);
            *(LAS unsigned*)(lds + L_BDT + swz_off(nb + 2 * q + 1, l0 >> 3) + (l0 & 7) * 2) = cvt_pk_bf16(bfhi(rw[0][q]) * sa, bfhi(rw[1][q]) * sb);
        }
    } else {
        *(LAS u32x4*)(lds + L_CM + l0 * SROW + nb * 2) = rw[0]; *(LAS u32x4*)(lds + L_CM + (l0 + 1) * SROW + nb * 2) = rw[1];
    }
}
__device__ __forceinline__ void bc_wait(unsigned* f, unsigned need, int wv) {
    if (wv == 0) {
    unsigned sp = 0;
    for (;;) {
        const unsigned a = __hip_atomic_load(f, __ATOMIC_RELAXED, __HIP_MEMORY_SCOPE_AGENT), b2 = __hip_atomic_load(f + 1, __ATOMIC_RELAXED, __HIP_MEMORY_SCOPE_AGENT);
        const unsigned c = __hip_atomic_load(f + 16, __ATOMIC_RELAXED, __HIP_MEMORY_SCOPE_AGENT), d = __hip_atomic_load(f + 17, __ATOMIC_RELAXED, __HIP_MEMORY_SCOPE_AGENT);
        const unsigned m = min(min(a, b2), min(c, d));
        if (__builtin_amdgcn_readfirstlane(m) >= need) break;
        __builtin_amdgcn_s_sleep(4);
        if (++sp > (1u << 19)) break;
    }
    __builtin_amdgcn_fence(__ATOMIC_ACQUIRE, "agent"); asm volatile("s_waitcnt vmcnt(0)" ::: "memory");
    }
    asm volatile("s_waitcnt lgkmcnt(0)" ::: "memory"); __builtin_amdgcn_s_barrier(); asm volatile("" ::: "memory");
}
__device__ void ssd_unit(const Params& p, LAS unsigned char* lds, int b, int h, int wv) {
    const int lane = lane_id(), w = wv, tid = wv * 64 + lane, fr = lane & 15, fq = lane >> 4;
    const int g = h >> 2;
    const bf16_t* proj = (const bf16_t*)(p.ws + WS_PROJ);
    const float* dtg = (const float*)((const unsigned char*)p.out + DO_DT);
    bf16_t* ymix = (bf16_t*)(p.ws + WS_YMIX);
    float* ssq1 = (float*)((unsigned char*)p.out + DO_SSQ1);
    LAS float* CSv = (LAS float*)(lds + L_CS);
    LAS float* DTv = (LAS float*)(lds + L_DT);
    LAS float* CW = (LAS float*)(lds + L_CW);
    const float Aneg = -__expf(p.ssm_A_log[h]);
    const float Dh = p.ssm_D[h];
    for (int idx = tid; idx < 320; idx += 512) {
        const int e = idx & 7, k = (idx >> 3) % 5, cvi = idx / 40;
        const int xcol = h * 64 + cvi * 8 + e;
        CW[idx] = (k < 4) ? p.ssm_conv_w[k * 4096 + xcol] : p.ssm_conv_b[xcol];
    }
    for (int idx = tid; idx < 64 * 17; idx += 512) *(LAS u32x4*)(lds + L_HB + idx * 16) = (u32x4){0u, 0u, 0u, 0u};
    f32x4 Hacc[4];
#pragma unroll
    for (int pt = 0; pt < 4; ++pt) Hacc[pt] = (f32x4){0.f, 0.f, 0.f, 0.f};
    __syncthreads();
    const int cv = lane & 7;
    const int l0 = 16 * w + 2 * (lane >> 3);
    const int srcl = (w & 3) * 16 + 2 * (lane >> 3);
    u32x4 r0[5], r1[2], r2[2], r3[2], r4[2];
    const bf16_t* pbase = proj + (size_t)(b * SEQ + l0) * NPROJ + 2048 + cv * 8;
    const int xc0 = h * 64, xc1 = 2048 + g * 128, xc2 = xc1 + 64, xc3 = 3072 + g * 128, xc4 = xc3 + 64;
    unsigned* bcf = (unsigned*)((unsigned char*)p.out + DO_BCFLAG) + b * 32 + 2 * g;
    bc_wait(bcf, 1u, wv);
    ssd_load(r0, pbase + xc0, true, l0);
    r1[0] = *(const u32x4*)(pbase + xc1); r1[1] = *(const u32x4*)(pbase + xc1 + NPROJ); r2[0] = *(const u32x4*)(pbase + xc2); r2[1] = *(const u32x4*)(pbase + xc2 + NPROJ);
    r3[0] = *(const u32x4*)(pbase + xc3); r3[1] = *(const u32x4*)(pbase + xc3 + NPROJ); r4[0] = *(const u32x4*)(pbase + xc4); r4[1] = *(const u32x4*)(pbase + xc4 + NPROJ);
    float dt0n = dtg[(size_t)(b * SEQ + lane) * 32 + h], dt1n = dtg[(size_t)(b * SEQ + 64 + lane) * 32 + h];
    for (int c = 0; c < 32; ++c) {
        const int row0 = b * SEQ + c * 128;
        const float dt0 = dt0n, dt1 = dt1n;
        float a0 = dt0 * Aneg, a1 = dt1 * Aneg;
#pragma unroll
        for (int o = 1; o < 64; o <<= 1) { const float t0 = __shfl_up(a0, o), t1 = __shfl_up(a1, o); if (lane >= o) { a0 += t0; a1 += t1; } }
        a1 += __shfl(a0, 63);
        const float cs_end = __shfl(a1, 63);
        if (w == 0) { CSv[lane] = a0; CSv[64 + lane] = a1; DTv[lane] = dt0; DTv[64 + lane] = dt1; }
        const float csv = (w >= 4) ? a1 : a0, dtv = (w >= 4) ? dt1 : dt0;
        const float cs_l0 = __shfl(csv, srcl), cs_l1 = __shfl(csv, srcl + 1), dt_l0 = __shfl(dtv, srcl), dt_l1 = __shfl(dtv, srcl + 1);
        const float dec0 = __expf(cs_end - cs_l0), dec1 = __expf(cs_end - cs_l1);
        ssd_conv<0>(lds, r0, cv, l0, dt_l0, dt_l1);
        ssd_put<1>(lds, r1, cv, l0, dec0, dec1); ssd_put<2>(lds, r2, cv, l0, dec0, dec1);
        ssd_put<3>(lds, r3, cv, l0, 0.f, 0.f);   ssd_put<4>(lds, r4, cv, l0, 0.f, 0.f);
        __builtin_amdgcn_sched_barrier(0);
        if (c + 1 < 32) {
            if (((c + 1) & 3) == 0) bc_wait(bcf, (unsigned)(((c + 1) >> 2) + 1), wv);
            dt0n = dtg[(size_t)(row0 + 128 + lane) * 32 + h]; dt1n = dtg[(size_t)(row0 + 192 + lane) * 32 + h];
            const bf16_t* cb = pbase + (size_t)(c + 1) * 128 * NPROJ;
            ssd_load(r0, cb + xc0, false, l0);
            r1[0] = *(const u32x4*)(cb + xc1); r1[1] = *(const u32x4*)(cb + xc1 + NPROJ); r2[0] = *(const u32x4*)(cb + xc2); r2[1] = *(const u32x4*)(cb + xc2 + NPROJ);
            r3[0] = *(const u32x4*)(cb + xc3); r3[1] = *(const u32x4*)(cb + xc3 + NPROJ); r4[0] = *(const u32x4*)(cb + xc4); r4[1] = *(const u32x4*)(cb + xc4 + NPROJ);
        }
        __builtin_amdgcn_sched_barrier(0);
        u32x2 zr[4];
#pragma unroll
        for (int pt = 0; pt < 4; ++pt) zr[pt] = *(const u32x2*)(proj + (size_t)(row0 + 16 * w + fr) * NPROJ + h * 64 + 16 * pt + 4 * fq);
        asm volatile("s_waitcnt lgkmcnt(0)" ::: "memory"); __builtin_amdgcn_s_barrier(); asm volatile("" ::: "memory");
        const int lrow = 16 * w + fr;
        const int hb_cur = L_HB + (c & 1) * 17408, hb_nxt = L_HB + ((c + 1) & 1) * 17408;
        bf16x8 cf[4];
#pragma unroll
        for (int ks = 0; ks < 4; ++ks) cf[ks] = *(LAS const bf16x8*)(lds + L_CM + lrow * SROW + (32 * ks + 8 * fq) * 2);
        const float cs_l = CSv[lrow], dt_l = DTv[lrow];
        asm volatile("" ::: "memory");
        const int dd = fr - 4 * fq; const float ddiag = Dh / dt_l;
        f32x4 y[4];
        { const float el = __expf(cs_l);
#pragma unroll
          for (int pt = 0; pt < 4; ++pt) { f32x4 a = (f32x4){0.f, 0.f, 0.f, 0.f};
#pragma unroll
            for (int ks = 0; ks < 4; ++ks) { const bf16x8 hf = *(LAS const bf16x8*)(lds + hb_cur + (16 * pt + fr) * SROW + (32 * ks + 8 * fq) * 2);
                a = __builtin_amdgcn_mfma_f32_16x16x32_bf16(hf, cf[ks], a, 0, 0, 0); }
            y[pt] = a * el; } }
#pragma unroll
        for (int j = 0; j < 8; ++j) {
            if (j <= w) {
                f32x4 gacc = (f32x4){0.f, 0.f, 0.f, 0.f};
#pragma unroll
                for (int ks = 0; ks < 4; ++ks) { const bf16x8 bf = *(LAS const bf16x8*)(lds + L_BM + (16 * j + fr) * SROW + (32 * ks + 8 * fq) * 2);
                    gacc = __builtin_amdgcn_mfma_f32_16x16x32_bf16(bf, cf[ks], gacc, 0, 0, 0); }
                const f32x4 css = *(LAS const f32x4*)(CSv + 16 * j + 4 * fq);
                float mv[4];
#pragma unroll
                for (int i = 0; i < 4; ++i) { float v = gacc[i] * __expf(cs_l - css[i]);
                    if (j == w) { v = (i <= dd) ? v : 0.f; if (i == dd) v += ddiag; }
                    mv[i] = v; }
                u32x2 wv2; wv2.x = cvt_pk_bf16(mv[0], mv[1]); wv2.y = cvt_pk_bf16(mv[2], mv[3]);
                *(LAS u32x2*)(lds + L_CM + lrow * SROW + (16 * j + 4 * fq) * 2) = wv2;
            } else if (j == w + 1 && (w & 1) == 0) {
                *(LAS u32x2*)(lds + L_CM + lrow * SROW + (16 * j + 4 * fq) * 2) = (u32x2){0u, 0u};
            }
        }
        asm volatile("" ::: "memory");
        { const float de = __expf(cs_end);
#pragma unroll
          for (int pt = 0; pt < 4; ++pt) Hacc[pt] *= de; }
        const int nks2 = (w >> 1) + 1;
#pragma unroll
        for (int ks = 0; ks < 4; ++ks) {
            bf16x8 xf[4];
#pragma unroll
            for (int pt = 0; pt < 4; ++pt) xf[pt] = *(LAS const bf16x8*)(lds + L_XT + swz_off(16 * pt + fr, 4 * ks + fq));
            if (ks < nks2) { const bf16x8 mf = *(LAS const bf16x8*)(lds + L_CM + lrow * SROW + (32 * ks + 8 * fq) * 2);
#pragma unroll
                for (int pt = 0; pt < 4; ++pt) y[pt] = __builtin_amdgcn_mfma_f32_16x16x32_bf16(xf[pt], mf, y[pt], 0, 0, 0); }
            const bf16x8 bdf = *(LAS const bf16x8*)(lds + L_BDT + swz_off(16 * w + fr, 4 * ks + fq));
#pragma unroll
            for (int pt = 0; pt < 4; ++pt) Hacc[pt] = __builtin_amdgcn_mfma_f32_16x16x32_bf16(bdf, xf[pt], Hacc[pt], 0, 0, 0);
        }
#pragma unroll
        for (int pt = 0; pt < 4; ++pt) { u32x2 wv2; wv2.x = cvt_pk_bf16(Hacc[pt][0], Hacc[pt][1]); wv2.y = cvt_pk_bf16(Hacc[pt][2], Hacc[pt][3]);
            *(LAS u32x2*)(lds + hb_nxt + (16 * pt + fr) * SROW + (16 * w + 4 * fq) * 2) = wv2; }
        { float ss = 0.f; const size_t orow = (size_t)(row0 + lrow);
#pragma unroll
          for (int pt = 0; pt < 4; ++pt) {
            const float z0 = bflo(zr[pt].x), z1 = bfhi(zr[pt].x), z2 = bflo(zr[pt].y), z3 = bfhi(zr[pt].y);
            const float v0 = y[pt][0] * silu_f(z0), v1 = y[pt][1] * silu_f(z1), v2 = y[pt][2] * silu_f(z2), v3 = y[pt][3] * silu_f(z3);
            ss += (v0 * v0 + v1 * v1) + (v2 * v2 + v3 * v3);
            u32x2 wv; wv.x = cvt_pk_bf16(v0, v1); wv.y = cvt_pk_bf16(v2, v3);
            *(u32x2*)(ymix + orow * DMIX + h * 64 + 16 * pt + 4 * fq) = wv; }
          ss += __shfl_xor(ss, 16); ss += __shfl_xor(ss, 32);
          if (fq == 0) ssq1[ssq_idx((int)orow, h)] = ss; }
        asm volatile("s_waitcnt lgkmcnt(0)" ::: "memory"); __builtin_amdgcn_s_barrier(); asm volatile("" ::: "memory");
    }
}
__device__ void sc_unit(const Params& p, int unit, int wv) {
    const int tid = wv * 64 + lane_id(), cvx = tid & 255, th = tid >> 8;
    const bf16_t* proj = (const bf16_t*)(p.ws + WS_PROJ);
    bf16_t* ymix = (bf16_t*)(p.ws + WS_YMIX);
    const int t0 = unit * 64 + th * 32, c0 = cvx * 8;
    float w0[8], w1[8], w2[8];
    { const f32x4* a = (const f32x4*)(p.sc_conv_w + c0); const f32x4* bq = (const f32x4*)(p.sc_conv_w + 2048 + c0); const f32x4* cq = (const f32x4*)(p.sc_conv_w + 4096 + c0);
#pragma unroll
      for (int q = 0; q < 2; ++q) { const f32x4 x0 = a[q], x1 = bq[q], x2 = cq[q];
#pragma unroll
        for (int j = 0; j < 4; ++j) { w0[q * 4 + j] = x0[j]; w1[q * 4 + j] = x1[j]; w2[q * 4 + j] = x2[j]; } } }
    float pm1[8], pm2[8];
#pragma unroll
    for (int e = 0; e < 8; ++e) { pm1[e] = 0.f; pm2[e] = 0.f; }
    if ((t0 & (SEQ - 1)) != 0) {
        const bf16_t* r2 = proj + (size_t)(t0 - 2) * NPROJ, * r1 = proj + (size_t)(t0 - 1) * NPROJ;
        const u32x4 c2 = *(const u32x4*)(r2 + 8192 + c0), c1 = *(const u32x4*)(r1 + 8192 + c0);
#pragma unroll
        for (int q = 0; q < 4; ++q) { pm2[2 * q] = bflo(c2[q]); pm2[2 * q + 1] = bfhi(c2[q]); pm1[2 * q] = bflo(c1[q]); pm1[2 * q + 1] = bfhi(c1[q]); }
    }
#pragma unroll 4
    for (int i = 0; i < 32; ++i) {
        const bf16_t* r = proj + (size_t)(t0 + i) * NPROJ;
        const u32x4 gb = *(const u32x4*)(r + 6144 + c0), gp = *(const u32x4*)(r + 8192 + c0);
        float o[8];
#pragma unroll
        for (int q = 0; q < 4; ++q) {
            const float pa = bflo(gp[q]), pb = bfhi(gp[q]);
            o[2 * q] = bflo(gb[q]) * (w0[2 * q] * pm2[2 * q] + w1[2 * q] * pm1[2 * q] + w2[2 * q] * pa);
            o[2 * q + 1] = bfhi(gb[q]) * (w0[2 * q + 1] * pm2[2 * q + 1] + w1[2 * q + 1] * pm1[2 * q + 1] + w2[2 * q + 1] * pb);
            pm2[2 * q] = pm1[2 * q]; pm2[2 * q + 1] = pm1[2 * q + 1]; pm1[2 * q] = pa; pm1[2 * q + 1] = pb;
        }
        u32x4 wv; wv.x = cvt_pk_bf16(o[0], o[1]); wv.y = cvt_pk_bf16(o[2], o[3]); wv.z = cvt_pk_bf16(o[4], o[5]); wv.w = cvt_pk_bf16(o[6], o[7]);
        *(u32x4*)(ymix + (size_t)(t0 + i) * DMIX + 2048 + c0) = wv;
    }
}
__device__ void phase2(const Params& p, LAS unsigned char* lds, int wv) {
    const int G = gridDim.x, bid = blockIdx.x;
    const bool split = G >= 256;
    if (!split) bc_sequences(p, lds, bid, G, wv);
    if (!split || bid < 128) { for (int u = bid; u < 128; u += (split ? 128 : G)) ssd_unit(p, lds, u >> 5, u & 31, wv); }
    if (split && bid >= 128) bc_sequences(p, lds, bid - 128, G - 128, wv);
    if (!split || bid >= 128) { for (int u = (split ? bid - 128 : bid); u < M_ / 64; u += (split ? G - 128 : G)) sc_unit(p, u, wv); }
    if (!split || bid >= 128) wconv_units(p, lds, split ? bid - 128 : bid, split ? G - 128 : G, wv);
}

__device__ void phase6(const Params& p, int wv) {
    const int lane = lane_id(), wave = wv;
    const bf16_t* h2 = (const bf16_t*)(p.ws + WS_H1B);
    const float* ssq3 = (const float*)(p.ws + WS_SSQ3);
    for (int row = blockIdx.x * 8 + wave; row < M_; row += gridDim.x * 8) {
        float s = (lane < 32) ? ssq3[ssq_idx(row, lane)] : 0.f;
#pragma unroll
        for (int o = 32; o >= 1; o >>= 1) s += __shfl_xor(s, o);
        const float rstd = rsqrtf(s * (1.0f / 2048.0f) + EPS);
        const u32x2* hr = (const u32x2*)(h2 + (size_t)row * D_);
        f32x4* orow = (f32x4*)(p.out + (size_t)row * D_);
#pragma unroll
        for (int i = 0; i < 8; ++i) { const u32x2 hv = hr[lane + 64 * i]; const f32x4 v = (f32x4){bflo(hv.x), bfhi(hv.x), bflo(hv.y), bfhi(hv.y)}, g4 = ((const f32x4*)p.norm_final_g)[lane + 64 * i]; orow[lane + 64 * i] = v * rstd * g4; }
    }
}


#define XB_TMO      128
#define XB_XCNT(j)  (256  + 64 * (j))
#define XB_XSUB(j)  (1280 + 64 * (j))
#define XB_XGEN(j)  (2304 + 64 * (j))
#define XB_TOP      3328
#define XB_TOPGEN   3392
#define XCD_BAR_WORDS 3456
#define XB_SPIN_CAP (1u << 18)
__device__ __forceinline__ unsigned xb_ld(unsigned* p)              { return __hip_atomic_load(p, __ATOMIC_RELAXED, __HIP_MEMORY_SCOPE_AGENT); }
__device__ __forceinline__ unsigned xb_add(unsigned* p, unsigned v) { return __hip_atomic_fetch_add(p, v, __ATOMIC_RELAXED, __HIP_MEMORY_SCOPE_AGENT); }
__device__ __forceinline__ unsigned xb_xcc_id() { return (unsigned)__builtin_amdgcn_s_getreg((3 << 11) | 20) & 0xFu; }
#define XB_SPIN(cond, bar) do { unsigned _sp = 0; while (cond) { __builtin_amdgcn_s_sleep(1); \
    if ((++_sp & 255u) == 0u) { if (xb_ld(&(bar)[XB_TMO])) break; if (_sp > XB_SPIN_CAP) { atomicAdd(&(bar)[XB_TMO], 1u); break; } } } } while (0)
struct XcdBarrier { unsigned* bar; unsigned x; volatile LAS unsigned* st; };
__device__ __forceinline__ void xcd_barrier_complete(unsigned* bar, unsigned x, unsigned& nloc, unsigned& nx) {
    const unsigned G = gridDim.x * gridDim.y * gridDim.z;
    unsigned sum, cnt, mine, sp = 0u;
    for (;;) {
        sum = 0u; cnt = 0u; mine = 0u;
#pragma unroll
        for (unsigned j = 0; j < 16; ++j) { const unsigned c = xb_ld(&bar[XB_XCNT(j)]); sum += c; cnt += (c > 0u) ? 1u : 0u; mine = (j == x) ? c : mine; }
        if (sum == G) break;
        __builtin_amdgcn_s_sleep(1);
        if ((++sp & 255u) == 0u) { if (xb_ld(&bar[XB_TMO])) break; if (sp > XB_SPIN_CAP) { atomicAdd(&bar[XB_TMO], 1u); break; } }
    }
    nloc = mine > 0u ? mine : 1u; nx = cnt > 0u ? cnt : 1u;
}
__device__ __forceinline__ void xcd_barrier(const XcdBarrier& b, bool leader) {
    asm volatile("s_waitcnt vmcnt(0)" ::: "memory");
    __syncthreads();
    if (leader) {
        unsigned* bar = b.bar;
        __builtin_amdgcn_s_waitcnt(0);
        unsigned nloc = b.st[0], nx = b.st[1];
        if (nloc == 0u) { xcd_barrier_complete(bar, b.x, nloc, nx); b.st[0] = nloc; b.st[1] = nx; }
        const unsigned old = xb_add(&bar[XB_XSUB(b.x)], 1u);
        const unsigned gen = old / nloc;
        if (old + 1u == (gen + 1u) * nloc) {
            __builtin_amdgcn_fence(__ATOMIC_RELEASE, "agent");
            asm volatile("s_waitcnt vmcnt(0)" ::: "memory");
            const unsigned og = xb_add(&bar[XB_TOP], 1u);
            const unsigned tg = og / nx;
            if (og + 1u == (tg + 1u) * nx) xb_add(&bar[XB_TOPGEN], 1u);
            else XB_SPIN(xb_ld(&bar[XB_TOPGEN]) == tg, bar);
            __builtin_amdgcn_fence(__ATOMIC_ACQUIRE, "agent");
            xb_add(&bar[XB_XGEN(b.x)], 1u);
            asm volatile("s_waitcnt vmcnt(0)" ::: "memory");
        } else {
            XB_SPIN(xb_ld(&bar[XB_XGEN(b.x)]) == gen, bar);
            __builtin_amdgcn_fence(__ATOMIC_ACQUIRE, "agent");
            asm volatile("s_waitcnt vmcnt(0)" ::: "memory");
        }
    }
    __syncthreads();
}

__global__ void __launch_bounds__(512) hymba_fwd(Params p) {
    extern __shared__ __attribute__((aligned(16))) unsigned char shm[];
    LAS unsigned char* lds = (LAS unsigned char*)shm;
    cg::grid_group grid = cg::this_grid();
    const int lo = p.ph_lo, hi = p.ph_hi;
    const int wv = __builtin_amdgcn_readfirstlane(threadIdx.x >> 6);
#ifdef DBG_CLEAR
    for (int i = threadIdx.x; i < LDS_BYTES / 16; i += 512) *(LAS u32x4*)(lds + i * 16) = (u32x4){0u, 0u, 0u, 0u};
    __syncthreads();
#endif
#define IN(k) (lo <= (k) && (k) < hi)
#define SEAM(k) do { if (IN(k) && IN((k) + 1)) { \
        asm volatile("s_waitcnt vmcnt(0) lgkmcnt(0)" ::: "memory"); __syncthreads();                 \
        if (wv == 0) { __builtin_amdgcn_fence(__ATOMIC_RELEASE, "agent"); asm volatile("s_waitcnt vmcnt(0)" ::: "memory"); }     \
        grid.sync(); \
        if (wv == 0) { __builtin_amdgcn_fence(__ATOMIC_ACQUIRE, "agent"); asm volatile("s_waitcnt vmcnt(0)" ::: "memory"); }     \
        __syncthreads(); } } while (0)
    volatile LAS unsigned* xst = (volatile LAS unsigned*)(lds + LDS_BYTES - 16);
    const bool xlead = (wv == 0) && (lane_id() == 0);
    if (xlead) { xst[0] = 0u; xst[1] = 0u; }
    __syncthreads();
    XcdBarrier xb; xb.bar = (unsigned*)((unsigned char*)p.out + DO_XBAR); xb.x = xb_xcc_id(); xb.st = xst;
    if (xlead) (void)xb_add(&xb.bar[XB_XCNT(xb.x)], 1u);
#define XSEAM(k) do { if (IN(k) && IN((k) + 1)) xcd_barrier(xb, (wv == 0) && (lane_id() == 0)); } while (0)
    if (IN(0)) for (int rep = 0; rep < NREP(0); ++rep) phase0(p, lds, wv);
    XSEAM(0);
    if (IN(1)) for (int rep = 0; rep < NREP(1); ++rep) {
        pg8::Gemm g{(const bf16_t*)(p.ws + WS_XN), (const bf16_t*)(p.ws + WS_BTIN), M_, NPROJ, D_}; pg8::StaticOrder S; S.init(M_, NPROJ, gridDim.x, blockIdx.x);
        if (gridDim.x == 256) { S.nrounds = 12; S.rot = 3 * ((blockIdx.x >> 6) & 3); }
        EpiProj E{(bf16_t*)(p.ws + WS_PROJ)};
        pg8::gemm_phase<EpiProj>(lds, g, S, E, wv);
        dt_units(p, lds, wv);
    }
    XSEAM(1);
    if (IN(3)) for (int rep = 0; rep < NREP(3); ++rep) phase2(p, lds, wv);
    XSEAM(3);
    if (IN(4)) for (int rep = 0; rep < NREP(4); ++rep) {
        pg8::Gemm g{(const bf16_t*)(p.ws + WS_YMIX), (const bf16_t*)((unsigned char*)p.out + DO_BTOUT), M_, D_, DMIX}; pg8::StaticOrder S; S.init(M_, D_, gridDim.x, blockIdx.x);
        EpiOut E{p.x, (bf16_t*)(p.ws + WS_H1B), (const float*)((unsigned char*)p.out + DO_SSQ1), (float*)((unsigned char*)p.out + DO_SSQ2)};
        pg8::gemm_phase<EpiOut>(lds, g, S, E, wv);
    }
    XSEAM(4);
    if (IN(5)) for (int rep = 0; rep < NREP(5); ++rep) {
        pg8::Gemm g{(const bf16_t*)(p.ws + WS_H1B), (const bf16_t*)((unsigned char*)p.out + DO_BTGU), M_, NGU, D_}; pg8::StaticOrder S; S.init(M_, NGU, gridDim.x, blockIdx.x);
        EpiGU E{(const float*)((unsigned char*)p.out + DO_SSQ2), (bf16_t*)(p.ws + WS_HFF)};
        pg8::gemm_phase<EpiGU>(lds, g, S, E, wv);
    }
    XSEAM(5);
    if (IN(6)) {
        pg8::Gemm g{(const bf16_t*)(p.ws + WS_HFF), (const bf16_t*)((unsigned char*)p.out + DO_BTDN), M_, D_, DFF}; pg8::StaticOrder S; S.init(M_, D_, gridDim.x, blockIdx.x);
        EpiDown E{(bf16_t*)(p.ws + WS_H1B), (float*)(p.ws + WS_SSQ3)};
        pg8::gemm_phase<EpiDown>(lds, g, S, E, wv);
    }
    XSEAM(6);
    if (p.ph_hi > 1000) grid.sync();
    if (IN(7)) for (int rep = 0; rep < NREP(7); ++rep) phase6(p, wv);
#undef IN
#undef SEAM
}

extern "C" void kernel_launch(void* const* d_in, const int* in_sizes, int n_in, void* d_out, int out_size, void* d_ws, size_t ws_size, hipStream_t stream) {
    static int grid = 0;
    if (grid == 0) {
        if (n_in != 16 || out_size != M_ * D_ || ws_size < WS_NEED) { fprintf(stderr, "kernel_launch: unexpected shapes (n_in %d out %d ws %zu, need %zu)\n", n_in, out_size, ws_size, (size_t)WS_NEED); grid = -1; return; }
        int dev = 0, cus = 0, per_cu = 0;
        (void)hipGetDevice(&dev);
        (void)hipDeviceGetAttribute(&cus, hipDeviceAttributeMultiprocessorCount, dev);
        if (hipFuncSetAttribute((const void*)hymba_fwd, hipFuncAttributeMaxDynamicSharedMemorySize, LDS_BYTES) != hipSuccess) { fprintf(stderr, "kernel_launch: hipFuncSetAttribute failed\n"); grid = -1; return; }
        if (hipOccupancyMaxActiveBlocksPerMultiprocessor(&per_cu, (const void*)hymba_fwd, 512, LDS_BYTES) != hipSuccess || per_cu < 1) { fprintf(stderr, "kernel_launch: occupancy query failed (%d)\n", per_cu); (void)hipGetLastError(); per_cu = 1; }
        grid = cus * per_cu;
    }
    if (grid < 0) return;
    Params p{};
    p.x = (const float*)d_in[0]; p.norm_mix_g = (const float*)d_in[1]; p.w_in = (const float*)d_in[2]; p.ssm_conv_w = (const float*)d_in[3]; p.ssm_conv_b = (const float*)d_in[4];
    p.ssm_dt_bias = (const float*)d_in[5]; p.ssm_A_log = (const float*)d_in[6]; p.ssm_D = (const float*)d_in[7]; p.ssm_norm_g = (const float*)d_in[8]; p.sc_conv_w = (const float*)d_in[9];
    p.w_out = (const float*)d_in[10]; p.norm_ffn_g = (const float*)d_in[11]; p.w_gate = (const float*)d_in[12]; p.w_up = (const float*)d_in[13]; p.w_down = (const float*)d_in[14]; p.norm_final_g = (const float*)d_in[15];
    p.out = (float*)d_out; p.ws = (unsigned char*)d_ws;
#ifdef DBG_MEMSET
    (void)hipMemsetAsync(d_ws, 0, WS_NEED, stream); (void)hipMemsetAsync(d_out, 0, (size_t)out_size * 4, stream);
#endif
#ifndef N_CUTS
#define N_CUTS 1
#endif
    for (int li = 0; li < N_CUTS; ++li) {
        p.ph_lo = (N_CUTS == 8) ? li : 0; p.ph_hi = (N_CUTS == 8) ? li + 1 : 8;
        (void)hipMemsetAsync((unsigned char*)d_out + DO_BCFLAG, 0, 4096 + XCD_BAR_WORDS * sizeof(unsigned), stream);
    void* args[] = {&p};
        hipError_t e = hipLaunchCooperativeKernel((const void*)hymba_fwd, dim3(grid), dim3(512), args, LDS_BYTES, stream);
        if (e != hipSuccess) fprintf(stderr, "kernel_launch: cooperative launch failed: %s (grid %d)\n", hipGetErrorString(e), grid);
    }
}
```

```cpp
#include <hip/hip_runtime.h>
#include <hip/hip_cooperative_groups.h>
#include <cstdio>
namespace cg = cooperative_groups;

#define LAS __attribute__((address_space(3)))
typedef unsigned short bf16_t;
typedef short bf16x8 __attribute__((ext_vector_type(8)));
typedef float f32x4 __attribute__((ext_vector_type(4)));
typedef unsigned u32x4 __attribute__((ext_vector_type(4)));
typedef unsigned u32x2 __attribute__((ext_vector_type(2)));

constexpr int M_ = 16384, D_ = 2048, DIN = 12320, NPROJ = 12288, DFF = 5632, DMIX = 4096, NGU = 11264;
constexpr int SEQ = 4096;
constexpr float EPS = 1e-5f;
constexpr int LDS_BYTES = 159744;
constexpr int XCD_BAR_WORDS_C = 3456;
#ifndef PROBE_PHASE
#define PROBE_PHASE -1
#endif
#define NREP(k) ((PROBE_PHASE == (k)) ? 1 + (p.ph_hi < 100) : 1)
constexpr int TAB_OFF = 131072;

constexpr size_t WS_PROJ = 0;
constexpr size_t WS_R = (size_t)M_ * NPROJ * 2;
constexpr size_t WS_XN = WS_R;
constexpr size_t WS_BTIN = WS_R + (size_t)M_ * D_ * 2;
constexpr size_t WS_YMIX = WS_R;
constexpr size_t WS_H1F = 0;
constexpr size_t WS_H1B = (size_t)M_ * D_ * 4;
constexpr size_t WS_HFF = WS_H1B + (size_t)M_ * D_ * 2;
constexpr size_t WS_SSQ3 = WS_HFF + (size_t)M_ * DFF * 2;
constexpr size_t WS_NEED = WS_R + (size_t)M_ * DMIX * 2;
constexpr size_t DO_BTOUT = 0;
constexpr size_t DO_BTGU = (size_t)D_ * DMIX * 2;
constexpr size_t DO_BTDN = DO_BTGU + (size_t)NGU * D_ * 2;
constexpr size_t DO_DT = DO_BTDN + (size_t)D_ * DFF * 2;
constexpr size_t DO_SSQ1 = DO_DT + (size_t)M_ * 32 * 4;
constexpr size_t DO_SSQ2 = DO_SSQ1 + (size_t)M_ * 32 * 4;
constexpr size_t DO_XBAR = (size_t)M_ * D_ * 4 - 16384;
constexpr size_t DO_BCFLAG = DO_XBAR - 4096;
static_assert(DO_SSQ2 + (size_t)M_ * 32 * 4 <= DO_BCFLAG && XCD_BAR_WORDS_C * 4 <= 16384, "d_out scratch");

static_assert(WS_SSQ3 + (size_t)M_ * 32 * 4 <= WS_R, "ws overlay");

struct Params {
    const float* x; const float* norm_mix_g; const float* w_in; const float* ssm_conv_w; const float* ssm_conv_b;
    const float* ssm_dt_bias; const float* ssm_A_log; const float* ssm_D; const float* ssm_norm_g; const float* sc_conv_w;
    const float* w_out; const float* norm_ffn_g; const float* w_gate; const float* w_up; const float* w_down; const float* norm_final_g;
    float* out; unsigned char* ws; int ph_lo, ph_hi;
};

typedef float f32x2_t __attribute__((ext_vector_type(2)));
typedef __bf16 bf16x2_t __attribute__((ext_vector_type(2)));
__device__ __forceinline__ unsigned cvt_pk_bf16(float lo, float hi) { const f32x2_t v = {lo, hi}; return __builtin_bit_cast(unsigned, __builtin_convertvector(v, bf16x2_t)); }
__device__ __forceinline__ float bflo(unsigned u) { return __uint_as_float(u << 16); }
__device__ __forceinline__ float bfhi(unsigned u) { return __uint_as_float(u & 0xffff0000u); }
__device__ __forceinline__ int lane_id() { int l; asm volatile("v_mbcnt_lo_u32_b32 %0, -1, 0\n\tv_mbcnt_hi_u32_b32 %0, -1, %0" : "=v"(l)); return l; }
__device__ __forceinline__ float silu_f(float v) { return v * __builtin_amdgcn_rcpf(1.0f + __expf(-v)); }

__device__ __forceinline__ size_t ssq_idx(int row, int part) { return ((size_t)(row >> 5) * 32 + part) * 32 + (row & 31); }

namespace pg8 {
constexpr int BM = 256, BK = 64, HALF = 128, HTB = HALF * BK * 2, STAGE_BYTES = 8 * HTB, NXCD = 8, WGM = 8;
__device__ __forceinline__ int lds_byte(int r, int c) { const int st = (r >> 4) * 2 + (c >> 5), rr = r & 15, cc = c & 31, ob = rr * 64 + cc * 2; return st * 1024 + (ob ^ (((ob >> 9) & 1) << 5)); }
__device__ __forceinline__ void stage_rc(int b, int& R, int& C) { const int st = b / 1024, sb = b % 1024, swz = sb ^ (((sb >> 9) & 1) << 5); R = (st >> 1) * 16 + swz / 64; C = (st & 1) * 32 + (swz % 64) / 2; }
__device__ __forceinline__ int perm32(int rho) { const int n = rho >> 4, i = rho & 15; return 8 * (i >> 2) + 4 * n + (i & 3); }
struct Unit { int pm, pn; };
struct Gemm { const bf16_t* A; const bf16_t* Bt; int M, N, K; };
struct StaticOrder {
    int nM, nN, nwg, G, c, rot = 0, nrounds = 1;
    __device__ void init(int M, int N, int G_, int c_) { nM = M / BM; nN = N / BM; nwg = nM * nN; G = G_; c = c_; }
    __device__ bool next(int i, Unit& u) const {
        if (rot != 0 && i < nrounds) i = (i + rot) % nrounds;
        const long L = (long)i * G + c; if (L >= nwg) return false;
        int wgid = (int)L; { const int q = nwg / NXCD, r = nwg % NXCD, xcd = wgid % NXCD, off = wgid / NXCD; wgid = (xcd < r ? xcd * (q + 1) : r * (q + 1) + (xcd - r) * q) + off; }
        const int nig = WGM * nN, gid = wgid / nig, fm = gid * WGM, gsz = (nM - fm) < WGM ? (nM - fm) : WGM;
        u.pm = fm + ((wgid % nig) % gsz); u.pn = (wgid % nig) / gsz; return true;
    }
};
template <class Epi>
__device__ __forceinline__ void gemm_phase(LAS unsigned char* lds, const Gemm g, const StaticOrder& S, const Epi& E, int wv) {
    const int wid = wv, lane = lane_id(), tid = wid * 64 + lane, wr = wid >> 2, wc = wid & 3, fr = lane & 15, fq = lane >> 4;
    const int K = g.K, nt = K / BK;
    unsigned voffA[2], voffB[2];
#pragma unroll
    for (int i = 0; i < 2; ++i) { int R, C; stage_rc(tid * 16 + i * 8192, R, C); const int Rb = (R & ~31) + perm32(R & 31);
        voffA[i] = (unsigned)(R * K + C) * 2u; voffB[i] = (unsigned)(Rb * K + C) * 2u; }
    const size_t kstep = (size_t)(BK * 2);
    const size_t hstep = (size_t)HALF * K * 2;
    const size_t tstep = 2 * hstep;
    const unsigned ldsw = (unsigned)wid * 1024u;
    const int aoff = lds_byte(wr * 64 + fr, fq * 8), boff = lds_byte(wc * 32 + fr, fq * 8);
#define PG8_SA(b, h) (((b) * 2 + (h)) * HTB)
#define PG8_SB(b, h) ((4 + (b) * 2 + (h)) * HTB)
#define PG8_STAGE(bufoff, gbase, voff) do { _Pragma("unroll") for (int _i = 0; _i < 2; ++_i) \
        __builtin_amdgcn_global_load_lds((const unsigned*)((const char*)(gbase) + (voff)[_i]), (LAS unsigned*)(lds + (bufoff) + ldsw + _i * 8192), 16, 0, 0); } while (0)
#define PG8_LDA(dst, b, h) do { _Pragma("unroll") for (int m = 0; m < 4; ++m) _Pragma("unroll") for (int k = 0; k < 2; ++k) dst[m][k] = *(const LAS bf16x8*)(lds + PG8_SA(b, h) + aoff + m * 2048 + k * 1024); } while (0)
#define PG8_LDB(dst, b, h) do { _Pragma("unroll") for (int n = 0; n < 2; ++n) _Pragma("unroll") for (int k = 0; k < 2; ++k) dst[n][k] = *(const LAS bf16x8*)(lds + PG8_SB(b, h) + boff + n * 2048 + k * 1024); } while (0)
#define PG8_MMA(ai, bj, At, Bt) do { __builtin_amdgcn_s_setprio(1); _Pragma("unroll") for (int m = 0; m < 4; ++m) _Pragma("unroll") for (int n = 0; n < 2; ++n) _Pragma("unroll") for (int k = 0; k < 2; ++k) \
        acc[ai][bj][m][n] = __builtin_amdgcn_mfma_f32_16x16x32_bf16(Bt[n][k], At[m][k], acc[ai][bj][m][n], 0, 0, 0); __builtin_amdgcn_s_setprio(0); } while (0)
#define PG8_WAIT_V(n) asm volatile("s_waitcnt vmcnt(" #n ")" ::: "memory")
#define PG8_WAIT_L(n) asm volatile("s_waitcnt lgkmcnt(" #n ")" ::: "memory")
#define PG8_BAR __builtin_amdgcn_s_barrier()
#define PG8_SCHED __builtin_amdgcn_sched_barrier(0)
    Unit cur, nxt; int ui = 0;
    if (!S.next(0, cur)) return;
    f32x4 acc[2][2][4][2];
#pragma unroll
    for (int a = 0; a < 2; ++a)
#pragma unroll
        for (int b = 0; b < 2; ++b)
#pragma unroll
            for (int m = 0; m < 4; ++m)
#pragma unroll
                for (int n = 0; n < 2; ++n) acc[a][b][m][n] = (f32x4){0.f, 0.f, 0.f, 0.f};
    bf16x8 At[4][2], B0[2][2], B1[2][2];
    const char* cA = (const char*)g.A + (size_t)cur.pm * tstep; const char* cB = (const char*)g.Bt + (size_t)cur.pn * tstep;
    if constexpr (Epi::HAS_TAB) {
        Unit uu; for (int i = 0; i < 27 && S.next(i, uu); ++i) E.prep(uu, (LAS float*)(lds + TAB_OFF + i * 1024), tid);
    }
    PG8_STAGE(PG8_SB(0, 0), cB, voffB); PG8_STAGE(PG8_SB(0, 1), cB + hstep, voffB); PG8_STAGE(PG8_SA(0, 0), cA, voffA); PG8_STAGE(PG8_SA(0, 1), cA + hstep, voffA);
    if (wr == 1) PG8_BAR;
    PG8_WAIT_V(2); PG8_BAR;
    PG8_STAGE(PG8_SB(1, 0), cB + kstep, voffB); PG8_STAGE(PG8_SA(1, 0), cA + kstep, voffA); PG8_STAGE(PG8_SB(1, 1), cB + hstep + kstep, voffB);
    PG8_WAIT_V(6); PG8_BAR;
    for (;;) {
        const bool has_next = S.next(ui + 1, nxt);
        const char* nA = has_next ? (const char*)g.A + (size_t)nxt.pm * tstep : cA; const char* nB = has_next ? (const char*)g.Bt + (size_t)nxt.pn * tstep : cB;
        LAS const float* tabc = (LAS const float*)(lds + TAB_OFF + ui * 1024);
        for (int t = 0; t < nt; t += 2) {
            const bool last = (t == nt - 2);
            const char* a1 = cA + (size_t)(t + 1) * kstep;
            const char* a2 = last ? nA : cA + (size_t)(t + 2) * kstep; const char* b2 = last ? nB : cB + (size_t)(t + 2) * kstep;
            const char* a3 = a2 + kstep; const char* b3 = b2 + kstep;
            if constexpr (Epi::MID_T >= 0) { if (t == Epi::MID_T) {
#pragma unroll
                for (int ai = 0; ai < 2; ++ai)
#pragma unroll
                    for (int m = 0; m < 4; ++m) { const float s = tabc[ai * HALF + wr * 64 + m * 16 + fr];
#pragma unroll
                        for (int bj = 0; bj < 2; ++bj)
#pragma unroll
                            for (int n = 0; n < 2; ++n) acc[ai][bj][m][n] *= s; } } }
            PG8_LDB(B0, 0, 0); PG8_LDB(B1, 0, 1); PG8_SCHED; PG8_LDA(At, 0, 0); PG8_STAGE(PG8_SA(1, 1), a1 + hstep, voffA);
            PG8_WAIT_V(8); PG8_WAIT_L(0); PG8_BAR; PG8_MMA(0, 0, At, B0); PG8_MMA(0, 1, At, B1); PG8_BAR; PG8_SCHED;
            PG8_LDA(At, 0, 1); PG8_STAGE(PG8_SB(0, 0), b2, voffB); PG8_STAGE(PG8_SB(0, 1), b2 + hstep, voffB); PG8_STAGE(PG8_SA(0, 0), a2, voffA);
            PG8_WAIT_V(8); PG8_WAIT_L(0); PG8_BAR; PG8_MMA(1, 0, At, B0); PG8_MMA(1, 1, At, B1); PG8_BAR; PG8_SCHED;
            PG8_LDB(B0, 1, 0); PG8_LDB(B1, 1, 1); PG8_SCHED; PG8_LDA(At, 1, 0); PG8_STAGE(PG8_SA(0, 1), a2 + hstep, voffA);
            PG8_WAIT_V(8); PG8_WAIT_L(0); PG8_BAR; PG8_MMA(0, 0, At, B0); PG8_MMA(0, 1, At, B1); PG8_BAR; PG8_SCHED;
            PG8_LDA(At, 1, 1); PG8_STAGE(PG8_SB(1, 0), b3, voffB); PG8_STAGE(PG8_SB(1, 1), b3 + hstep, voffB); PG8_STAGE(PG8_SA(1, 0), a3, voffA);
            PG8_WAIT_V(8); PG8_WAIT_L(0); PG8_BAR; PG8_MMA(1, 0, At, B0); PG8_MMA(1, 1, At, B1); PG8_BAR; PG8_SCHED;
        }
        if (wr == 0) PG8_BAR;
        E(acc, cur, tabc, wr, wc, fr, fq);
        if (!has_next) break;
#pragma unroll
        for (int a = 0; a < 2; ++a)
#pragma unroll
            for (int b = 0; b < 2; ++b)
#pragma unroll
                for (int m = 0; m < 4; ++m)
#pragma unroll
                    for (int n = 0; n < 2; ++n) acc[a][b][m][n] = (f32x4){0.f, 0.f, 0.f, 0.f};
        cur = nxt; cA = nA; cB = nB; ++ui;
        if (wr == 1) PG8_BAR;
    }
    PG8_WAIT_V(0);
    PG8_BAR;
#undef PG8_SA
#undef PG8_SB
#undef PG8_STAGE
#undef PG8_LDA
#undef PG8_LDB
#undef PG8_MMA
#undef PG8_WAIT_V
#undef PG8_WAIT_L
#undef PG8_BAR
#undef PG8_SCHED
}
}

__device__ __forceinline__ void rstd_table(const float* ssq, int row0, LAS float* tab, int t) {
    const int r = t >> 1, hf = t & 1;
    const float* p = ssq + ssq_idx(row0 + r, hf * 16);
    float s = 0.f;
#pragma unroll
    for (int i = 0; i < 16; ++i) s += p[i * 32];
    s += __shfl_xor(s, 1);
    if (!hf) tab[r] = rsqrtf(s * (1.0f / 2048.0f) + EPS);
}

struct EpiProj {
    static constexpr bool HAS_TAB = false; static constexpr int MID_T = -1;
    bf16_t* O;
    __device__ __forceinline__ void prep(const pg8::Unit&, LAS float*, int) const {}
    __device__ __forceinline__ void operator()(const f32x4 (&acc)[2][2][4][2], const pg8::Unit& u, LAS const float*, int wr, int wc, int fr, int fq) const {
        const int row0 = u.pm * 256 + wr * 64 + fr, col0 = u.pn * 256 + wc * 32 + 8 * fq;
        if (u.pn >= 32) {
            const int pcol = 8192 + (u.pn - 32) * 128 + wc * 32 + 8 * fq;
#pragma unroll
            for (int ai = 0; ai < 2; ++ai)
#pragma unroll
                for (int m = 0; m < 4; ++m) { const f32x4 v0 = acc[ai][0][m][0] * acc[ai][1][m][0], v1 = acc[ai][0][m][1] * acc[ai][1][m][1];
                    u32x4 w; w.x = cvt_pk_bf16(v0[0], v0[1]); w.y = cvt_pk_bf16(v0[2], v0[3]); w.z = cvt_pk_bf16(v1[0], v1[1]); w.w = cvt_pk_bf16(v1[2], v1[3]);
                    *(u32x4*)(O + (size_t)(row0 + ai * 128 + m * 16) * NPROJ + pcol) = w; }
            return;
        }
#pragma unroll
        for (int ai = 0; ai < 2; ++ai)
#pragma unroll
            for (int m = 0; m < 4; ++m) { bf16_t* rowp = O + (size_t)(row0 + ai * 128 + m * 16) * NPROJ + col0;
#pragma unroll
                for (int bj = 0; bj < 2; ++bj) { const f32x4 v0 = acc[ai][bj][m][0], v1 = acc[ai][bj][m][1];
                    u32x4 w; w.x = cvt_pk_bf16(v0[0], v0[1]); w.y = cvt_pk_bf16(v0[2], v0[3]); w.z = cvt_pk_bf16(v1[0], v1[1]); w.w = cvt_pk_bf16(v1[2], v1[3]);
                    *(u32x4*)(rowp + bj * 128) = w; } }
    }
};
struct EpiOut {
    static constexpr bool HAS_TAB = true; static constexpr int MID_T = 32;
    const float* x; bf16_t* h1b; const float* ssq1; float* ssq2;
    __device__ __forceinline__ void prep(const pg8::Unit& u, LAS float* tab, int t) const { rstd_table(ssq1, u.pm * 256, tab, t); }
    __device__ __forceinline__ void operator()(const f32x4 (&acc)[2][2][4][2], const pg8::Unit& u, LAS const float*, int wr, int wc, int fr, int fq) const {
        const int row0 = u.pm * 256 + wr * 64 + fr, col0 = u.pn * 256 + wc * 32 + 8 * fq;
#pragma unroll
        for (int ai = 0; ai < 2; ++ai)
#pragma unroll
            for (int m = 0; m < 4; ++m) { const int row = row0 + ai * 128 + m * 16; const size_t off = (size_t)row * D_ + col0; float ss = 0.f;
#pragma unroll
                for (int bj = 0; bj < 2; ++bj) {
                    const f32x4 x0 = *(const f32x4*)(x + off + bj * 128), x1 = *(const f32x4*)(x + off + bj * 128 + 4);
                    const f32x4 v0 = acc[ai][bj][m][0] + x0, v1 = acc[ai][bj][m][1] + x1;
                    u32x4 w; w.x = cvt_pk_bf16(v0[0], v0[1]); w.y = cvt_pk_bf16(v0[2], v0[3]); w.z = cvt_pk_bf16(v1[0], v1[1]); w.w = cvt_pk_bf16(v1[2], v1[3]);
                    *(u32x4*)(h1b + off + bj * 128) = w;
                    ss += (v0[0] * v0[0] + v0[1] * v0[1]) + (v0[2] * v0[2] + v0[3] * v0[3]) + (v1[0] * v1[0] + v1[1] * v1[1]) + (v1[2] * v1[2] + v1[3] * v1[3]); }
                ss += __shfl_xor(ss, 16); ss += __shfl_xor(ss, 32);
                if (fq == 0) ssq2[ssq_idx(row, u.pn * 4 + wc)] = ss; }
    }
};
struct EpiGU {
    static constexpr bool HAS_TAB = true; static constexpr int MID_T = -1;
    const float* ssq2; bf16_t* hff;
    __device__ __forceinline__ void prep(const pg8::Unit& u, LAS float* tab, int t) const { rstd_table(ssq2, u.pm * 256, tab, t); }
    __device__ __forceinline__ void operator()(const f32x4 (&acc)[2][2][4][2], const pg8::Unit& u, LAS const float* tab, int wr, int wc, int fr, int fq) const {
        const int row0 = u.pm * 256 + wr * 64 + fr, col0 = u.pn * 128 + wc * 32 + 8 * fq;
#pragma unroll
        for (int ai = 0; ai < 2; ++ai)
#pragma unroll
            for (int m = 0; m < 4; ++m) { const float rs = tab[ai * 128 + wr * 64 + m * 16 + fr];
                float o[8];
#pragma unroll
                for (int n = 0; n < 2; ++n)
#pragma unroll
                    for (int j = 0; j < 4; ++j) { const float gg = acc[ai][0][m][n][j] * rs, uu = acc[ai][1][m][n][j] * rs; o[n * 4 + j] = silu_f(gg) * uu; }
                u32x4 w; w.x = cvt_pk_bf16(o[0], o[1]); w.y = cvt_pk_bf16(o[2], o[3]); w.z = cvt_pk_bf16(o[4], o[5]); w.w = cvt_pk_bf16(o[6], o[7]);
                *(u32x4*)(hff + (size_t)(row0 + ai * 128 + m * 16) * DFF + col0) = w; }
    }
};
struct EpiDown {
    static constexpr bool HAS_TAB = false; static constexpr int MID_T = -1;
    bf16_t* h; float* ssq3;
    __device__ __forceinline__ void prep(const pg8::Unit&, LAS float*, int) const {}
    __device__ __forceinline__ void operator()(const f32x4 (&acc)[2][2][4][2], const pg8::Unit& u, LAS const float*, int wr, int wc, int fr, int fq) const {
        const int row0 = u.pm * 256 + wr * 64 + fr, col0 = u.pn * 256 + wc * 32 + 8 * fq;
#pragma unroll
        for (int ai = 0; ai < 2; ++ai)
#pragma unroll
            for (int m = 0; m < 4; ++m) { const int row = row0 + ai * 128 + m * 16; const size_t off = (size_t)row * D_ + col0; float ss = 0.f;
#pragma unroll
                for (int bj = 0; bj < 2; ++bj) {
                    const u32x4 xb = *(const u32x4*)(h + off + bj * 128);
                    const f32x4 x0 = (f32x4){bflo(xb.x), bfhi(xb.x), bflo(xb.y), bfhi(xb.y)}, x1 = (f32x4){bflo(xb.z), bfhi(xb.z), bflo(xb.w), bfhi(xb.w)};
                    const f32x4 v0 = acc[ai][bj][m][0] + x0, v1 = acc[ai][bj][m][1] + x1;
                    u32x4 w; w.x = cvt_pk_bf16(v0[0], v0[1]); w.y = cvt_pk_bf16(v0[2], v0[3]); w.z = cvt_pk_bf16(v1[0], v1[1]); w.w = cvt_pk_bf16(v1[2], v1[3]);
                    *(u32x4*)(h + off + bj * 128) = w;
                    ss += (v0[0] * v0[0] + v0[1] * v0[1]) + (v0[2] * v0[2] + v0[3] * v0[3]) + (v1[0] * v1[0] + v1[1] * v1[1]) + (v1[2] * v1[2] + v1[3] * v1[3]); }
                ss += __shfl_xor(ss, 16); ss += __shfl_xor(ss, 32);
                if (fq == 0) ssq3[ssq_idx(row, u.pn * 4 + wc)] = ss; }
    }
};

__device__ __forceinline__ void p0_tile(LAS float* t, const float* src, int ldsrc, int k0, int c0, int jvalid, bf16_t* dst, int K, int j0, const float* scale, int scale_kmax, int tid) {
    const int jc4 = (tid & 15) * 4, kr0 = tid >> 4;
#pragma unroll
    for (int i = 0; i < 4; ++i) {
        const int kr = kr0 + 32 * i;
        f32x4 v = (f32x4){0.f, 0.f, 0.f, 0.f};
        if (jc4 < jvalid) v = *(const f32x4*)(src + (size_t)(k0 + kr) * ldsrc + c0 + jc4);
        const float s = (scale != nullptr && (k0 + kr) < scale_kmax) ? scale[k0 + kr] : 1.0f;
        t[kr * 65 + jc4 + 0] = v[0] * s; t[kr * 65 + jc4 + 1] = v[1] * s; t[kr * 65 + jc4 + 2] = v[2] * s; t[kr * 65 + jc4 + 3] = v[3] * s;
    }
    __syncthreads();
    const int kp = (tid & 63) * 2, jr0 = tid >> 6;
#pragma unroll
    for (int i = 0; i < 8; ++i) {
        const int j = jr0 + 8 * i;
        if (j < jvalid) { const float a = t[kp * 65 + j], b = t[(kp + 1) * 65 + j];
            *(unsigned*)(dst + (size_t)(j0 + j) * K + k0 + kp) = cvt_pk_bf16(a, b); }
    }
    __syncthreads();
}
struct TileD { const float* src; const float* scale; bf16_t* dst; int ldsrc, k0, c0, jvalid, K, j0, kmax; };
__device__ __forceinline__ TileD tile_decode(const Params& p, int u) {
    constexpr int U_IN = 16 * 193, U_OUT = 32 * 32, U_GU = 16 * 176;
    TileD d;
    if (u < U_IN) { const int kt = u & 15, jt = u >> 4, j0 = jt * 64;
        d.src = p.w_in; d.scale = nullptr; d.dst = (bf16_t*)(p.ws + WS_BTIN); d.ldsrc = DIN; d.k0 = kt * 128; d.c0 = j0 < 6144 ? j0 : (j0 < 8192 ? j0 + 32 : (j0 < 12288 ? (((j0 & 255) < 128 ? 8224 : 10272 - 128) + 128 * ((j0 - 8192) >> 8) + (j0 & 255)) : 6144));     d.jvalid = (jt == 192) ? 32 : 64; d.K = D_; d.j0 = j0; d.kmax = 0; }
    else if (u < U_IN + U_OUT) { const int v = u - U_IN, kt = v & 31, jt = v >> 5;
        d.src = p.w_out; d.scale = p.ssm_norm_g; d.dst = (bf16_t*)((unsigned char*)p.out + DO_BTOUT); d.ldsrc = D_; d.k0 = kt * 128; d.c0 = jt * 64; d.jvalid = 64; d.K = DMIX; d.j0 = jt * 64; d.kmax = 2048; }
    else if (u < U_IN + U_OUT + U_GU) { const int v = u - U_IN - U_OUT, kt = v & 15, jt = v >> 4, j0 = jt * 64, pn = j0 >> 8, r0 = j0 & 255;
        d.src = r0 < 128 ? p.w_gate : p.w_up; d.scale = p.norm_ffn_g; d.dst = (bf16_t*)((unsigned char*)p.out + DO_BTGU); d.ldsrc = DFF; d.k0 = kt * 128; d.c0 = 128 * pn + (r0 & 127); d.jvalid = 64; d.K = D_; d.j0 = j0; d.kmax = 2048; }
    else { const int v = u - U_IN - U_OUT - U_GU, kt = v % 44, jt = v / 44;
        d.src = p.w_down; d.scale = nullptr; d.dst = (bf16_t*)((unsigned char*)p.out + DO_BTDN); d.ldsrc = D_; d.k0 = kt * 128; d.c0 = jt * 64; d.jvalid = 64; d.K = DFF; d.j0 = jt * 64; d.kmax = 0; }
    return d;
}
__device__ __forceinline__ void tile_load(const TileD& d, int tid, f32x4 (&v)[4], float (&scl)[4]) {
    const int jc4 = (tid & 15) * 4, kr0 = tid >> 4;
#pragma unroll
    for (int i = 0; i < 4; ++i) { const int kr = kr0 + 32 * i;
        f32x4 x = (f32x4){0.f, 0.f, 0.f, 0.f};
        if (jc4 < d.jvalid) x = *(const f32x4*)(d.src + (size_t)(d.k0 + kr) * d.ldsrc + d.c0 + jc4);
        scl[i] = (d.scale != nullptr && (d.k0 + kr) < d.kmax) ? d.scale[d.k0 + kr] : 1.0f;
        v[i] = x; }
}
__device__ __forceinline__ void tile_finish(LAS float* t, const TileD& d, int tid, const f32x4 (&v)[4], const float (&scl)[4]) {
    const int jc4 = (tid & 15) * 4, kr0 = tid >> 4;
#pragma unroll
    for (int i = 0; i < 4; ++i) { const int kr = kr0 + 32 * i;
        t[kr * 65 + jc4 + 0] = v[i][0] * scl[i]; t[kr * 65 + jc4 + 1] = v[i][1] * scl[i]; t[kr * 65 + jc4 + 2] = v[i][2] * scl[i]; t[kr * 65 + jc4 + 3] = v[i][3] * scl[i]; }
    asm volatile("s_waitcnt lgkmcnt(0)" ::: "memory"); __builtin_amdgcn_s_barrier(); asm volatile("" ::: "memory");
    const int kp = (tid & 63) * 2, jr0 = tid >> 6;
#pragma unroll
    for (int i = 0; i < 8; ++i) { const int j = jr0 + 8 * i;
        if (j < d.jvalid) { const float a = t[kp * 65 + j], b = t[(kp + 1) * 65 + j];
            *(unsigned*)(d.dst + (size_t)(d.j0 + j) * d.K + d.k0 + kp) = cvt_pk_bf16(a, b); } }
    asm volatile("s_waitcnt lgkmcnt(0)" ::: "memory"); __builtin_amdgcn_s_barrier(); asm volatile("" ::: "memory");
}
__device__ __forceinline__ void conv_tiles(const Params& p, LAS unsigned char* lds, int u_begin, int u_end, int first, int stride, int tid) {
    LAS float* t = (LAS float*)lds;
    int u = u_begin + first;
    if (u >= u_end) return;
    TileD d = tile_decode(p, u); f32x4 v[4]; float sc[4]; tile_load(d, tid, v, sc);
    for (;;) {
        const int un = u + stride; const bool more = un < u_end;
        TileD dn = d; f32x4 vn[4]; float scn[4];
#pragma unroll
        for (int i = 0; i < 4; ++i) { vn[i] = v[i]; scn[i] = sc[i]; }
        if (more) { dn = tile_decode(p, un); tile_load(dn, tid, vn, scn); }
        tile_finish(t, d, tid, v, sc);
        if (!more) break;
        d = dn; u = un;
#pragma unroll
        for (int i = 0; i < 4; ++i) { v[i] = vn[i]; sc[i] = scn[i]; }
    }
}
__device__ void phase0(const Params& p, LAS unsigned char* lds, int wv) {
    const int lane = lane_id(), wave = wv, tid = wv * 64 + lane, G = gridDim.x;
    LAS float* t = (LAS float*)lds;
    bf16_t* bt_in = (bf16_t*)(p.ws + WS_BTIN);
    bf16_t* xn = (bf16_t*)(p.ws + WS_XN);
    for (int row = blockIdx.x * 8 + wave; row < M_; row += G * 8) {
        const f32x4* xr = (const f32x4*)(p.x + (size_t)row * D_);
        f32x4 v[8]; float ss = 0.f;
#pragma unroll
        for (int i = 0; i < 8; ++i) { v[i] = xr[lane + 64 * i]; ss += (v[i][0] * v[i][0] + v[i][1] * v[i][1]) + (v[i][2] * v[i][2] + v[i][3] * v[i][3]); }
#pragma unroll
        for (int o = 32; o >= 1; o >>= 1) ss += __shfl_xor(ss, o);
        const float rstd = rsqrtf(ss * (1.0f / 2048.0f) + EPS);
#pragma unroll
        for (int i = 0; i < 8; ++i) { const f32x4 g4 = ((const f32x4*)p.norm_mix_g)[lane + 64 * i];
            u32x2 w; w.x = cvt_pk_bf16(v[i][0] * rstd * g4[0], v[i][1] * rstd * g4[1]); w.y = cvt_pk_bf16(v[i][2] * rstd * g4[2], v[i][3] * rstd * g4[3]);
            *(u32x2*)(xn + (size_t)row * D_ + 4 * (lane + 64 * i)) = w; }
    }
    __syncthreads();
    conv_tiles(p, lds, 0, 16 * 193, blockIdx.x, G, tid);
}
__device__ void wconv_units(const Params& p, LAS unsigned char* lds, int first, int stride, int wv) {
    const int tid = wv * 64 + lane_id();
    __syncthreads();
    conv_tiles(p, lds, 16 * 193, 16 * 193 + 32 * 32 + 16 * 176 + 44 * 32, first, stride, tid);
}

__device__ void dt_units(const Params& p, LAS unsigned char* lds, int wv) {
    const int lane = lane_id(), w = wv, tid = wv * 64 + lane, fr = lane & 15, fq = lane >> 4;
    const bf16_t* xn = (const bf16_t*)(p.ws + WS_XN);
    const bf16_t* bt = (const bf16_t*)(p.ws + WS_BTIN) + (size_t)NPROJ * D_;
    float* dt = (float*)((unsigned char*)p.out + DO_DT);
    LAS float* red = (LAS float*)lds;
    for (int rb = blockIdx.x; rb < M_ / 64; rb += gridDim.x) {
        const int row0 = rb * 64;
        f32x4 acc[4][2];
#pragma unroll
        for (int m = 0; m < 4; ++m)
#pragma unroll
            for (int n = 0; n < 2; ++n) acc[m][n] = (f32x4){0.f, 0.f, 0.f, 0.f};
#pragma unroll 4
        for (int ks = 0; ks < 8; ++ks) {
            const int kb = w * 256 + ks * 32 + fq * 8;
            bf16x8 a[4], b[2];
#pragma unroll
            for (int m = 0; m < 4; ++m) a[m] = *(const bf16x8*)(xn + (size_t)(row0 + 16 * m + fr) * D_ + kb);
#pragma unroll
            for (int n = 0; n < 2; ++n) b[n] = *(const bf16x8*)(bt + (size_t)(16 * n + fr) * D_ + kb);
#pragma unroll
            for (int m = 0; m < 4; ++m)
#pragma unroll
                for (int n = 0; n < 2; ++n) acc[m][n] = __builtin_amdgcn_mfma_f32_16x16x32_bf16(a[m], b[n], acc[m][n], 0, 0, 0);
        }
#pragma unroll
        for (int m = 0; m < 4; ++m)
#pragma unroll
            for (int n = 0; n < 2; ++n)
#pragma unroll
                for (int j = 0; j < 4; ++j) red[w * 2048 + (16 * m + 4 * fq + j) * 32 + 16 * n + fr] = acc[m][n][j];
        __syncthreads();
        {
            const int idx = tid * 4, r = idx >> 5, c = idx & 31;
            f32x4 s = (f32x4){0.f, 0.f, 0.f, 0.f};
#pragma unroll
            for (int ww = 0; ww < 8; ++ww) s += *(LAS const f32x4*)(red + ww * 2048 + idx);
            const f32x4 bias = *(const f32x4*)(p.ssm_dt_bias + c);
            f32x4 o;
#pragma unroll
            for (int j = 0; j < 4; ++j) { const float v = s[j] + bias[j]; o[j] = v > 20.f ? v : log1pf(expf(v)); }
            *(f32x4*)(dt + (size_t)(row0 + r) * 32 + c) = o;
        }
        __syncthreads();
    }
}

__device__ void bc_sequences(const Params& p, LAS unsigned char* lds, int first, int stride, int wv) {
    const int tid = wv * 64 + lane_id(), cv = tid & 7, run = tid >> 3;
    bf16_t* proj = (bf16_t*)(p.ws + WS_PROJ);
    LAS u32x4* stash = (LAS u32x4*)lds;
    unsigned* bcflag = (unsigned*)((unsigned char*)p.out + DO_BCFLAG);
    for (int sq = first; sq < 4 * 32; sq += stride) {
        const int b = sq >> 5, slab = sq & 31;
        const int xcol = 2048 + slab * 64 + cv * 8;
        float wk[4][8], bs[8];
#pragma unroll
        for (int k = 0; k < 4; ++k) { const f32x4 a = *(const f32x4*)(p.ssm_conv_w + k * 4096 + xcol), c = *(const f32x4*)(p.ssm_conv_w + k * 4096 + xcol + 4);
#pragma unroll
            for (int j = 0; j < 4; ++j) { wk[k][j] = a[j]; wk[k][4 + j] = c[j]; } }
        { const f32x4 a = *(const f32x4*)(p.ssm_conv_b + xcol), c = *(const f32x4*)(p.ssm_conv_b + xcol + 4);
#pragma unroll
          for (int j = 0; j < 4; ++j) { bs[j] = a[j]; bs[4 + j] = c[j]; } }
        __syncthreads();
#pragma unroll 1
        for (int tile = 0; tile < 8; ++tile) {
            bf16_t* base = proj + (size_t)(b * SEQ + tile * 512 + run * 8) * NPROJ + 2048 + xcol;
            u32x4 raw[11];
#pragma unroll
            for (int r = 0; r < 11; ++r) {
                const int row = run * 8 + r - 3;
                if (row >= 0) raw[r] = *(const u32x4*)(base + (long)(r - 3) * NPROJ);
                else raw[r] = (tile == 0) ? (u32x4){0u, 0u, 0u, 0u} : stash[(row + 3) * 8 + cv];
            }
            u32x4 ov[8];
#pragma unroll
            for (int j = 0; j < 8; ++j) {
                float o[8];
#pragma unroll
                for (int q = 0; q < 4; ++q) {
                    const unsigned x0 = raw[j][q], x1 = raw[j + 1][q], x2 = raw[j + 2][q], x3 = raw[j + 3][q];
                    o[2 * q] = silu_f(bs[2 * q] + wk[0][2 * q] * bflo(x0) + wk[1][2 * q] * bflo(x1) + wk[2][2 * q] * bflo(x2) + wk[3][2 * q] * bflo(x3));
                    o[2 * q + 1] = silu_f(bs[2 * q + 1] + wk[0][2 * q + 1] * bfhi(x0) + wk[1][2 * q + 1] * bfhi(x1) + wk[2][2 * q + 1] * bfhi(x2) + wk[3][2 * q + 1] * bfhi(x3));
                }
                ov[j].x = cvt_pk_bf16(o[0], o[1]); ov[j].y = cvt_pk_bf16(o[2], o[3]); ov[j].z = cvt_pk_bf16(o[4], o[5]); ov[j].w = cvt_pk_bf16(o[6], o[7]);
            }
            asm volatile("s_waitcnt vmcnt(0) lgkmcnt(0)" ::: "memory");
            __syncthreads();
            if (run == 63) { stash[0 * 8 + cv] = raw[8]; stash[1 * 8 + cv] = raw[9]; stash[2 * 8 + cv] = raw[10]; }
#pragma unroll
            for (int j = 0; j < 8; ++j) { const bf16_t* q = base + (long)j * NPROJ;
                asm volatile("global_store_dwordx4 %0, %1, off sc1" :: "v"(q), "v"(ov[j]) : "memory"); }
            asm volatile("s_waitcnt vmcnt(0) lgkmcnt(0)" ::: "memory");
            __syncthreads();
            if (wv == 0) {
                if (lane_id() == 0) __hip_atomic_store(bcflag + sq, (unsigned)(tile + 1), __ATOMIC_RELAXED, __HIP_MEMORY_SCOPE_AGENT);
            }
        }
    }
}

constexpr int SROW = 272;
constexpr int L_CM = 0, L_BM = 34816, L_BDT = 69632, L_XT = 104448, L_HB = 121856  , L_CS = 156672, L_DT = 157184, L_CW = 157696  ;
__device__ __forceinline__ int swz_off(int row, int kblk) { return row * SROW + ((kblk ^ ((row >> 3) & 7)) << 4); }
__device__ __forceinline__ void ssd_load(u32x4 (&raw)[5], const bf16_t* base, bool first, int l0) {
#pragma unroll
    for (int r = 0; r < 5; ++r) raw[r] = (first && (l0 + r - 3) < 0) ? (u32x4){0u, 0u, 0u, 0u} : *(const u32x4*)(base + (long)(r - 3) * NPROJ);
}
template <int GI>
__device__ __forceinline__ void ssd_conv(LAS unsigned char* lds, const u32x4 (&raw)[5], int cv, int l0, float sa, float sb) {
    LAS const f32x4* cw = (LAS const f32x4*)(lds + L_CW) + cv * 10;
    float o0[8], o1[8];
#pragma unroll
    for (int hq = 0; hq < 2; ++hq) {
        const f32x4 w0 = cw[0 + hq], w1 = cw[2 + hq], w2 = cw[4 + hq], w3 = cw[6 + hq], bs = cw[8 + hq];
#pragma unroll
        for (int e2 = 0; e2 < 2; ++e2) {
            const int q = hq * 2 + e2;
            const unsigned x0 = raw[0][q], x1 = raw[1][q], x2 = raw[2][q], x3 = raw[3][q], x4 = raw[4][q];
            const int ea = e2 * 2, eb = e2 * 2 + 1;
            const float va = bs[ea] + w0[ea] * bflo(x0) + w1[ea] * bflo(x1) + w2[ea] * bflo(x2) + w3[ea] * bflo(x3);
            const float vb = bs[eb] + w0[eb] * bfhi(x0) + w1[eb] * bfhi(x1) + w2[eb] * bfhi(x2) + w3[eb] * bfhi(x3);
            const float ua = bs[ea] + w0[ea] * bflo(x1) + w1[ea] * bflo(x2) + w2[ea] * bflo(x3) + w3[ea] * bflo(x4);
            const float ub = bs[eb] + w0[eb] * bfhi(x1) + w1[eb] * bfhi(x2) + w2[eb] * bfhi(x3) + w3[eb] * bfhi(x4);
            o0[2 * q] = silu_f(va); o0[2 * q + 1] = silu_f(vb); o1[2 * q] = silu_f(ua); o1[2 * q + 1] = silu_f(ub);
        }
    }
    if (GI == 0) {
#pragma unroll
        for (int e = 0; e < 8; ++e) { const int prow = cv * 8 + e;
            *(LAS unsigned*)(lds + L_XT + swz_off(prow, l0 >> 3) + (l0 & 7) * 2) = cvt_pk_bf16(o0[e] * sa, o1[e] * sb); }
    } else {
        u32x4 w0; w0.x = cvt_pk_bf16(o0[0], o0[1]); w0.y = cvt_pk_bf16(o0[2], o0[3]); w0.z = cvt_pk_bf16(o0[4], o0[5]); w0.w = cvt_pk_bf16(o0[6], o0[7]);
        u32x4 w1; w1.x = cvt_pk_bf16(o1[0], o1[1]); w1.y = cvt_pk_bf16(o1[2], o1[3]); w1.z = cvt_pk_bf16(o1[4], o1[5]); w1.w = cvt_pk_bf16(o1[6], o1[7]);
        const int nb = ((GI - 1) & 1) * 64 + cv * 8;
        if (GI < 3) {
            *(LAS u32x4*)(lds + L_BM + l0 * SROW + nb * 2) = w0; *(LAS u32x4*)(lds + L_BM + (l0 + 1) * SROW + nb * 2) = w1;
#pragma unroll
            for (int e = 0; e < 8; ++e) { const int nrow = nb + e;
                *(LAS unsigned*)(lds + L_BDT + swz_off(nrow, l0 >> 3) + (l0 & 7) * 2) = cvt_pk_bf16(o0[e] * sa, o1[e] * sb); }
        } else {
            *(LAS u32x4*)(lds + L_CM + l0 * SROW + nb * 2) = w0; *(LAS u32x4*)(lds + L_CM + (l0 + 1) * SROW + nb * 2) = w1;
        }
    }
}
template <int GI>
__device__ __forceinline__ void ssd_put(LAS unsigned char* lds, const u32x4 (&rw)[2], int cv, int l0, float sa, float sb) {
    const int nb = ((GI - 1) & 1) * 64 + cv * 8;
    if (GI < 3) {
        *(LAS u32x4*)(lds + L_BM + l0 * SROW + nb * 2) = rw[0]; *(LAS u32x4*)(lds + L_BM + (l0 + 1) * SROW + nb * 2) = rw[1];
#pragma unroll
        for (int q = 0; q < 4; ++q) {
            *(LAS unsigned*)(lds + L_BDT + swz_off(nb + 2 * q, l0 >> 3) + (l0 & 7) * 2) = cvt_pk_bf16(bflo(rw[0][q]) * sa, bflo(rw[1][q]) * sb);
            *(LAS unsigned*)(lds + L_BDT + swz_off(nb + 2 * q + 1, l0 >> 3) + (l0 & 7) * 2) = cvt_pk_bf16(bfhi(rw[0][q]) * sa, bfhi(rw[1][q]) * sb);
        }
    } else {
        *(LAS u32x4*)(lds + L_CM + l0 * SROW + nb * 2) = rw[0]; *(LAS u32x4*)(lds + L_CM + (l0 + 1) * SROW + nb * 2) = rw[1];
    }
}
__device__ __forceinline__ void bc_wait(unsigned* f, unsigned need, int wv) {
    if (wv == 0) {
    unsigned sp = 0;
    for (;;) {
        const unsigned a = __hip_atomic_load(f, __ATOMIC_RELAXED, __HIP_MEMORY_SCOPE_AGENT), b2 = __hip_atomic_load(f + 1, __ATOMIC_RELAXED, __HIP_MEMORY_SCOPE_AGENT);
        const unsigned c = __hip_atomic_load(f + 16, __ATOMIC_RELAXED, __HIP_MEMORY_SCOPE_AGENT), d = __hip_atomic_load(f + 17, __ATOMIC_RELAXED, __HIP_MEMORY_SCOPE_AGENT);
        const unsigned m = min(min(a, b2), min(c, d));
        if (__builtin_amdgcn_readfirstlane(m) >= need) break;
        __builtin_amdgcn_s_sleep(4);
        if (++sp > (1u << 19)) break;
    }
    __builtin_amdgcn_fence(__ATOMIC_ACQUIRE, "agent"); asm volatile("s_waitcnt vmcnt(0)" ::: "memory");
    }
    asm volatile("s_waitcnt lgkmcnt(0)" ::: "memory"); __builtin_amdgcn_s_barrier(); asm volatile("" ::: "memory");
}
__device__ void ssd_unit(const Params& p, LAS unsigned char* lds, int b, int h, int wv) {
    const int lane = lane_id(), w = wv, tid = wv * 64 + lane, fr = lane & 15, fq = lane >> 4;
    const int g = h >> 2;
    const bf16_t* proj = (const bf16_t*)(p.ws + WS_PROJ);
    const float* dtg = (const float*)((const unsigned char*)p.out + DO_DT);
    bf16_t* ymix = (bf16_t*)(p.ws + WS_YMIX);
    float* ssq1 = (float*)((unsigned char*)p.out + DO_SSQ1);
    LAS float* CSv = (LAS float*)(lds + L_CS);
    LAS float* DTv = (LAS float*)(lds + L_DT);
    LAS float* CW = (LAS float*)(lds + L_CW);
    const float Aneg = -__expf(p.ssm_A_log[h]);
    const float Dh = p.ssm_D[h];
    for (int idx = tid; idx < 320; idx += 512) {
        const int e = idx & 7, k = (idx >> 3) % 5, cvi = idx / 40;
        const int xcol = h * 64 + cvi * 8 + e;
        CW[idx] = (k < 4) ? p.ssm_conv_w[k * 4096 + xcol] : p.ssm_conv_b[xcol];
    }
    for (int idx = tid; idx < 64 * 17; idx += 512) *(LAS u32x4*)(lds + L_HB + idx * 16) = (u32x4){0u, 0u, 0u, 0u};
    f32x4 Hacc[4];
#pragma unroll
    for (int pt = 0; pt < 4; ++pt) Hacc[pt] = (f32x4){0.f, 0.f, 0.f, 0.f};
    __syncthreads();
    const int cv = lane & 7;
    const int l0 = 16 * w + 2 * (lane >> 3);
    const int srcl = (w & 3) * 16 + 2 * (lane >> 3);
    u32x4 r0[5], r1[2], r2[2], r3[2], r4[2];
    const bf16_t* pbase = proj + (size_t)(b * SEQ + l0) * NPROJ + 2048 + cv * 8;
    const int xc0 = h * 64, xc1 = 2048 + g * 128, xc2 = xc1 + 64, xc3 = 3072 + g * 128, xc4 = xc3 + 64;
    unsigned* bcf = (unsigned*)((unsigned char*)p.out + DO_BCFLAG) + b * 32 + 2 * g;
    bc_wait(bcf, 1u, wv);
    ssd_load(r0, pbase + xc0, true, l0);
    r1[0] = *(const u32x4*)(pbase + xc1); r1[1] = *(const u32x4*)(pbase + xc1 + NPROJ); r2[0] = *(const u32x4*)(pbase + xc2); r2[1] = *(const u32x4*)(pbase + xc2 + NPROJ);
    r3[0] = *(const u32x4*)(pbase + xc3); r3[1] = *(const u32x4*)(pbase + xc3 + NPROJ); r4[0] = *(const u32x4*)(pbase + xc4); r4[1] = *(const u32x4*)(pbase + xc4 + NPROJ);
    float dt0n = dtg[(size_t)(b * SEQ + lane) * 32 + h], dt1n = dtg[(size_t)(b * SEQ + 64 + lane) * 32 + h];
    for (int c = 0; c < 32; ++c) {
        const int row0 = b * SEQ + c * 128;
        const float dt0 = dt0n, dt1 = dt1n;
        if (c + 1 < 32) { dt0n = dtg[(size_t)(row0 + 128 + lane) * 32 + h]; dt1n = dtg[(size_t)(row0 + 192 + lane) * 32 + h]; }
        u32x2 zr[4];
#pragma unroll
        for (int pt = 0; pt < 4; ++pt) zr[pt] = *(const u32x2*)(proj + (size_t)(row0 + 16 * w + fr) * NPROJ + h * 64 + 16 * pt + 4 * fq);
        __builtin_amdgcn_sched_barrier(0);
        float a0 = dt0 * Aneg, a1 = dt1 * Aneg;
#pragma unroll
        for (int o = 1; o < 64; o <<= 1) { const float t0 = __shfl_up(a0, o), t1 = __shfl_up(a1, o); if (lane >= o) { a0 += t0; a1 += t1; } }
        a1 += __shfl(a0, 63);
        const float cs_end = __shfl(a1, 63);
        if (w == 0) { CSv[lane] = a0; CSv[64 + lane] = a1; DTv[lane] = dt0; DTv[64 + lane] = dt1; }
        const float csv = (w >= 4) ? a1 : a0, dtv = (w >= 4) ? dt1 : dt0;
        const float cs_l0 = __shfl(csv, srcl), cs_l1 = __shfl(csv, srcl + 1), dt_l0 = __shfl(dtv, srcl), dt_l1 = __shfl(dtv, srcl + 1);
        const float dec0 = __expf(cs_end - cs_l0), dec1 = __expf(cs_end - cs_l1);
        ssd_conv<0>(lds, r0, cv, l0, dt_l0, dt_l1);
        __builtin_amdgcn_sched_barrier(0);
        if (c + 1 < 32) ssd_load(r0, pbase + (size_t)(c + 1) * 128 * NPROJ + xc0, false, l0);
        __builtin_amdgcn_sched_barrier(0);
        ssd_put<1>(lds, r1, cv, l0, dec0, dec1); ssd_put<2>(lds, r2, cv, l0, dec0, dec1);
        ssd_put<3>(lds, r3, cv, l0, 0.f, 0.f);   ssd_put<4>(lds, r4, cv, l0, 0.f, 0.f);
        __builtin_amdgcn_sched_barrier(0);
        if (c + 1 < 32) {
            if (((c + 1) & 3) == 0) bc_wait(bcf, (unsigned)(((c + 1) >> 2) + 1), wv);
            const bf16_t* cb = pbase + (size_t)(c + 1) * 128 * NPROJ;
            r1[0] = *(const u32x4*)(cb + xc1); r1[1] = *(const u32x4*)(cb + xc1 + NPROJ); r2[0] = *(const u32x4*)(cb + xc2); r2[1] = *(const u32x4*)(cb + xc2 + NPROJ);
            r3[0] = *(const u32x4*)(cb + xc3); r3[1] = *(const u32x4*)(cb + xc3 + NPROJ); r4[0] = *(const u32x4*)(cb + xc4); r4[1] = *(const u32x4*)(cb + xc4 + NPROJ);
        }
        __builtin_amdgcn_sched_barrier(0);
        asm volatile("s_waitcnt lgkmcnt(0)" ::: "memory"); __builtin_amdgcn_s_barrier(); asm volatile("" ::: "memory");
        const int lrow = 16 * w + fr;
        const int hb_cur = L_HB + (c & 1) * 17408, hb_nxt = L_HB + ((c + 1) & 1) * 17408;
        bf16x8 cf[4];
#pragma unroll
        for (int ks = 0; ks < 4; ++ks) cf[ks] = *(LAS const bf16x8*)(lds + L_CM + lrow * SROW + (32 * ks + 8 * fq) * 2);
        const float cs_l = CSv[lrow], dt_l = DTv[lrow];
        asm volatile("" ::: "memory");
        const int dd = fr - 4 * fq; const float ddiag = Dh / dt_l;
        f32x4 y[4];
        { const float el = __expf(cs_l);
#pragma unroll
          for (int pt = 0; pt < 4; ++pt) { f32x4 a = (f32x4){0.f, 0.f, 0.f, 0.f};
#pragma unroll
            for (int ks = 0; ks < 4; ++ks) { const bf16x8 hf = *(LAS const bf16x8*)(lds + hb_cur + (16 * pt + fr) * SROW + (32 * ks + 8 * fq) * 2);
                a = __builtin_amdgcn_mfma_f32_16x16x32_bf16(hf, cf[ks], a, 0, 0, 0); }
            y[pt] = a * el; } }
#pragma unroll
        for (int j = 0; j < 8; ++j) {
            if (j <= w) {
                f32x4 gacc = (f32x4){0.f, 0.f, 0.f, 0.f};
#pragma unroll
                for (int ks = 0; ks < 4; ++ks) { const bf16x8 bf = *(LAS const bf16x8*)(lds + L_BM + (16 * j + fr) * SROW + (32 * ks + 8 * fq) * 2);
                    gacc = __builtin_amdgcn_mfma_f32_16x16x32_bf16(bf, cf[ks], gacc, 0, 0, 0); }
                const f32x4 css = *(LAS const f32x4*)(CSv + 16 * j + 4 * fq);
                float mv[4];
#pragma unroll
                for (int i = 0; i < 4; ++i) { float v = gacc[i] * __expf(cs_l - css[i]);
                    if (j == w) { v = (i <= dd) ? v : 0.f; if (i == dd) v += ddiag; }
                    mv[i] = v; }
                u32x2 wv2; wv2.x = cvt_pk_bf16(mv[0], mv[1]); wv2.y = cvt_pk_bf16(mv[2], mv[3]);
                *(LAS u32x2*)(lds + L_CM + lrow * SROW + (16 * j + 4 * fq) * 2) = wv2;
            } else if (j == w + 1 && (w & 1) == 0) {
                *(LAS u32x2*)(lds + L_CM + lrow * SROW + (16 * j + 4 * fq) * 2) = (u32x2){0u, 0u};
            }
        }
        asm volatile("" ::: "memory");
        { const float de = __expf(cs_end);
#pragma unroll
          for (int pt = 0; pt < 4; ++pt) Hacc[pt] *= de; }
        const int nks2 = (w >> 1) + 1;
#pragma unroll
        for (int ks = 0; ks < 4; ++ks) {
            bf16x8 xf[4];
#pragma unroll
            for (int pt = 0; pt < 4; ++pt) xf[pt] = *(LAS const bf16x8*)(lds + L_XT + swz_off(16 * pt + fr, 4 * ks + fq));
            if (ks < nks2) { const bf16x8 mf = *(LAS const bf16x8*)(lds + L_CM + lrow * SROW + (32 * ks + 8 * fq) * 2);
#pragma unroll
                for (int pt = 0; pt < 4; ++pt) y[pt] = __builtin_amdgcn_mfma_f32_16x16x32_bf16(xf[pt], mf, y[pt], 0, 0, 0); }
            const bf16x8 bdf = *(LAS const bf16x8*)(lds + L_BDT + swz_off(16 * w + fr, 4 * ks + fq));
#pragma unroll
            for (int pt = 0; pt < 4; ++pt) Hacc[pt] = __builtin_amdgcn_mfma_f32_16x16x32_bf16(bdf, xf[pt], Hacc[pt], 0, 0, 0);
        }
#pragma unroll
        for (int pt = 0; pt < 4; ++pt) { u32x2 wv2; wv2.x = cvt_pk_bf16(Hacc[pt][0], Hacc[pt][1]); wv2.y = cvt_pk_bf16(Hacc[pt][2], Hacc[pt][3]);
            *(LAS u32x2*)(lds + hb_nxt + (16 * pt + fr) * SROW + (16 * w + 4 * fq) * 2) = wv2; }
        { float ss = 0.f; const size_t orow = (size_t)(row0 + lrow);
#pragma unroll
          for (int pt = 0; pt < 4; ++pt) {
            const float z0 = bflo(zr[pt].x), z1 = bfhi(zr[pt].x), z2 = bflo(zr[pt].y), z3 = bfhi(zr[pt].y);
            const float v0 = y[pt][0] * silu_f(z0), v1 = y[pt][1] * silu_f(z1), v2 = y[pt][2] * silu_f(z2), v3 = y[pt][3] * silu_f(z3);
            ss += (v0 * v0 + v1 * v1) + (v2 * v2 + v3 * v3);
            u32x2 wv; wv.x = cvt_pk_bf16(v0, v1); wv.y = cvt_pk_bf16(v2, v3);
            *(u32x2*)(ymix + orow * DMIX + h * 64 + 16 * pt + 4 * fq) = wv; }
          ss += __shfl_xor(ss, 16); ss += __shfl_xor(ss, 32);
          if (fq == 0) ssq1[ssq_idx((int)orow, h)] = ss; }
        asm volatile("s_waitcnt lgkmcnt(0)" ::: "memory"); __builtin_amdgcn_s_barrier(); asm volatile("" ::: "memory");
    }
}
__device__ void sc_unit(const Params& p, int unit, int wv) {
    const int tid = wv * 64 + lane_id(), cvx = tid & 255, th = tid >> 8;
    const bf16_t* proj = (const bf16_t*)(p.ws + WS_PROJ);
    bf16_t* ymix = (bf16_t*)(p.ws + WS_YMIX);
    const int t0 = unit * 64 + th * 32, c0 = cvx * 8;
    float w0[8], w1[8], w2[8];
    { const f32x4* a = (const f32x4*)(p.sc_conv_w + c0); const f32x4* bq = (const f32x4*)(p.sc_conv_w + 2048 + c0); const f32x4* cq = (const f32x4*)(p.sc_conv_w + 4096 + c0);
#pragma unroll
      for (int q = 0; q < 2; ++q) { const f32x4 x0 = a[q], x1 = bq[q], x2 = cq[q];
#pragma unroll
        for (int j = 0; j < 4; ++j) { w0[q * 4 + j] = x0[j]; w1[q * 4 + j] = x1[j]; w2[q * 4 + j] = x2[j]; } } }
    float pm1[8], pm2[8];
#pragma unroll
    for (int e = 0; e < 8; ++e) { pm1[e] = 0.f; pm2[e] = 0.f; }
    if ((t0 & (SEQ - 1)) != 0) {
        const bf16_t* r2 = proj + (size_t)(t0 - 2) * NPROJ, * r1 = proj + (size_t)(t0 - 1) * NPROJ;
        const u32x4 c2 = *(const u32x4*)(r2 + 8192 + c0), c1 = *(const u32x4*)(r1 + 8192 + c0);
#pragma unroll
        for (int q = 0; q < 4; ++q) { pm2[2 * q] = bflo(c2[q]); pm2[2 * q + 1] = bfhi(c2[q]); pm1[2 * q] = bflo(c1[q]); pm1[2 * q + 1] = bfhi(c1[q]); }
    }
#pragma unroll 4
    for (int i = 0; i < 32; ++i) {
        const bf16_t* r = proj + (size_t)(t0 + i) * NPROJ;
        const u32x4 gb = *(const u32x4*)(r + 6144 + c0), gp = *(const u32x4*)(r + 8192 + c0);
        float o[8];
#pragma unroll
        for (int q = 0; q < 4; ++q) {
            const float pa = bflo(gp[q]), pb = bfhi(gp[q]);
            o[2 * q] = bflo(gb[q]) * (w0[2 * q] * pm2[2 * q] + w1[2 * q] * pm1[2 * q] + w2[2 * q] * pa);
            o[2 * q + 1] = bfhi(gb[q]) * (w0[2 * q + 1] * pm2[2 * q + 1] + w1[2 * q + 1] * pm1[2 * q + 1] + w2[2 * q + 1] * pb);
            pm2[2 * q] = pm1[2 * q]; pm2[2 * q + 1] = pm1[2 * q + 1]; pm1[2 * q] = pa; pm1[2 * q + 1] = pb;
        }
        u32x4 wv; wv.x = cvt_pk_bf16(o[0], o[1]); wv.y = cvt_pk_bf16(o[2], o[3]); wv.z = cvt_pk_bf16(o[4], o[5]); wv.w = cvt_pk_bf16(o[6], o[7]);
        *(u32x4*)(ymix + (size_t)(t0 + i) * DMIX + 2048 + c0) = wv;
    }
}
__device__ void phase2(const Params& p, LAS unsigned char* lds, int wv) {
    const int G = gridDim.x, bid = blockIdx.x;
    const bool split = G >= 256;
    if (!split) bc_sequences(p, lds, bid, G, wv);
    if (!split || bid < 128) { for (int u = bid; u < 128; u += (split ? 128 : G)) ssd_unit(p, lds, u >> 5, u & 31, wv); }
    if (split && bid >= 128) bc_sequences(p, lds, bid - 128, G - 128, wv);
    if (!split || bid >= 128) { for (int u = (split ? bid - 128 : bid); u < M_ / 64; u += (split ? G - 128 : G)) sc_unit(p, u, wv); }
    if (!split || bid >= 128) wconv_units(p, lds, split ? bid - 128 : bid, split ? G - 128 : G, wv);
}

__device__ void phase6(const Params& p, int wv) {
    const int lane = lane_id(), wave = wv;
    const bf16_t* h2 = (const bf16_t*)(p.ws + WS_H1B);
    const float* ssq3 = (const float*)(p.ws + WS_SSQ3);
    for (int row = blockIdx.x * 8 + wave; row < M_; row += gridDim.x * 8) {
        float s = (lane < 32) ? ssq3[ssq_idx(row, lane)] : 0.f;
#pragma unroll
        for (int o = 32; o >= 1; o >>= 1) s += __shfl_xor(s, o);
        const float rstd = rsqrtf(s * (1.0f / 2048.0f) + EPS);
        const u32x2* hr = (const u32x2*)(h2 + (size_t)row * D_);
        f32x4* orow = (f32x4*)(p.out + (size_t)row * D_);
#pragma unroll
        for (int i = 0; i < 8; ++i) { const u32x2 hv = hr[lane + 64 * i]; const f32x4 v = (f32x4){bflo(hv.x), bfhi(hv.x), bflo(hv.y), bfhi(hv.y)}, g4 = ((const f32x4*)p.norm_final_g)[lane + 64 * i]; orow[lane + 64 * i] = v * rstd * g4; }
    }
}


#define XB_TMO      128
#define XB_XCNT(j)  (256  + 64 * (j))
#define XB_XSUB(j)  (1280 + 64 * (j))
#define XB_XGEN(j)  (2304 + 64 * (j))
#define XB_TOP      3328
#define XB_TOPGEN   3392
#define XCD_BAR_WORDS 3456
#define XB_SPIN_CAP (1u << 18)
__device__ __forceinline__ unsigned xb_ld(unsigned* p)              { return __hip_atomic_load(p, __ATOMIC_RELAXED, __HIP_MEMORY_SCOPE_AGENT); }
__device__ __forceinline__ unsigned xb_add(unsigned* p, unsigned v) { return __hip_atomic_fetch_add(p, v, __ATOMIC_RELAXED, __HIP_MEMORY_SCOPE_AGENT); }
__device__ __forceinline__ unsigned xb_xcc_id() { return (unsigned)__builtin_amdgcn_s_getreg((3 << 11) | 20) & 0xFu; }
#define XB_SPIN(cond, bar) do { unsigned _sp = 0; while (cond) { __builtin_amdgcn_s_sleep(1); \
    if ((++_sp & 255u) == 0u) { if (xb_ld(&(bar)[XB_TMO])) break; if (_sp > XB_SPIN_CAP) { atomicAdd(&(bar)[XB_TMO], 1u); break; } } } } while (0)
struct XcdBarrier { unsigned* bar; unsigned x; volatile LAS unsigned* st; };
__device__ __forceinline__ void xcd_barrier_complete(unsigned* bar, unsigned x, unsigned& nloc, unsigned& nx) {
    const unsigned G = gridDim.x * gridDim.y * gridDim.z;
    unsigned sum, cnt, mine, sp = 0u;
    for (;;) {
        sum = 0u; cnt = 0u; mine = 0u;
#pragma unroll
        for (unsigned j = 0; j < 16; ++j) { const unsigned c = xb_ld(&bar[XB_XCNT(j)]); sum += c; cnt += (c > 0u) ? 1u : 0u; mine = (j == x) ? c : mine; }
        if (sum == G) break;
        __builtin_amdgcn_s_sleep(1);
        if ((++sp & 255u) == 0u) { if (xb_ld(&bar[XB_TMO])) break; if (sp > XB_SPIN_CAP) { atomicAdd(&bar[XB_TMO], 1u); break; } }
    }
    nloc = mine > 0u ? mine : 1u; nx = cnt > 0u ? cnt : 1u;
}
__device__ __forceinline__ void xcd_barrier(const XcdBarrier& b, bool leader) {
    asm volatile("s_waitcnt vmcnt(0)" ::: "memory");
    __syncthreads();
    if (leader) {
        unsigned* bar = b.bar;
        __builtin_amdgcn_s_waitcnt(0);
        unsigned nloc = b.st[0], nx = b.st[1];
        if (nloc == 0u) { xcd_barrier_complete(bar, b.x, nloc, nx); b.st[0] = nloc; b.st[1] = nx; }
        const unsigned old = xb_add(&bar[XB_XSUB(b.x)], 1u);
        const unsigned gen = old / nloc;
        if (old + 1u == (gen + 1u) * nloc) {
            __builtin_amdgcn_fence(__ATOMIC_RELEASE, "agent");
            asm volatile("s_waitcnt vmcnt(0)" ::: "memory");
            const unsigned og = xb_add(&bar[XB_TOP], 1u);
            const unsigned tg = og / nx;
            if (og + 1u == (tg + 1u) * nx) xb_add(&bar[XB_TOPGEN], 1u);
            else XB_SPIN(xb_ld(&bar[XB_TOPGEN]) == tg, bar);
            __builtin_amdgcn_fence(__ATOMIC_ACQUIRE, "agent");
            xb_add(&bar[XB_XGEN(b.x)], 1u);
            asm volatile("s_waitcnt vmcnt(0)" ::: "memory");
        } else {
            XB_SPIN(xb_ld(&bar[XB_XGEN(b.x)]) == gen, bar);
            __builtin_amdgcn_fence(__ATOMIC_ACQUIRE, "agent");
            asm volatile("s_waitcnt vmcnt(0)" ::: "memory");
        }
    }
    __syncthreads();
}

__global__ void __launch_bounds__(512) hymba_fwd(Params p) {
    extern __shared__ __attribute__((aligned(16))) unsigned char shm[];
    LAS unsigned char* lds = (LAS unsigned char*)shm;
    cg::grid_group grid = cg::this_grid();
    const int lo = p.ph_lo, hi = p.ph_hi;
    const int wv = __builtin_amdgcn_readfirstlane(threadIdx.x >> 6);
#ifdef DBG_CLEAR
    for (int i = threadIdx.x; i < LDS_BYTES / 16; i += 512) *(LAS u32x4*)(lds + i * 16) = (u32x4){0u, 0u, 0u, 0u};
    __syncthreads();
#endif
#define IN(k) (lo <= (k) && (k) < hi)
#define SEAM(k) do { if (IN(k) && IN((k) + 1)) { \
        asm volatile("s_waitcnt vmcnt(0) lgkmcnt(0)" ::: "memory"); __syncthreads();                 \
        if (wv == 0) { __builtin_amdgcn_fence(__ATOMIC_RELEASE, "agent"); asm volatile("s_waitcnt vmcnt(0)" ::: "memory"); }     \
        grid.sync(); \
        if (wv == 0) { __builtin_amdgcn_fence(__ATOMIC_ACQUIRE, "agent"); asm volatile("s_waitcnt vmcnt(0)" ::: "memory"); }     \
        __syncthreads(); } } while (0)
    volatile LAS unsigned* xst = (volatile LAS unsigned*)(lds + LDS_BYTES - 16);
    const bool xlead = (wv == 0) && (lane_id() == 0);
    if (xlead) { xst[0] = 0u; xst[1] = 0u; }
    __syncthreads();
    XcdBarrier xb; xb.bar = (unsigned*)((unsigned char*)p.out + DO_XBAR); xb.x = xb_xcc_id(); xb.st = xst;
    if (xlead) (void)xb_add(&xb.bar[XB_XCNT(xb.x)], 1u);
#define XSEAM(k) do { if (IN(k) && IN((k) + 1)) xcd_barrier(xb, (wv == 0) && (lane_id() == 0)); } while (0)
    if (IN(0)) for (int rep = 0; rep < NREP(0); ++rep) phase0(p, lds, wv);
    XSEAM(0);
    if (IN(1)) for (int rep = 0; rep < NREP(1); ++rep) {
        pg8::Gemm g{(const bf16_t*)(p.ws + WS_XN), (const bf16_t*)(p.ws + WS_BTIN), M_, NPROJ, D_}; pg8::StaticOrder S; S.init(M_, NPROJ, gridDim.x, blockIdx.x);
        if (gridDim.x == 256) { S.nrounds = 12; S.rot = 3 * ((blockIdx.x >> 6) & 3); }
        EpiProj E{(bf16_t*)(p.ws + WS_PROJ)};
        pg8::gemm_phase<EpiProj>(lds, g, S, E, wv);
        dt_units(p, lds, wv);
    }
    XSEAM(1);
    if (IN(3)) for (int rep = 0; rep < NREP(3); ++rep) phase2(p, lds, wv);
    XSEAM(3);
    if (IN(4)) for (int rep = 0; rep < NREP(4); ++rep) {
        pg8::Gemm g{(const bf16_t*)(p.ws + WS_YMIX), (const bf16_t*)((unsigned char*)p.out + DO_BTOUT), M_, D_, DMIX}; pg8::StaticOrder S; S.init(M_, D_, gridDim.x, blockIdx.x);
        EpiOut E{p.x, (bf16_t*)(p.ws + WS_H1B), (const float*)((unsigned char*)p.out + DO_SSQ1), (float*)((unsigned char*)p.out + DO_SSQ2)};
        pg8::gemm_phase<EpiOut>(lds, g, S, E, wv);
    }
    XSEAM(4);
    if (IN(5)) for (int rep = 0; rep < NREP(5); ++rep) {
        pg8::Gemm g{(const bf16_t*)(p.ws + WS_H1B), (const bf16_t*)((unsigned char*)p.out + DO_BTGU), M_, NGU, D_}; pg8::StaticOrder S; S.init(M_, NGU, gridDim.x, blockIdx.x);
        EpiGU E{(const float*)((unsigned char*)p.out + DO_SSQ2), (bf16_t*)(p.ws + WS_HFF)};
        pg8::gemm_phase<EpiGU>(lds, g, S, E, wv);
    }
    XSEAM(5);
    if (IN(6)) {
        pg8::Gemm g{(const bf16_t*)(p.ws + WS_HFF), (const bf16_t*)((unsigned char*)p.out + DO_BTDN), M_, D_, DFF}; pg8::StaticOrder S; S.init(M_, D_, gridDim.x, blockIdx.x);
        EpiDown E{(bf16_t*)(p.ws + WS_H1B), (float*)(p.ws + WS_SSQ3)};
        pg8::gemm_phase<EpiDown>(lds, g, S, E, wv);
    }
    XSEAM(6);
    if (p.ph_hi > 1000) grid.sync();
    if (IN(7)) for (int rep = 0; rep < NREP(7); ++rep) phase6(p, wv);
#undef IN
#undef SEAM
}

extern "C" void kernel_launch(void* const* d_in, const int* in_sizes, int n_in, void* d_out, int out_size, void* d_ws, size_t ws_size, hipStream_t stream) {
    static int grid = 0;
    if (grid == 0) {
        if (n_in != 16 || out_size != M_ * D_ || ws_size < WS_NEED) { fprintf(stderr, "kernel_launch: unexpected shapes (n_in %d out %d ws %zu, need %zu)\n", n_in, out_size, ws_size, (size_t)WS_NEED); grid = -1; return; }
        int dev = 0, cus = 0, per_cu = 0;
        (void)hipGetDevice(&dev);
        (void)hipDeviceGetAttribute(&cus, hipDeviceAttributeMultiprocessorCount, dev);
        if (hipFuncSetAttribute((const void*)hymba_fwd, hipFuncAttributeMaxDynamicSharedMemorySize, LDS_BYTES) != hipSuccess) { fprintf(stderr, "kernel_launch: hipFuncSetAttribute failed\n"); grid = -1; return; }
        if (hipOccupancyMaxActiveBlocksPerMultiprocessor(&per_cu, (const void*)hymba_fwd, 512, LDS_BYTES) != hipSuccess || per_cu < 1) { fprintf(stderr, "kernel_launch: occupancy query failed (%d)\n", per_cu); (void)hipGetLastError(); per_cu = 1; }
        grid = cus * per_cu;
    }
    if (grid < 0) return;
    Params p{};
    p.x = (const float*)d_in[0]; p.norm_mix_g = (const float*)d_in[1]; p.w_in = (const float*)d_in[2]; p.ssm_conv_w = (const float*)d_in[3]; p.ssm_conv_b = (const float*)d_in[4];
    p.ssm_dt_bias = (const float*)d_in[5]; p.ssm_A_log = (const float*)d_in[6]; p.ssm_D = (const float*)d_in[7]; p.ssm_norm_g = (const float*)d_in[8]; p.sc_conv_w = (const float*)d_in[9];
    p.w_out = (const float*)d_in[10]; p.norm_ffn_g = (const float*)d_in[11]; p.w_gate = (const float*)d_in[12]; p.w_up = (const float*)d_in[13]; p.w_down = (const float*)d_in[14]; p.norm_final_g = (const float*)d_in[15];
    p.out = (float*)d_out; p.ws = (unsigned char*)d_ws;
#ifdef DBG_MEMSET
    (void)hipMemsetAsync(d_ws, 0, WS_NEED, stream); (void)hipMemsetAsync(d_out, 0, (size_t)out_size * 4, stream);
#endif
#ifndef N_CUTS
#define N_CUTS 1
#endif
    for (int li = 0; li < N_CUTS; ++li) {
        p.ph_lo = (N_CUTS == 8) ? li : 0; p.ph_hi = (N_CUTS == 8) ? li + 1 : 8;
        (void)hipMemsetAsync((unsigned char*)d_out + DO_BCFLAG, 0, 4096 + XCD_BAR_WORDS * sizeof(unsigned), stream);
    void* args[] = {&p};
        hipError_t e = hipLaunchCooperativeKernel((const void*)hymba_fwd, dim3(grid), dim3(512), args, LDS_BYTES, stream);
        if (e != hipSuccess) fprintf(stderr, "kernel_launch: cooperative launch failed: %s (grid %d)\n", hipGetErrorString(e), grid);
    }
}
```

```cpp
#include <hip/hip_runtime.h>
#include <hip/hip_cooperative_groups.h>
#include <cstdio>
namespace cg = cooperative_groups;

#define LAS __attribute__((address_space(3)))
typedef unsigned short bf16_t;
typedef short bf16x8 __attribute__((ext_vector_type(8)));
typedef float f32x4 __attribute__((ext_vector_type(4)));
typedef unsigned u32x4 __attribute__((ext_vector_type(4)));
typedef unsigned u32x2 __attribute__((ext_vector_type(2)));

constexpr int M_ = 16384, D_ = 2048, DIN = 12320, NPROJ = 12288, DFF = 5632, DMIX = 4096, NGU = 11264;
constexpr int SEQ = 4096;
constexpr float EPS = 1e-5f;
constexpr int LDS_BYTES = 159744;
constexpr int XCD_BAR_WORDS_C = 3456;
#ifndef PROBE_PHASE
#define PROBE_PHASE -1
#endif
#define NREP(k) ((PROBE_PHASE == (k)) ? 1 + (p.ph_hi < 100) : 1)
constexpr int TAB_OFF = 131072;

constexpr size_t WS_PROJ = 0;
constexpr size_t WS_R = (size_t)M_ * NPROJ * 2;
constexpr size_t WS_XN = WS_R;
constexpr size_t WS_BTIN = WS_R + (size_t)M_ * D_ * 2;
constexpr size_t WS_YMIX = WS_R;
constexpr size_t WS_H1F = 0;
constexpr size_t WS_H1B = (size_t)M_ * D_ * 4;
constexpr size_t WS_HFF = WS_H1B + (size_t)M_ * D_ * 2;
constexpr size_t WS_SSQ3 = WS_HFF + (size_t)M_ * DFF * 2;
constexpr size_t WS_NEED = WS_R + (size_t)M_ * DMIX * 2;
constexpr size_t DO_BTOUT = 0;
constexpr size_t DO_BTGU = (size_t)D_ * DMIX * 2;
constexpr size_t DO_BTDN = DO_BTGU + (size_t)NGU * D_ * 2;
constexpr size_t DO_DT = DO_BTDN + (size_t)D_ * DFF * 2;
constexpr size_t DO_SSQ1 = DO_DT + (size_t)M_ * 32 * 4;
constexpr size_t DO_SSQ2 = DO_SSQ1 + (size_t)M_ * 32 * 4;
constexpr size_t DO_XBAR = (size_t)M_ * D_ * 4 - 16384;
constexpr size_t DO_BCFLAG = DO_XBAR - 4096;
static_assert(DO_SSQ2 + (size_t)M_ * 32 * 4 <= DO_BCFLAG && XCD_BAR_WORDS_C * 4 <= 16384, "d_out scratch");

static_assert(WS_SSQ3 + (size_t)M_ * 32 * 4 <= WS_R, "ws overlay");

struct Params {
    const float* x; const float* norm_mix_g; const float* w_in; const float* ssm_conv_w; const float* ssm_conv_b;
    const float* ssm_dt_bias; const float* ssm_A_log; const float* ssm_D; const float* ssm_norm_g; const float* sc_conv_w;
    const float* w_out; const float* norm_ffn_g; const float* w_gate; const float* w_up; const float* w_down; const float* norm_final_g;
    float* out; unsigned char* ws; int ph_lo, ph_hi;
};

typedef float f32x2_t __attribute__((ext_vector_type(2)));
typedef __bf16 bf16x2_t __attribute__((ext_vector_type(2)));
__device__ __forceinline__ unsigned cvt_pk_bf16(float lo, float hi) { const f32x2_t v = {lo, hi}; return __builtin_bit_cast(unsigned, __builtin_convertvector(v, bf16x2_t)); }
__device__ __forceinline__ float bflo(unsigned u) { return __uint_as_float(u << 16); }
__device__ __forceinline__ float bfhi(unsigned u) { return __uint_as_float(u & 0xffff0000u); }
__device__ __forceinline__ int lane_id() { int l; asm volatile("v_mbcnt_lo_u32_b32 %0, -1, 0\n\tv_mbcnt_hi_u32_b32 %0, -1, %0" : "=v"(l)); return l; }
__device__ __forceinline__ float silu_f(float v) { return v * __builtin_amdgcn_rcpf(1.0f + __expf(-v)); }

__device__ __forceinline__ size_t ssq_idx(int row, int part) { return ((size_t)(row >> 5) * 32 + part) * 32 + (row & 31); }

namespace pg8 {
constexpr int BM = 256, BK = 64, HALF = 128, HTB = HALF * BK * 2, STAGE_BYTES = 8 * HTB, NXCD = 8, WGM = 8;
__device__ __forceinline__ int lds_byte(int r, int c) { const int st = (r >> 4) * 2 + (c >> 5), rr = r & 15, cc = c & 31, ob = rr * 64 + cc * 2; return st * 1024 + (ob ^ (((ob >> 9) & 1) << 5)); }
__device__ __forceinline__ void stage_rc(int b, int& R, int& C) { const int st = b / 1024, sb = b % 1024, swz = sb ^ (((sb >> 9) & 1) << 5); R = (st >> 1) * 16 + swz / 64; C = (st & 1) * 32 + (swz % 64) / 2; }
__device__ __forceinline__ int perm32(int rho) { const int n = rho >> 4, i = rho & 15; return 8 * (i >> 2) + 4 * n + (i & 3); }
struct Unit { int pm, pn; };
struct Gemm { const bf16_t* A; const bf16_t* Bt; int M, N, K; };
struct StaticOrder {
    int nM, nN, nwg, G, c, rot = 0, nrounds = 1;
    __device__ void init(int M, int N, int G_, int c_) { nM = M / BM; nN = N / BM; nwg = nM * nN; G = G_; c = c_; }
    __device__ bool next(int i, Unit& u) const {
        if (rot != 0 && i < nrounds) i = (i + rot) % nrounds;
        const long L = (long)i * G + c; if (L >= nwg) return false;
        int wgid = (int)L; { const int q = nwg / NXCD, r = nwg % NXCD, xcd = wgid % NXCD, off = wgid / NXCD; wgid = (xcd < r ? xcd * (q + 1) : r * (q + 1) + (xcd - r) * q) + off; }
        const int nig = WGM * nN, gid = wgid / nig, fm = gid * WGM, gsz = (nM - fm) < WGM ? (nM - fm) : WGM;
        u.pm = fm + ((wgid % nig) % gsz); u.pn = (wgid % nig) / gsz; return true;
    }
};
template <class Epi>
__device__ __forceinline__ void gemm_phase(LAS unsigned char* lds, const Gemm g, const StaticOrder& S, const Epi& E, int wv) {
    const int wid = wv, lane = lane_id(), tid = wid * 64 + lane, wr = wid >> 2, wc = wid & 3, fr = lane & 15, fq = lane >> 4;
    const int K = g.K, nt = K / BK;
    unsigned voffA[2], voffB[2];
#pragma unroll
    for (int i = 0; i < 2; ++i) { int R, C; stage_rc(tid * 16 + i * 8192, R, C); const int Rb = (R & ~31) + perm32(R & 31);
        voffA[i] = (unsigned)(R * K + C) * 2u; voffB[i] = (unsigned)(Rb * K + C) * 2u; }
    const size_t kstep = (size_t)(BK * 2);
    const size_t hstep = (size_t)HALF * K * 2;
    const size_t tstep = 2 * hstep;
    const unsigned ldsw = (unsigned)wid * 1024u;
    const int aoff = lds_byte(wr * 64 + fr, fq * 8), boff = lds_byte(wc * 32 + fr, fq * 8);
#define PG8_SA(b, h) (((b) * 2 + (h)) * HTB)
#define PG8_SB(b, h) ((4 + (b) * 2 + (h)) * HTB)
#define PG8_STAGE(bufoff, gbase, voff) do { _Pragma("unroll") for (int _i = 0; _i < 2; ++_i) \
        __builtin_amdgcn_global_load_lds((const unsigned*)((const char*)(gbase) + (voff)[_i]), (LAS unsigned*)(lds + (bufoff) + ldsw + _i * 8192), 16, 0, 0); } while (0)
#define PG8_LDA(dst, b, h) do { _Pragma("unroll") for (int m = 0; m < 4; ++m) _Pragma("unroll") for (int k = 0; k < 2; ++k) dst[m][k] = *(const LAS bf16x8*)(lds + PG8_SA(b, h) + aoff + m * 2048 + k * 1024); } while (0)
#define PG8_LDB(dst, b, h) do { _Pragma("unroll") for (int n = 0; n < 2; ++n) _Pragma("unroll") for (int k = 0; k < 2; ++k) dst[n][k] = *(const LAS bf16x8*)(lds + PG8_SB(b, h) + boff + n * 2048 + k * 1024); } while (0)
#define PG8_MMA(ai, bj, At, Bt) do { __builtin_amdgcn_s_setprio(1); _Pragma("unroll") for (int m = 0; m < 4; ++m) _Pragma("unroll") for (int n = 0; n < 2; ++n) _Pragma("unroll") for (int k = 0; k < 2; ++k) \
        acc[ai][bj][m][n] = __builtin_amdgcn_mfma_f32_16x16x32_bf16(Bt[n][k], At[m][k], acc[ai][bj][m][n], 0, 0, 0); __builtin_amdgcn_s_setprio(0); } while (0)
#define PG8_WAIT_V(n) asm volatile("s_waitcnt vmcnt(" #n ")" ::: "memory")
#define PG8_WAIT_L(n) asm volatile("s_waitcnt lgkmcnt(" #n ")" ::: "memory")
#define PG8_BAR __builtin_amdgcn_s_barrier()
#define PG8_SCHED __builtin_amdgcn_sched_barrier(0)
    Unit cur, nxt; int ui = 0;
    if (!S.next(0, cur)) return;
    f32x4 acc[2][2][4][2];
#pragma unroll
    for (int a = 0; a < 2; ++a)
#pragma unroll
        for (int b = 0; b < 2; ++b)
#pragma unroll
            for (int m = 0; m < 4; ++m)
#pragma unroll
                for (int n = 0; n < 2; ++n) acc[a][b][m][n] = (f32x4){0.f, 0.f, 0.f, 0.f};
    bf16x8 At[4][2], B0[2][2], B1[2][2];
    const char* cA = (const char*)g.A + (size_t)cur.pm * tstep; const char* cB = (const char*)g.Bt + (size_t)cur.pn * tstep;
    if constexpr (Epi::HAS_TAB) {
        Unit uu; for (int i = 0; i < 27 && S.next(i, uu); ++i) E.prep(uu, (LAS float*)(lds + TAB_OFF + i * 1024), tid);
    }
    PG8_STAGE(PG8_SB(0, 0), cB, voffB); PG8_STAGE(PG8_SB(0, 1), cB + hstep, voffB); PG8_STAGE(PG8_SA(0, 0), cA, voffA); PG8_STAGE(PG8_SA(0, 1), cA + hstep, voffA);
    if (wr == 1) PG8_BAR;
    PG8_WAIT_V(2); PG8_BAR;
    PG8_STAGE(PG8_SB(1, 0), cB + kstep, voffB); PG8_STAGE(PG8_SA(1, 0), cA + kstep, voffA); PG8_STAGE(PG8_SB(1, 1), cB + hstep + kstep, voffB);
    PG8_WAIT_V(6); PG8_BAR;
    for (;;) {
        const bool has_next = S.next(ui + 1, nxt);
        const char* nA = has_next ? (const char*)g.A + (size_t)nxt.pm * tstep : cA; const char* nB = has_next ? (const char*)g.Bt + (size_t)nxt.pn * tstep : cB;
        LAS const float* tabc = (LAS const float*)(lds + TAB_OFF + ui * 1024);
        for (int t = 0; t < nt; t += 2) {
            const bool last = (t == nt - 2);
            const char* a1 = cA + (size_t)(t + 1) * kstep;
            const char* a2 = last ? nA : cA + (size_t)(t + 2) * kstep; const char* b2 = last ? nB : cB + (size_t)(t + 2) * kstep;
            const char* a3 = a2 + kstep; const char* b3 = b2 + kstep;
            if constexpr (Epi::MID_T >= 0) { if (t == Epi::MID_T) {
#pragma unroll
                for (int ai = 0; ai < 2; ++ai)
#pragma unroll
                    for (int m = 0; m < 4; ++m) { const float s = tabc[ai * HALF + wr * 64 + m * 16 + fr];
#pragma unroll
                        for (int bj = 0; bj < 2; ++bj)
#pragma unroll
                            for (int n = 0; n < 2; ++n) acc[ai][bj][m][n] *= s; } } }
            PG8_LDB(B0, 0, 0); PG8_LDB(B1, 0, 1); PG8_SCHED; PG8_LDA(At, 0, 0); PG8_STAGE(PG8_SA(1, 1), a1 + hstep, voffA);
            PG8_WAIT_V(8); PG8_WAIT_L(0); PG8_BAR; PG8_MMA(0, 0, At, B0); PG8_MMA(0, 1, At, B1); PG8_BAR; PG8_SCHED;
            PG8_LDA(At, 0, 1); PG8_STAGE(PG8_SB(0, 0), b2, voffB); PG8_STAGE(PG8_SB(0, 1), b2 + hstep, voffB); PG8_STAGE(PG8_SA(0, 0), a2, voffA);
            PG8_WAIT_V(8); PG8_WAIT_L(0); PG8_BAR; PG8_MMA(1, 0, At, B0); PG8_MMA(1, 1, At, B1); PG8_BAR; PG8_SCHED;
            PG8_LDB(B0, 1, 0); PG8_LDB(B1, 1, 1); PG8_SCHED; PG8_LDA(At, 1, 0); PG8_STAGE(PG8_SA(0, 1), a2 + hstep, voffA);
            PG8_WAIT_V(8); PG8_WAIT_L(0); PG8_BAR; PG8_MMA(0, 0, At, B0); PG8_MMA(0, 1, At, B1); PG8_BAR; PG8_SCHED;
            PG8_LDA(At, 1, 1); PG8_STAGE(PG8_SB(1, 0), b3, voffB); PG8_STAGE(PG8_SB(1, 1), b3 + hstep, voffB); PG8_STAGE(PG8_SA(1, 0), a3, voffA);
            PG8_WAIT_V(8); PG8_WAIT_L(0); PG8_BAR; PG8_MMA(1, 0, At, B0); PG8_MMA(1, 1, At, B1); PG8_BAR; PG8_SCHED;
        }
        if (wr == 0) PG8_BAR;
        E(acc, cur, tabc, wr, wc, fr, fq);
        if (!has_next) break;
#pragma unroll
        for (int a = 0; a < 2; ++a)
#pragma unroll
            for (int b = 0; b < 2; ++b)
#pragma unroll
                for (int m = 0; m < 4; ++m)
#pragma unroll
                    for (int n = 0; n < 2; ++n) acc[a][b][m][n] = (f32x4){0.f, 0.f, 0.f, 0.f};
        cur = nxt; cA = nA; cB = nB; ++ui;
        if (wr == 1) PG8_BAR;
    }
    PG8_WAIT_V(0);
    PG8_BAR;
#undef PG8_SA
#undef PG8_SB
#undef PG8_STAGE
#undef PG8_LDA
#undef PG8_LDB
#undef PG8_MMA
#undef PG8_WAIT_V
#undef PG8_WAIT_L
#undef PG8_BAR
#undef PG8_SCHED
}
}

__device__ __forceinline__ void rstd_table(const float* ssq, int row0, LAS float* tab, int t) {
    const int r = t >> 1, hf = t & 1;
    const float* p = ssq + ssq_idx(row0 + r, hf * 16);
    float s = 0.f;
#pragma unroll
    for (int i = 0; i < 16; ++i) s += p[i * 32];
    s += __shfl_xor(s, 1);
    if (!hf) tab[r] = rsqrtf(s * (1.0f / 2048.0f) + EPS);
}

struct EpiProj {
    static constexpr bool HAS_TAB = false; static constexpr int MID_T = -1;
    bf16_t* O;
    __device__ __forceinline__ void prep(const pg8::Unit&, LAS float*, int) const {}
    __device__ __forceinline__ void operator()(const f32x4 (&acc)[2][2][4][2], const pg8::Unit& u, LAS const float*, int wr, int wc, int fr, int fq) const {
        const int row0 = u.pm * 256 + wr * 64 + fr, col0 = u.pn * 256 + wc * 32 + 8 * fq;
        if (u.pn >= 32) {
            const int pcol = 8192 + (u.pn - 32) * 128 + wc * 32 + 8 * fq;
#pragma unroll
            for (int ai = 0; ai < 2; ++ai)
#pragma unroll
                for (int m = 0; m < 4; ++m) { const f32x4 v0 = acc[ai][0][m][0] * acc[ai][1][m][0], v1 = acc[ai][0][m][1] * acc[ai][1][m][1];
                    u32x4 w; w.x = cvt_pk_bf16(v0[0], v0[1]); w.y = cvt_pk_bf16(v0[2], v0[3]); w.z = cvt_pk_bf16(v1[0], v1[1]); w.w = cvt_pk_bf16(v1[2], v1[3]);
                    *(u32x4*)(O + (size_t)(row0 + ai * 128 + m * 16) * NPROJ + pcol) = w; }
            return;
        }
#pragma unroll
        for (int ai = 0; ai < 2; ++ai)
#pragma unroll
            for (int m = 0; m < 4; ++m) { bf16_t* rowp = O + (size_t)(row0 + ai * 128 + m * 16) * NPROJ + col0;
#pragma unroll
                for (int bj = 0; bj < 2; ++bj) { const f32x4 v0 = acc[ai][bj][m][0], v1 = acc[ai][bj][m][1];
                    u32x4 w; w.x = cvt_pk_bf16(v0[0], v0[1]); w.y = cvt_pk_bf16(v0[2], v0[3]); w.z = cvt_pk_bf16(v1[0], v1[1]); w.w = cvt_pk_bf16(v1[2], v1[3]);
                    *(u32x4*)(rowp + bj * 128) = w; } }
    }
};
struct EpiOut {
    static constexpr bool HAS_TAB = true; static constexpr int MID_T = 32;
    const float* x; bf16_t* h1b; const float* ssq1; float* ssq2;
    __device__ __forceinline__ void prep(const pg8::Unit& u, LAS float* tab, int t) const { rstd_table(ssq1, u.pm * 256, tab, t); }
    __device__ __forceinline__ void operator()(const f32x4 (&acc)[2][2][4][2], const pg8::Unit& u, LAS const float*, int wr, int wc, int fr, int fq) const {
        const int row0 = u.pm * 256 + wr * 64 + fr, col0 = u.pn * 256 + wc * 32 + 8 * fq;
#pragma unroll
        for (int ai = 0; ai < 2; ++ai)
#pragma unroll
            for (int m = 0; m < 4; ++m) { const int row = row0 + ai * 128 + m * 16; const size_t off = (size_t)row * D_ + col0; float ss = 0.f;
#pragma unroll
                for (int bj = 0; bj < 2; ++bj) {
                    const f32x4 x0 = *(const f32x4*)(x + off + bj * 128), x1 = *(const f32x4*)(x + off + bj * 128 + 4);
                    const f32x4 v0 = acc[ai][bj][m][0] + x0, v1 = acc[ai][bj][m][1] + x1;
                    u32x4 w; w.x = cvt_pk_bf16(v0[0], v0[1]); w.y = cvt_pk_bf16(v0[2], v0[3]); w.z = cvt_pk_bf16(v1[0], v1[1]); w.w = cvt_pk_bf16(v1[2], v1[3]);
                    *(u32x4*)(h1b + off + bj * 128) = w;
                    ss += (v0[0] * v0[0] + v0[1] * v0[1]) + (v0[2] * v0[2] + v0[3] * v0[3]) + (v1[0] * v1[0] + v1[1] * v1[1]) + (v1[2] * v1[2] + v1[3] * v1[3]); }
                ss += __shfl_xor(ss, 16); ss += __shfl_xor(ss, 32);
                if (fq == 0) ssq2[ssq_idx(row, u.pn * 4 + wc)] = ss; }
    }
};
struct EpiGU {
    static constexpr bool HAS_TAB = true; static constexpr int MID_T = -1;
    const float* ssq2; bf16_t* hff;
    __device__ __forceinline__ void prep(const pg8::Unit& u, LAS float* tab, int t) const { rstd_table(ssq2, u.pm * 256, tab, t); }
    __device__ __forceinline__ void operator()(const f32x4 (&acc)[2][2][4][2], const pg8::Unit& u, LAS const float* tab, int wr, int wc, int fr, int fq) const {
        const int row0 = u.pm * 256 + wr * 64 + fr, col0 = u.pn * 128 + wc * 32 + 8 * fq;
#pragma unroll
        for (int ai = 0; ai < 2; ++ai)
#pragma unroll
            for (int m = 0; m < 4; ++m) { const float rs = tab[ai * 128 + wr * 64 + m * 16 + fr];
                float o[8];
#pragma unroll
                for (int n = 0; n < 2; ++n)
#pragma unroll
                    for (int j = 0; j < 4; ++j) { const float gg = acc[ai][0][m][n][j] * rs, uu = acc[ai][1][m][n][j] * rs; o[n * 4 + j] = silu_f(gg) * uu; }
                u32x4 w; w.x = cvt_pk_bf16(o[0], o[1]); w.y = cvt_pk_bf16(o[2], o[3]); w.z = cvt_pk_bf16(o[4], o[5]); w.w = cvt_pk_bf16(o[6], o[7]);
                *(u32x4*)(hff + (size_t)(row0 + ai * 128 + m * 16) * DFF + col0) = w; }
    }
};
struct EpiDown {
    static constexpr bool HAS_TAB = false; static constexpr int MID_T = -1;
    bf16_t* h; float* ssq3;
    __device__ __forceinline__ void prep(const pg8::Unit&, LAS float*, int) const {}
    __device__ __forceinline__ void operator()(const f32x4 (&acc)[2][2][4][2], const pg8::Unit& u, LAS const float*, int wr, int wc, int fr, int fq) const {
        const int row0 = u.pm * 256 + wr * 64 + fr, col0 = u.pn * 256 + wc * 32 + 8 * fq;
#pragma unroll
        for (int ai = 0; ai < 2; ++ai)
#pragma unroll
            for (int m = 0; m < 4; ++m) { const int row = row0 + ai * 128 + m * 16; const size_t off = (size_t)row * D_ + col0; float ss = 0.f;
#pragma unroll
                for (int bj = 0; bj < 2; ++bj) {
                    const u32x4 xb = *(const u32x4*)(h + off + bj * 128);
                    const f32x4 x0 = (f32x4){bflo(xb.x), bfhi(xb.x), bflo(xb.y), bfhi(xb.y)}, x1 = (f32x4){bflo(xb.z), bfhi(xb.z), bflo(xb.w), bfhi(xb.w)};
                    const f32x4 v0 = acc[ai][bj][m][0] + x0, v1 = acc[ai][bj][m][1] + x1;
                    u32x4 w; w.x = cvt_pk_bf16(v0[0], v0[1]); w.y = cvt_pk_bf16(v0[2], v0[3]); w.z = cvt_pk_bf16(v1[0], v1[1]); w.w = cvt_pk_bf16(v1[2], v1[3]);
                    *(u32x4*)(h + off + bj * 128) = w;
                    ss += (v0[0] * v0[0] + v0[1] * v0[1]) + (v0[2] * v0[2] + v0[3] * v0[3]) + (v1[0] * v1[0] + v1[1] * v1[1]) + (v1[2] * v1[2] + v1[3] * v1[3]); }
                ss += __shfl_xor(ss, 16); ss += __shfl_xor(ss, 32);
                if (fq == 0) ssq3[ssq_idx(row, u.pn * 4 + wc)] = ss; }
    }
};

__device__ __forceinline__ void p0_tile(LAS float* t, const float* src, int ldsrc, int k0, int c0, int jvalid, bf16_t* dst, int K, int j0, const float* scale, int scale_kmax, int tid) {
    const int jc4 = (tid & 15) * 4, kr0 = tid >> 4;
#pragma unroll
    for (int i = 0; i < 4; ++i) {
        const int kr = kr0 + 32 * i;
        f32x4 v = (f32x4){0.f, 0.f, 0.f, 0.f};
        if (jc4 < jvalid) v = *(const f32x4*)(src + (size_t)(k0 + kr) * ldsrc + c0 + jc4);
        const float s = (scale != nullptr && (k0 + kr) < scale_kmax) ? scale[k0 + kr] : 1.0f;
        t[kr * 65 + jc4 + 0] = v[0] * s; t[kr * 65 + jc4 + 1] = v[1] * s; t[kr * 65 + jc4 + 2] = v[2] * s; t[kr * 65 + jc4 + 3] = v[3] * s;
    }
    __syncthreads();
    const int kp = (tid & 63) * 2, jr0 = tid >> 6;
#pragma unroll
    for (int i = 0; i < 8; ++i) {
        const int j = jr0 + 8 * i;
        if (j < jvalid) { const float a = t[kp * 65 + j], b = t[(kp + 1) * 65 + j];
            *(unsigned*)(dst + (size_t)(j0 + j) * K + k0 + kp) = cvt_pk_bf16(a, b); }
    }
    __syncthreads();
}
struct TileD { const float* src; const float* scale; bf16_t* dst; int ldsrc, k0, c0, jvalid, K, j0, kmax; };
__device__ __forceinline__ TileD tile_decode(const Params& p, int u) {
    constexpr int U_IN = 16 * 193, U_OUT = 32 * 32, U_GU = 16 * 176;
    TileD d;
    if (u < U_IN) { const int kt = u & 15, jt = u >> 4, j0 = jt * 64;
        d.src = p.w_in; d.scale = nullptr; d.dst = (bf16_t*)(p.ws + WS_BTIN); d.ldsrc = DIN; d.k0 = kt * 128; d.c0 = j0 < 6144 ? j0 : (j0 < 8192 ? j0 + 32 : (j0 < 12288 ? (((j0 & 255) < 128 ? 8224 : 10272 - 128) + 128 * ((j0 - 8192) >> 8) + (j0 & 255)) : 6144));     d.jvalid = (jt == 192) ? 32 : 64; d.K = D_; d.j0 = j0; d.kmax = 0; }
    else if (u < U_IN + U_OUT) { const int v = u - U_IN, kt = v & 31, jt = v >> 5;
        d.src = p.w_out; d.scale = p.ssm_norm_g; d.dst = (bf16_t*)((unsigned char*)p.out + DO_BTOUT); d.ldsrc = D_; d.k0 = kt * 128; d.c0 = jt * 64; d.jvalid = 64; d.K = DMIX; d.j0 = jt * 64; d.kmax = 2048; }
    else if (u < U_IN + U_OUT + U_GU) { const int v = u - U_IN - U_OUT, kt = v & 15, jt = v >> 4, j0 = jt * 64, pn = j0 >> 8, r0 = j0 & 255;
        d.src = r0 < 128 ? p.w_gate : p.w_up; d.scale = p.norm_ffn_g; d.dst = (bf16_t*)((unsigned char*)p.out + DO_BTGU); d.ldsrc = DFF; d.k0 = kt * 128; d.c0 = 128 * pn + (r0 & 127); d.jvalid = 64; d.K = D_; d.j0 = j0; d.kmax = 2048; }
    else { const int v = u - U_IN - U_OUT - U_GU, kt = v % 44, jt = v / 44;
        d.src = p.w_down; d.scale = nullptr; d.dst = (bf16_t*)((unsigned char*)p.out + DO_BTDN); d.ldsrc = D_; d.k0 = kt * 128; d.c0 = jt * 64; d.jvalid = 64; d.K = DFF; d.j0 = jt * 64; d.kmax = 0; }
    return d;
}
__device__ __forceinline__ void tile_load(const TileD& d, int tid, f32x4 (&v)[4], float (&scl)[4]) {
    const int jc4 = (tid & 15) * 4, kr0 = tid >> 4;
#pragma unroll
    for (int i = 0; i < 4; ++i) { const int kr = kr0 + 32 * i;
        f32x4 x = (f32x4){0.f, 0.f, 0.f, 0.f};
        if (jc4 < d.jvalid) x = *(const f32x4*)(d.src + (size_t)(d.k0 + kr) * d.ldsrc + d.c0 + jc4);
        scl[i] = (d.scale != nullptr && (d.k0 + kr) < d.kmax) ? d.scale[d.k0 + kr] : 1.0f;
        v[i] = x; }
}
__device__ __forceinline__ void tile_finish(LAS float* t, const TileD& d, int tid, const f32x4 (&v)[4], const float (&scl)[4]) {
    const int jc4 = (tid & 15) * 4, kr0 = tid >> 4;
#pragma unroll
    for (int i = 0; i < 4; ++i) { const int kr = kr0 + 32 * i;
        t[kr * 65 + jc4 + 0] = v[i][0] * scl[i]; t[kr * 65 + jc4 + 1] = v[i][1] * scl[i]; t[kr * 65 + jc4 + 2] = v[i][2] * scl[i]; t[kr * 65 + jc4 + 3] = v[i][3] * scl[i]; }
    asm volatile("s_waitcnt lgkmcnt(0)" ::: "memory"); __builtin_amdgcn_s_barrier(); asm volatile("" ::: "memory");
    const int kp = (tid & 63) * 2, jr0 = tid >> 6;
#pragma unroll
    for (int i = 0; i < 8; ++i) { const int j = jr0 + 8 * i;
        if (j < d.jvalid) { const float a = t[kp * 65 + j], b = t[(kp + 1) * 65 + j];
            *(unsigned*)(d.dst + (size_t)(d.j0 + j) * d.K + d.k0 + kp) = cvt_pk_bf16(a, b); } }
    asm volatile("s_waitcnt lgkmcnt(0)" ::: "memory"); __builtin_amdgcn_s_barrier(); asm volatile("" ::: "memory");
}
__device__ __forceinline__ void conv_tiles(const Params& p, LAS unsigned char* lds, int u_begin, int u_end, int first, int stride, int tid) {
    LAS float* t = (LAS float*)lds;
    int u = u_begin + first;
    if (u >= u_end) return;
    TileD d = tile_decode(p, u); f32x4 v[4]; float sc[4]; tile_load(d, tid, v, sc);
    for (;;) {
        const int un = u + stride; const bool more = un < u_end;
        TileD dn = d; f32x4 vn[4]; float scn[4];
#pragma unroll
        for (int i = 0; i < 4; ++i) { vn[i] = v[i]; scn[i] = sc[i]; }
        if (more) { dn = tile_decode(p, un); tile_load(dn, tid, vn, scn); }
        tile_finish(t, d, tid, v, sc);
        if (!more) break;
        d = dn; u = un;
#pragma unroll
        for (int i = 0; i < 4; ++i) { v[i] = vn[i]; sc[i] = scn[i]; }
    }
}
__device__ void phase0(const Params& p, LAS unsigned char* lds, int wv) {
    const int lane = lane_id(), wave = wv, tid = wv * 64 + lane, G = gridDim.x;
    LAS float* t = (LAS float*)lds;
    bf16_t* bt_in = (bf16_t*)(p.ws + WS_BTIN);
    bf16_t* xn = (bf16_t*)(p.ws + WS_XN);
    for (int row = blockIdx.x * 8 + wave; row < M_; row += G * 8) {
        const f32x4* xr = (const f32x4*)(p.x + (size_t)row * D_);
        f32x4 v[8]; float ss = 0.f;
#pragma unroll
        for (int i = 0; i < 8; ++i) { v[i] = xr[lane + 64 * i]; ss += (v[i][0] * v[i][0] + v[i][1] * v[i][1]) + (v[i][2] * v[i][2] + v[i][3] * v[i][3]); }
#pragma unroll
        for (int o = 32; o >= 1; o >>= 1) ss += __shfl_xor(ss, o);
        const float rstd = rsqrtf(ss * (1.0f / 2048.0f) + EPS);
#pragma unroll
        for (int i = 0; i < 8; ++i) { const f32x4 g4 = ((const f32x4*)p.norm_mix_g)[lane + 64 * i];
            u32x2 w; w.x = cvt_pk_bf16(v[i][0] * rstd * g4[0], v[i][1] * rstd * g4[1]); w.y = cvt_pk_bf16(v[i][2] * rstd * g4[2], v[i][3] * rstd * g4[3]);
            *(u32x2*)(xn + (size_t)row * D_ + 4 * (lane + 64 * i)) = w; }
    }
    __syncthreads();
    conv_tiles(p, lds, 0, 16 * 193, blockIdx.x, G, tid);
}
__device__ void wconv_units(const Params& p, LAS unsigned char* lds, int first, int stride, int wv) {
    const int tid = wv * 64 + lane_id();
    __syncthreads();
    conv_tiles(p, lds, 16 * 193, 16 * 193 + 32 * 32 + 16 * 176 + 44 * 32, first, stride, tid);
}

__device__ void dt_units(const Params& p, LAS unsigned char* lds, int wv) {
    const int lane = lane_id(), w = wv, tid = wv * 64 + lane, fr = lane & 15, fq = lane >> 4;
    const bf16_t* xn = (const bf16_t*)(p.ws + WS_XN);
    const bf16_t* bt = (const bf16_t*)(p.ws + WS_BTIN) + (size_t)NPROJ * D_;
    float* dt = (float*)((unsigned char*)p.out + DO_DT);
    LAS float* red = (LAS float*)lds;
    for (int rb = blockIdx.x; rb < M_ / 64; rb += gridDim.x) {
        const int row0 = rb * 64;
        f32x4 acc[4][2];
#pragma unroll
        for (int m = 0; m < 4; ++m)
#pragma unroll
            for (int n = 0; n < 2; ++n) acc[m][n] = (f32x4){0.f, 0.f, 0.f, 0.f};
#pragma unroll 4
        for (int ks = 0; ks < 8; ++ks) {
            const int kb = w * 256 + ks * 32 + fq * 8;
            bf16x8 a[4], b[2];
#pragma unroll
            for (int m = 0; m < 4; ++m) a[m] = *(const bf16x8*)(xn + (size_t)(row0 + 16 * m + fr) * D_ + kb);
#pragma unroll
            for (int n = 0; n < 2; ++n) b[n] = *(const bf16x8*)(bt + (size_t)(16 * n + fr) * D_ + kb);
#pragma unroll
            for (int m = 0; m < 4; ++m)
#pragma unroll
                for (int n = 0; n < 2; ++n) acc[m][n] = __builtin_amdgcn_mfma_f32_16x16x32_bf16(a[m], b[n], acc[m][n], 0, 0, 0);
        }
#pragma unroll
        for (int m = 0; m < 4; ++m)
#pragma unroll
            for (int n = 0; n < 2; ++n)
#pragma unroll
                for (int j = 0; j < 4; ++j) red[w * 2048 + (16 * m + 4 * fq + j) * 32 + 16 * n + fr] = acc[m][n][j];
        __syncthreads();
        {
            const int idx = tid * 4, r = idx >> 5, c = idx & 31;
            f32x4 s = (f32x4){0.f, 0.f, 0.f, 0.f};
#pragma unroll
            for (int ww = 0; ww < 8; ++ww) s += *(LAS const f32x4*)(red + ww * 2048 + idx);
            const f32x4 bias = *(const f32x4*)(p.ssm_dt_bias + c);
            f32x4 o;
#pragma unroll
            for (int j = 0; j < 4; ++j) { const float v = s[j] + bias[j]; o[j] = v > 20.f ? v : log1pf(expf(v)); }
            *(f32x4*)(dt + (size_t)(row0 + r) * 32 + c) = o;
        }
        __syncthreads();
    }
}

__device__ void bc_sequences(const Params& p, LAS unsigned char* lds, int first, int stride, int wv) {
    const int tid = wv * 64 + lane_id(), cv = tid & 7, run = tid >> 3;
    bf16_t* proj = (bf16_t*)(p.ws + WS_PROJ);
    LAS u32x4* stash = (LAS u32x4*)lds;
    unsigned* bcflag = (unsigned*)((unsigned char*)p.out + DO_BCFLAG);
    for (int sq = first; sq < 4 * 32; sq += stride) {
        const int b = sq >> 5, slab = sq & 31;
        const int xcol = 2048 + slab * 64 + cv * 8;
        float wk[4][8], bs[8];
#pragma unroll
        for (int k = 0; k < 4; ++k) { const f32x4 a = *(const f32x4*)(p.ssm_conv_w + k * 4096 + xcol), c = *(const f32x4*)(p.ssm_conv_w + k * 4096 + xcol + 4);
#pragma unroll
            for (int j = 0; j < 4; ++j) { wk[k][j] = a[j]; wk[k][4 + j] = c[j]; } }
        { const f32x4 a = *(const f32x4*)(p.ssm_conv_b + xcol), c = *(const f32x4*)(p.ssm_conv_b + xcol + 4);
#pragma unroll
          for (int j = 0; j < 4; ++j) { bs[j] = a[j]; bs[4 + j] = c[j]; } }
        __syncthreads();
#pragma unroll 1
        for (int tile = 0; tile < 8; ++tile) {
            bf16_t* base = proj + (size_t)(b * SEQ + tile * 512 + run * 8) * NPROJ + 2048 + xcol;
            u32x4 raw[11];
#pragma unroll
            for (int r = 0; r < 11; ++r) {
                const int row = run * 8 + r - 3;
                if (row >= 0) raw[r] = *(const u32x4*)(base + (long)(r - 3) * NPROJ);
                else raw[r] = (tile == 0) ? (u32x4){0u, 0u, 0u, 0u} : stash[(row + 3) * 8 + cv];
            }
            u32x4 ov[8];
#pragma unroll
            for (int j = 0; j < 8; ++j) {
                float o[8];
#pragma unroll
                for (int q = 0; q < 4; ++q) {
                    const unsigned x0 = raw[j][q], x1 = raw[j + 1][q], x2 = raw[j + 2][q], x3 = raw[j + 3][q];
                    o[2 * q] = silu_f(bs[2 * q] + wk[0][2 * q] * bflo(x0) + wk[1][2 * q] * bflo(x1) + wk[2][2 * q] * bflo(x2) + wk[3][2 * q] * bflo(x3));
                    o[2 * q + 1] = silu_f(bs[2 * q + 1] + wk[0][2 * q + 1] * bfhi(x0) + wk[1][2 * q + 1] * bfhi(x1) + wk[2][2 * q + 1] * bfhi(x2) + wk[3][2 * q + 1] * bfhi(x3));
                }
                ov[j].x = cvt_pk_bf16(o[0], o[1]); ov[j].y = cvt_pk_bf16(o[2], o[3]); ov[j].z = cvt_pk_bf16(o[4], o[5]); ov[j].w = cvt_pk_bf16(o[6], o[7]);
            }
            asm volatile("s_waitcnt vmcnt(0) lgkmcnt(0)" ::: "memory");
            __syncthreads();
            if (run == 63) { stash[0 * 8 + cv] = raw[8]; stash[1 * 8 + cv] = raw[9]; stash[2 * 8 + cv] = raw[10]; }
#pragma unroll
            for (int j = 0; j < 8; ++j) { const bf16_t* q = base + (long)j * NPROJ;
                asm volatile("global_store_dwordx4 %0, %1, off sc1" :: "v"(q), "v"(ov[j]) : "memory"); }
            asm volatile("s_waitcnt vmcnt(0) lgkmcnt(0)" ::: "memory");
            __syncthreads();
            if (wv == 0) {
                if (lane_id() == 0) __hip_atomic_store(bcflag + sq, (unsigned)(tile + 1), __ATOMIC_RELAXED, __HIP_MEMORY_SCOPE_AGENT);
            }
        }
    }
}

constexpr int SROW = 272;
constexpr int L_CM = 0, L_BM = 34816, L_BDT = 69632, L_XT = 104448, L_HB = 121856  , L_CS = 156672, L_DT = 157184, L_CW = 157696  ;
__device__ __forceinline__ int swz_off(int row, int kblk) { return row * SROW + ((kblk ^ ((row >> 3) & 7)) << 4); }
__device__ __forceinline__ void ssd_load(u32x4 (&raw)[5], const bf16_t* base, bool first, int l0) {
#pragma unroll
    for (int r = 0; r < 5; ++r) raw[r] = (first && (l0 + r - 3) < 0) ? (u32x4){0u, 0u, 0u, 0u} : *(const u32x4*)(base + (long)(r - 3) * NPROJ);
}
template <int GI>
__device__ __forceinline__ void ssd_conv(LAS unsigned char* lds, const u32x4 (&raw)[5], int cv, int l0, float sa, float sb) {
    LAS const f32x4* cw = (LAS const f32x4*)(lds + L_CW) + cv * 10;
    float o0[8], o1[8];
#pragma unroll
    for (int hq = 0; hq < 2; ++hq) {
        const f32x4 w0 = cw[0 + hq], w1 = cw[2 + hq], w2 = cw[4 + hq], w3 = cw[6 + hq], bs = cw[8 + hq];
#pragma unroll
        for (int e2 = 0; e2 < 2; ++e2) {
            const int q = hq * 2 + e2;
            const unsigned x0 = raw[0][q], x1 = raw[1][q], x2 = raw[2][q], x3 = raw[3][q], x4 = raw[4][q];
            const int ea = e2 * 2, eb = e2 * 2 + 1;
            const float va = bs[ea] + w0[ea] * bflo(x0) + w1[ea] * bflo(x1) + w2[ea] * bflo(x2) + w3[ea] * bflo(x3);
            const float vb = bs[eb] + w0[eb] * bfhi(x0) + w1[eb] * bfhi(x1) + w2[eb] * bfhi(x2) + w3[eb] * bfhi(x3);
            const float ua = bs[ea] + w0[ea] * bflo(x1) + w1[ea] * bflo(x2) + w2[ea] * bflo(x3) + w3[ea] * bflo(x4);
            const float ub = bs[eb] + w0[eb] * bfhi(x1) + w1[eb] * bfhi(x2) + w2[eb] * bfhi(x3) + w3[eb] * bfhi(x4);
            o0[2 * q] = silu_f(va); o0[2 * q + 1] = silu_f(vb); o1[2 * q] = silu_f(ua); o1[2 * q + 1] = silu_f(ub);
        }
    }
    if (GI == 0) {
#pragma unroll
        for (int e = 0; e < 8; ++e) { const int prow = cv * 8 + e;
            *(LAS unsigned*)(lds + L_XT + swz_off(prow, l0 >> 3) + (l0 & 7) * 2) = cvt_pk_bf16(o0[e] * sa, o1[e] * sb); }
    } else {
        u32x4 w0; w0.x = cvt_pk_bf16(o0[0], o0[1]); w0.y = cvt_pk_bf16(o0[2], o0[3]); w0.z = cvt_pk_bf16(o0[4], o0[5]); w0.w = cvt_pk_bf16(o0[6], o0[7]);
        u32x4 w1; w1.x = cvt_pk_bf16(o1[0], o1[1]); w1.y = cvt_pk_bf16(o1[2], o1[3]); w1.z = cvt_pk_bf16(o1[4], o1[5]); w1.w = cvt_pk_bf16(o1[6], o1[7]);
        const int nb = ((GI - 1) & 1) * 64 + cv * 8;
        if (GI < 3) {
            *(LAS u32x4*)(lds + L_BM + l0 * SROW + nb * 2) = w0; *(LAS u32x4*)(lds + L_BM + (l0 + 1) * SROW + nb * 2) = w1;
#pragma unroll
            for (int e = 0; e < 8; ++e) { const int nrow = nb + e;
                *(LAS unsigned*)(lds + L_BDT + swz_off(nrow, l0 >> 3) + (l0 & 7) * 2) = cvt_pk_bf16(o0[e] * sa, o1[e] * sb); }
        } else {
            *(LAS u32x4*)(lds + L_CM + l0 * SROW + nb * 2) = w0; *(LAS u32x4*)(lds + L_CM + (l0 + 1) * SROW + nb * 2) = w1;
        }
    }
}
template <int GI>
__device__ __forceinline__ void ssd_put(LAS unsigned char* lds, const u32x4 (&rw)[2], int cv, int l0, float sa, float sb) {
    const int nb = ((GI - 1) & 1) * 64 + cv * 8;
    if (GI < 3) {
        *(LAS u32x4*)(lds + L_BM + l0 * SROW + nb * 2) = rw[0]; *(LAS u32x4*)(lds + L_BM + (l0 + 1) * SROW + nb * 2) = rw[1];
#pragma unroll
        for (int q = 0; q < 4; ++q) {
            *(LAS unsigned*)(lds + L_BDT + swz_off(nb + 2 * q, l0 >> 3) + (l0 & 7) * 2) = cvt_pk_bf16(bflo(rw[0][q]) * sa, bflo(rw[1][q]) * sb);
            *(LAS unsigned*)(lds + L_BDT + swz_off(nb + 2 * q + 1, l0 >> 3) + (l0 & 7) * 2) = cvt_pk_bf16(bfhi(rw[0][q]) * sa, bfhi(rw[1][q]) * sb);
        }
    } else {
        *(LAS u32x4*)(lds + L_CM + l0 * SROW + nb * 2) = rw[0]; *(LAS u32x4*)(lds + L_CM + (l0 + 1) * SROW + nb * 2) = rw[1];
    }
}
__device__ __forceinline__ void bc_wait(unsigned* f, unsigned need, int wv) {
    if (wv == 0) {
    unsigned sp = 0;
    for (;;) {
        const unsigned a = __hip_atomic_load(f, __ATOMIC_RELAXED, __HIP_MEMORY_SCOPE_AGENT), b2 = __hip_atomic_load(f + 1, __ATOMIC_RELAXED, __HIP_MEMORY_SCOPE_AGENT);
        const unsigned c = __hip_atomic_load(f + 16, __ATOMIC_RELAXED, __HIP_MEMORY_SCOPE_AGENT), d = __hip_atomic_load(f + 17, __ATOMIC_RELAXED, __HIP_MEMORY_SCOPE_AGENT);
        const unsigned m = min(min(a, b2), min(c, d));
        if (__builtin_amdgcn_readfirstlane(m) >= need) break;
        __builtin_amdgcn_s_sleep(4);
        if (++sp > (1u << 19)) break;
    }
    __builtin_amdgcn_fence(__ATOMIC_ACQUIRE, "agent"); asm volatile("s_waitcnt vmcnt(0)" ::: "memory");
    }
    asm volatile("s_waitcnt lgkmcnt(0)" ::: "memory"); __builtin_amdgcn_s_barrier(); asm volatile("" ::: "memory");
}
__device__ void ssd_unit(const Params& p, LAS unsigned char* lds, int b, int h, int wv) {
    const int lane = lane_id(), w = wv, tid = wv * 64 + lane, fr = lane & 15, fq = lane >> 4;
    const int g = h >> 2;
    const bf16_t* proj = (const bf16_t*)(p.ws + WS_PROJ);
    const float* dtg = (const float*)((const unsigned char*)p.out + DO_DT);
    bf16_t* ymix = (bf16_t*)(p.ws + WS_YMIX);
    float* ssq1 = (float*)((unsigned char*)p.out + DO_SSQ1);
    LAS float* CSv = (LAS float*)(lds + L_CS);
    LAS float* DTv = (LAS float*)(lds + L_DT);
    LAS float* CW = (LAS float*)(lds + L_CW);
    const float Aneg = -__expf(p.ssm_A_log[h]);
    const float Dh = p.ssm_D[h];
    for (int idx = tid; idx < 320; idx += 512) {
        const int e = idx & 7, k = (idx >> 3) % 5, cvi = idx / 40;
        const int xcol = h * 64 + cvi * 8 + e;
        CW[idx] = (k < 4) ? p.ssm_conv_w[k * 4096 + xcol] : p.ssm_conv_b[xcol];
    }
    for (int idx = tid; idx < 64 * 17; idx += 512) *(LAS u32x4*)(lds + L_HB + idx * 16) = (u32x4){0u, 0u, 0u, 0u};
    f32x4 Hacc[4];
#pragma unroll
    for (int pt = 0; pt < 4; ++pt) Hacc[pt] = (f32x4){0.f, 0.f, 0.f, 0.f};
    __syncthreads();
    const int cv = lane & 7;
    const int l0 = 16 * w + 2 * (lane >> 3);
    const int srcl = (w & 3) * 16 + 2 * (lane >> 3);
    u32x4 r0[5], r1[2], r2[2], r3[2], r4[2];
    const bf16_t* pbase = proj + (size_t)(b * SEQ + l0) * NPROJ + 2048 + cv * 8;
    const int xc0 = h * 64, xc1 = 2048 + g * 128, xc2 = xc1 + 64, xc3 = 3072 + g * 128, xc4 = xc3 + 64;
    unsigned* bcf = (unsigned*)((unsigned char*)p.out + DO_BCFLAG) + b * 32 + 2 * g;
    bc_wait(bcf, 1u, wv);
    ssd_load(r0, pbase + xc0, true, l0);
    r1[0] = *(const u32x4*)(pbase + xc1); r1[1] = *(const u32x4*)(pbase + xc1 + NPROJ); r2[0] = *(const u32x4*)(pbase + xc2); r2[1] = *(const u32x4*)(pbase + xc2 + NPROJ);
    r3[0] = *(const u32x4*)(pbase + xc3); r3[1] = *(const u32x4*)(pbase + xc3 + NPROJ); r4[0] = *(const u32x4*)(pbase + xc4); r4[1] = *(const u32x4*)(pbase + xc4 + NPROJ);
    float dt0n = dtg[(size_t)(b * SEQ + lane) * 32 + h], dt1n = dtg[(size_t)(b * SEQ + 64 + lane) * 32 + h];
    for (int c = 0; c < 32; ++c) {
        const int row0 = b * SEQ + c * 128;
        if (c + 1 < 32 && ((c + 1) & 3) == 0) bc_wait(bcf, (unsigned)(((c + 1) >> 2) + 1), wv);
        const float dt0 = dt0n, dt1 = dt1n;
        if (c + 1 < 32) { dt0n = dtg[(size_t)(row0 + 128 + lane) * 32 + h]; dt1n = dtg[(size_t)(row0 + 192 + lane) * 32 + h]; }
        u32x2 zr[4];
#pragma unroll
        for (int pt = 0; pt < 4; ++pt) zr[pt] = *(const u32x2*)(proj + (size_t)(row0 + 16 * w + fr) * NPROJ + h * 64 + 16 * pt + 4 * fq);
        __builtin_amdgcn_sched_barrier(0);
        float a0 = dt0 * Aneg, a1 = dt1 * Aneg;
#pragma unroll
        for (int o = 1; o < 64; o <<= 1) { const float t0 = __shfl_up(a0, o), t1 = __shfl_up(a1, o); if (lane >= o) { a0 += t0; a1 += t1; } }
        a1 += __shfl(a0, 63);
        const float cs_end = __shfl(a1, 63);
        if (w == 0) { CSv[lane] = a0; CSv[64 + lane] = a1; DTv[lane] = dt0; DTv[64 + lane] = dt1; }
        const float csv = (w >= 4) ? a1 : a0, dtv = (w >= 4) ? dt1 : dt0;
        const float cs_l0 = __shfl(csv, srcl), cs_l1 = __shfl(csv, srcl + 1), dt_l0 = __shfl(dtv, srcl), dt_l1 = __shfl(dtv, srcl + 1);
        const float dec0 = __expf(cs_end - cs_l0), dec1 = __expf(cs_end - cs_l1);
        ssd_conv<0>(lds, r0, cv, l0, dt_l0, dt_l1);
        __builtin_amdgcn_sched_barrier(0);
        if (c + 1 < 32) ssd_load(r0, pbase + (size_t)(c + 1) * 128 * NPROJ + xc0, false, l0);
        __builtin_amdgcn_sched_barrier(0);
        ssd_put<1>(lds, r1, cv, l0, dec0, dec1); ssd_put<2>(lds, r2, cv, l0, dec0, dec1);
        ssd_put<3>(lds, r3, cv, l0, 0.f, 0.f);   ssd_put<4>(lds, r4, cv, l0, 0.f, 0.f);
        __builtin_amdgcn_sched_barrier(0);
        if (c + 1 < 32) {
            const bf16_t* cb = pbase + (size_t)(c + 1) * 128 * NPROJ;
            r1[0] = *(const u32x4*)(cb + xc1); r1[1] = *(const u32x4*)(cb + xc1 + NPROJ); r2[0] = *(const u32x4*)(cb + xc2); r2[1] = *(const u32x4*)(cb + xc2 + NPROJ);
            r3[0] = *(const u32x4*)(cb + xc3); r3[1] = *(const u32x4*)(cb + xc3 + NPROJ); r4[0] = *(const u32x4*)(cb + xc4); r4[1] = *(const u32x4*)(cb + xc4 + NPROJ);
        }
        __builtin_amdgcn_sched_barrier(0);
        asm volatile("s_waitcnt lgkmcnt(0)" ::: "memory"); __builtin_amdgcn_s_barrier(); asm volatile("" ::: "memory");
        const int lrow = 16 * w + fr;
        const int hb_cur = L_HB + (c & 1) * 17408, hb_nxt = L_HB + ((c + 1) & 1) * 17408;
        bf16x8 cf[4];
#pragma unroll
        for (int ks = 0; ks < 4; ++ks) cf[ks] = *(LAS const bf16x8*)(lds + L_CM + lrow * SROW + (32 * ks + 8 * fq) * 2);
        const float cs_l = CSv[lrow], dt_l = DTv[lrow];
        asm volatile("" ::: "memory");
        const int dd = fr - 4 * fq; const float ddiag = Dh / dt_l;
        f32x4 y[4];
        { const float el = __expf(cs_l);
#pragma unroll
          for (int pt = 0; pt < 4; ++pt) { f32x4 a = (f32x4){0.f, 0.f, 0.f, 0.f};
#pragma unroll
            for (int ks = 0; ks < 4; ++ks) { const bf16x8 hf = *(LAS const bf16x8*)(lds + hb_cur + (16 * pt + fr) * SROW + (32 * ks + 8 * fq) * 2);
                a = __builtin_amdgcn_mfma_f32_16x16x32_bf16(hf, cf[ks], a, 0, 0, 0); }
            y[pt] = a * el; } }
#pragma unroll
        for (int j = 0; j < 8; ++j) {
            if (j <= w) {
                f32x4 gacc = (f32x4){0.f, 0.f, 0.f, 0.f};
#pragma unroll
                for (int ks = 0; ks < 4; ++ks) { const bf16x8 bf = *(LAS const bf16x8*)(lds + L_BM + (16 * j + fr) * SROW + (32 * ks + 8 * fq) * 2);
                    gacc = __builtin_amdgcn_mfma_f32_16x16x32_bf16(bf, cf[ks], gacc, 0, 0, 0); }
                const f32x4 css = *(LAS const f32x4*)(CSv + 16 * j + 4 * fq);
                float mv[4];
#pragma unroll
                for (int i = 0; i < 4; ++i) { float v = gacc[i] * __expf(cs_l - css[i]);
                    if (j == w) { v = (i <= dd) ? v : 0.f; if (i == dd) v += ddiag; }
                    mv[i] = v; }
                u32x2 wv2; wv2.x = cvt_pk_bf16(mv[0], mv[1]); wv2.y = cvt_pk_bf16(mv[2], mv[3]);
                *(LAS u32x2*)(lds + L_CM + lrow * SROW + (16 * j + 4 * fq) * 2) = wv2;
            } else if (j == w + 1 && (w & 1) == 0) {
                *(LAS u32x2*)(lds + L_CM + lrow * SROW + (16 * j + 4 * fq) * 2) = (u32x2){0u, 0u};
            }
        }
        asm volatile("" ::: "memory");
        { const float de = __expf(cs_end);
#pragma unroll
          for (int pt = 0; pt < 4; ++pt) Hacc[pt] *= de; }
        const int nks2 = (w >> 1) + 1;
#pragma unroll
        for (int ks = 0; ks < 4; ++ks) {
            bf16x8 xf[4];
#pragma unroll
            for (int pt = 0; pt < 4; ++pt) xf[pt] = *(LAS const bf16x8*)(lds + L_XT + swz_off(16 * pt + fr, 4 * ks + fq));
            if (ks < nks2) { const bf16x8 mf = *(LAS const bf16x8*)(lds + L_CM + lrow * SROW + (32 * ks + 8 * fq) * 2);
#pragma unroll
                for (int pt = 0; pt < 4; ++pt) y[pt] = __builtin_amdgcn_mfma_f32_16x16x32_bf16(xf[pt], mf, y[pt], 0, 0, 0); }
            const bf16x8 bdf = *(LAS const bf16x8*)(lds + L_BDT + swz_off(16 * w + fr, 4 * ks + fq));
#pragma unroll
            for (int pt = 0; pt < 4; ++pt) Hacc[pt] = __builtin_amdgcn_mfma_f32_16x16x32_bf16(bdf, xf[pt], Hacc[pt], 0, 0, 0);
        }
#pragma unroll
        for (int pt = 0; pt < 4; ++pt) { u32x2 wv2; wv2.x = cvt_pk_bf16(Hacc[pt][0], Hacc[pt][1]); wv2.y = cvt_pk_bf16(Hacc[pt][2], Hacc[pt][3]);
            *(LAS u32x2*)(lds + hb_nxt + (16 * pt + fr) * SROW + (16 * w + 4 * fq) * 2) = wv2; }
        { float ss = 0.f; const size_t orow = (size_t)(row0 + lrow);
#pragma unroll
          for (int pt = 0; pt < 4; ++pt) {
            const float z0 = bflo(zr[pt].x), z1 = bfhi(zr[pt].x), z2 = bflo(zr[pt].y), z3 = bfhi(zr[pt].y);
            const float v0 = y[pt][0] * silu_f(z0), v1 = y[pt][1] * silu_f(z1), v2 = y[pt][2] * silu_f(z2), v3 = y[pt][3] * silu_f(z3);
            ss += (v0 * v0 + v1 * v1) + (v2 * v2 + v3 * v3);
            u32x2 wv; wv.x = cvt_pk_bf16(v0, v1); wv.y = cvt_pk_bf16(v2, v3);
            *(u32x2*)(ymix + orow * DMIX + h * 64 + 16 * pt + 4 * fq) = wv; }
          ss += __shfl_xor(ss, 16); ss += __shfl_xor(ss, 32);
          if (fq == 0) ssq1[ssq_idx((int)orow, h)] = ss; }
        asm volatile("s_waitcnt lgkmcnt(0)" ::: "memory"); __builtin_amdgcn_s_barrier(); asm volatile("" ::: "memory");
    }
}
__device__ void sc_unit(const Params& p, int unit, int wv) {
    const int tid = wv * 64 + lane_id(), cvx = tid & 255, th = tid >> 8;
    const bf16_t* proj = (const bf16_t*)(p.ws + WS_PROJ);
    bf16_t* ymix = (bf16_t*)(p.ws + WS_YMIX);
    const int t0 = unit * 64 + th * 32, c0 = cvx * 8;
    float w0[8], w1[8], w2[8];
    { const f32x4* a = (const f32x4*)(p.sc_conv_w + c0); const f32x4* bq = (const f32x4*)(p.sc_conv_w + 2048 + c0); const f32x4* cq = (const f32x4*)(p.sc_conv_w + 4096 + c0);
#pragma unroll
      for (int q = 0; q < 2; ++q) { const f32x4 x0 = a[q], x1 = bq[q], x2 = cq[q];
#pragma unroll
        for (int j = 0; j < 4; ++j) { w0[q * 4 + j] = x0[j]; w1[q * 4 + j] = x1[j]; w2[q * 4 + j] = x2[j]; } } }
    float pm1[8], pm2[8];
#pragma unroll
    for (int e = 0; e < 8; ++e) { pm1[e] = 0.f; pm2[e] = 0.f; }
    if ((t0 & (SEQ - 1)) != 0) {
        const bf16_t* r2 = proj + (size_t)(t0 - 2) * NPROJ, * r1 = proj + (size_t)(t0 - 1) * NPROJ;
        const u32x4 c2 = *(const u32x4*)(r2 + 8192 + c0), c1 = *(const u32x4*)(r1 + 8192 + c0);
#pragma unroll
        for (int q = 0; q < 4; ++q) { pm2[2 * q] = bflo(c2[q]); pm2[2 * q + 1] = bfhi(c2[q]); pm1[2 * q] = bflo(c1[q]); pm1[2 * q + 1] = bfhi(c1[q]); }
    }
#pragma unroll 4
    for (int i = 0; i < 32; ++i) {
        const bf16_t* r = proj + (size_t)(t0 + i) * NPROJ;
        const u32x4 gb = *(const u32x4*)(r + 6144 + c0), gp = *(const u32x4*)(r + 8192 + c0);
        float o[8];
#pragma unroll
        for (int q = 0; q < 4; ++q) {
            const float pa = bflo(gp[q]), pb = bfhi(gp[q]);
            o[2 * q] = bflo(gb[q]) * (w0[2 * q] * pm2[2 * q] + w1[2 * q] * pm1[2 * q] + w2[2 * q] * pa);
            o[2 * q + 1] = bfhi(gb[q]) * (w0[2 * q + 1] * pm2[2 * q + 1] + w1[2 * q + 1] * pm1[2 * q + 1] + w2[2 * q + 1] * pb);
            pm2[2 * q] = pm1[2 * q]; pm2[2 * q + 1] = pm1[2 * q + 1]; pm1[2 * q] = pa; pm1[2 * q + 1] = pb;
        }
        u32x4 wv; wv.x = cvt_pk_bf16(o[0], o[1]); wv.y = cvt_pk_bf16(o[2], o[3]); wv.z = cvt_pk_bf16(o[4], o[5]); wv.w = cvt_pk_bf16(o[6], o[7]);
        *(u32x4*)(ymix + (size_t)(t0 + i) * DMIX + 2048 + c0) = wv;
    }
}
__device__ void phase2(const Params& p, LAS unsigned char* lds, int wv) {
    const int G = gridDim.x, bid = blockIdx.x;
    const bool split = G >= 256;
    if (!split) bc_sequences(p, lds, bid, G, wv);
    if (!split || bid < 128) { for (int u = bid; u < 128; u += (split ? 128 : G)) ssd_unit(p, lds, u >> 5, u & 31, wv); }
    if (split && bid >= 128) bc_sequences(p, lds, bid - 128, G - 128, wv);
    if (!split || bid >= 128) { for (int u = (split ? bid - 128 : bid); u < M_ / 64; u += (split ? G - 128 : G)) sc_unit(p, u, wv); }
    if (!split || bid >= 128) wconv_units(p, lds, split ? bid - 128 : bid, split ? G - 128 : G, wv);
}

__device__ void phase6(const Params& p, int wv) {
    const int lane = lane_id(), wave = wv;
    const bf16_t* h2 = (const bf16_t*)(p.ws + WS_H1B);
    const float* ssq3 = (const float*)(p.ws + WS_SSQ3);
    for (int row = blockIdx.x * 8 + wave; row < M_; row += gridDim.x * 8) {
        float s = (lane < 32) ? ssq3[ssq_idx(row, lane)] : 0.f;
#pragma unroll
        for (int o = 32; o >= 1; o >>= 1) s += __shfl_xor(s, o);
        const float rstd = rsqrtf(s * (1.0f / 2048.0f) + EPS);
        const u32x2* hr = (const u32x2*)(h2 + (size_t)row * D_);
        f32x4* orow = (f32x4*)(p.out + (size_t)row * D_);
#pragma unroll
        for (int i = 0; i < 8; ++i) { const u32x2 hv = hr[lane + 64 * i]; const f32x4 v = (f32x4){bflo(hv.x), bfhi(hv.x), bflo(hv.y), bfhi(hv.y)}, g4 = ((const f32x4*)p.norm_final_g)[lane + 64 * i]; orow[lane + 64 * i] = v * rstd * g4; }
    }
}


#define XB_TMO      128
#define XB_XCNT(j)  (256  + 64 * (j))
#define XB_XSUB(j)  (1280 + 64 * (j))
#define XB_XGEN(j)  (2304 + 64 * (j))
#define XB_TOP      3328
#define XB_TOPGEN   3392
#define XCD_BAR_WORDS 3456
#define XB_SPIN_CAP (1u << 18)
__device__ __forceinline__ unsigned xb_ld(unsigned* p)              { return __hip_atomic_load(p, __ATOMIC_RELAXED, __HIP_MEMORY_SCOPE_AGENT); }
__device__ __forceinline__ unsigned xb_add(unsigned* p, unsigned v) { return __hip_atomic_fetch_add(p, v, __ATOMIC_RELAXED, __HIP_MEMORY_SCOPE_AGENT); }
__device__ __forceinline__ unsigned xb_xcc_id() { return (unsigned)__builtin_amdgcn_s_getreg((3 << 11) | 20) & 0xFu; }
#define XB_SPIN(cond, bar) do { unsigned _sp = 0; while (cond) { __builtin_amdgcn_s_sleep(1); \
    if ((++_sp & 255u) == 0u) { if (xb_ld(&(bar)[XB_TMO])) break; if (_sp > XB_SPIN_CAP) { atomicAdd(&(bar)[XB_TMO], 1u); break; } } } } while (0)
struct XcdBarrier { unsigned* bar; unsigned x; volatile LAS unsigned* st; };
__device__ __forceinline__ void xcd_barrier_complete(unsigned* bar, unsigned x, unsigned& nloc, unsigned& nx) {
    const unsigned G = gridDim.x * gridDim.y * gridDim.z;
    unsigned sum, cnt, mine, sp = 0u;
    for (;;) {
        sum = 0u; cnt = 0u; mine = 0u;
#pragma unroll
        for (unsigned j = 0; j < 16; ++j) { const unsigned c = xb_ld(&bar[XB_XCNT(j)]); sum += c; cnt += (c > 0u) ? 1u : 0u; mine = (j == x) ? c : mine; }
        if (sum == G) break;
        __builtin_amdgcn_s_sleep(1);
        if ((++sp & 255u) == 0u) { if (xb_ld(&bar[XB_TMO])) break; if (sp > XB_SPIN_CAP) { atomicAdd(&bar[XB_TMO], 1u); break; } }
    }
    nloc = mine > 0u ? mine : 1u; nx = cnt > 0u ? cnt : 1u;
}
__device__ __forceinline__ void xcd_barrier(const XcdBarrier& b, bool leader) {
    asm volatile("s_waitcnt vmcnt(0)" ::: "memory");
    __syncthreads();
    if (leader) {
        unsigned* bar = b.bar;
        __builtin_amdgcn_s_waitcnt(0);
        unsigned nloc = b.st[0], nx = b.st[1];
        if (nloc == 0u) { xcd_barrier_complete(bar, b.x, nloc, nx); b.st[0] = nloc; b.st[1] = nx; }
        const unsigned old = xb_add(&bar[XB_XSUB(b.x)], 1u);
        const unsigned gen = old / nloc;
        if (old + 1u == (gen + 1u) * nloc) {
            __builtin_amdgcn_fence(__ATOMIC_RELEASE, "agent");
            asm volatile("s_waitcnt vmcnt(0)" ::: "memory");
            const unsigned og = xb_add(&bar[XB_TOP], 1u);
            const unsigned tg = og / nx;
            if (og + 1u == (tg + 1u) * nx) xb_add(&bar[XB_TOPGEN], 1u);
            else XB_SPIN(xb_ld(&bar[XB_TOPGEN]) == tg, bar);
            __builtin_amdgcn_fence(__ATOMIC_ACQUIRE, "agent");
            xb_add(&bar[XB_XGEN(b.x)], 1u);
            asm volatile("s_waitcnt vmcnt(0)" ::: "memory");
        } else {
            XB_SPIN(xb_ld(&bar[XB_XGEN(b.x)]) == gen, bar);
            __builtin_amdgcn_fence(__ATOMIC_ACQUIRE, "agent");
            asm volatile("s_waitcnt vmcnt(0)" ::: "memory");
        }
    }
    __syncthreads();
}

__global__ void __launch_bounds__(512) hymba_fwd(Params p) {
    extern __shared__ __attribute__((aligned(16))) unsigned char shm[];
    LAS unsigned char* lds = (LAS unsigned char*)shm;
    cg::grid_group grid = cg::this_grid();
    const int lo = p.ph_lo, hi = p.ph_hi;
    const int wv = __builtin_amdgcn_readfirstlane(threadIdx.x >> 6);
#ifdef DBG_CLEAR
    for (int i = threadIdx.x; i < LDS_BYTES / 16; i += 512) *(LAS u32x4*)(lds + i * 16) = (u32x4){0u, 0u, 0u, 0u};
    __syncthreads();
#endif
#define IN(k) (lo <= (k) && (k) < hi)
#define SEAM(k) do { if (IN(k) && IN((k) + 1)) { \
        asm volatile("s_waitcnt vmcnt(0) lgkmcnt(0)" ::: "memory"); __syncthreads();                 \
        if (wv == 0) { __builtin_amdgcn_fence(__ATOMIC_RELEASE, "agent"); asm volatile("s_waitcnt vmcnt(0)" ::: "memory"); }     \
        grid.sync(); \
        if (wv == 0) { __builtin_amdgcn_fence(__ATOMIC_ACQUIRE, "agent"); asm volatile("s_waitcnt vmcnt(0)" ::: "memory"); }     \
        __syncthreads(); } } while (0)
    volatile LAS unsigned* xst = (volatile LAS unsigned*)(lds + LDS_BYTES - 16);
    const bool xlead = (wv == 0) && (lane_id() == 0);
    if (xlead) { xst[0] = 0u; xst[1] = 0u; }
    __syncthreads();
    XcdBarrier xb; xb.bar = (unsigned*)((unsigned char*)p.out + DO_XBAR); xb.x = xb_xcc_id(); xb.st = xst;
    if (xlead) (void)xb_add(&xb.bar[XB_XCNT(xb.x)], 1u);
#define XSEAM(k) do { if (IN(k) && IN((k) + 1)) xcd_barrier(xb, (wv == 0) && (lane_id() == 0)); } while (0)
    if (IN(0)) for (int rep = 0; rep < NREP(0); ++rep) phase0(p, lds, wv);
    XSEAM(0);
    if (IN(1)) for (int rep = 0; rep < NREP(1); ++rep) {
        pg8::Gemm g{(const bf16_t*)(p.ws + WS_XN), (const bf16_t*)(p.ws + WS_BTIN), M_, NPROJ, D_}; pg8::StaticOrder S; S.init(M_, NPROJ, gridDim.x, blockIdx.x);
        if (gridDim.x == 256) { S.nrounds = 12; S.rot = 3 * ((blockIdx.x >> 6) & 3); }
        EpiProj E{(bf16_t*)(p.ws + WS_PROJ)};
        pg8::gemm_phase<EpiProj>(lds, g, S, E, wv);
        dt_units(p, lds, wv);
    }
    XSEAM(1);
    if (IN(3)) for (int rep = 0; rep < NREP(3); ++rep) phase2(p, lds, wv);
    XSEAM(3);
    if (IN(4)) for (int rep = 0; rep < NREP(4); ++rep) {
        pg8::Gemm g{(const bf16_t*)(p.ws + WS_YMIX), (const bf16_t*)((unsigned char*)p.out + DO_BTOUT), M_, D_, DMIX}; pg8::StaticOrder S; S.init(M_, D_, gridDim.x, blockIdx.x);
        EpiOut E{p.x, (bf16_t*)(p.ws + WS_H1B), (const float*)((unsigned char*)p.out + DO_SSQ1), (float*)((unsigned char*)p.out + DO_SSQ2)};
        pg8::gemm_phase<EpiOut>(lds, g, S, E, wv);
    }
    XSEAM(4);
    if (IN(5)) for (int rep = 0; rep < NREP(5); ++rep) {
        pg8::Gemm g{(const bf16_t*)(p.ws + WS_H1B), (const bf16_t*)((unsigned char*)p.out + DO_BTGU), M_, NGU, D_}; pg8::StaticOrder S; S.init(M_, NGU, gridDim.x, blockIdx.x);
        EpiGU E{(const float*)((unsigned char*)p.out + DO_SSQ2), (bf16_t*)(p.ws + WS_HFF)};
        pg8::gemm_phase<EpiGU>(lds, g, S, E, wv);
    }
    XSEAM(5);
    if (IN(6)) {
        pg8::Gemm g{(const bf16_t*)(p.ws + WS_HFF), (const bf16_t*)((unsigned char*)p.out + DO_BTDN), M_, D_, DFF}; pg8::StaticOrder S; S.init(M_, D_, gridDim.x, blockIdx.x);
        EpiDown E{(bf16_t*)(p.ws + WS_H1B), (float*)(p.ws + WS_SSQ3)};
        pg8::gemm_phase<EpiDown>(lds, g, S, E, wv);
    }
    XSEAM(6);
    if (p.ph_hi > 1000) grid.sync();
    if (IN(7)) for (int rep = 0; rep < NREP(7); ++rep) phase6(p, wv);
#undef IN
#undef SEAM
}

extern "C" void kernel_launch(void* const* d_in, const int* in_sizes, int n_in, void* d_out, int out_size, void* d_ws, size_t ws_size, hipStream_t stream) {
    static int grid = 0;
    if (grid == 0) {
        if (n_in != 16 || out_size != M_ * D_ || ws_size < WS_NEED) { fprintf(stderr, "kernel_launch: unexpected shapes (n_in %d out %d ws %zu, need %zu)\n", n_in, out_size, ws_size, (size_t)WS_NEED); grid = -1; return; }
        int dev = 0, cus = 0, per_cu = 0;
        (void)hipGetDevice(&dev);
        (void)hipDeviceGetAttribute(&cus, hipDeviceAttributeMultiprocessorCount, dev);
        if (hipFuncSetAttribute((const void*)hymba_fwd, hipFuncAttributeMaxDynamicSharedMemorySize, LDS_BYTES) != hipSuccess) { fprintf(stderr, "kernel_launch: hipFuncSetAttribute failed\n"); grid = -1; return; }
        if (hipOccupancyMaxActiveBlocksPerMultiprocessor(&per_cu, (const void*)hymba_fwd, 512, LDS_BYTES) != hipSuccess || per_cu < 1) { fprintf(stderr, "kernel_launch: occupancy query failed (%d)\n", per_cu); (void)hipGetLastError(); per_cu = 1; }
        grid = cus * per_cu;
    }
    if (grid < 0) return;
    Params p{};
    p.x = (const float*)d_in[0]; p.norm_mix_g = (const float*)d_in[1]; p.w_in = (const float*)d_in[2]; p.ssm_conv_w = (const float*)d_in[3]; p.ssm_conv_b = (const float*)d_in[4];
    p.ssm_dt_bias = (const float*)d_in[5]; p.ssm_A_log = (const float*)d_in[6]; p.ssm_D = (const float*)d_in[7]; p.ssm_norm_g = (const float*)d_in[8]; p.sc_conv_w = (const float*)d_in[9];
    p.w_out = (const float*)d_in[10]; p.norm_ffn_g = (const float*)d_in[11]; p.w_gate = (const float*)d_in[12]; p.w_up = (const float*)d_in[13]; p.w_down = (const float*)d_in[14]; p.norm_final_g = (const float*)d_in[15];
    p.out = (float*)d_out; p.ws = (unsigned char*)d_ws;
#ifdef DBG_MEMSET
    (void)hipMemsetAsync(d_ws, 0, WS_NEED, stream); (void)hipMemsetAsync(d_out, 0, (size_t)out_size * 4, stream);
#endif
#ifndef N_CUTS
#define N_CUTS 1
#endif
    for (int li = 0; li < N_CUTS; ++li) {
        p.ph_lo = (N_CUTS == 8) ? li : 0; p.ph_hi = (N_CUTS == 8) ? li + 1 : 8;
        (void)hipMemsetAsync((unsigned char*)d_out + DO_BCFLAG, 0, 4096 + XCD_BAR_WORDS * sizeof(unsigned), stream);
    void* args[] = {&p};
        hipError_t e = hipLaunchCooperativeKernel((const void*)hymba_fwd, dim3(grid), dim3(512), args, LDS_BYTES, stream);
        if (e != hipSuccess) fprintf(stderr, "kernel_launch: cooperative launch failed: %s (grid %d)\n", hipGetErrorString(e), grid);
    }
}
```

```cpp
#include <hip/hip_runtime.h>
#include <hip/hip_cooperative_groups.h>
#include <cstdio>
namespace cg = cooperative_groups;

#define LAS __attribute__((address_space(3)))
typedef unsigned short bf16_t;
typedef short bf16x8 __attribute__((ext_vector_type(8)));
typedef float f32x4 __attribute__((ext_vector_type(4)));
typedef unsigned u32x4 __attribute__((ext_vector_type(4)));
typedef unsigned u32x2 __attribute__((ext_vector_type(2)));

constexpr int M_ = 16384, D_ = 2048, DIN = 12320, NPROJ = 12288, DFF = 5632, DMIX = 4096, NGU = 11264;
constexpr int SEQ = 4096;
constexpr float EPS = 1e-5f;
constexpr int LDS_BYTES = 159744;
constexpr int XCD_BAR_WORDS_C = 3456;
#ifndef PROBE_PHASE
#define PROBE_PHASE -1
#endif
#define NREP(k) ((PROBE_PHASE == (k)) ? 1 + (p.ph_hi < 100) : 1)
constexpr int TAB_OFF = 131072;

constexpr size_t WS_PROJ = 0;
constexpr size_t WS_R = (size_t)M_ * NPROJ * 2;
constexpr size_t WS_XN = WS_R;
constexpr size_t WS_BTIN = WS_R + (size_t)M_ * D_ * 2;
constexpr size_t WS_YMIX = WS_R;
constexpr size_t WS_H1F = 0;
constexpr size_t WS_H1B = (size_t)M_ * D_ * 4;
constexpr size_t WS_HFF = WS_H1B + (size_t)M_ * D_ * 2;
constexpr size_t WS_SSQ3 = WS_HFF + (size_t)M_ * DFF * 2;
constexpr size_t WS_NEED = WS_R + (size_t)M_ * DMIX * 2;
constexpr size_t DO_BTOUT = 0;
constexpr size_t DO_BTGU = (size_t)D_ * DMIX * 2;
constexpr size_t DO_BTDN = DO_BTGU + (size_t)NGU * D_ * 2;
constexpr size_t DO_DT = DO_BTDN + (size_t)D_ * DFF * 2;
constexpr size_t DO_SSQ1 = DO_DT + (size_t)M_ * 32 * 4;
constexpr size_t DO_SSQ2 = DO_SSQ1 + (size_t)M_ * 32 * 4;
constexpr size_t DO_XBAR = (size_t)M_ * D_ * 4 - 16384;
constexpr size_t DO_BCFLAG = DO_XBAR - 4096;
static_assert(DO_SSQ2 + (size_t)M_ * 32 * 4 <= DO_BCFLAG && XCD_BAR_WORDS_C * 4 <= 16384, "d_out scratch");

static_assert(WS_SSQ3 + (size_t)M_ * 32 * 4 <= WS_R, "ws overlay");

struct Params {
    const float* x; const float* norm_mix_g; const float* w_in; const float* ssm_conv_w; const float* ssm_conv_b;
    const float* ssm_dt_bias; const float* ssm_A_log; const float* ssm_D; const float* ssm_norm_g; const float* sc_conv_w;
    const float* w_out; const float* norm_ffn_g; const float* w_gate; const float* w_up; const float* w_down; const float* norm_final_g;
    float* out; unsigned char* ws; int ph_lo, ph_hi;
};

typedef float f32x2_t __attribute__((ext_vector_type(2)));
typedef __bf16 bf16x2_t __attribute__((ext_vector_type(2)));
__device__ __forceinline__ unsigned cvt_pk_bf16(float lo, float hi) { const f32x2_t v = {lo, hi}; return __builtin_bit_cast(unsigned, __builtin_convertvector(v, bf16x2_t)); }
__device__ __forceinline__ float bflo(unsigned u) { return __uint_as_float(u << 16); }
__device__ __forceinline__ float bfhi(unsigned u) { return __uint_as_float(u & 0xffff0000u); }
__device__ __forceinline__ int lane_id() { int l; asm volatile("v_mbcnt_lo_u32_b32 %0, -1, 0\n\tv_mbcnt_hi_u32_b32 %0, -1, %0" : "=v"(l)); return l; }
__device__ __forceinline__ float silu_f(float v) { return v * __builtin_amdgcn_rcpf(1.0f + __expf(-v)); }

__device__ __forceinline__ size_t ssq_idx(int row, int part) { return ((size_t)(row >> 5) * 32 + part) * 32 + (row & 31); }

namespace pg8 {
constexpr int BM = 256, BK = 64, HALF = 128, HTB = HALF * BK * 2, STAGE_BYTES = 8 * HTB, NXCD = 8, WGM = 8;
__device__ __forceinline__ int lds_byte(int r, int c) { const int st = (r >> 4) * 2 + (c >> 5), rr = r & 15, cc = c & 31, ob = rr * 64 + cc * 2; return st * 1024 + (ob ^ (((ob >> 9) & 1) << 5)); }
__device__ __forceinline__ void stage_rc(int b, int& R, int& C) { const int st = b / 1024, sb = b % 1024, swz = sb ^ (((sb >> 9) & 1) << 5); R = (st >> 1) * 16 + swz / 64; C = (st & 1) * 32 + (swz % 64) / 2; }
__device__ __forceinline__ int perm32(int rho) { const int n = rho >> 4, i = rho & 15; return 8 * (i >> 2) + 4 * n + (i & 3); }
struct Unit { int pm, pn; };
struct Gemm { const bf16_t* A; const bf16_t* Bt; int M, N, K; };
struct StaticOrder {
    int nM, nN, nwg, G, c, rot = 0, nrounds = 1;
    __device__ void init(int M, int N, int G_, int c_) { nM = M / BM; nN = N / BM; nwg = nM * nN; G = G_; c = c_; }
    __device__ bool next(int i, Unit& u) const {
        if (rot != 0 && i < nrounds) i = (i + rot) % nrounds;
        const long L = (long)i * G + c; if (L >= nwg) return false;
        int wgid = (int)L; { const int q = nwg / NXCD, r = nwg % NXCD, xcd = wgid % NXCD, off = wgid / NXCD; wgid = (xcd < r ? xcd * (q + 1) : r * (q + 1) + (xcd - r) * q) + off; }
        const int nig = WGM * nN, gid = wgid / nig, fm = gid * WGM, gsz = (nM - fm) < WGM ? (nM - fm) : WGM;
        u.pm = fm + ((wgid % nig) % gsz); u.pn = (wgid % nig) / gsz; return true;
    }
};
template <class Epi>
__device__ __forceinline__ void gemm_phase(LAS unsigned char* lds, const Gemm g, const StaticOrder& S, const Epi& E, int wv) {
    const int wid = wv, lane = lane_id(), tid = wid * 64 + lane, wr = wid >> 2, wc = wid & 3, fr = lane & 15, fq = lane >> 4;
    const int K = g.K, nt = K / BK;
    unsigned voffA[2], voffB[2];
#pragma unroll
    for (int i = 0; i < 2; ++i) { int R, C; stage_rc(tid * 16 + i * 8192, R, C); const int Rb = (R & ~31) + perm32(R & 31);
        voffA[i] = (unsigned)(R * K + C) * 2u; voffB[i] = (unsigned)(Rb * K + C) * 2u; }
    const size_t kstep = (size_t)(BK * 2);
    const size_t hstep = (size_t)HALF * K * 2;
    const size_t tstep = 2 * hstep;
    const unsigned ldsw = (unsigned)wid * 1024u;
    const int aoff = lds_byte(wr * 64 + fr, fq * 8), boff = lds_byte(wc * 32 + fr, fq * 8);
#define PG8_SA(b, h) (((b) * 2 + (h)) * HTB)
#define PG8_SB(b, h) ((4 + (b) * 2 + (h)) * HTB)
#define PG8_STAGE(bufoff, gbase, voff) do { _Pragma("unroll") for (int _i = 0; _i < 2; ++_i) \
        __builtin_amdgcn_global_load_lds((const unsigned*)((const char*)(gbase) + (voff)[_i]), (LAS unsigned*)(lds + (bufoff) + ldsw + _i * 8192), 16, 0, 0); } while (0)
#define PG8_LDA(dst, b, h) do { _Pragma("unroll") for (int m = 0; m < 4; ++m) _Pragma("unroll") for (int k = 0; k < 2; ++k) dst[m][k] = *(const LAS bf16x8*)(lds + PG8_SA(b, h) + aoff + m * 2048 + k * 1024); } while (0)
#define PG8_LDB(dst, b, h) do { _Pragma("unroll") for (int n = 0; n < 2; ++n) _Pragma("unroll") for (int k = 0; k < 2; ++k) dst[n][k] = *(const LAS bf16x8*)(lds + PG8_SB(b, h) + boff + n * 2048 + k * 1024); } while (0)
#define PG8_MMA(ai, bj, At, Bt) do { __builtin_amdgcn_s_setprio(1); _Pragma("unroll") for (int m = 0; m < 4; ++m) _Pragma("unroll") for (int n = 0; n < 2; ++n) _Pragma("unroll") for (int k = 0; k < 2; ++k) \
        acc[ai][bj][m][n] = __builtin_amdgcn_mfma_f32_16x16x32_bf16(Bt[n][k], At[m][k], acc[ai][bj][m][n], 0, 0, 0); __builtin_amdgcn_s_setprio(0); } while (0)
#define PG8_WAIT_V(n) asm volatile("s_waitcnt vmcnt(" #n ")" ::: "memory")
#define PG8_WAIT_L(n) asm volatile("s_waitcnt lgkmcnt(" #n ")" ::: "memory")
#define PG8_BAR __builtin_amdgcn_s_barrier()
#define PG8_SCHED __builtin_amdgcn_sched_barrier(0)
    Unit cur, nxt; int ui = 0;
    if (!S.next(0, cur)) return;
    f32x4 acc[2][2][4][2];
#pragma unroll
    for (int a = 0; a < 2; ++a)
#pragma unroll
        for (int b = 0; b < 2; ++b)
#pragma unroll
            for (int m = 0; m < 4; ++m)
#pragma unroll
                for (int n = 0; n < 2; ++n) acc[a][b][m][n] = (f32x4){0.f, 0.f, 0.f, 0.f};
    bf16x8 At[4][2], B0[2][2], B1[2][2];
    const char* cA = (const char*)g.A + (size_t)cur.pm * tstep; const char* cB = (const char*)g.Bt + (size_t)cur.pn * tstep;
    if constexpr (Epi::HAS_TAB) {
        Unit uu; for (int i = 0; i < 27 && S.next(i, uu); ++i) E.prep(uu, (LAS float*)(lds + TAB_OFF + i * 1024), tid);
    }
    PG8_STAGE(PG8_SB(0, 0), cB, voffB); PG8_STAGE(PG8_SB(0, 1), cB + hstep, voffB); PG8_STAGE(PG8_SA(0, 0), cA, voffA); PG8_STAGE(PG8_SA(0, 1), cA + hstep, voffA);
    if (wr == 1) PG8_BAR;
    PG8_WAIT_V(2); PG8_BAR;
    PG8_STAGE(PG8_SB(1, 0), cB + kstep, voffB); PG8_STAGE(PG8_SA(1, 0), cA + kstep, voffA); PG8_STAGE(PG8_SB(1, 1), cB + hstep + kstep, voffB);
    PG8_WAIT_V(6); PG8_BAR;
    for (;;) {
        const bool has_next = S.next(ui + 1, nxt);
        const char* nA = has_next ? (const char*)g.A + (size_t)nxt.pm * tstep : cA; const char* nB = has_next ? (const char*)g.Bt + (size_t)nxt.pn * tstep : cB;
        LAS const float* tabc = (LAS const float*)(lds + TAB_OFF + ui * 1024);
        for (int t = 0; t < nt; t += 2) {
            const bool last = (t == nt - 2);
            const char* a1 = cA + (size_t)(t + 1) * kstep;
            const char* a2 = last ? nA : cA + (size_t)(t + 2) * kstep; const char* b2 = last ? nB : cB + (size_t)(t + 2) * kstep;
            const char* a3 = a2 + kstep; const char* b3 = b2 + kstep;
            if constexpr (Epi::MID_T >= 0) { if (t == Epi::MID_T) {
#pragma unroll
                for (int ai = 0; ai < 2; ++ai)
#pragma unroll
                    for (int m = 0; m < 4; ++m) { const float s = tabc[ai * HALF + wr * 64 + m * 16 + fr];
#pragma unroll
                        for (int bj = 0; bj < 2; ++bj)
#pragma unroll
                            for (int n = 0; n < 2; ++n) acc[ai][bj][m][n] *= s; } } }
            PG8_LDB(B0, 0, 0); PG8_LDB(B1, 0, 1); PG8_SCHED; PG8_LDA(At, 0, 0); PG8_STAGE(PG8_SA(1, 1), a1 + hstep, voffA);
            PG8_WAIT_V(8); PG8_WAIT_L(0); PG8_BAR; PG8_MMA(0, 0, At, B0); PG8_MMA(0, 1, At, B1); PG8_BAR; PG8_SCHED;
            PG8_LDA(At, 0, 1); PG8_STAGE(PG8_SB(0, 0), b2, voffB); PG8_STAGE(PG8_SB(0, 1), b2 + hstep, voffB); PG8_STAGE(PG8_SA(0, 0), a2, voffA);
            PG8_WAIT_V(8); PG8_WAIT_L(0); PG8_BAR; PG8_MMA(1, 0, At, B0); PG8_MMA(1, 1, At, B1); PG8_BAR; PG8_SCHED;
            PG8_LDB(B0, 1, 0); PG8_LDB(B1, 1, 1); PG8_SCHED; PG8_LDA(At, 1, 0); PG8_STAGE(PG8_SA(0, 1), a2 + hstep, voffA);
            PG8_WAIT_V(8); PG8_WAIT_L(0); PG8_BAR; PG8_MMA(0, 0, At, B0); PG8_MMA(0, 1, At, B1); PG8_BAR; PG8_SCHED;
            PG8_LDA(At, 1, 1); PG8_STAGE(PG8_SB(1, 0), b3, voffB); PG8_STAGE(PG8_SB(1, 1), b3 + hstep, voffB); PG8_STAGE(PG8_SA(1, 0), a3, voffA);
            PG8_WAIT_V(8); PG8_WAIT_L(0); PG8_BAR; PG8_MMA(1, 0, At, B0); PG8_MMA(1, 1, At, B1); PG8_BAR; PG8_SCHED;
        }
        if (wr == 0) PG8_BAR;
        E(acc, cur, tabc, wr, wc, fr, fq);
        if (!has_next) break;
#pragma unroll
        for (int a = 0; a < 2; ++a)
#pragma unroll
            for (int b = 0; b < 2; ++b)
#pragma unroll
                for (int m = 0; m < 4; ++m)
#pragma unroll
                    for (int n = 0; n < 2; ++n) acc[a][b][m][n] = (f32x4){0.f, 0.f, 0.f, 0.f};
        cur = nxt; cA = nA; cB = nB; ++ui;
        if (wr == 1) PG8_BAR;
    }
    PG8_WAIT_V(0);
    PG8_BAR;
#undef PG8_SA
#undef PG8_SB
#undef PG8_STAGE
#undef PG8_LDA
#undef PG8_LDB
#undef PG8_MMA
#undef PG8_WAIT_V
#undef PG8_WAIT_L
#undef PG8_BAR
#undef PG8_SCHED
}
}

__device__ __forceinline__ void rstd_table(const float* ssq, int row0, LAS float* tab, int t) {
    const int r = t >> 1, hf = t & 1;
    const float* p = ssq + ssq_idx(row0 + r, hf * 16);
    float s = 0.f;
#pragma unroll
    for (int i = 0; i < 16; ++i) s += p[i * 32];
    s += __shfl_xor(s, 1);
    if (!hf) tab[r] = rsqrtf(s * (1.0f / 2048.0f) + EPS);
}

struct EpiProj {
    static constexpr bool HAS_TAB = false; static constexpr int MID_T = -1;
    bf16_t* O;
    __device__ __forceinline__ void prep(const pg8::Unit&, LAS float*, int) const {}
    __device__ __forceinline__ void operator()(const f32x4 (&acc)[2][2][4][2], const pg8::Unit& u, LAS const float*, int wr, int wc, int fr, int fq) const {
        const int row0 = u.pm * 256 + wr * 64 + fr, col0 = u.pn * 256 + wc * 32 + 8 * fq;
        if (u.pn >= 32) {
            const int pcol = 8192 + (u.pn - 32) * 128 + wc * 32 + 8 * fq;
#pragma unroll
            for (int ai = 0; ai < 2; ++ai)
#pragma unroll
                for (int m = 0; m < 4; ++m) { const f32x4 v0 = acc[ai][0][m][0] * acc[ai][1][m][0], v1 = acc[ai][0][m][1] * acc[ai][1][m][1];
                    u32x4 w; w.x = cvt_pk_bf16(v0[0], v0[1]); w.y = cvt_pk_bf16(v0[2], v0[3]); w.z = cvt_pk_bf16(v1[0], v1[1]); w.w = cvt_pk_bf16(v1[2], v1[3]);
                    *(u32x4*)(O + (size_t)(row0 + ai * 128 + m * 16) * NPROJ + pcol) = w; }
            return;
        }
#pragma unroll
        for (int ai = 0; ai < 2; ++ai)
#pragma unroll
            for (int m = 0; m < 4; ++m) { bf16_t* rowp = O + (size_t)(row0 + ai * 128 + m * 16) * NPROJ + col0;
#pragma unroll
                for (int bj = 0; bj < 2; ++bj) { const f32x4 v0 = acc[ai][bj][m][0], v1 = acc[ai][bj][m][1];
                    u32x4 w; w.x = cvt_pk_bf16(v0[0], v0[1]); w.y = cvt_pk_bf16(v0[2], v0[3]); w.z = cvt_pk_bf16(v1[0], v1[1]); w.w = cvt_pk_bf16(v1[2], v1[3]);
                    *(u32x4*)(rowp + bj * 128) = w; } }
    }
};
struct EpiOut {
    static constexpr bool HAS_TAB = true; static constexpr int MID_T = 32;
    const float* x; bf16_t* h1b; const float* ssq1; float* ssq2;
    __device__ __forceinline__ void prep(const pg8::Unit& u, LAS float* tab, int t) const { rstd_table(ssq1, u.pm * 256, tab, t); }
    __device__ __forceinline__ void operator()(const f32x4 (&acc)[2][2][4][2], const pg8::Unit& u, LAS const float*, int wr, int wc, int fr, int fq) const {
        const int row0 = u.pm * 256 + wr * 64 + fr, col0 = u.pn * 256 + wc * 32 + 8 * fq;
#pragma unroll
        for (int ai = 0; ai < 2; ++ai)
#pragma unroll
            for (int m = 0; m < 4; ++m) { const int row = row0 + ai * 128 + m * 16; const size_t off = (size_t)row * D_ + col0; float ss = 0.f;
#pragma unroll
                for (int bj = 0; bj < 2; ++bj) {
                    const f32x4 x0 = *(const f32x4*)(x + off + bj * 128), x1 = *(const f32x4*)(x + off + bj * 128 + 4);
                    const f32x4 v0 = acc[ai][bj][m][0] + x0, v1 = acc[ai][bj][m][1] + x1;
                    u32x4 w; w.x = cvt_pk_bf16(v0[0], v0[1]); w.y = cvt_pk_bf16(v0[2], v0[3]); w.z = cvt_pk_bf16(v1[0], v1[1]); w.w = cvt_pk_bf16(v1[2], v1[3]);
                    *(u32x4*)(h1b + off + bj * 128) = w;
                    ss += (v0[0] * v0[0] + v0[1] * v0[1]) + (v0[2] * v0[2] + v0[3] * v0[3]) + (v1[0] * v1[0] + v1[1] * v1[1]) + (v1[2] * v1[2] + v1[3] * v1[3]); }
                ss += __shfl_xor(ss, 16); ss += __shfl_xor(ss, 32);
                if (fq == 0) ssq2[ssq_idx(row, u.pn * 4 + wc)] = ss; }
    }
};
struct EpiGU {
    static constexpr bool HAS_TAB = true; static constexpr int MID_T = -1;
    const float* ssq2; bf16_t* hff;
    __device__ __forceinline__ void prep(const pg8::Unit& u, LAS float* tab, int t) const { rstd_table(ssq2, u.pm * 256, tab, t); }
    __device__ __forceinline__ void operator()(const f32x4 (&acc)[2][2][4][2], const pg8::Unit& u, LAS const float* tab, int wr, int wc, int fr, int fq) const {
        const int row0 = u.pm * 256 + wr * 64 + fr, col0 = u.pn * 128 + wc * 32 + 8 * fq;
#pragma unroll
        for (int ai = 0; ai < 2; ++ai)
#pragma unroll
            for (int m = 0; m < 4; ++m) { const float rs = tab[ai * 128 + wr * 64 + m * 16 + fr];
                float o[8];
#pragma unroll
                for (int n = 0; n < 2; ++n)
#pragma unroll
                    for (int j = 0; j < 4; ++j) { const float gg = acc[ai][0][m][n][j] * rs, uu = acc[ai][1][m][n][j] * rs; o[n * 4 + j] = silu_f(gg) * uu; }
                u32x4 w; w.x = cvt_pk_bf16(o[0], o[1]); w.y = cvt_pk_bf16(o[2], o[3]); w.z = cvt_pk_bf16(o[4], o[5]); w.w = cvt_pk_bf16(o[6], o[7]);
                *(u32x4*)(hff + (size_t)(row0 + ai * 128 + m * 16) * DFF + col0) = w; }
    }
};
struct EpiDown {
    static constexpr bool HAS_TAB = false; static constexpr int MID_T = -1;
    bf16_t* h; float* ssq3;
    __device__ __forceinline__ void prep(const pg8::Unit&, LAS float*, int) const {}
    __device__ __forceinline__ void operator()(const f32x4 (&acc)[2][2][4][2], const pg8::Unit& u, LAS const float*, int wr, int wc, int fr, int fq) const {
        const int row0 = u.pm * 256 + wr * 64 + fr, col0 = u.pn * 256 + wc * 32 + 8 * fq;
#pragma unroll
        for (int ai = 0; ai < 2; ++ai)
#pragma unroll
            for (int m = 0; m < 4; ++m) { const int row = row0 + ai * 128 + m * 16; const size_t off = (size_t)row * D_ + col0; float ss = 0.f;
#pragma unroll
                for (int bj = 0; bj < 2; ++bj) {
                    const u32x4 xb = *(const u32x4*)(h + off + bj * 128);
                    const f32x4 x0 = (f32x4){bflo(xb.x), bfhi(xb.x), bflo(xb.y), bfhi(xb.y)}, x1 = (f32x4){bflo(xb.z), bfhi(xb.z), bflo(xb.w), bfhi(xb.w)};
                    const f32x4 v0 = acc[ai][bj][m][0] + x0, v1 = acc[ai][bj][m][1] + x1;
                    u32x4 w; w.x = cvt_pk_bf16(v0[0], v0[1]); w.y = cvt_pk_bf16(v0[2], v0[3]); w.z = cvt_pk_bf16(v1[0], v1[1]); w.w = cvt_pk_bf16(v1[2], v1[3]);
                    *(u32x4*)(h + off + bj * 128) = w;
                    ss += (v0[0] * v0[0] + v0[1] * v0[1]) + (v0[2] * v0[2] + v0[3] * v0[3]) + (v1[0] * v1[0] + v1[1] * v1[1]) + (v1[2] * v1[2] + v1[3] * v1[3]); }
                ss += __shfl_xor(ss, 16); ss += __shfl_xor(ss, 32);
                if (fq == 0) ssq3[ssq_idx(row, u.pn * 4 + wc)] = ss; }
    }
};

__device__ __forceinline__ void p0_tile(LAS float* t, const float* src, int ldsrc, int k0, int c0, int jvalid, bf16_t* dst, int K, int j0, const float* scale, int scale_kmax, int tid) {
    const int jc4 = (tid & 15) * 4, kr0 = tid >> 4;
#pragma unroll
    for (int i = 0; i < 4; ++i) {
        const int kr = kr0 + 32 * i;
        f32x4 v = (f32x4){0.f, 0.f, 0.f, 0.f};
        if (jc4 < jvalid) v = *(const f32x4*)(src + (size_t)(k0 + kr) * ldsrc + c0 + jc4);
        const float s = (scale != nullptr && (k0 + kr) < scale_kmax) ? scale[k0 + kr] : 1.0f;
        t[kr * 65 + jc4 + 0] = v[0] * s; t[kr * 65 + jc4 + 1] = v[1] * s; t[kr * 65 + jc4 + 2] = v[2] * s; t[kr * 65 + jc4 + 3] = v[3] * s;
    }
    __syncthreads();
    const int kp = (tid & 63) * 2, jr0 = tid >> 6;
#pragma unroll
    for (int i = 0; i < 8; ++i) {
        const int j = jr0 + 8 * i;
        if (j < jvalid) { const float a = t[kp * 65 + j], b = t[(kp + 1) * 65 + j];
            *(unsigned*)(dst + (size_t)(j0 + j) * K + k0 + kp) = cvt_pk_bf16(a, b); }
    }
    __syncthreads();
}
struct TileD { const float* src; const float* scale; bf16_t* dst; int ldsrc, k0, c0, jvalid, K, j0, kmax; };
__device__ __forceinline__ TileD tile_decode(const Params& p, int u) {
    constexpr int U_IN = 16 * 193, U_OUT = 32 * 32, U_GU = 16 * 176;
    TileD d;
    if (u < U_IN) { const int kt = u & 15, jt = u >> 4, j0 = jt * 64;
        d.src = p.w_in; d.scale = nullptr; d.dst = (bf16_t*)(p.ws + WS_BTIN); d.ldsrc = DIN; d.k0 = kt * 128; d.c0 = j0 < 6144 ? j0 : (j0 < 8192 ? j0 + 32 : (j0 < 12288 ? (((j0 & 255) < 128 ? 8224 : 10272 - 128) + 128 * ((j0 - 8192) >> 8) + (j0 & 255)) : 6144));     d.jvalid = (jt == 192) ? 32 : 64; d.K = D_; d.j0 = j0; d.kmax = 0; }
    else if (u < U_IN + U_OUT) { const int v = u - U_IN, kt = v & 31, jt = v >> 5;
        d.src = p.w_out; d.scale = p.ssm_norm_g; d.dst = (bf16_t*)((unsigned char*)p.out + DO_BTOUT); d.ldsrc = D_; d.k0 = kt * 128; d.c0 = jt * 64; d.jvalid = 64; d.K = DMIX; d.j0 = jt * 64; d.kmax = 2048; }
    else if (u < U_IN + U_OUT + U_GU) { const int v = u - U_IN - U_OUT, kt = v & 15, jt = v >> 4, j0 = jt * 64, pn = j0 >> 8, r0 = j0 & 255;
        d.src = r0 < 128 ? p.w_gate : p.w_up; d.scale = p.norm_ffn_g; d.dst = (bf16_t*)((unsigned char*)p.out + DO_BTGU); d.ldsrc = DFF; d.k0 = kt * 128; d.c0 = 128 * pn + (r0 & 127); d.jvalid = 64; d.K = D_; d.j0 = j0; d.kmax = 2048; }
    else { const int v = u - U_IN - U_OUT - U_GU, kt = v % 44, jt = v / 44;
        d.src = p.w_down; d.scale = nullptr; d.dst = (bf16_t*)((unsigned char*)p.out + DO_BTDN); d.ldsrc = D_; d.k0 = kt * 128; d.c0 = jt * 64; d.jvalid = 64; d.K = DFF; d.j0 = jt * 64; d.kmax = 0; }
    return d;
}
__device__ __forceinline__ void tile_load(const TileD& d, int tid, f32x4 (&v)[4], float (&scl)[4]) {
    const int jc4 = (tid & 15) * 4, kr0 = tid >> 4;
#pragma unroll
    for (int i = 0; i < 4; ++i) { const int kr = kr0 + 32 * i;
        f32x4 x = (f32x4){0.f, 0.f, 0.f, 0.f};
        if (jc4 < d.jvalid) x = *(const f32x4*)(d.src + (size_t)(d.k0 + kr) * d.ldsrc + d.c0 + jc4);
        scl[i] = (d.scale != nullptr && (d.k0 + kr) < d.kmax) ? d.scale[d.k0 + kr] : 1.0f;
        v[i] = x; }
}
__device__ __forceinline__ void tile_finish(LAS float* t, const TileD& d, int tid, const f32x4 (&v)[4], const float (&scl)[4]) {
    const int jc4 = (tid & 15) * 4, kr0 = tid >> 4;
#pragma unroll
    for (int i = 0; i < 4; ++i) { const int kr = kr0 + 32 * i;
        t[kr * 65 + jc4 + 0] = v[i][0] * scl[i]; t[kr * 65 + jc4 + 1] = v[i][1] * scl[i]; t[kr * 65 + jc4 + 2] = v[i][2] * scl[i]; t[kr * 65 + jc4 + 3] = v[i][3] * scl[i]; }
    asm volatile("s_waitcnt lgkmcnt(0)" ::: "memory"); __builtin_amdgcn_s_barrier(); asm volatile("" ::: "memory");
    const int kp = (tid & 63) * 2, jr0 = tid >> 6;
#pragma unroll
    for (int i = 0; i < 8; ++i) { const int j = jr0 + 8 * i;
        if (j < d.jvalid) { const float a = t[kp * 65 + j], b = t[(kp + 1) * 65 + j];
            *(unsigned*)(d.dst + (size_t)(d.j0 + j) * d.K + d.k0 + kp) = cvt_pk_bf16(a, b); } }
    asm volatile("s_waitcnt lgkmcnt(0)" ::: "memory"); __builtin_amdgcn_s_barrier(); asm volatile("" ::: "memory");
}
__device__ __forceinline__ void conv_tiles(const Params& p, LAS unsigned char* lds, int u_begin, int u_end, int first, int stride, int tid) {
    LAS float* t = (LAS float*)lds;
    int u = u_begin + first;
    if (u >= u_end) return;
    TileD d = tile_decode(p, u); f32x4 v[4]; float sc[4]; tile_load(d, tid, v, sc);
    for (;;) {
        const int un = u + stride; const bool more = un < u_end;
        TileD dn = d; f32x4 vn[4]; float scn[4];
#pragma unroll
        for (int i = 0; i < 4; ++i) { vn[i] = v[i]; scn[i] = sc[i]; }
        if (more) { dn = tile_decode(p, un); tile_load(dn, tid, vn, scn); }
        tile_finish(t, d, tid, v, sc);
        if (!more) break;
        d = dn; u = un;
#pragma unroll
        for (int i = 0; i < 4; ++i) { v[i] = vn[i]; sc[i] = scn[i]; }
    }
}
__device__ void phase0(const Params& p, LAS unsigned char* lds, int wv) {
    const int lane = lane_id(), wave = wv, tid = wv * 64 + lane, G = gridDim.x;
    LAS float* t = (LAS float*)lds;
    bf16_t* bt_in = (bf16_t*)(p.ws + WS_BTIN);
    bf16_t* xn = (bf16_t*)(p.ws + WS_XN);
    for (int row = blockIdx.x * 8 + wave; row < M_; row += G * 8) {
        const f32x4* xr = (const f32x4*)(p.x + (size_t)row * D_);
        f32x4 v[8]; float ss = 0.f;
#pragma unroll
        for (int i = 0; i < 8; ++i) { v[i] = xr[lane + 64 * i]; ss += (v[i][0] * v[i][0] + v[i][1] * v[i][1]) + (v[i][2] * v[i][2] + v[i][3] * v[i][3]); }
#pragma unroll
        for (int o = 32; o >= 1; o >>= 1) ss += __shfl_xor(ss, o);
        const float rstd = rsqrtf(ss * (1.0f / 2048.0f) + EPS);
#pragma unroll
        for (int i = 0; i < 8; ++i) { const f32x4 g4 = ((const f32x4*)p.norm_mix_g)[lane + 64 * i];
            u32x2 w; w.x = cvt_pk_bf16(v[i][0] * rstd * g4[0], v[i][1] * rstd * g4[1]); w.y = cvt_pk_bf16(v[i][2] * rstd * g4[2], v[i][3] * rstd * g4[3]);
            *(u32x2*)(xn + (size_t)row * D_ + 4 * (lane + 64 * i)) = w; }
    }
    __syncthreads();
    conv_tiles(p, lds, 0, 16 * 193, blockIdx.x, G, tid);
}
__device__ void wconv_units(const Params& p, LAS unsigned char* lds, int first, int stride, int wv) {
    const int tid = wv * 64 + lane_id();
    __syncthreads();
    conv_tiles(p, lds, 16 * 193, 16 * 193 + 32 * 32 + 16 * 176 + 44 * 32, first, stride, tid);
}

__device__ void dt_units(const Params& p, LAS unsigned char* lds, int wv) {
    const int lane = lane_id(), w = wv, tid = wv * 64 + lane, fr = lane & 15, fq = lane >> 4;
    const bf16_t* xn = (const bf16_t*)(p.ws + WS_XN);
    const bf16_t* bt = (const bf16_t*)(p.ws + WS_BTIN) + (size_t)NPROJ * D_;
    float* dt = (float*)((unsigned char*)p.out + DO_DT);
    LAS float* red = (LAS float*)lds;
    for (int rb = blockIdx.x; rb < M_ / 64; rb += gridDim.x) {
        const int row0 = rb * 64;
        f32x4 acc[4][2];
#pragma unroll
        for (int m = 0; m < 4; ++m)
#pragma unroll
            for (int n = 0; n < 2; ++n) acc[m][n] = (f32x4){0.f, 0.f, 0.f, 0.f};
#pragma unroll 4
        for (int ks = 0; ks < 8; ++ks) {
            const int kb = w * 256 + ks * 32 + fq * 8;
            bf16x8 a[4], b[2];
#pragma unroll
            for (int m = 0; m < 4; ++m) a[m] = *(const bf16x8*)(xn + (size_t)(row0 + 16 * m + fr) * D_ + kb);
#pragma unroll
            for (int n = 0; n < 2; ++n) b[n] = *(const bf16x8*)(bt + (size_t)(16 * n + fr) * D_ + kb);
#pragma unroll
            for (int m = 0; m < 4; ++m)
#pragma unroll
                for (int n = 0; n < 2; ++n) acc[m][n] = __builtin_amdgcn_mfma_f32_16x16x32_bf16(a[m], b[n], acc[m][n], 0, 0, 0);
        }
#pragma unroll
        for (int m = 0; m < 4; ++m)
#pragma unroll
            for (int n = 0; n < 2; ++n)
#pragma unroll
                for (int j = 0; j < 4; ++j) red[w * 2048 + (16 * m + 4 * fq + j) * 32 + 16 * n + fr] = acc[m][n][j];
        __syncthreads();
        {
            const int idx = tid * 4, r = idx >> 5, c = idx & 31;
            f32x4 s = (f32x4){0.f, 0.f, 0.f, 0.f};
#pragma unroll
            for (int ww = 0; ww < 8; ++ww) s += *(LAS const f32x4*)(red + ww * 2048 + idx);
            const f32x4 bias = *(const f32x4*)(p.ssm_dt_bias + c);
            f32x4 o;
#pragma unroll
            for (int j = 0; j < 4; ++j) { const float v = s[j] + bias[j]; o[j] = v > 20.f ? v : log1pf(expf(v)); }
            *(f32x4*)(dt + (size_t)(row0 + r) * 32 + c) = o;
        }
        __syncthreads();
    }
}

__device__ void bc_sequences(const Params& p, LAS unsigned char* lds, int first, int stride, int wv) {
    const int tid = wv * 64 + lane_id(), cv = tid & 7, run = tid >> 3;
    bf16_t* proj = (bf16_t*)(p.ws + WS_PROJ);
    LAS u32x4* stash = (LAS u32x4*)lds;
    unsigned* bcflag = (unsigned*)((unsigned char*)p.out + DO_BCFLAG);
    for (int sq = first; sq < 4 * 32; sq += stride) {
        const int b = sq >> 5, slab = sq & 31;
        const int xcol = 2048 + slab * 64 + cv * 8;
        float wk[4][8], bs[8];
#pragma unroll
        for (int k = 0; k < 4; ++k) { const f32x4 a = *(const f32x4*)(p.ssm_conv_w + k * 4096 + xcol), c = *(const f32x4*)(p.ssm_conv_w + k * 4096 + xcol + 4);
#pragma unroll
            for (int j = 0; j < 4; ++j) { wk[k][j] = a[j]; wk[k][4 + j] = c[j]; } }
        { const f32x4 a = *(const f32x4*)(p.ssm_conv_b + xcol), c = *(const f32x4*)(p.ssm_conv_b + xcol + 4);
#pragma unroll
          for (int j = 0; j < 4; ++j) { bs[j] = a[j]; bs[4 + j] = c[j]; } }
        __syncthreads();
#pragma unroll 1
        for (int tile = 0; tile < 8; ++tile) {
            bf16_t* base = proj + (size_t)(b * SEQ + tile * 512 + run * 8) * NPROJ + 2048 + xcol;
            u32x4 raw[11];
#pragma unroll
            for (int r = 0; r < 11; ++r) {
                const int row = run * 8 + r - 3;
                if (row >= 0) raw[r] = *(const u32x4*)(base + (long)(r - 3) * NPROJ);
                else raw[r] = (tile == 0) ? (u32x4){0u, 0u, 0u, 0u} : stash[(row + 3) * 8 + cv];
            }
            u32x4 ov[8];
#pragma unroll
            for (int j = 0; j < 8; ++j) {
                float o[8];
#pragma unroll
                for (int q = 0; q < 4; ++q) {
                    const unsigned x0 = raw[j][q], x1 = raw[j + 1][q], x2 = raw[j + 2][q], x3 = raw[j + 3][q];
                    o[2 * q] = silu_f(bs[2 * q] + wk[0][2 * q] * bflo(x0) + wk[1][2 * q] * bflo(x1) + wk[2][2 * q] * bflo(x2) + wk[3][2 * q] * bflo(x3));
                    o[2 * q + 1] = silu_f(bs[2 * q + 1] + wk[0][2 * q + 1] * bfhi(x0) + wk[1][2 * q + 1] * bfhi(x1) + wk[2][2 * q + 1] * bfhi(x2) + wk[3][2 * q + 1] * bfhi(x3));
                }
                ov[j].x = cvt_pk_bf16(o[0], o[1]); ov[j].y = cvt_pk_bf16(o[2], o[3]); ov[j].z = cvt_pk_bf16(o[4], o[5]); ov[j].w = cvt_pk_bf16(o[6], o[7]);
            }
            asm volatile("s_waitcnt vmcnt(0) lgkmcnt(0)" ::: "memory");
            __syncthreads();
            if (run == 63) { stash[0 * 8 + cv] = raw[8]; stash[1 * 8 + cv] = raw[9]; stash[2 * 8 + cv] = raw[10]; }
#pragma unroll
            for (int j = 0; j < 8; ++j) { const bf16_t* q = base + (long)j * NPROJ;
                asm volatile("global_store_dwordx4 %0, %1, off sc1" :: "v"(q), "v"(ov[j]) : "memory"); }
            asm volatile("s_waitcnt vmcnt(0) lgkmcnt(0)" ::: "memory");
            __syncthreads();
            if (wv == 0) {
                if (lane_id() == 0) __hip_atomic_store(bcflag + sq, (unsigned)(tile + 1), __ATOMIC_RELAXED, __HIP_MEMORY_SCOPE_AGENT);
            }
        }
    }
}

constexpr int SROW = 272;
constexpr int L_CM = 0, L_BM = 34816, L_BDT = 69632, L_XT = 104448, L_HB = 121856  , L_CS = 156672, L_DT = 157184, L_CW = 157696  ;
__device__ __forceinline__ int swz_off(int row, int kblk) { return row * SROW + ((kblk ^ ((row >> 3) & 7)) << 4); }
__device__ __forceinline__ void ssd_load(u32x4 (&raw)[5], const bf16_t* base, bool first, int l0) {
#pragma unroll
    for (int r = 0; r < 5; ++r) raw[r] = (first && (l0 + r - 3) < 0) ? (u32x4){0u, 0u, 0u, 0u} : *(const u32x4*)(base + (long)(r - 3) * NPROJ);
}
template <int GI>
__device__ __forceinline__ void ssd_conv(LAS unsigned char* lds, const u32x4 (&raw)[5], int cv, int l0, float sa, float sb) {
    LAS const f32x4* cw = (LAS const f32x4*)(lds + L_CW) + cv * 10;
    float o0[8], o1[8];
#pragma unroll
    for (int hq = 0; hq < 2; ++hq) {
        const f32x4 w0 = cw[0 + hq], w1 = cw[2 + hq], w2 = cw[4 + hq], w3 = cw[6 + hq], bs = cw[8 + hq];
#pragma unroll
        for (int e2 = 0; e2 < 2; ++e2) {
            const int q = hq * 2 + e2;
            const unsigned x0 = raw[0][q], x1 = raw[1][q], x2 = raw[2][q], x3 = raw[3][q], x4 = raw[4][q];
            const int ea = e2 * 2, eb = e2 * 2 + 1;
            const float va = bs[ea] + w0[ea] * bflo(x0) + w1[ea] * bflo(x1) + w2[ea] * bflo(x2) + w3[ea] * bflo(x3);
            const float vb = bs[eb] + w0[eb] * bfhi(x0) + w1[eb] * bfhi(x1) + w2[eb] * bfhi(x2) + w3[eb] * bfhi(x3);
            const float ua = bs[ea] + w0[ea] * bflo(x1) + w1[ea] * bflo(x2) + w2[ea] * bflo(x3) + w3[ea] * bflo(x4);
            const float ub = bs[eb] + w0[eb] * bfhi(x1) + w1[eb] * bfhi(x2) + w2[eb] * bfhi(x3) + w3[eb] * bfhi(x4);
            o0[2 * q] = silu_f(va); o0[2 * q + 1] = silu_f(vb); o1[2 * q] = silu_f(ua); o1[2 * q + 1] = silu_f(ub);
        }
    }
    if (GI == 0) {
#pragma unroll
        for (int e = 0; e < 8; ++e) { const int prow = cv * 8 + e;
            *(LAS unsigned*)(lds + L_XT + swz_off(prow, l0 >> 3) + (l0 & 7) * 2) = cvt_pk_bf16(o0[e] * sa, o1[e] * sb); }
    } else {
        u32x4 w0; w0.x = cvt_pk_bf16(o0[0], o0[1]); w0.y = cvt_pk_bf16(o0[2], o0[3]); w0.z = cvt_pk_bf16(o0[4], o0[5]); w0.w = cvt_pk_bf16(o0[6], o0[7]);
        u32x4 w1; w1.x = cvt_pk_bf16(o1[0], o1[1]); w1.y = cvt_pk_bf16(o1[2], o1[3]); w1.z = cvt_pk_bf16(o1[4], o1[5]); w1.w = cvt_pk_bf16(o1[6], o1[7]);
        const int nb = ((GI - 1) & 1) * 64 + cv * 8;
        if (GI < 3) {
            *(LAS u32x4*)(lds + L_BM + l0 * SROW + nb * 2) = w0; *(LAS u32x4*)(lds + L_BM + (l0 + 1) * SROW + nb * 2) = w1;
#pragma unroll
            for (int e = 0; e < 8; ++e) { const int nrow = nb + e;
                *(LAS unsigned*)(lds + L_BDT + swz_off(nrow, l0 >> 3) + (l0 & 7) * 2) = cvt_pk_bf16(o0[e] * sa, o1[e] * sb); }
        } else {
            *(LAS u32x4*)(lds + L_CM + l0 * SROW + nb * 2) = w0; *(LAS u32x4*)(lds + L_CM + (l0 + 1) * SROW + nb * 2) = w1;
        }
    }
}
template <int GI>
__device__ __forceinline__ void ssd_put(LAS unsigned char* lds, const u32x4 (&rw)[2], int cv, int l0, float sa, float sb) {
    const int nb = ((GI - 1) & 1) * 64 + cv * 8;
    if (GI < 3) {
        *(LAS u32x4*)(lds + L_BM + l0 * SROW + nb * 2) = rw[0]; *(LAS u32x4*)(lds + L_BM + (l0 + 1) * SROW + nb * 2) = rw[1];
#pragma unroll
        for (int q = 0; q < 4; ++q) {
            *(LAS unsigned*)(lds + L_BDT + swz_off(nb + 2 * q, l0 >> 3) + (l0 & 7) * 2) = cvt_pk_bf16(bflo(rw[0][q]) * sa, bflo(rw[1][q]) * sb);
            *(LAS unsigned*)(lds + L_BDT + swz_off(nb + 2 * q + 1, l0 >> 3) + (l0 & 7) * 2) = cvt_pk_bf16(bfhi(rw[0][q]) * sa, bfhi(rw[1][q]) * sb);
        }
    } else {
        *(LAS u32x4*)(lds + L_CM + l0 * SROW + nb * 2) = rw[0]; *(LAS u32x4*)(lds + L_CM + (l0 + 1) * SROW + nb * 2) = rw[1];
    }
}
__device__ __forceinline__ void bc_wait(unsigned* f, unsigned need, int wv) {
    if (wv == 0) {
    unsigned sp = 0;
    for (;;) {
        const unsigned a = __hip_atomic_load(f, __ATOMIC_RELAXED, __HIP_MEMORY_SCOPE_AGENT), b2 = __hip_atomic_load(f + 1, __ATOMIC_RELAXED, __HIP_MEMORY_SCOPE_AGENT);
        const unsigned c = __hip_atomic_load(f + 16, __ATOMIC_RELAXED, __HIP_MEMORY_SCOPE_AGENT), d = __hip_atomic_load(f + 17, __ATOMIC_RELAXED, __HIP_MEMORY_SCOPE_AGENT);
        const unsigned m = min(min(a, b2), min(c, d));
        if (__builtin_amdgcn_readfirstlane(m) >= need) break;
        __builtin_amdgcn_s_sleep(4);
        if (++sp > (1u << 19)) break;
    }
    __builtin_amdgcn_fence(__ATOMIC_ACQUIRE, "agent"); asm volatile("s_waitcnt vmcnt(0)" ::: "memory");
    }
    asm volatile("s_waitcnt lgkmcnt(0)" ::: "memory"); __builtin_amdgcn_s_barrier(); asm volatile("" ::: "memory");
}
__device__ void ssd_unit(const Params& p, LAS unsigned char* lds, int b, int h, int wv) {
    const int lane = lane_id(), w = wv, tid = wv * 64 + lane, fr = lane & 15, fq = lane >> 4;
    const int g = h >> 2;
    const bf16_t* proj = (const bf16_t*)(p.ws + WS_PROJ);
    const float* dtg = (const float*)((const unsigned char*)p.out + DO_DT);
    bf16_t* ymix = (bf16_t*)(p.ws + WS_YMIX);
    float* ssq1 = (float*)((unsigned char*)p.out + DO_SSQ1);
    LAS float* CSv = (LAS float*)(lds + L_CS);
    LAS float* DTv = (LAS float*)(lds + L_DT);
    LAS float* CW = (LAS float*)(lds + L_CW);
    const float Aneg = -__expf(p.ssm_A_log[h]);
    const float Dh = p.ssm_D[h];
    for (int idx = tid; idx < 320; idx += 512) {
        const int e = idx & 7, k = (idx >> 3) % 5, cvi = idx / 40;
        const int xcol = h * 64 + cvi * 8 + e;
        CW[idx] = (k < 4) ? p.ssm_conv_w[k * 4096 + xcol] : p.ssm_conv_b[xcol];
    }
    for (int idx = tid; idx < 64 * 17; idx += 512) *(LAS u32x4*)(lds + L_HB + idx * 16) = (u32x4){0u, 0u, 0u, 0u};
    f32x4 Hacc[4];
#pragma unroll
    for (int pt = 0; pt < 4; ++pt) Hacc[pt] = (f32x4){0.f, 0.f, 0.f, 0.f};
    __syncthreads();
    const int cv = lane & 7;
    const int l0 = 16 * w + 2 * (lane >> 3);
    const int srcl = (w & 3) * 16 + 2 * (lane >> 3);
    u32x4 r0[5], r1[2], r2[2], r3[2], r4[2];
    const bf16_t* pbase = proj + (size_t)(b * SEQ + l0) * NPROJ + 2048 + cv * 8;
    const int xc0 = h * 64, xc1 = 2048 + g * 128, xc2 = xc1 + 64, xc3 = 3072 + g * 128, xc4 = xc3 + 64;
    unsigned* bcf = (unsigned*)((unsigned char*)p.out + DO_BCFLAG) + b * 32 + 2 * g;
    bc_wait(bcf, 1u, wv);
    ssd_load(r0, pbase + xc0, true, l0);
    r1[0] = *(const u32x4*)(pbase + xc1); r1[1] = *(const u32x4*)(pbase + xc1 + NPROJ); r2[0] = *(const u32x4*)(pbase + xc2); r2[1] = *(const u32x4*)(pbase + xc2 + NPROJ);
    r3[0] = *(const u32x4*)(pbase + xc3); r3[1] = *(const u32x4*)(pbase + xc3 + NPROJ); r4[0] = *(const u32x4*)(pbase + xc4); r4[1] = *(const u32x4*)(pbase + xc4 + NPROJ);
    float dt0n = dtg[(size_t)(b * SEQ + lane) * 32 + h], dt1n = dtg[(size_t)(b * SEQ + 64 + lane) * 32 + h];
    for (int c = 0; c < 32; ++c) {
        const int row0 = b * SEQ + c * 128;
        if (c + 1 < 32 && ((c + 1) & 3) == 0) bc_wait(bcf, (unsigned)(((c + 1) >> 2) + 1), wv);
        const float dt0 = dt0n, dt1 = dt1n;
        if (c + 1 < 32) { dt0n = dtg[(size_t)(row0 + 128 + lane) * 32 + h]; dt1n = dtg[(size_t)(row0 + 192 + lane) * 32 + h]; }
        u32x2 zr[4];
#pragma unroll
        for (int pt = 0; pt < 4; ++pt) zr[pt] = *(const u32x2*)(proj + (size_t)(row0 + 16 * w + fr) * NPROJ + h * 64 + 16 * pt + 4 * fq);
        __builtin_amdgcn_sched_barrier(0);
        float a0 = dt0 * Aneg, a1 = dt1 * Aneg;
#pragma unroll
        for (int o = 1; o < 64; o <<= 1) { const float t0 = __shfl_up(a0, o), t1 = __shfl_up(a1, o); if (lane >= o) { a0 += t0; a1 += t1; } }
        a1 += __shfl(a0, 63);
        const float cs_end = __shfl(a1, 63);
        if (w == 0) { CSv[lane] = a0; CSv[64 + lane] = a1; DTv[lane] = dt0; DTv[64 + lane] = dt1; }
        const float csv = (w >= 4) ? a1 : a0, dtv = (w >= 4) ? dt1 : dt0;
        const float cs_l0 = __shfl(csv, srcl), cs_l1 = __shfl(csv, srcl + 1), dt_l0 = __shfl(dtv, srcl), dt_l1 = __shfl(dtv, srcl + 1);
        const float dec0 = __expf(cs_end - cs_l0), dec1 = __expf(cs_end - cs_l1);
        ssd_conv<0>(lds, r0, cv, l0, dt_l0, dt_l1);
        __builtin_amdgcn_sched_barrier(0);
        if (c + 1 < 32) ssd_load(r0, pbase + (size_t)(c + 1) * 128 * NPROJ + xc0, false, l0);
        __builtin_amdgcn_sched_barrier(0);
        ssd_put<1>(lds, r1, cv, l0, dec0, dec1); ssd_put<2>(lds, r2, cv, l0, dec0, dec1);
        ssd_put<3>(lds, r3, cv, l0, 0.f, 0.f);   ssd_put<4>(lds, r4, cv, l0, 0.f, 0.f);
        __builtin_amdgcn_sched_barrier(0);
        if (c + 1 < 32) {
            const bf16_t* cb = pbase + (size_t)(c + 1) * 128 * NPROJ;
            r1[0] = *(const u32x4*)(cb + xc1); r1[1] = *(const u32x4*)(cb + xc1 + NPROJ); r2[0] = *(const u32x4*)(cb + xc2); r2[1] = *(const u32x4*)(cb + xc2 + NPROJ);
            r3[0] = *(const u32x4*)(cb + xc3); r3[1] = *(const u32x4*)(cb + xc3 + NPROJ); r4[0] = *(const u32x4*)(cb + xc4); r4[1] = *(const u32x4*)(cb + xc4 + NPROJ);
        }
        __builtin_amdgcn_sched_barrier(0);
        asm volatile("s_waitcnt lgkmcnt(0)" ::: "memory"); __builtin_amdgcn_s_barrier(); asm volatile("" ::: "memory");
        const int lrow = 16 * w + fr;
        const int hb_cur = L_HB + (c & 1) * 17408, hb_nxt = L_HB + ((c + 1) & 1) * 17408;
        bf16x8 cf[4];
#pragma unroll
        for (int ks = 0; ks < 4; ++ks) cf[ks] = *(LAS const bf16x8*)(lds + L_CM + lrow * SROW + (32 * ks + 8 * fq) * 2);
        const float cs_l = CSv[lrow], dt_l = DTv[lrow];
        asm volatile("" ::: "memory");
        const int dd = fr - 4 * fq; const float ddiag = Dh / dt_l;
        f32x4 y[4];
        { const float el = __expf(cs_l);
#pragma unroll
          for (int pt = 0; pt < 4; ++pt) { f32x4 a = (f32x4){0.f, 0.f, 0.f, 0.f};
#pragma unroll
            for (int ks = 0; ks < 4; ++ks) { const bf16x8 hf = *(LAS const bf16x8*)(lds + hb_cur + (16 * pt + fr) * SROW + (32 * ks + 8 * fq) * 2);
                a = __builtin_amdgcn_mfma_f32_16x16x32_bf16(hf, cf[ks], a, 0, 0, 0); }
            y[pt] = a * el; } }
#pragma unroll
        for (int j = 0; j < 8; ++j) {
            if (j <= w) {
                f32x4 gacc = (f32x4){0.f, 0.f, 0.f, 0.f};
#pragma unroll
                for (int ks = 0; ks < 4; ++ks) { const bf16x8 bf = *(LAS const bf16x8*)(lds + L_BM + (16 * j + fr) * SROW + (32 * ks + 8 * fq) * 2);
                    gacc = __builtin_amdgcn_mfma_f32_16x16x32_bf16(bf, cf[ks], gacc, 0, 0, 0); }
                const f32x4 css = *(LAS const f32x4*)(CSv + 16 * j + 4 * fq);
                float mv[4];
#pragma unroll
                for (int i = 0; i < 4; ++i) { float v = gacc[i] * __expf(cs_l - css[i]);
                    if (j == w) { v = (i <= dd) ? v : 0.f; if (i == dd) v += ddiag; }
                    mv[i] = v; }
                u32x2 wv2; wv2.x = cvt_pk_bf16(mv[0], mv[1]); wv2.y = cvt_pk_bf16(mv[2], mv[3]);
                *(LAS u32x2*)(lds + L_CM + lrow * SROW + (16 * j + 4 * fq) * 2) = wv2;
            } else if (j == w + 1 && (w & 1) == 0) {
                *(LAS u32x2*)(lds + L_CM + lrow * SROW + (16 * j + 4 * fq) * 2) = (u32x2){0u, 0u};
            }
        }
        asm volatile("" ::: "memory");
        { const float de = __expf(cs_end);
#pragma unroll
          for (int pt = 0; pt < 4; ++pt) Hacc[pt] *= de; }
        const int nks2 = (w >> 1) + 1;
#pragma unroll
        for (int ks = 0; ks < 4; ++ks) {
            bf16x8 xf[4];
#pragma unroll
            for (int pt = 0; pt < 4; ++pt) xf[pt] = *(LAS const bf16x8*)(lds + L_XT + swz_off(16 * pt + fr, 4 * ks + fq));
            if (ks < nks2) { const bf16x8 mf = *(LAS const bf16x8*)(lds + L_CM + lrow * SROW + (32 * ks + 8 * fq) * 2);
#pragma unroll
                for (int pt = 0; pt < 4; ++pt) y[pt] = __builtin_amdgcn_mfma_f32_16x16x32_bf16(xf[pt], mf, y[pt], 0, 0, 0); }
            const bf16x8 bdf = *(LAS const bf16x8*)(lds + L_BDT + swz_off(16 * w + fr, 4 * ks + fq));
#pragma unroll
            for (int pt = 0; pt < 4; ++pt) Hacc[pt] = __builtin_amdgcn_mfma_f32_16x16x32_bf16(bdf, xf[pt], Hacc[pt], 0, 0, 0);
        }
#pragma unroll
        for (int pt = 0; pt < 4; ++pt) { u32x2 wv2; wv2.x = cvt_pk_bf16(Hacc[pt][0], Hacc[pt][1]); wv2.y = cvt_pk_bf16(Hacc[pt][2], Hacc[pt][3]);
            *(LAS u32x2*)(lds + hb_nxt + (16 * pt + fr) * SROW + (16 * w + 4 * fq) * 2) = wv2; }
        { float ss = 0.f; const size_t orow = (size_t)(row0 + lrow);
#pragma unroll
          for (int pt = 0; pt < 4; ++pt) {
            const float z0 = bflo(zr[pt].x), z1 = bfhi(zr[pt].x), z2 = bflo(zr[pt].y), z3 = bfhi(zr[pt].y);
            const float v0 = y[pt][0] * silu_f(z0), v1 = y[pt][1] * silu_f(z1), v2 = y[pt][2] * silu_f(z2), v3 = y[pt][3] * silu_f(z3);
            ss += (v0 * v0 + v1 * v1) + (v2 * v2 + v3 * v3);
            u32x2 wv; wv.x = cvt_pk_bf16(v0, v1); wv.y = cvt_pk_bf16(v2, v3);
            *(u32x2*)(ymix + orow * DMIX + h * 64 + 16 * pt + 4 * fq) = wv; }
          ss += __shfl_xor(ss, 16); ss += __shfl_xor(ss, 32);
          if (fq == 0) ssq1[ssq_idx((int)orow, h)] = ss; }
        asm volatile("s_waitcnt lgkmcnt(0)" ::: "memory"); __builtin_amdgcn_s_barrier(); asm volatile("" ::: "memory");
    }
}
__device__ void sc_unit(const Params& p, int unit, int wv) {
    const int tid = wv * 64 + lane_id(), cvx = tid & 255, th = tid >> 8;
    const bf16_t* proj = (const bf16_t*)(p.ws + WS_PROJ);
    bf16_t* ymix = (bf16_t*)(p.ws + WS_YMIX);
    const int t0 = unit * 64 + th * 32, c0 = cvx * 8;
    float w0[8], w1[8], w2[8];
    { const f32x4* a = (const f32x4*)(p.sc_conv_w + c0); const f32x4* bq = (const f32x4*)(p.sc_conv_w + 2048 + c0); const f32x4* cq = (const f32x4*)(p.sc_conv_w + 4096 + c0);
#pragma unroll
      for (int q = 0; q < 2; ++q) { const f32x4 x0 = a[q], x1 = bq[q], x2 = cq[q];
#pragma unroll
        for (int j = 0; j < 4; ++j) { w0[q * 4 + j] = x0[j]; w1[q * 4 + j] = x1[j]; w2[q * 4 + j] = x2[j]; } } }
    float pm1[8], pm2[8];
#pragma unroll
    for (int e = 0; e < 8; ++e) { pm1[e] = 0.f; pm2[e] = 0.f; }
    if ((t0 & (SEQ - 1)) != 0) {
        const bf16_t* r2 = proj + (size_t)(t0 - 2) * NPROJ, * r1 = proj + (size_t)(t0 - 1) * NPROJ;
        const u32x4 c2 = *(const u32x4*)(r2 + 8192 + c0), c1 = *(const u32x4*)(r1 + 8192 + c0);
#pragma unroll
        for (int q = 0; q < 4; ++q) { pm2[2 * q] = bflo(c2[q]); pm2[2 * q + 1] = bfhi(c2[q]); pm1[2 * q] = bflo(c1[q]); pm1[2 * q + 1] = bfhi(c1[q]); }
    }
#pragma unroll 4
    for (int i = 0; i < 32; ++i) {
        const bf16_t* r = proj + (size_t)(t0 + i) * NPROJ;
        const u32x4 gb = *(const u32x4*)(r + 6144 + c0), gp = *(const u32x4*)(r + 8192 + c0);
        float o[8];
#pragma unroll
        for (int q = 0; q < 4; ++q) {
            const float pa = bflo(gp[q]), pb = bfhi(gp[q]);
            o[2 * q] = bflo(gb[q]) * (w0[2 * q] * pm2[2 * q] + w1[2 * q] * pm1[2 * q] + w2[2 * q] * pa);
            o[2 * q + 1] = bfhi(gb[q]) * (w0[2 * q + 1] * pm2[2 * q + 1] + w1[2 * q + 1] * pm1[2 * q + 1] + w2[2 * q + 1] * pb);
            pm2[2 * q] = pm1[2 * q]; pm2[2 * q + 1] = pm1[2 * q + 1]; pm1[2 * q] = pa; pm1[2 * q + 1] = pb;
        }
        u32x4 wv; wv.x = cvt_pk_bf16(o[0], o[1]); wv.y = cvt_pk_bf16(o[2], o[3]); wv.z = cvt_pk_bf16(o[4], o[5]); wv.w = cvt_pk_bf16(o[6], o[7]);
        *(u32x4*)(ymix + (size_t)(t0 + i) * DMIX + 2048 + c0) = wv;
    }
}
__device__ void phase2(const Params& p, LAS unsigned char* lds, int wv) {
    const int G = gridDim.x, bid = blockIdx.x;
    const bool split = G >= 256;
    if (!split) bc_sequences(p, lds, bid, G, wv);
    if (!split || bid < 128) { for (int u = bid; u < 128; u += (split ? 128 : G)) ssd_unit(p, lds, u >> 5, u & 31, wv); }
    if (split && bid >= 128) bc_sequences(p, lds, bid - 128, G - 128, wv);
    if (!split || bid >= 128) { for (int u = (split ? bid - 128 : bid); u < M_ / 64; u += (split ? G - 128 : G)) sc_unit(p, u, wv); }
    if (!split || bid >= 128) wconv_units(p, lds, split ? bid - 128 : bid, split ? G - 128 : G, wv);
}

__device__ void phase6(const Params& p, int wv) {
    const int lane = lane_id(), wave = wv;
    const bf16_t* h2 = (const bf16_t*)(p.ws + WS_H1B);
    const float* ssq3 = (const float*)(p.ws + WS_SSQ3);
    const int stride = gridDim.x * 8;
    int row = blockIdx.x * 8 + wave;
    if (row >= M_) return;
    u32x2 hv[8]; float sp = (lane < 32) ? ssq3[ssq_idx(row, lane)] : 0.f;
#pragma unroll
    for (int i = 0; i < 8; ++i) hv[i] = ((const u32x2*)(h2 + (size_t)row * D_))[lane + 64 * i];
    for (;;) {
        const int rown = row + stride; const bool more = rown < M_;
        u32x2 hvn[8]; float spn = 0.f;
#pragma unroll
        for (int i = 0; i < 8; ++i) hvn[i] = hv[i];
        if (more) { spn = (lane < 32) ? ssq3[ssq_idx(rown, lane)] : 0.f;
#pragma unroll
            for (int i = 0; i < 8; ++i) hvn[i] = ((const u32x2*)(h2 + (size_t)rown * D_))[lane + 64 * i]; }
        float s = sp;
#pragma unroll
        for (int o = 32; o >= 1; o >>= 1) s += __shfl_xor(s, o);
        const float rstd = rsqrtf(s * (1.0f / 2048.0f) + EPS);
        f32x4* orow = (f32x4*)(p.out + (size_t)row * D_);
#pragma unroll
        for (int i = 0; i < 8; ++i) { const f32x4 v = (f32x4){bflo(hv[i].x), bfhi(hv[i].x), bflo(hv[i].y), bfhi(hv[i].y)}, g4 = ((const f32x4*)p.norm_final_g)[lane + 64 * i]; orow[lane + 64 * i] = v * rstd * g4; }
        if (!more) break;
        row = rown; sp = spn;
#pragma unroll
        for (int i = 0; i < 8; ++i) hv[i] = hvn[i];
    }
}


#define XB_TMO      128
#define XB_XCNT(j)  (256  + 64 * (j))
#define XB_XSUB(j)  (1280 + 64 * (j))
#define XB_XGEN(j)  (2304 + 64 * (j))
#define XB_TOP      3328
#define XB_TOPGEN   3392
#define XCD_BAR_WORDS 3456
#define XB_SPIN_CAP (1u << 18)
__device__ __forceinline__ unsigned xb_ld(unsigned* p)              { return __hip_atomic_load(p, __ATOMIC_RELAXED, __HIP_MEMORY_SCOPE_AGENT); }
__device__ __forceinline__ unsigned xb_add(unsigned* p, unsigned v) { return __hip_atomic_fetch_add(p, v, __ATOMIC_RELAXED, __HIP_MEMORY_SCOPE_AGENT); }
__device__ __forceinline__ unsigned xb_xcc_id() { return (unsigned)__builtin_amdgcn_s_getreg((3 << 11) | 20) & 0xFu; }
#define XB_SPIN(cond, bar) do { unsigned _sp = 0; while (cond) { __builtin_amdgcn_s_sleep(1); \
    if ((++_sp & 255u) == 0u) { if (xb_ld(&(bar)[XB_TMO])) break; if (_sp > XB_SPIN_CAP) { atomicAdd(&(bar)[XB_TMO], 1u); break; } } } } while (0)
struct XcdBarrier { unsigned* bar; unsigned x; volatile LAS unsigned* st; };
__device__ __forceinline__ void xcd_barrier_complete(unsigned* bar, unsigned x, unsigned& nloc, unsigned& nx) {
    const unsigned G = gridDim.x * gridDim.y * gridDim.z;
    unsigned sum, cnt, mine, sp = 0u;
    for (;;) {
        sum = 0u; cnt = 0u; mine = 0u;
#pragma unroll
        for (unsigned j = 0; j < 16; ++j) { const unsigned c = xb_ld(&bar[XB_XCNT(j)]); sum += c; cnt += (c > 0u) ? 1u : 0u; mine = (j == x) ? c : mine; }
        if (sum == G) break;
        __builtin_amdgcn_s_sleep(1);
        if ((++sp & 255u) == 0u) { if (xb_ld(&bar[XB_TMO])) break; if (sp > XB_SPIN_CAP) { atomicAdd(&bar[XB_TMO], 1u); break; } }
    }
    nloc = mine > 0u ? mine : 1u; nx = cnt > 0u ? cnt : 1u;
}
__device__ __forceinline__ void xcd_barrier(const XcdBarrier& b, bool leader) {
    asm volatile("s_waitcnt vmcnt(0)" ::: "memory");
    __syncthreads();
    if (leader) {
        unsigned* bar = b.bar;
        __builtin_amdgcn_s_waitcnt(0);
        unsigned nloc = b.st[0], nx = b.st[1];
        if (nloc == 0u) { xcd_barrier_complete(bar, b.x, nloc, nx); b.st[0] = nloc; b.st[1] = nx; }
        const unsigned old = xb_add(&bar[XB_XSUB(b.x)], 1u);
        const unsigned gen = old / nloc;
        if (old + 1u == (gen + 1u) * nloc) {
            __builtin_amdgcn_fence(__ATOMIC_RELEASE, "agent");
            asm volatile("s_waitcnt vmcnt(0)" ::: "memory");
            const unsigned og = xb_add(&bar[XB_TOP], 1u);
            const unsigned tg = og / nx;
            if (og + 1u == (tg + 1u) * nx) xb_add(&bar[XB_TOPGEN], 1u);
            else XB_SPIN(xb_ld(&bar[XB_TOPGEN]) == tg, bar);
            __builtin_amdgcn_fence(__ATOMIC_ACQUIRE, "agent");
            xb_add(&bar[XB_XGEN(b.x)], 1u);
            asm volatile("s_waitcnt vmcnt(0)" ::: "memory");
        } else {
            XB_SPIN(xb_ld(&bar[XB_XGEN(b.x)]) == gen, bar);
            __builtin_amdgcn_fence(__ATOMIC_ACQUIRE, "agent");
            asm volatile("s_waitcnt vmcnt(0)" ::: "memory");
        }
    }
    __syncthreads();
}

__global__ void __launch_bounds__(512) hymba_fwd(Params p) {
    extern __shared__ __attribute__((aligned(16))) unsigned char shm[];
    LAS unsigned char* lds = (LAS unsigned char*)shm;
    cg::grid_group grid = cg::this_grid();
    const int lo = p.ph_lo, hi = p.ph_hi;
    const int wv = __builtin_amdgcn_readfirstlane(threadIdx.x >> 6);
#ifdef DBG_CLEAR
    for (int i = threadIdx.x; i < LDS_BYTES / 16; i += 512) *(LAS u32x4*)(lds + i * 16) = (u32x4){0u, 0u, 0u, 0u};
    __syncthreads();
#endif
#define IN(k) (lo <= (k) && (k) < hi)
#define SEAM(k) do { if (IN(k) && IN((k) + 1)) { \
        asm volatile("s_waitcnt vmcnt(0) lgkmcnt(0)" ::: "memory"); __syncthreads();                 \
        if (wv == 0) { __builtin_amdgcn_fence(__ATOMIC_RELEASE, "agent"); asm volatile("s_waitcnt vmcnt(0)" ::: "memory"); }     \
        grid.sync(); \
        if (wv == 0) { __builtin_amdgcn_fence(__ATOMIC_ACQUIRE, "agent"); asm volatile("s_waitcnt vmcnt(0)" ::: "memory"); }     \
        __syncthreads(); } } while (0)
    volatile LAS unsigned* xst = (volatile LAS unsigned*)(lds + LDS_BYTES - 16);
    const bool xlead = (wv == 0) && (lane_id() == 0);
    if (xlead) { xst[0] = 0u; xst[1] = 0u; }
    __syncthreads();
    XcdBarrier xb; xb.bar = (unsigned*)((unsigned char*)p.out + DO_XBAR); xb.x = xb_xcc_id(); xb.st = xst;
    if (xlead) (void)xb_add(&xb.bar[XB_XCNT(xb.x)], 1u);
#define XSEAM(k) do { if (IN(k) && IN((k) + 1)) xcd_barrier(xb, (wv == 0) && (lane_id() == 0)); } while (0)
    if (IN(0)) for (int rep = 0; rep < NREP(0); ++rep) phase0(p, lds, wv);
    XSEAM(0);
    if (IN(1)) for (int rep = 0; rep < NREP(1); ++rep) {
        pg8::Gemm g{(const bf16_t*)(p.ws + WS_XN), (const bf16_t*)(p.ws + WS_BTIN), M_, NPROJ, D_}; pg8::StaticOrder S; S.init(M_, NPROJ, gridDim.x, blockIdx.x);
        if (gridDim.x == 256) { S.nrounds = 12; S.rot = 3 * ((blockIdx.x >> 6) & 3); }
        EpiProj E{(bf16_t*)(p.ws + WS_PROJ)};
        pg8::gemm_phase<EpiProj>(lds, g, S, E, wv);
        dt_units(p, lds, wv);
    }
    XSEAM(1);
    if (IN(3)) for (int rep = 0; rep < NREP(3); ++rep) phase2(p, lds, wv);
    XSEAM(3);
    if (IN(4)) for (int rep = 0; rep < NREP(4); ++rep) {
        pg8::Gemm g{(const bf16_t*)(p.ws + WS_YMIX), (const bf16_t*)((unsigned char*)p.out + DO_BTOUT), M_, D_, DMIX}; pg8::StaticOrder S; S.init(M_, D_, gridDim.x, blockIdx.x);
        EpiOut E{p.x, (bf16_t*)(p.ws + WS_H1B), (const float*)((unsigned char*)p.out + DO_SSQ1), (float*)((unsigned char*)p.out + DO_SSQ2)};
        pg8::gemm_phase<EpiOut>(lds, g, S, E, wv);
    }
    XSEAM(4);
    if (IN(5)) for (int rep = 0; rep < NREP(5); ++rep) {
        pg8::Gemm g{(const bf16_t*)(p.ws + WS_H1B), (const bf16_t*)((unsigned char*)p.out + DO_BTGU), M_, NGU, D_}; pg8::StaticOrder S; S.init(M_, NGU, gridDim.x, blockIdx.x);
        EpiGU E{(const float*)((unsigned char*)p.out + DO_SSQ2), (bf16_t*)(p.ws + WS_HFF)};
        pg8::gemm_phase<EpiGU>(lds, g, S, E, wv);
    }
    XSEAM(5);
    if (IN(6)) {
        pg8::Gemm g{(const bf16_t*)(p.ws + WS_HFF), (const bf16_t*)((unsigned char*)p.out + DO_BTDN), M_, D_, DFF}; pg8::StaticOrder S; S.init(M_, D_, gridDim.x, blockIdx.x);
        EpiDown E{(bf16_t*)(p.ws + WS_H1B), (float*)(p.ws + WS_SSQ3)};
        pg8::gemm_phase<EpiDown>(lds, g, S, E, wv);
    }
    XSEAM(6);
    if (p.ph_hi > 1000) grid.sync();
    if (IN(7)) for (int rep = 0; rep < NREP(7); ++rep) phase6(p, wv);
#undef IN
#undef SEAM
}

extern "C" void kernel_launch(void* const* d_in, const int* in_sizes, int n_in, void* d_out, int out_size, void* d_ws, size_t ws_size, hipStream_t stream) {
    static int grid = 0;
    if (grid == 0) {
        if (n_in != 16 || out_size != M_ * D_ || ws_size < WS_NEED) { fprintf(stderr, "kernel_launch: unexpected shapes (n_in %d out %d ws %zu, need %zu)\n", n_in, out_size, ws_size, (size_t)WS_NEED); grid = -1; return; }
        int dev = 0, cus = 0, per_cu = 0;
        (void)hipGetDevice(&dev);
        (void)hipDeviceGetAttribute(&cus, hipDeviceAttributeMultiprocessorCount, dev);
        if (hipFuncSetAttribute((const void*)hymba_fwd, hipFuncAttributeMaxDynamicSharedMemorySize, LDS_BYTES) != hipSuccess) { fprintf(stderr, "kernel_launch: hipFuncSetAttribute failed\n"); grid = -1; return; }
        if (hipOccupancyMaxActiveBlocksPerMultiprocessor(&per_cu, (const void*)hymba_fwd, 512, LDS_BYTES) != hipSuccess || per_cu < 1) { fprintf(stderr, "kernel_launch: occupancy query failed (%d)\n", per_cu); (void)hipGetLastError(); per_cu = 1; }
        grid = cus * per_cu;
    }
    if (grid < 0) return;
    Params p{};
    p.x = (const float*)d_in[0]; p.norm_mix_g = (const float*)d_in[1]; p.w_in = (const float*)d_in[2]; p.ssm_conv_w = (const float*)d_in[3]; p.ssm_conv_b = (const float*)d_in[4];
    p.ssm_dt_bias = (const float*)d_in[5]; p.ssm_A_log = (const float*)d_in[6]; p.ssm_D = (const float*)d_in[7]; p.ssm_norm_g = (const float*)d_in[8]; p.sc_conv_w = (const float*)d_in[9];
    p.w_out = (const float*)d_in[10]; p.norm_ffn_g = (const float*)d_in[11]; p.w_gate = (const float*)d_in[12]; p.w_up = (const float*)d_in[13]; p.w_down = (const float*)d_in[14]; p.norm_final_g = (const float*)d_in[15];
    p.out = (float*)d_out; p.ws = (unsigned char*)d_ws;
#ifdef DBG_MEMSET
    (void)hipMemsetAsync(d_ws, 0, WS_NEED, stream); (void)hipMemsetAsync(d_out, 0, (size_t)out_size * 4, stream);
#endif
#ifndef N_CUTS
#define N_CUTS 1
#endif
    for (int li = 0; li < N_CUTS; ++li) {
        p.ph_lo = (N_CUTS == 8) ? li : 0; p.ph_hi = (N_CUTS == 8) ? li + 1 : 8;
        (void)hipMemsetAsync((unsigned char*)d_out + DO_BCFLAG, 0, 4096 + XCD_BAR_WORDS * sizeof(unsigned), stream);
    void* args[] = {&p};
        hipError_t e = hipLaunchCooperativeKernel((const void*)hymba_fwd, dim3(grid), dim3(512), args, LDS_BYTES, stream);
        if (e != hipSuccess) fprintf(stderr, "kernel_launch: cooperative launch failed: %s (grid %d)\n", hipGetErrorString(e), grid);
    }
}
```

```cpp
#include <hip/hip_runtime.h>
#include <hip/hip_cooperative_groups.h>
#include <cstdio>
namespace cg = cooperative_groups;

#define LAS __attribute__((address_space(3)))
typedef unsigned short bf16_t;
typedef short bf16x8 __attribute__((ext_vector_type(8)));
typedef float f32x4 __attribute__((ext_vector_type(4)));
typedef unsigned u32x4 __attribute__((ext_vector_type(4)));
typedef unsigned u32x2 __attribute__((ext_vector_type(2)));

constexpr int M_ = 16384, D_ = 2048, DIN = 12320, NPROJ = 12288, DFF = 5632, DMIX = 4096, NGU = 11264;
constexpr int SEQ = 4096;
constexpr float EPS = 1e-5f;
constexpr int LDS_BYTES = 159744;
constexpr int XCD_BAR_WORDS_C = 3456;
#ifndef PROBE_PHASE
#define PROBE_PHASE -1
#endif
#define NREP(k) ((PROBE_PHASE == (k)) ? 1 + (p.ph_hi < 100) : 1)
constexpr int TAB_OFF = 131072;

constexpr size_t WS_PROJ = 0;
constexpr size_t WS_R = (size_t)M_ * NPROJ * 2;
constexpr size_t WS_XN = WS_R;
constexpr size_t WS_BTIN = WS_R + (size_t)M_ * D_ * 2;
constexpr size_t WS_YMIX = WS_R;
constexpr size_t WS_H1F = 0;
constexpr size_t WS_H1B = (size_t)M_ * D_ * 4;
constexpr size_t WS_HFF = WS_H1B + (size_t)M_ * D_ * 2;
constexpr size_t WS_SSQ3 = WS_HFF + (size_t)M_ * DFF * 2;
constexpr size_t WS_NEED = WS_R + (size_t)M_ * DMIX * 2;
constexpr size_t DO_BTOUT = 0;
constexpr size_t DO_BTGU = (size_t)D_ * DMIX * 2;
constexpr size_t DO_BTDN = DO_BTGU + (size_t)NGU * D_ * 2;
constexpr size_t DO_DT = DO_BTDN + (size_t)D_ * DFF * 2;
constexpr size_t DO_SSQ1 = DO_DT + (size_t)M_ * 32 * 4;
constexpr size_t DO_SSQ2 = DO_SSQ1 + (size_t)M_ * 32 * 4;
constexpr size_t DO_XBAR = (size_t)M_ * D_ * 4 - 16384;
constexpr size_t DO_BCFLAG = DO_XBAR - 4096;
static_assert(DO_SSQ2 + (size_t)M_ * 32 * 4 <= DO_BCFLAG && XCD_BAR_WORDS_C * 4 <= 16384, "d_out scratch");

static_assert(WS_SSQ3 + (size_t)M_ * 32 * 4 <= WS_R, "ws overlay");

struct Params {
    const float* x; const float* norm_mix_g; const float* w_in; const float* ssm_conv_w; const float* ssm_conv_b;
    const float* ssm_dt_bias; const float* ssm_A_log; const float* ssm_D; const float* ssm_norm_g; const float* sc_conv_w;
    const float* w_out; const float* norm_ffn_g; const float* w_gate; const float* w_up; const float* w_down; const float* norm_final_g;
    float* out; unsigned char* ws; int ph_lo, ph_hi;
};

typedef float f32x2_t __attribute__((ext_vector_type(2)));
typedef __bf16 bf16x2_t __attribute__((ext_vector_type(2)));
__device__ __forceinline__ unsigned cvt_pk_bf16(float lo, float hi) { const f32x2_t v = {lo, hi}; return __builtin_bit_cast(unsigned, __builtin_convertvector(v, bf16x2_t)); }
__device__ __forceinline__ float bflo(unsigned u) { return __uint_as_float(u << 16); }
__device__ __forceinline__ float bfhi(unsigned u) { return __uint_as_float(u & 0xffff0000u); }
__device__ __forceinline__ int lane_id() { int l; asm volatile("v_mbcnt_lo_u32_b32 %0, -1, 0\n\tv_mbcnt_hi_u32_b32 %0, -1, %0" : "=v"(l)); return l; }
__device__ __forceinline__ float silu_f(float v) { return v * __builtin_amdgcn_rcpf(1.0f + __expf(-v)); }

__device__ __forceinline__ size_t ssq_idx(int row, int part) { return ((size_t)(row >> 5) * 32 + part) * 32 + (row & 31); }

namespace pg8 {
constexpr int BM = 256, BK = 64, HALF = 128, HTB = HALF * BK * 2, STAGE_BYTES = 8 * HTB, NXCD = 8, WGM = 8;
__device__ __forceinline__ int lds_byte(int r, int c) { const int st = (r >> 4) * 2 + (c >> 5), rr = r & 15, cc = c & 31, ob = rr * 64 + cc * 2; return st * 1024 + (ob ^ (((ob >> 9) & 1) << 5)); }
__device__ __forceinline__ void stage_rc(int b, int& R, int& C) { const int st = b / 1024, sb = b % 1024, swz = sb ^ (((sb >> 9) & 1) << 5); R = (st >> 1) * 16 + swz / 64; C = (st & 1) * 32 + (swz % 64) / 2; }
__device__ __forceinline__ int perm32(int rho) { const int n = rho >> 4, i = rho & 15; return 8 * (i >> 2) + 4 * n + (i & 3); }
struct Unit { int pm, pn; };
struct Gemm { const bf16_t* A; const bf16_t* Bt; int M, N, K; };
struct StaticOrder {
    int nM, nN, nwg, G, c, rot = 0, nrounds = 1;
    __device__ void init(int M, int N, int G_, int c_) { nM = M / BM; nN = N / BM; nwg = nM * nN; G = G_; c = c_; }
    __device__ bool next(int i, Unit& u) const {
        if (rot != 0 && i < nrounds) i = (i + rot) % nrounds;
        const long L = (long)i * G + c; if (L >= nwg) return false;
        int wgid = (int)L; { const int q = nwg / NXCD, r = nwg % NXCD, xcd = wgid % NXCD, off = wgid / NXCD; wgid = (xcd < r ? xcd * (q + 1) : r * (q + 1) + (xcd - r) * q) + off; }
        const int nig = WGM * nN, gid = wgid / nig, fm = gid * WGM, gsz = (nM - fm) < WGM ? (nM - fm) : WGM;
        u.pm = fm + ((wgid % nig) % gsz); u.pn = (wgid % nig) / gsz; return true;
    }
};
template <class Epi>
__device__ __forceinline__ void gemm_phase(LAS unsigned char* lds, const Gemm g, const StaticOrder& S, const Epi& E, int wv) {
    const int wid = wv, lane = lane_id(), tid = wid * 64 + lane, wr = wid >> 2, wc = wid & 3, fr = lane & 15, fq = lane >> 4;
    const int K = g.K, nt = K / BK;
    unsigned voffA[2], voffB[2];
#pragma unroll
    for (int i = 0; i < 2; ++i) { int R, C; stage_rc(tid * 16 + i * 8192, R, C); const int Rb = (R & ~31) + perm32(R & 31);
        voffA[i] = (unsigned)(R * K + C) * 2u; voffB[i] = (unsigned)(Rb * K + C) * 2u; }
    const size_t kstep = (size_t)(BK * 2);
    const size_t hstep = (size_t)HALF * K * 2;
    const size_t tstep = 2 * hstep;
    const unsigned ldsw = (unsigned)wid * 1024u;
    const int aoff = lds_byte(wr * 64 + fr, fq * 8), boff = lds_byte(wc * 32 + fr, fq * 8);
#define PG8_SA(b, h) (((b) * 2 + (h)) * HTB)
#define PG8_SB(b, h) ((4 + (b) * 2 + (h)) * HTB)
#define PG8_STAGE(bufoff, gbase, voff) do { _Pragma("unroll") for (int _i = 0; _i < 2; ++_i) \
        __builtin_amdgcn_global_load_lds((const unsigned*)((const char*)(gbase) + (voff)[_i]), (LAS unsigned*)(lds + (bufoff) + ldsw + _i * 8192), 16, 0, 0); } while (0)
#define PG8_LDA(dst, b, h) do { _Pragma("unroll") for (int m = 0; m < 4; ++m) _Pragma("unroll") for (int k = 0; k < 2; ++k) dst[m][k] = *(const LAS bf16x8*)(lds + PG8_SA(b, h) + aoff + m * 2048 + k * 1024); } while (0)
#define PG8_LDB(dst, b, h) do { _Pragma("unroll") for (int n = 0; n < 2; ++n) _Pragma("unroll") for (int k = 0; k < 2; ++k) dst[n][k] = *(const LAS bf16x8*)(lds + PG8_SB(b, h) + boff + n * 2048 + k * 1024); } while (0)
#define PG8_MMA(ai, bj, At, Bt) do { __builtin_amdgcn_s_setprio(1); _Pragma("unroll") for (int m = 0; m < 4; ++m) _Pragma("unroll") for (int n = 0; n < 2; ++n) _Pragma("unroll") for (int k = 0; k < 2; ++k) \
        acc[ai][bj][m][n] = __builtin_amdgcn_mfma_f32_16x16x32_bf16(Bt[n][k], At[m][k], acc[ai][bj][m][n], 0, 0, 0); __builtin_amdgcn_s_setprio(0); } while (0)
#define PG8_WAIT_V(n) asm volatile("s_waitcnt vmcnt(" #n ")" ::: "memory")
#define PG8_WAIT_L(n) asm volatile("s_waitcnt lgkmcnt(" #n ")" ::: "memory")
#define PG8_BAR __builtin_amdgcn_s_barrier()
#define PG8_SCHED __builtin_amdgcn_sched_barrier(0)
    Unit cur, nxt; int ui = 0;
    if (!S.next(0, cur)) return;
    f32x4 acc[2][2][4][2];
#pragma unroll
    for (int a = 0; a < 2; ++a)
#pragma unroll
        for (int b = 0; b < 2; ++b)
#pragma unroll
            for (int m = 0; m < 4; ++m)
#pragma unroll
                for (int n = 0; n < 2; ++n) acc[a][b][m][n] = (f32x4){0.f, 0.f, 0.f, 0.f};
    bf16x8 At[4][2], B0[2][2], B1[2][2];
    const char* cA = (const char*)g.A + (size_t)cur.pm * tstep; const char* cB = (const char*)g.Bt + (size_t)cur.pn * tstep;
    if constexpr (Epi::HAS_TAB) {
        Unit uu; for (int i = 0; i < 27 && S.next(i, uu); ++i) E.prep(uu, (LAS float*)(lds + TAB_OFF + i * 1024), tid);
    }
    PG8_STAGE(PG8_SB(0, 0), cB, voffB); PG8_STAGE(PG8_SB(0, 1), cB + hstep, voffB); PG8_STAGE(PG8_SA(0, 0), cA, voffA); PG8_STAGE(PG8_SA(0, 1), cA + hstep, voffA);
    if (wr == 1) PG8_BAR;
    PG8_WAIT_V(2); PG8_BAR;
    PG8_STAGE(PG8_SB(1, 0), cB + kstep, voffB); PG8_STAGE(PG8_SA(1, 0), cA + kstep, voffA); PG8_STAGE(PG8_SB(1, 1), cB + hstep + kstep, voffB);
    PG8_WAIT_V(6); PG8_BAR;
    for (;;) {
        const bool has_next = S.next(ui + 1, nxt);
        const char* nA = has_next ? (const char*)g.A + (size_t)nxt.pm * tstep : cA; const char* nB = has_next ? (const char*)g.Bt + (size_t)nxt.pn * tstep : cB;
        LAS const float* tabc = (LAS const float*)(lds + TAB_OFF + ui * 1024);
        for (int t = 0; t < nt; t += 2) {
            const bool last = (t == nt - 2);
            const char* a1 = cA + (size_t)(t + 1) * kstep;
            const char* a2 = last ? nA : cA + (size_t)(t + 2) * kstep; const char* b2 = last ? nB : cB + (size_t)(t + 2) * kstep;
            const char* a3 = a2 + kstep; const char* b3 = b2 + kstep;
            if constexpr (Epi::MID_T >= 0) { if (t == Epi::MID_T) {
#pragma unroll
                for (int ai = 0; ai < 2; ++ai)
#pragma unroll
                    for (int m = 0; m < 4; ++m) { const float s = tabc[ai * HALF + wr * 64 + m * 16 + fr];
#pragma unroll
                        for (int bj = 0; bj < 2; ++bj)
#pragma unroll
                            for (int n = 0; n < 2; ++n) acc[ai][bj][m][n] *= s; } } }
            PG8_LDB(B0, 0, 0); PG8_LDB(B1, 0, 1); PG8_SCHED; PG8_LDA(At, 0, 0); PG8_STAGE(PG8_SA(1, 1), a1 + hstep, voffA);
            PG8_WAIT_V(8); PG8_WAIT_L(0); PG8_BAR; PG8_MMA(0, 0, At, B0); PG8_MMA(0, 1, At, B1); PG8_BAR; PG8_SCHED;
            PG8_LDA(At, 0, 1); PG8_STAGE(PG8_SB(0, 0), b2, voffB); PG8_STAGE(PG8_SB(0, 1), b2 + hstep, voffB); PG8_STAGE(PG8_SA(0, 0), a2, voffA);
            PG8_WAIT_V(8); PG8_WAIT_L(0); PG8_BAR; PG8_MMA(1, 0, At, B0); PG8_MMA(1, 1, At, B1); PG8_BAR; PG8_SCHED;
            PG8_LDB(B0, 1, 0); PG8_LDB(B1, 1, 1); PG8_SCHED; PG8_LDA(At, 1, 0); PG8_STAGE(PG8_SA(0, 1), a2 + hstep, voffA);
            PG8_WAIT_V(8); PG8_WAIT_L(0); PG8_BAR; PG8_MMA(0, 0, At, B0); PG8_MMA(0, 1, At, B1); PG8_BAR; PG8_SCHED;
            PG8_LDA(At, 1, 1); PG8_STAGE(PG8_SB(1, 0), b3, voffB); PG8_STAGE(PG8_SB(1, 1), b3 + hstep, voffB); PG8_STAGE(PG8_SA(1, 0), a3, voffA);
            PG8_WAIT_V(8); PG8_WAIT_L(0); PG8_BAR; PG8_MMA(1, 0, At, B0); PG8_MMA(1, 1, At, B1); PG8_BAR; PG8_SCHED;
        }
        if (wr == 0) PG8_BAR;
        E(acc, cur, tabc, wr, wc, fr, fq);
        if (!has_next) break;
#pragma unroll
        for (int a = 0; a < 2; ++a)
#pragma unroll
            for (int b = 0; b < 2; ++b)
#pragma unroll
                for (int m = 0; m < 4; ++m)
#pragma unroll
                    for (int n = 0; n < 2; ++n) acc[a][b][m][n] = (f32x4){0.f, 0.f, 0.f, 0.f};
        cur = nxt; cA = nA; cB = nB; ++ui;
        if (wr == 1) PG8_BAR;
    }
    PG8_WAIT_V(0);
    PG8_BAR;
#undef PG8_SA
#undef PG8_SB
#undef PG8_STAGE
#undef PG8_LDA
#undef PG8_LDB
#undef PG8_MMA
#undef PG8_WAIT_V
#undef PG8_WAIT_L
#undef PG8_BAR
#undef PG8_SCHED
}
}

__device__ __forceinline__ void rstd_table(const float* ssq, int row0, LAS float* tab, int t) {
    const int r = t >> 1, hf = t & 1;
    const float* p = ssq + ssq_idx(row0 + r, hf * 16);
    float s = 0.f;
#pragma unroll
    for (int i = 0; i < 16; ++i) s += p[i * 32];
    s += __shfl_xor(s, 1);
    if (!hf) tab[r] = rsqrtf(s * (1.0f / 2048.0f) + EPS);
}

struct EpiProj {
    static constexpr bool HAS_TAB = false; static constexpr int MID_T = -1;
    bf16_t* O;
    __device__ __forceinline__ void prep(const pg8::Unit&, LAS float*, int) const {}
    __device__ __forceinline__ void operator()(const f32x4 (&acc)[2][2][4][2], const pg8::Unit& u, LAS const float*, int wr, int wc, int fr, int fq) const {
        const int row0 = u.pm * 256 + wr * 64 + fr, col0 = u.pn * 256 + wc * 32 + 8 * fq;
        if (u.pn >= 32) {
            const int pcol = 8192 + (u.pn - 32) * 128 + wc * 32 + 8 * fq;
#pragma unroll
            for (int ai = 0; ai < 2; ++ai)
#pragma unroll
                for (int m = 0; m < 4; ++m) { const f32x4 v0 = acc[ai][0][m][0] * acc[ai][1][m][0], v1 = acc[ai][0][m][1] * acc[ai][1][m][1];
                    u32x4 w; w.x = cvt_pk_bf16(v0[0], v0[1]); w.y = cvt_pk_bf16(v0[2], v0[3]); w.z = cvt_pk_bf16(v1[0], v1[1]); w.w = cvt_pk_bf16(v1[2], v1[3]);
                    *(u32x4*)(O + (size_t)(row0 + ai * 128 + m * 16) * NPROJ + pcol) = w; }
            return;
        }
#pragma unroll
        for (int ai = 0; ai < 2; ++ai)
#pragma unroll
            for (int m = 0; m < 4; ++m) { bf16_t* rowp = O + (size_t)(row0 + ai * 128 + m * 16) * NPROJ + col0;
#pragma unroll
                for (int bj = 0; bj < 2; ++bj) { const f32x4 v0 = acc[ai][bj][m][0], v1 = acc[ai][bj][m][1];
                    u32x4 w; w.x = cvt_pk_bf16(v0[0], v0[1]); w.y = cvt_pk_bf16(v0[2], v0[3]); w.z = cvt_pk_bf16(v1[0], v1[1]); w.w = cvt_pk_bf16(v1[2], v1[3]);
                    *(u32x4*)(rowp + bj * 128) = w; } }
    }
};
struct EpiOut {
    static constexpr bool HAS_TAB = true; static constexpr int MID_T = 32;
    const float* x; bf16_t* h1b; const float* ssq1; float* ssq2;
    __device__ __forceinline__ void prep(const pg8::Unit& u, LAS float* tab, int t) const { rstd_table(ssq1, u.pm * 256, tab, t); }
    __device__ __forceinline__ void operator()(const f32x4 (&acc)[2][2][4][2], const pg8::Unit& u, LAS const float*, int wr, int wc, int fr, int fq) const {
        const int row0 = u.pm * 256 + wr * 64 + fr, col0 = u.pn * 256 + wc * 32 + 8 * fq;
#pragma unroll
        for (int ai = 0; ai < 2; ++ai) {
            f32x4 xv[4][2][2];
#pragma unroll
            for (int m = 0; m < 4; ++m) { const size_t off = (size_t)(row0 + ai * 128 + m * 16) * D_ + col0;
#pragma unroll
                for (int bj = 0; bj < 2; ++bj) { xv[m][bj][0] = *(const f32x4*)(x + off + bj * 128); xv[m][bj][1] = *(const f32x4*)(x + off + bj * 128 + 4); } }
#pragma unroll
            for (int m = 0; m < 4; ++m) { const int row = row0 + ai * 128 + m * 16; const size_t off = (size_t)row * D_ + col0; float ss = 0.f;
#pragma unroll
                for (int bj = 0; bj < 2; ++bj) {
                    const f32x4 v0 = acc[ai][bj][m][0] + xv[m][bj][0], v1 = acc[ai][bj][m][1] + xv[m][bj][1];
                    u32x4 w; w.x = cvt_pk_bf16(v0[0], v0[1]); w.y = cvt_pk_bf16(v0[2], v0[3]); w.z = cvt_pk_bf16(v1[0], v1[1]); w.w = cvt_pk_bf16(v1[2], v1[3]);
                    *(u32x4*)(h1b + off + bj * 128) = w;
                    ss += (v0[0] * v0[0] + v0[1] * v0[1]) + (v0[2] * v0[2] + v0[3] * v0[3]) + (v1[0] * v1[0] + v1[1] * v1[1]) + (v1[2] * v1[2] + v1[3] * v1[3]); }
                ss += __shfl_xor(ss, 16); ss += __shfl_xor(ss, 32);
                if (fq == 0) ssq2[ssq_idx(row, u.pn * 4 + wc)] = ss; }
        }
    }
};
struct EpiGU {
    static constexpr bool HAS_TAB = true; static constexpr int MID_T = -1;
    const float* ssq2; bf16_t* hff;
    __device__ __forceinline__ void prep(const pg8::Unit& u, LAS float* tab, int t) const { rstd_table(ssq2, u.pm * 256, tab, t); }
    __device__ __forceinline__ void operator()(const f32x4 (&acc)[2][2][4][2], const pg8::Unit& u, LAS const float* tab, int wr, int wc, int fr, int fq) const {
        const int row0 = u.pm * 256 + wr * 64 + fr, col0 = u.pn * 128 + wc * 32 + 8 * fq;
#pragma unroll
        for (int ai = 0; ai < 2; ++ai)
#pragma unroll
            for (int m = 0; m < 4; ++m) { const float rs = tab[ai * 128 + wr * 64 + m * 16 + fr];
                float o[8];
#pragma unroll
                for (int n = 0; n < 2; ++n)
#pragma unroll
                    for (int j = 0; j < 4; ++j) { const float gg = acc[ai][0][m][n][j] * rs, uu = acc[ai][1][m][n][j] * rs; o[n * 4 + j] = silu_f(gg) * uu; }
                u32x4 w; w.x = cvt_pk_bf16(o[0], o[1]); w.y = cvt_pk_bf16(o[2], o[3]); w.z = cvt_pk_bf16(o[4], o[5]); w.w = cvt_pk_bf16(o[6], o[7]);
                *(u32x4*)(hff + (size_t)(row0 + ai * 128 + m * 16) * DFF + col0) = w; }
    }
};
struct EpiDown {
    static constexpr bool HAS_TAB = false; static constexpr int MID_T = -1;
    bf16_t* h; float* ssq3;
    __device__ __forceinline__ void prep(const pg8::Unit&, LAS float*, int) const {}
    __device__ __forceinline__ void operator()(const f32x4 (&acc)[2][2][4][2], const pg8::Unit& u, LAS const float*, int wr, int wc, int fr, int fq) const {
        const int row0 = u.pm * 256 + wr * 64 + fr, col0 = u.pn * 256 + wc * 32 + 8 * fq;
#pragma unroll
        for (int ai = 0; ai < 2; ++ai) {
            u32x4 xb[4][2];
#pragma unroll
            for (int m = 0; m < 4; ++m) { const size_t off = (size_t)(row0 + ai * 128 + m * 16) * D_ + col0;
#pragma unroll
                for (int bj = 0; bj < 2; ++bj) xb[m][bj] = *(const u32x4*)(h + off + bj * 128); }
#pragma unroll
            for (int m = 0; m < 4; ++m) { const int row = row0 + ai * 128 + m * 16; const size_t off = (size_t)row * D_ + col0; float ss = 0.f;
#pragma unroll
                for (int bj = 0; bj < 2; ++bj) {
                    const u32x4 q = xb[m][bj];
                    const f32x4 x0 = (f32x4){bflo(q.x), bfhi(q.x), bflo(q.y), bfhi(q.y)}, x1 = (f32x4){bflo(q.z), bfhi(q.z), bflo(q.w), bfhi(q.w)};
                    const f32x4 v0 = acc[ai][bj][m][0] + x0, v1 = acc[ai][bj][m][1] + x1;
                    u32x4 w; w.x = cvt_pk_bf16(v0[0], v0[1]); w.y = cvt_pk_bf16(v0[2], v0[3]); w.z = cvt_pk_bf16(v1[0], v1[1]); w.w = cvt_pk_bf16(v1[2], v1[3]);
                    *(u32x4*)(h + off + bj * 128) = w;
                    ss += (v0[0] * v0[0] + v0[1] * v0[1]) + (v0[2] * v0[2] + v0[3] * v0[3]) + (v1[0] * v1[0] + v1[1] * v1[1]) + (v1[2] * v1[2] + v1[3] * v1[3]); }
                ss += __shfl_xor(ss, 16); ss += __shfl_xor(ss, 32);
                if (fq == 0) ssq3[ssq_idx(row, u.pn * 4 + wc)] = ss; }
        }
    }
};

__device__ __forceinline__ void p0_tile(LAS float* t, const float* src, int ldsrc, int k0, int c0, int jvalid, bf16_t* dst, int K, int j0, const float* scale, int scale_kmax, int tid) {
    const int jc4 = (tid & 15) * 4, kr0 = tid >> 4;
#pragma unroll
    for (int i = 0; i < 4; ++i) {
        const int kr = kr0 + 32 * i;
        f32x4 v = (f32x4){0.f, 0.f, 0.f, 0.f};
        if (jc4 < jvalid) v = *(const f32x4*)(src + (size_t)(k0 + kr) * ldsrc + c0 + jc4);
        const float s = (scale != nullptr && (k0 + kr) < scale_kmax) ? scale[k0 + kr] : 1.0f;
        t[kr * 65 + jc4 + 0] = v[0] * s; t[kr * 65 + jc4 + 1] = v[1] * s; t[kr * 65 + jc4 + 2] = v[2] * s; t[kr * 65 + jc4 + 3] = v[3] * s;
    }
    __syncthreads();
    const int kp = (tid & 63) * 2, jr0 = tid >> 6;
#pragma unroll
    for (int i = 0; i < 8; ++i) {
        const int j = jr0 + 8 * i;
        if (j < jvalid) { const float a = t[kp * 65 + j], b = t[(kp + 1) * 65 + j];
            *(unsigned*)(dst + (size_t)(j0 + j) * K + k0 + kp) = cvt_pk_bf16(a, b); }
    }
    __syncthreads();
}
struct TileD { const float* src; const float* scale; bf16_t* dst; int ldsrc, k0, c0, jvalid, K, j0, kmax; };
__device__ __forceinline__ TileD tile_decode(const Params& p, int u) {
    constexpr int U_IN = 16 * 193, U_OUT = 32 * 32, U_GU = 16 * 176;
    TileD d;
    if (u < U_IN) { const int kt = u & 15, jt = u >> 4, j0 = jt * 64;
        d.src = p.w_in; d.scale = nullptr; d.dst = (bf16_t*)(p.ws + WS_BTIN); d.ldsrc = DIN; d.k0 = kt * 128; d.c0 = j0 < 6144 ? j0 : (j0 < 8192 ? j0 + 32 : (j0 < 12288 ? (((j0 & 255) < 128 ? 8224 : 10272 - 128) + 128 * ((j0 - 8192) >> 8) + (j0 & 255)) : 6144));     d.jvalid = (jt == 192) ? 32 : 64; d.K = D_; d.j0 = j0; d.kmax = 0; }
    else if (u < U_IN + U_OUT) { const int v = u - U_IN, kt = v & 31, jt = v >> 5;
        d.src = p.w_out; d.scale = p.ssm_norm_g; d.dst = (bf16_t*)((unsigned char*)p.out + DO_BTOUT); d.ldsrc = D_; d.k0 = kt * 128; d.c0 = jt * 64; d.jvalid = 64; d.K = DMIX; d.j0 = jt * 64; d.kmax = 2048; }
    else if (u < U_IN + U_OUT + U_GU) { const int v = u - U_IN - U_OUT, kt = v & 15, jt = v >> 4, j0 = jt * 64, pn = j0 >> 8, r0 = j0 & 255;
        d.src = r0 < 128 ? p.w_gate : p.w_up; d.scale = p.norm_ffn_g; d.dst = (bf16_t*)((unsigned char*)p.out + DO_BTGU); d.ldsrc = DFF; d.k0 = kt * 128; d.c0 = 128 * pn + (r0 & 127); d.jvalid = 64; d.K = D_; d.j0 = j0; d.kmax = 2048; }
    else { const int v = u - U_IN - U_OUT - U_GU, kt = v % 44, jt = v / 44;
        d.src = p.w_down; d.scale = nullptr; d.dst = (bf16_t*)((unsigned char*)p.out + DO_BTDN); d.ldsrc = D_; d.k0 = kt * 128; d.c0 = jt * 64; d.jvalid = 64; d.K = DFF; d.j0 = jt * 64; d.kmax = 0; }
    return d;
}
__device__ __forceinline__ void tile_load(const TileD& d, int tid, f32x4 (&v)[4], float (&scl)[4]) {
    const int jc4 = (tid & 15) * 4, kr0 = tid >> 4;
#pragma unroll
    for (int i = 0; i < 4; ++i) { const int kr = kr0 + 32 * i;
        f32x4 x = (f32x4){0.f, 0.f, 0.f, 0.f};
        if (jc4 < d.jvalid) x = *(const f32x4*)(d.src + (size_t)(d.k0 + kr) * d.ldsrc + d.c0 + jc4);
        scl[i] = (d.scale != nullptr && (d.k0 + kr) < d.kmax) ? d.scale[d.k0 + kr] : 1.0f;
        v[i] = x; }
}
__device__ __forceinline__ void tile_finish(LAS float* t, const TileD& d, int tid, const f32x4 (&v)[4], const float (&scl)[4]) {
    const int jc4 = (tid & 15) * 4, kr0 = tid >> 4;
#pragma unroll
    for (int i = 0; i < 4; ++i) { const int kr = kr0 + 32 * i;
        t[kr * 65 + jc4 + 0] = v[i][0] * scl[i]; t[kr * 65 + jc4 + 1] = v[i][1] * scl[i]; t[kr * 65 + jc4 + 2] = v[i][2] * scl[i]; t[kr * 65 + jc4 + 3] = v[i][3] * scl[i]; }
    asm volatile("s_waitcnt lgkmcnt(0)" ::: "memory"); __builtin_amdgcn_s_barrier(); asm volatile("" ::: "memory");
    const int kp = (tid & 63) * 2, jr0 = tid >> 6;
#pragma unroll
    for (int i = 0; i < 8; ++i) { const int j = jr0 + 8 * i;
        if (j < d.jvalid) { const float a = t[kp * 65 + j], b = t[(kp + 1) * 65 + j];
            *(unsigned*)(d.dst + (size_t)(d.j0 + j) * d.K + d.k0 + kp) = cvt_pk_bf16(a, b); } }
    asm volatile("s_waitcnt lgkmcnt(0)" ::: "memory"); __builtin_amdgcn_s_barrier(); asm volatile("" ::: "memory");
}
__device__ __forceinline__ void conv_tiles(const Params& p, LAS unsigned char* lds, int u_begin, int u_end, int first, int stride, int tid) {
    LAS float* t = (LAS float*)lds;
    int u = u_begin + first;
    if (u >= u_end) return;
    TileD d = tile_decode(p, u); f32x4 v[4]; float sc[4]; tile_load(d, tid, v, sc);
    for (;;) {
        const int un = u + stride; const bool more = un < u_end;
        TileD dn = d; f32x4 vn[4]; float scn[4];
#pragma unroll
        for (int i = 0; i < 4; ++i) { vn[i] = v[i]; scn[i] = sc[i]; }
        if (more) { dn = tile_decode(p, un); tile_load(dn, tid, vn, scn); }
        tile_finish(t, d, tid, v, sc);
        if (!more) break;
        d = dn; u = un;
#pragma unroll
        for (int i = 0; i < 4; ++i) { v[i] = vn[i]; sc[i] = scn[i]; }
    }
}
__device__ void phase0(const Params& p, LAS unsigned char* lds, int wv) {
    const int lane = lane_id(), wave = wv, tid = wv * 64 + lane, G = gridDim.x;
    LAS float* t = (LAS float*)lds;
    bf16_t* bt_in = (bf16_t*)(p.ws + WS_BTIN);
    bf16_t* xn = (bf16_t*)(p.ws + WS_XN);
    for (int row = blockIdx.x * 8 + wave; row < M_; row += G * 8) {
        const f32x4* xr = (const f32x4*)(p.x + (size_t)row * D_);
        f32x4 v[8]; float ss = 0.f;
#pragma unroll
        for (int i = 0; i < 8; ++i) { v[i] = xr[lane + 64 * i]; ss += (v[i][0] * v[i][0] + v[i][1] * v[i][1]) + (v[i][2] * v[i][2] + v[i][3] * v[i][3]); }
#pragma unroll
        for (int o = 32; o >= 1; o >>= 1) ss += __shfl_xor(ss, o);
        const float rstd = rsqrtf(ss * (1.0f / 2048.0f) + EPS);
#pragma unroll
        for (int i = 0; i < 8; ++i) { const f32x4 g4 = ((const f32x4*)p.norm_mix_g)[lane + 64 * i];
            u32x2 w; w.x = cvt_pk_bf16(v[i][0] * rstd * g4[0], v[i][1] * rstd * g4[1]); w.y = cvt_pk_bf16(v[i][2] * rstd * g4[2], v[i][3] * rstd * g4[3]);
            *(u32x2*)(xn + (size_t)row * D_ + 4 * (lane + 64 * i)) = w; }
    }
    __syncthreads();
    conv_tiles(p, lds, 0, 16 * 193, blockIdx.x, G, tid);
}
__device__ void wconv_units(const Params& p, LAS unsigned char* lds, int first, int stride, int wv) {
    const int tid = wv * 64 + lane_id();
    __syncthreads();
    conv_tiles(p, lds, 16 * 193, 16 * 193 + 32 * 32 + 16 * 176 + 44 * 32, first, stride, tid);
}

__device__ void dt_units(const Params& p, LAS unsigned char* lds, int wv) {
    const int lane = lane_id(), w = wv, tid = wv * 64 + lane, fr = lane & 15, fq = lane >> 4;
    const bf16_t* xn = (const bf16_t*)(p.ws + WS_XN);
    const bf16_t* bt = (const bf16_t*)(p.ws + WS_BTIN) + (size_t)NPROJ * D_;
    float* dt = (float*)((unsigned char*)p.out + DO_DT);
    LAS float* red = (LAS float*)lds;
    for (int rb = blockIdx.x; rb < M_ / 64; rb += gridDim.x) {
        const int row0 = rb * 64;
        f32x4 acc[4][2];
#pragma unroll
        for (int m = 0; m < 4; ++m)
#pragma unroll
            for (int n = 0; n < 2; ++n) acc[m][n] = (f32x4){0.f, 0.f, 0.f, 0.f};
#pragma unroll 4
        for (int ks = 0; ks < 8; ++ks) {
            const int kb = w * 256 + ks * 32 + fq * 8;
            bf16x8 a[4], b[2];
#pragma unroll
            for (int m = 0; m < 4; ++m) a[m] = *(const bf16x8*)(xn + (size_t)(row0 + 16 * m + fr) * D_ + kb);
#pragma unroll
            for (int n = 0; n < 2; ++n) b[n] = *(const bf16x8*)(bt + (size_t)(16 * n + fr) * D_ + kb);
#pragma unroll
            for (int m = 0; m < 4; ++m)
#pragma unroll
                for (int n = 0; n < 2; ++n) acc[m][n] = __builtin_amdgcn_mfma_f32_16x16x32_bf16(a[m], b[n], acc[m][n], 0, 0, 0);
        }
#pragma unroll
        for (int m = 0; m < 4; ++m)
#pragma unroll
            for (int n = 0; n < 2; ++n)
#pragma unroll
                for (int j = 0; j < 4; ++j) red[w * 2048 + (16 * m + 4 * fq + j) * 32 + 16 * n + fr] = acc[m][n][j];
        __syncthreads();
        {
            const int idx = tid * 4, r = idx >> 5, c = idx & 31;
            f32x4 s = (f32x4){0.f, 0.f, 0.f, 0.f};
#pragma unroll
            for (int ww = 0; ww < 8; ++ww) s += *(LAS const f32x4*)(red + ww * 2048 + idx);
            const f32x4 bias = *(const f32x4*)(p.ssm_dt_bias + c);
            f32x4 o;
#pragma unroll
            for (int j = 0; j < 4; ++j) { const float v = s[j] + bias[j]; o[j] = v > 20.f ? v : log1pf(expf(v)); }
            *(f32x4*)(dt + (size_t)(row0 + r) * 32 + c) = o;
        }
        __syncthreads();
    }
}

__device__ void bc_sequences(const Params& p, LAS unsigned char* lds, int first, int stride, int wv) {
    const int tid = wv * 64 + lane_id(), cv = tid & 7, run = tid >> 3;
    bf16_t* proj = (bf16_t*)(p.ws + WS_PROJ);
    LAS u32x4* stash = (LAS u32x4*)lds;
    unsigned* bcflag = (unsigned*)((unsigned char*)p.out + DO_BCFLAG);
    for (int sq = first; sq < 4 * 32; sq += stride) {
        const int b = sq >> 5, slab = sq & 31;
        const int xcol = 2048 + slab * 64 + cv * 8;
        float wk[4][8], bs[8];
#pragma unroll
        for (int k = 0; k < 4; ++k) { const f32x4 a = *(const f32x4*)(p.ssm_conv_w + k * 4096 + xcol), c = *(const f32x4*)(p.ssm_conv_w + k * 4096 + xcol + 4);
#pragma unroll
            for (int j = 0; j < 4; ++j) { wk[k][j] = a[j]; wk[k][4 + j] = c[j]; } }
        { const f32x4 a = *(const f32x4*)(p.ssm_conv_b + xcol), c = *(const f32x4*)(p.ssm_conv_b + xcol + 4);
#pragma unroll
          for (int j = 0; j < 4; ++j) { bs[j] = a[j]; bs[4 + j] = c[j]; } }
        __syncthreads();
#pragma unroll 1
        for (int tile = 0; tile < 8; ++tile) {
            bf16_t* base = proj + (size_t)(b * SEQ + tile * 512 + run * 8) * NPROJ + 2048 + xcol;
            u32x4 raw[11];
#pragma unroll
            for (int r = 0; r < 11; ++r) {
                const int row = run * 8 + r - 3;
                if (row >= 0) raw[r] = *(const u32x4*)(base + (long)(r - 3) * NPROJ);
                else raw[r] = (tile == 0) ? (u32x4){0u, 0u, 0u, 0u} : stash[(row + 3) * 8 + cv];
            }
            u32x4 ov[8];
#pragma unroll
            for (int j = 0; j < 8; ++j) {
                float o[8];
#pragma unroll
                for (int q = 0; q < 4; ++q) {
                    const unsigned x0 = raw[j][q], x1 = raw[j + 1][q], x2 = raw[j + 2][q], x3 = raw[j + 3][q];
                    o[2 * q] = silu_f(bs[2 * q] + wk[0][2 * q] * bflo(x0) + wk[1][2 * q] * bflo(x1) + wk[2][2 * q] * bflo(x2) + wk[3][2 * q] * bflo(x3));
                    o[2 * q + 1] = silu_f(bs[2 * q + 1] + wk[0][2 * q + 1] * bfhi(x0) + wk[1][2 * q + 1] * bfhi(x1) + wk[2][2 * q + 1] * bfhi(x2) + wk[3][2 * q + 1] * bfhi(x3));
                }
                ov[j].x = cvt_pk_bf16(o[0], o[1]); ov[j].y = cvt_pk_bf16(o[2], o[3]); ov[j].z = cvt_pk_bf16(o[4], o[5]); ov[j].w = cvt_pk_bf16(o[6], o[7]);
            }
            asm volatile("s_waitcnt vmcnt(0) lgkmcnt(0)" ::: "memory");
            __syncthreads();
            if (run == 63) { stash[0 * 8 + cv] = raw[8]; stash[1 * 8 + cv] = raw[9]; stash[2 * 8 + cv] = raw[10]; }
#pragma unroll
            for (int j = 0; j < 8; ++j) { const bf16_t* q = base + (long)j * NPROJ;
                asm volatile("global_store_dwordx4 %0, %1, off sc1" :: "v"(q), "v"(ov[j]) : "memory"); }
            asm volatile("s_waitcnt vmcnt(0) lgkmcnt(0)" ::: "memory");
            __syncthreads();
            if (wv == 0) {
                if (lane_id() == 0) __hip_atomic_store(bcflag + sq, (unsigned)(tile + 1), __ATOMIC_RELAXED, __HIP_MEMORY_SCOPE_AGENT);
            }
        }
    }
}

constexpr int SROW = 272;
constexpr int L_CM = 0, L_BM = 34816, L_BDT = 69632, L_XT = 104448, L_HB = 121856  , L_CS = 156672, L_DT = 157184, L_CW = 157696  ;
__device__ __forceinline__ int swz_off(int row, int kblk) { return row * SROW + ((kblk ^ ((row >> 3) & 7)) << 4); }
__device__ __forceinline__ void ssd_load(u32x4 (&raw)[5], const bf16_t* base, bool first, int l0) {
#pragma unroll
    for (int r = 0; r < 5; ++r) raw[r] = (first && (l0 + r - 3) < 0) ? (u32x4){0u, 0u, 0u, 0u} : *(const u32x4*)(base + (long)(r - 3) * NPROJ);
}
template <int GI>
__device__ __forceinline__ void ssd_conv(LAS unsigned char* lds, const u32x4 (&raw)[5], int cv, int l0, float sa, float sb) {
    LAS const f32x4* cw = (LAS const f32x4*)(lds + L_CW) + cv * 10;
    float o0[8], o1[8];
#pragma unroll
    for (int hq = 0; hq < 2; ++hq) {
        const f32x4 w0 = cw[0 + hq], w1 = cw[2 + hq], w2 = cw[4 + hq], w3 = cw[6 + hq], bs = cw[8 + hq];
#pragma unroll
        for (int e2 = 0; e2 < 2; ++e2) {
            const int q = hq * 2 + e2;
            const unsigned x0 = raw[0][q], x1 = raw[1][q], x2 = raw[2][q], x3 = raw[3][q], x4 = raw[4][q];
            const int ea = e2 * 2, eb = e2 * 2 + 1;
            const float va = bs[ea] + w0[ea] * bflo(x0) + w1[ea] * bflo(x1) + w2[ea] * bflo(x2) + w3[ea] * bflo(x3);
            const float vb = bs[eb] + w0[eb] * bfhi(x0) + w1[eb] * bfhi(x1) + w2[eb] * bfhi(x2) + w3[eb] * bfhi(x3);
            const float ua = bs[ea] + w0[ea] * bflo(x1) + w1[ea] * bflo(x2) + w2[ea] * bflo(x3) + w3[ea] * bflo(x4);
            const float ub = bs[eb] + w0[eb] * bfhi(x1) + w1[eb] * bfhi(x2) + w2[eb] * bfhi(x3) + w3[eb] * bfhi(x4);
            o0[2 * q] = silu_f(va); o0[2 * q + 1] = silu_f(vb); o1[2 * q] = silu_f(ua); o1[2 * q + 1] = silu_f(ub);
        }
    }
    if (GI == 0) {
#pragma unroll
        for (int e = 0; e < 8; ++e) { const int prow = cv * 8 + e;
            *(LAS unsigned*)(lds + L_XT + swz_off(prow, l0 >> 3) + (l0 & 7) * 2) = cvt_pk_bf16(o0[e] * sa, o1[e] * sb); }
    } else {
        u32x4 w0; w0.x = cvt_pk_bf16(o0[0], o0[1]); w0.y = cvt_pk_bf16(o0[2], o0[3]); w0.z = cvt_pk_bf16(o0[4], o0[5]); w0.w = cvt_pk_bf16(o0[6], o0[7]);
        u32x4 w1; w1.x = cvt_pk_bf16(o1[0], o1[1]); w1.y = cvt_pk_bf16(o1[2], o1[3]); w1.z = cvt_pk_bf16(o1[4], o1[5]); w1.w = cvt_pk_bf16(o1[6], o1[7]);
        const int nb = ((GI - 1) & 1) * 64 + cv * 8;
        if (GI < 3) {
            *(LAS u32x4*)(lds + L_BM + l0 * SROW + nb * 2) = w0; *(LAS u32x4*)(lds + L_BM + (l0 + 1) * SROW + nb * 2) = w1;
#pragma unroll
            for (int e = 0; e < 8; ++e) { const int nrow = nb + e;
                *(LAS unsigned*)(lds + L_BDT + swz_off(nrow, l0 >> 3) + (l0 & 7) * 2) = cvt_pk_bf16(o0[e] * sa, o1[e] * sb); }
        } else {
            *(LAS u32x4*)(lds + L_CM + l0 * SROW + nb * 2) = w0; *(LAS u32x4*)(lds + L_CM + (l0 + 1) * SROW + nb * 2) = w1;
        }
    }
}
template <int GI>
__device__ __forceinline__ void ssd_put(LAS unsigned char* lds, const u32x4 (&rw)[2], int cv, int l0, float sa, float sb) {
    const int nb = ((GI - 1) & 1) * 64 + cv * 8;
    if (GI < 3) {
        *(LAS u32x4*)(lds + L_BM + l0 * SROW + nb * 2) = rw[0]; *(LAS u32x4*)(lds + L_BM + (l0 + 1) * SROW + nb * 2) = rw[1];
#pragma unroll
        for (int q = 0; q < 4; ++q) {
            *(LAS unsigned*)(lds + L_BDT + swz_off(nb + 2 * q, l0 >> 3) + (l0 & 7) * 2) = cvt_pk_bf16(bflo(rw[0][q]) * sa, bflo(rw[1][q]) * sb);
            *(LAS unsigned*)(lds + L_BDT + swz_off(nb + 2 * q + 1, l0 >> 3) + (l0 & 7) * 2) = cvt_pk_bf16(bfhi(rw[0][q]) * sa, bfhi(rw[1][q]) * sb);
        }
    } else {
        *(LAS u32x4*)(lds + L_CM + l0 * SROW + nb * 2) = rw[0]; *(LAS u32x4*)(lds + L_CM + (l0 + 1) * SROW + nb * 2) = rw[1];
    }
}
__device__ __forceinline__ void bc_wait(unsigned* f, unsigned need, int wv) {
    if (wv == 0) {
    unsigned sp = 0;
    for (;;) {
        const unsigned a = __hip_atomic_load(f, __ATOMIC_RELAXED, __HIP_MEMORY_SCOPE_AGENT), b2 = __hip_atomic_load(f + 1, __ATOMIC_RELAXED, __HIP_MEMORY_SCOPE_AGENT);
        const unsigned c = __hip_atomic_load(f + 16, __ATOMIC_RELAXED, __HIP_MEMORY_SCOPE_AGENT), d = __hip_atomic_load(f + 17, __ATOMIC_RELAXED, __HIP_MEMORY_SCOPE_AGENT);
        const unsigned m = min(min(a, b2), min(c, d));
        if (__builtin_amdgcn_readfirstlane(m) >= need) break;
        __builtin_amdgcn_s_sleep(4);
        if (++sp > (1u << 19)) break;
    }
    __builtin_amdgcn_fence(__ATOMIC_ACQUIRE, "agent"); asm volatile("s_waitcnt vmcnt(0)" ::: "memory");
    }
    asm volatile("s_waitcnt lgkmcnt(0)" ::: "memory"); __builtin_amdgcn_s_barrier(); asm volatile("" ::: "memory");
}
__device__ void ssd_unit(const Params& p, LAS unsigned char* lds, int b, int h, int wv) {
    const int lane = lane_id(), w = wv, tid = wv * 64 + lane, fr = lane & 15, fq = lane >> 4;
    const int g = h >> 2;
    const bf16_t* proj = (const bf16_t*)(p.ws + WS_PROJ);
    const float* dtg = (const float*)((const unsigned char*)p.out + DO_DT);
    bf16_t* ymix = (bf16_t*)(p.ws + WS_YMIX);
    float* ssq1 = (float*)((unsigned char*)p.out + DO_SSQ1);
    LAS float* CSv = (LAS float*)(lds + L_CS);
    LAS float* DTv = (LAS float*)(lds + L_DT);
    LAS float* CW = (LAS float*)(lds + L_CW);
    const float Aneg = -__expf(p.ssm_A_log[h]);
    const float Dh = p.ssm_D[h];
    for (int idx = tid; idx < 320; idx += 512) {
        const int e = idx & 7, k = (idx >> 3) % 5, cvi = idx / 40;
        const int xcol = h * 64 + cvi * 8 + e;
        CW[idx] = (k < 4) ? p.ssm_conv_w[k * 4096 + xcol] : p.ssm_conv_b[xcol];
    }
    for (int idx = tid; idx < 64 * 17; idx += 512) *(LAS u32x4*)(lds + L_HB + idx * 16) = (u32x4){0u, 0u, 0u, 0u};
    f32x4 Hacc[4];
#pragma unroll
    for (int pt = 0; pt < 4; ++pt) Hacc[pt] = (f32x4){0.f, 0.f, 0.f, 0.f};
    __syncthreads();
    const int cv = lane & 7;
    const int l0 = 16 * w + 2 * (lane >> 3);
    const int srcl = (w & 3) * 16 + 2 * (lane >> 3);
    u32x4 r0[5], r1[2], r2[2], r3[2], r4[2];
    const bf16_t* pbase = proj + (size_t)(b * SEQ + l0) * NPROJ + 2048 + cv * 8;
    const int xc0 = h * 64, xc1 = 2048 + g * 128, xc2 = xc1 + 64, xc3 = 3072 + g * 128, xc4 = xc3 + 64;
    unsigned* bcf = (unsigned*)((unsigned char*)p.out + DO_BCFLAG) + b * 32 + 2 * g;
    bc_wait(bcf, 1u, wv);
    ssd_load(r0, pbase + xc0, true, l0);
    r1[0] = *(const u32x4*)(pbase + xc1); r1[1] = *(const u32x4*)(pbase + xc1 + NPROJ); r2[0] = *(const u32x4*)(pbase + xc2); r2[1] = *(const u32x4*)(pbase + xc2 + NPROJ);
    r3[0] = *(const u32x4*)(pbase + xc3); r3[1] = *(const u32x4*)(pbase + xc3 + NPROJ); r4[0] = *(const u32x4*)(pbase + xc4); r4[1] = *(const u32x4*)(pbase + xc4 + NPROJ);
    float dt0n = dtg[(size_t)(b * SEQ + lane) * 32 + h], dt1n = dtg[(size_t)(b * SEQ + 64 + lane) * 32 + h];
    for (int c = 0; c < 32; ++c) {
        const int row0 = b * SEQ + c * 128;
        if (c + 1 < 32 && ((c + 1) & 3) == 0) bc_wait(bcf, (unsigned)(((c + 1) >> 2) + 1), wv);
        const float dt0 = dt0n, dt1 = dt1n;
        if (c + 1 < 32) { dt0n = dtg[(size_t)(row0 + 128 + lane) * 32 + h]; dt1n = dtg[(size_t)(row0 + 192 + lane) * 32 + h]; }
        u32x2 zr[4];
#pragma unroll
        for (int pt = 0; pt < 4; ++pt) zr[pt] = *(const u32x2*)(proj + (size_t)(row0 + 16 * w + fr) * NPROJ + h * 64 + 16 * pt + 4 * fq);
        __builtin_amdgcn_sched_barrier(0);
        float a0 = dt0 * Aneg, a1 = dt1 * Aneg;
#pragma unroll
        for (int o = 1; o < 64; o <<= 1) { const float t0 = __shfl_up(a0, o), t1 = __shfl_up(a1, o); if (lane >= o) { a0 += t0; a1 += t1; } }
        a1 += __shfl(a0, 63);
        const float cs_end = __shfl(a1, 63);
        if (w == 0) { CSv[lane] = a0; CSv[64 + lane] = a1; DTv[lane] = dt0; DTv[64 + lane] = dt1; }
        const float csv = (w >= 4) ? a1 : a0, dtv = (w >= 4) ? dt1 : dt0;
        const float cs_l0 = __shfl(csv, srcl), cs_l1 = __shfl(csv, srcl + 1), dt_l0 = __shfl(dtv, srcl), dt_l1 = __shfl(dtv, srcl + 1);
        const float dec0 = __expf(cs_end - cs_l0), dec1 = __expf(cs_end - cs_l1);
        ssd_conv<0>(lds, r0, cv, l0, dt_l0, dt_l1);
        __builtin_amdgcn_sched_barrier(0);
        if (c + 1 < 32) ssd_load(r0, pbase + (size_t)(c + 1) * 128 * NPROJ + xc0, false, l0);
        __builtin_amdgcn_sched_barrier(0);
        ssd_put<1>(lds, r1, cv, l0, dec0, dec1); ssd_put<2>(lds, r2, cv, l0, dec0, dec1);
        ssd_put<3>(lds, r3, cv, l0, 0.f, 0.f);   ssd_put<4>(lds, r4, cv, l0, 0.f, 0.f);
        __builtin_amdgcn_sched_barrier(0);
        if (c + 1 < 32) {
            const bf16_t* cb = pbase + (size_t)(c + 1) * 128 * NPROJ;
            r1[0] = *(const u32x4*)(cb + xc1); r1[1] = *(const u32x4*)(cb + xc1 + NPROJ); r2[0] = *(const u32x4*)(cb + xc2); r2[1] = *(const u32x4*)(cb + xc2 + NPROJ);
            r3[0] = *(const u32x4*)(cb + xc3); r3[1] = *(const u32x4*)(cb + xc3 + NPROJ); r4[0] = *(const u32x4*)(cb + xc4); r4[1] = *(const u32x4*)(cb + xc4 + NPROJ);
        }
        __builtin_amdgcn_sched_barrier(0);
        asm volatile("s_waitcnt lgkmcnt(0)" ::: "memory"); __builtin_amdgcn_s_barrier(); asm volatile("" ::: "memory");
        const int lrow = 16 * w + fr;
        const int hb_cur = L_HB + (c & 1) * 17408, hb_nxt = L_HB + ((c + 1) & 1) * 17408;
        bf16x8 cf[4];
#pragma unroll
        for (int ks = 0; ks < 4; ++ks) cf[ks] = *(LAS const bf16x8*)(lds + L_CM + lrow * SROW + (32 * ks + 8 * fq) * 2);
        const float cs_l = CSv[lrow], dt_l = DTv[lrow];
        asm volatile("" ::: "memory");
        const int dd = fr - 4 * fq; const float ddiag = Dh / dt_l;
        f32x4 y[4];
        { const float el = __expf(cs_l);
#pragma unroll
          for (int pt = 0; pt < 4; ++pt) { f32x4 a = (f32x4){0.f, 0.f, 0.f, 0.f};
#pragma unroll
            for (int ks = 0; ks < 4; ++ks) { const bf16x8 hf = *(LAS const bf16x8*)(lds + hb_cur + (16 * pt + fr) * SROW + (32 * ks + 8 * fq) * 2);
                a = __builtin_amdgcn_mfma_f32_16x16x32_bf16(hf, cf[ks], a, 0, 0, 0); }
            y[pt] = a * el; } }
#pragma unroll
        for (int j = 0; j < 8; ++j) {
            if (j <= w) {
                f32x4 gacc = (f32x4){0.f, 0.f, 0.f, 0.f};
#pragma unroll
                for (int ks = 0; ks < 4; ++ks) { const bf16x8 bf = *(LAS const bf16x8*)(lds + L_BM + (16 * j + fr) * SROW + (32 * ks + 8 * fq) * 2);
                    gacc = __builtin_amdgcn_mfma_f32_16x16x32_bf16(bf, cf[ks], gacc, 0, 0, 0); }
                const f32x4 css = *(LAS const f32x4*)(CSv + 16 * j + 4 * fq);
                float mv[4];
#pragma unroll
                for (int i = 0; i < 4; ++i) { float v = gacc[i] * __expf(cs_l - css[i]);
                    if (j == w) { v = (i <= dd) ? v : 0.f; if (i == dd) v += ddiag; }
                    mv[i] = v; }
                u32x2 wv2; wv2.x = cvt_pk_bf16(mv[0], mv[1]); wv2.y = cvt_pk_bf16(mv[2], mv[3]);
                *(LAS u32x2*)(lds + L_CM + lrow * SROW + (16 * j + 4 * fq) * 2) = wv2;
            } else if (j == w + 1 && (w & 1) == 0) {
                *(LAS u32x2*)(lds + L_CM + lrow * SROW + (16 * j + 4 * fq) * 2) = (u32x2){0u, 0u};
            }
        }
        asm volatile("" ::: "memory");
        { const float de = __expf(cs_end);
#pragma unroll
          for (int pt = 0; pt < 4; ++pt) Hacc[pt] *= de; }
        const int nks2 = (w >> 1) + 1;
#pragma unroll
        for (int ks = 0; ks < 4; ++ks) {
            bf16x8 xf[4];
#pragma unroll
            for (int pt = 0; pt < 4; ++pt) xf[pt] = *(LAS const bf16x8*)(lds + L_XT + swz_off(16 * pt + fr, 4 * ks + fq));
            if (ks < nks2) { const bf16x8 mf = *(LAS const bf16x8*)(lds + L_CM + lrow * SROW + (32 * ks + 8 * fq) * 2);
#pragma unroll
                for (int pt = 0; pt < 4; ++pt) y[pt] = __builtin_amdgcn_mfma_f32_16x16x32_bf16(xf[pt], mf, y[pt], 0, 0, 0); }
            const bf16x8 bdf = *(LAS const bf16x8*)(lds + L_BDT + swz_off(16 * w + fr, 4 * ks + fq));
#pragma unroll
            for (int pt = 0; pt < 4; ++pt) Hacc[pt] = __builtin_amdgcn_mfma_f32_16x16x32_bf16(bdf, xf[pt], Hacc[pt], 0, 0, 0);
        }
#pragma unroll
        for (int pt = 0; pt < 4; ++pt) { u32x2 wv2; wv2.x = cvt_pk_bf16(Hacc[pt][0], Hacc[pt][1]); wv2.y = cvt_pk_bf16(Hacc[pt][2], Hacc[pt][3]);
            *(LAS u32x2*)(lds + hb_nxt + (16 * pt + fr) * SROW + (16 * w + 4 * fq) * 2) = wv2; }
        { float ss = 0.f; const size_t orow = (size_t)(row0 + lrow);
#pragma unroll
          for (int pt = 0; pt < 4; ++pt) {
            const float z0 = bflo(zr[pt].x), z1 = bfhi(zr[pt].x), z2 = bflo(zr[pt].y), z3 = bfhi(zr[pt].y);
            const float v0 = y[pt][0] * silu_f(z0), v1 = y[pt][1] * silu_f(z1), v2 = y[pt][2] * silu_f(z2), v3 = y[pt][3] * silu_f(z3);
            ss += (v0 * v0 + v1 * v1) + (v2 * v2 + v3 * v3);
            u32x2 wv; wv.x = cvt_pk_bf16(v0, v1); wv.y = cvt_pk_bf16(v2, v3);
            *(u32x2*)(ymix + orow * DMIX + h * 64 + 16 * pt + 4 * fq) = wv; }
          ss += __shfl_xor(ss, 16); ss += __shfl_xor(ss, 32);
          if (fq == 0) ssq1[ssq_idx((int)orow, h)] = ss; }
        asm volatile("s_waitcnt lgkmcnt(0)" ::: "memory"); __builtin_amdgcn_s_barrier(); asm volatile("" ::: "memory");
    }
}
__device__ void sc_unit(const Params& p, int unit, int wv) {
    const int tid = wv * 64 + lane_id(), cvx = tid & 255, th = tid >> 8;
    const bf16_t* proj = (const bf16_t*)(p.ws + WS_PROJ);
    bf16_t* ymix = (bf16_t*)(p.ws + WS_YMIX);
    const int t0 = unit * 64 + th * 32, c0 = cvx * 8;
    float w0[8], w1[8], w2[8];
    { const f32x4* a = (const f32x4*)(p.sc_conv_w + c0); const f32x4* bq = (const f32x4*)(p.sc_conv_w + 2048 + c0); const f32x4* cq = (const f32x4*)(p.sc_conv_w + 4096 + c0);
#pragma unroll
      for (int q = 0; q < 2; ++q) { const f32x4 x0 = a[q], x1 = bq[q], x2 = cq[q];
#pragma unroll
        for (int j = 0; j < 4; ++j) { w0[q * 4 + j] = x0[j]; w1[q * 4 + j] = x1[j]; w2[q * 4 + j] = x2[j]; } } }
    float pm1[8], pm2[8];
#pragma unroll
    for (int e = 0; e < 8; ++e) { pm1[e] = 0.f; pm2[e] = 0.f; }
    if ((t0 & (SEQ - 1)) != 0) {
        const bf16_t* r2 = proj + (size_t)(t0 - 2) * NPROJ, * r1 = proj + (size_t)(t0 - 1) * NPROJ;
        const u32x4 c2 = *(const u32x4*)(r2 + 8192 + c0), c1 = *(const u32x4*)(r1 + 8192 + c0);
#pragma unroll
        for (int q = 0; q < 4; ++q) { pm2[2 * q] = bflo(c2[q]); pm2[2 * q + 1] = bfhi(c2[q]); pm1[2 * q] = bflo(c1[q]); pm1[2 * q + 1] = bfhi(c1[q]); }
    }
#pragma unroll 4
    for (int i = 0; i < 32; ++i) {
        const bf16_t* r = proj + (size_t)(t0 + i) * NPROJ;
        const u32x4 gb = *(const u32x4*)(r + 6144 + c0), gp = *(const u32x4*)(r + 8192 + c0);
        float o[8];
#pragma unroll
        for (int q = 0; q < 4; ++q) {
            const float pa = bflo(gp[q]), pb = bfhi(gp[q]);
            o[2 * q] = bflo(gb[q]) * (w0[2 * q] * pm2[2 * q] + w1[2 * q] * pm1[2 * q] + w2[2 * q] * pa);
            o[2 * q + 1] = bfhi(gb[q]) * (w0[2 * q + 1] * pm2[2 * q + 1] + w1[2 * q + 1] * pm1[2 * q + 1] + w2[2 * q + 1] * pb);
            pm2[2 * q] = pm1[2 * q]; pm2[2 * q + 1] = pm1[2 * q + 1]; pm1[2 * q] = pa; pm1[2 * q + 1] = pb;
        }
        u32x4 wv; wv.x = cvt_pk_bf16(o[0], o[1]); wv.y = cvt_pk_bf16(o[2], o[3]); wv.z = cvt_pk_bf16(o[4], o[5]); wv.w = cvt_pk_bf16(o[6], o[7]);
        *(u32x4*)(ymix + (size_t)(t0 + i) * DMIX + 2048 + c0) = wv;
    }
}
__device__ void phase2(const Params& p, LAS unsigned char* lds, int wv) {
    const int G = gridDim.x, bid = blockIdx.x;
    const bool split = G >= 256;
    if (!split) bc_sequences(p, lds, bid, G, wv);
    if (!split || bid < 128) { for (int u = bid; u < 128; u += (split ? 128 : G)) ssd_unit(p, lds, u >> 5, u & 31, wv); }
    if (split && bid >= 128) bc_sequences(p, lds, bid - 128, G - 128, wv);
    if (!split || bid >= 128) { for (int u = (split ? bid - 128 : bid); u < M_ / 64; u += (split ? G - 128 : G)) sc_unit(p, u, wv); }
    if (!split || bid >= 128) wconv_units(p, lds, split ? bid - 128 : bid, split ? G - 128 : G, wv);
}

__device__ void phase6(const Params& p, int wv) {
    const int lane = lane_id(), wave = wv;
    const bf16_t* h2 = (const bf16_t*)(p.ws + WS_H1B);
    const float* ssq3 = (const float*)(p.ws + WS_SSQ3);
    const int stride = gridDim.x * 8;
    int row = blockIdx.x * 8 + wave;
    if (row >= M_) return;
    u32x2 hv[8]; float sp = (lane < 32) ? ssq3[ssq_idx(row, lane)] : 0.f;
#pragma unroll
    for (int i = 0; i < 8; ++i) hv[i] = ((const u32x2*)(h2 + (size_t)row * D_))[lane + 64 * i];
    for (;;) {
        const int rown = row + stride; const bool more = rown < M_;
        u32x2 hvn[8]; float spn = 0.f;
#pragma unroll
        for (int i = 0; i < 8; ++i) hvn[i] = hv[i];
        if (more) { spn = (lane < 32) ? ssq3[ssq_idx(rown, lane)] : 0.f;
#pragma unroll
            for (int i = 0; i < 8; ++i) hvn[i] = ((const u32x2*)(h2 + (size_t)rown * D_))[lane + 64 * i]; }
        float s = sp;
#pragma unroll
        for (int o = 32; o >= 1; o >>= 1) s += __shfl_xor(s, o);
        const float rstd = rsqrtf(s * (1.0f / 2048.0f) + EPS);
        f32x4* orow = (f32x4*)(p.out + (size_t)row * D_);
#pragma unroll
        for (int i = 0; i < 8; ++i) { const f32x4 v = (f32x4){bflo(hv[i].x), bfhi(hv[i].x), bflo(hv[i].y), bfhi(hv[i].y)}, g4 = ((const f32x4*)p.norm_final_g)[lane + 64 * i]; orow[lane + 64 * i] = v * rstd * g4; }
        if (!more) break;
        row = rown; sp = spn;
#pragma unroll
        for (int i = 0; i < 8; ++i) hv[i] = hvn[i];
    }
}


#define XB_TMO      128
#define XB_XCNT(j)  (256  + 64 * (j))
#define XB_XSUB(j)  (1280 + 64 * (j))
#define XB_XGEN(j)  (2304 + 64 * (j))
#define XB_TOP      3328
#define XB_TOPGEN   3392
#define XCD_BAR_WORDS 3456
#define XB_SPIN_CAP (1u << 18)
__device__ __forceinline__ unsigned xb_ld(unsigned* p)              { return __hip_atomic_load(p, __ATOMIC_RELAXED, __HIP_MEMORY_SCOPE_AGENT); }
__device__ __forceinline__ unsigned xb_add(unsigned* p, unsigned v) { return __hip_atomic_fetch_add(p, v, __ATOMIC_RELAXED, __HIP_MEMORY_SCOPE_AGENT); }
__device__ __forceinline__ unsigned xb_xcc_id() { return (unsigned)__builtin_amdgcn_s_getreg((3 << 11) | 20) & 0xFu; }
#define XB_SPIN(cond, bar) do { unsigned _sp = 0; while (cond) { __builtin_amdgcn_s_sleep(1); \
    if ((++_sp & 255u) == 0u) { if (xb_ld(&(bar)[XB_TMO])) break; if (_sp > XB_SPIN_CAP) { atomicAdd(&(bar)[XB_TMO], 1u); break; } } } } while (0)
struct XcdBarrier { unsigned* bar; unsigned x; volatile LAS unsigned* st; };
__device__ __forceinline__ void xcd_barrier_complete(unsigned* bar, unsigned x, unsigned& nloc, unsigned& nx) {
    const unsigned G = gridDim.x * gridDim.y * gridDim.z;
    unsigned sum, cnt, mine, sp = 0u;
    for (;;) {
        sum = 0u; cnt = 0u; mine = 0u;
#pragma unroll
        for (unsigned j = 0; j < 16; ++j) { const unsigned c = xb_ld(&bar[XB_XCNT(j)]); sum += c; cnt += (c > 0u) ? 1u : 0u; mine = (j == x) ? c : mine; }
        if (sum == G) break;
        __builtin_amdgcn_s_sleep(1);
        if ((++sp & 255u) == 0u) { if (xb_ld(&bar[XB_TMO])) break; if (sp > XB_SPIN_CAP) { atomicAdd(&bar[XB_TMO], 1u); break; } }
    }
    nloc = mine > 0u ? mine : 1u; nx = cnt > 0u ? cnt : 1u;
}
__device__ __forceinline__ void xcd_barrier(const XcdBarrier& b, bool leader) {
    asm volatile("s_waitcnt vmcnt(0)" ::: "memory");
    __syncthreads();
    if (leader) {
        unsigned* bar = b.bar;
        __builtin_amdgcn_s_waitcnt(0);
        unsigned nloc = b.st[0], nx = b.st[1];
        if (nloc == 0u) { xcd_barrier_complete(bar, b.x, nloc, nx); b.st[0] = nloc; b.st[1] = nx; }
        const unsigned old = xb_add(&bar[XB_XSUB(b.x)], 1u);
        const unsigned gen = old / nloc;
        if (old + 1u == (gen + 1u) * nloc) {
            __builtin_amdgcn_fence(__ATOMIC_RELEASE, "agent");
            asm volatile("s_waitcnt vmcnt(0)" ::: "memory");
            const unsigned og = xb_add(&bar[XB_TOP], 1u);
            const unsigned tg = og / nx;
            if (og + 1u == (tg + 1u) * nx) xb_add(&bar[XB_TOPGEN], 1u);
            else XB_SPIN(xb_ld(&bar[XB_TOPGEN]) == tg, bar);
            __builtin_amdgcn_fence(__ATOMIC_ACQUIRE, "agent");
            xb_add(&bar[XB_XGEN(b.x)], 1u);
            asm volatile("s_waitcnt vmcnt(0)" ::: "memory");
        } else {
            XB_SPIN(xb_ld(&bar[XB_XGEN(b.x)]) == gen, bar);
            __builtin_amdgcn_fence(__ATOMIC_ACQUIRE, "agent");
            asm volatile("s_waitcnt vmcnt(0)" ::: "memory");
        }
    }
    __syncthreads();
}

__global__ void __launch_bounds__(512) hymba_fwd(Params p) {
    extern __shared__ __attribute__((aligned(16))) unsigned char shm[];
    LAS unsigned char* lds = (LAS unsigned char*)shm;
    cg::grid_group grid = cg::this_grid();
    const int lo = p.ph_lo, hi = p.ph_hi;
    const int wv = __builtin_amdgcn_readfirstlane(threadIdx.x >> 6);
#ifdef DBG_CLEAR
    for (int i = threadIdx.x; i < LDS_BYTES / 16; i += 512) *(LAS u32x4*)(lds + i * 16) = (u32x4){0u, 0u, 0u, 0u};
    __syncthreads();
#endif
#define IN(k) (lo <= (k) && (k) < hi)
#define SEAM(k) do { if (IN(k) && IN((k) + 1)) { \
        asm volatile("s_waitcnt vmcnt(0) lgkmcnt(0)" ::: "memory"); __syncthreads();                 \
        if (wv == 0) { __builtin_amdgcn_fence(__ATOMIC_RELEASE, "agent"); asm volatile("s_waitcnt vmcnt(0)" ::: "memory"); }     \
        grid.sync(); \
        if (wv == 0) { __builtin_amdgcn_fence(__ATOMIC_ACQUIRE, "agent"); asm volatile("s_waitcnt vmcnt(0)" ::: "memory"); }     \
        __syncthreads(); } } while (0)
    volatile LAS unsigned* xst = (volatile LAS unsigned*)(lds + LDS_BYTES - 16);
    const bool xlead = (wv == 0) && (lane_id() == 0);
    if (xlead) { xst[0] = 0u; xst[1] = 0u; }
    __syncthreads();
    XcdBarrier xb; xb.bar = (unsigned*)((unsigned char*)p.out + DO_XBAR); xb.x = xb_xcc_id(); xb.st = xst;
    if (xlead) (void)xb_add(&xb.bar[XB_XCNT(xb.x)], 1u);
#define XSEAM(k) do { if (IN(k) && IN((k) + 1)) xcd_barrier(xb, (wv == 0) && (lane_id() == 0)); } while (0)
    if (IN(0)) for (int rep = 0; rep < NREP(0); ++rep) phase0(p, lds, wv);
    XSEAM(0);
    if (IN(1)) for (int rep = 0; rep < NREP(1); ++rep) {
        pg8::Gemm g{(const bf16_t*)(p.ws + WS_XN), (const bf16_t*)(p.ws + WS_BTIN), M_, NPROJ, D_}; pg8::StaticOrder S; S.init(M_, NPROJ, gridDim.x, blockIdx.x);
        if (gridDim.x == 256) { S.nrounds = 12; S.rot = 3 * ((blockIdx.x >> 6) & 3); }
        EpiProj E{(bf16_t*)(p.ws + WS_PROJ)};
        pg8::gemm_phase<EpiProj>(lds, g, S, E, wv);
        dt_units(p, lds, wv);
    }
    XSEAM(1);
    if (IN(3)) for (int rep = 0; rep < NREP(3); ++rep) phase2(p, lds, wv);
    XSEAM(3);
    if (IN(4)) for (int rep = 0; rep < NREP(4); ++rep) {
        pg8::Gemm g{(const bf16_t*)(p.ws + WS_YMIX), (const bf16_t*)((unsigned char*)p.out + DO_BTOUT), M_, D_, DMIX}; pg8::StaticOrder S; S.init(M_, D_, gridDim.x, blockIdx.x);
        EpiOut E{p.x, (bf16_t*)(p.ws + WS_H1B), (const float*)((unsigned char*)p.out + DO_SSQ1), (float*)((unsigned char*)p.out + DO_SSQ2)};
        pg8::gemm_phase<EpiOut>(lds, g, S, E, wv);
    }
    XSEAM(4);
    if (IN(5)) for (int rep = 0; rep < NREP(5); ++rep) {
        pg8::Gemm g{(const bf16_t*)(p.ws + WS_H1B), (const bf16_t*)((unsigned char*)p.out + DO_BTGU), M_, NGU, D_}; pg8::StaticOrder S; S.init(M_, NGU, gridDim.x, blockIdx.x);
        EpiGU E{(const float*)((unsigned char*)p.out + DO_SSQ2), (bf16_t*)(p.ws + WS_HFF)};
        pg8::gemm_phase<EpiGU>(lds, g, S, E, wv);
    }
    XSEAM(5);
    if (IN(6)) {
        pg8::Gemm g{(const bf16_t*)(p.ws + WS_HFF), (const bf16_t*)((unsigned char*)p.out + DO_BTDN), M_, D_, DFF}; pg8::StaticOrder S; S.init(M_, D_, gridDim.x, blockIdx.x);
        EpiDown E{(bf16_t*)(p.ws + WS_H1B), (float*)(p.ws + WS_SSQ3)};
        pg8::gemm_phase<EpiDown>(lds, g, S, E, wv);
    }
    XSEAM(6);
    if (p.ph_hi > 1000) grid.sync();
    if (IN(7)) for (int rep = 0; rep < NREP(7); ++rep) phase6(p, wv);
#undef IN
#undef SEAM
}

extern "C" void kernel_launch(void* const* d_in, const int* in_sizes, int n_in, void* d_out, int out_size, void* d_ws, size_t ws_size, hipStream_t stream) {
    static int grid = 0;
    if (grid == 0) {
        if (n_in != 16 || out_size != M_ * D_ || ws_size < WS_NEED) { fprintf(stderr, "kernel_launch: unexpected shapes (n_in %d out %d ws %zu, need %zu)\n", n_in, out_size, ws_size, (size_t)WS_NEED); grid = -1; return; }
        int dev = 0, cus = 0, per_cu = 0;
        (void)hipGetDevice(&dev);
        (void)hipDeviceGetAttribute(&cus, hipDeviceAttributeMultiprocessorCount, dev);
        if (hipFuncSetAttribute((const void*)hymba_fwd, hipFuncAttributeMaxDynamicSharedMemorySize, LDS_BYTES) != hipSuccess) { fprintf(stderr, "kernel_launch: hipFuncSetAttribute failed\n"); grid = -1; return; }
        if (hipOccupancyMaxActiveBlocksPerMultiprocessor(&per_cu, (const void*)hymba_fwd, 512, LDS_BYTES) != hipSuccess || per_cu < 1) { fprintf(stderr, "kernel_launch: occupancy query failed (%d)\n", per_cu); (void)hipGetLastError(); per_cu = 1; }
        grid = cus * per_cu;
    }
    if (grid < 0) return;
    Params p{};
    p.x = (const float*)d_in[0]; p.norm_mix_g = (const float*)d_in[1]; p.w_in = (const float*)d_in[2]; p.ssm_conv_w = (const float*)d_in[3]; p.ssm_conv_b = (const float*)d_in[4];
    p.ssm_dt_bias = (const float*)d_in[5]; p.ssm_A_log = (const float*)d_in[6]; p.ssm_D = (const float*)d_in[7]; p.ssm_norm_g = (const float*)d_in[8]; p.sc_conv_w = (const float*)d_in[9];
    p.w_out = (const float*)d_in[10]; p.norm_ffn_g = (const float*)d_in[11]; p.w_gate = (const float*)d_in[12]; p.w_up = (const float*)d_in[13]; p.w_down = (const float*)d_in[14]; p.norm_final_g = (const float*)d_in[15];
    p.out = (float*)d_out; p.ws = (unsigned char*)d_ws;
#ifdef DBG_MEMSET
    (void)hipMemsetAsync(d_ws, 0, WS_NEED, stream); (void)hipMemsetAsync(d_out, 0, (size_t)out_size * 4, stream);
#endif
#ifndef N_CUTS
#define N_CUTS 1
#endif
    for (int li = 0; li < N_CUTS; ++li) {
        p.ph_lo = (N_CUTS == 8) ? li : 0; p.ph_hi = (N_CUTS == 8) ? li + 1 : 8;
        (void)hipMemsetAsync((unsigned char*)d_out + DO_BCFLAG, 0, 4096 + XCD_BAR_WORDS * sizeof(unsigned), stream);
    void* args[] = {&p};
        hipError_t e = hipLaunchCooperativeKernel((const void*)hymba_fwd, dim3(grid), dim3(512), args, LDS_BYTES, stream);
        if (e != hipSuccess) fprintf(stderr, "kernel_launch: cooperative launch failed: %s (grid %d)\n", hipGetErrorString(e), grid);
    }
}
```
